# Optimizing an MI355X kernel written in HIP

```python
import math
import jax, jax.numpy as jnp
from jax import lax
import numpy as np

D_MODEL = 1024
BATCH = 8
SEQ = 2048
DEPTH = 1
DEC_BATCH = 128
DEC_SEQ = 4
PAST_LEN = 16384
PAGE_SIZE = 128

M_HEADS = 4
M_DK = 128
M_DV = 256
G_HEADS = 4
G_DK = 128
G_DV = 256
G_RANK = 16
G_TAU = 16.0
CHUNK = 64
N_MEM = 256
C_HEADS = 4
C_HD = D_MODEL // C_HEADS
D_FF = 2816
EPS = 1e-6

M_QK = M_HEADS * M_DK
M_V = M_HEADS * M_DV
G_QK = G_HEADS * G_DK
G_V = G_HEADS * G_DV
IN_SPLITS = (M_QK, M_QK, M_V, M_V, M_HEADS, M_HEADS, G_QK, G_QK, G_V, G_V, G_RANK, D_MODEL, D_MODEL)
IN_WIDTH = 2 * M_QK + 2 * M_V + 2 * M_HEADS + 2 * G_QK + 2 * G_V + G_RANK + 2 * D_MODEL

kernel_name = 'hybrid_mlstm_gla_macaron_memxattn_step'


def rmsnorm(x, g):
    xf = x.astype(jnp.float32)
    xf = xf * lax.rsqrt(jnp.mean(xf * xf, axis=-1, keepdims=True) + EPS)
    return (xf * g.astype(jnp.float32)).astype(x.dtype)


def head_rmsnorm(h):
    return h * lax.rsqrt(jnp.mean(h * h, axis=-1, keepdims=True) + EPS)


def swiglu(x, wg, wu, wd):
    return (jax.nn.silu(x @ wg) * (x @ wu)) @ wd


def chunk_len(T):
    return CHUNK if T % CHUNK == 0 else T


def to_chunks(a, L):
    B, T = a.shape[:2]
    return jnp.swapaxes(a.reshape((B, T // L, L) + a.shape[2:]), 0, 1)


def from_chunks(a):
    N, B, L = a.shape[:3]
    return jnp.swapaxes(a, 0, 1).reshape((B, N * L) + a.shape[3:])


def mlstm_chunk(carry, inp):
    C0, n0, m0 = carry
    q, k, v, ig, lf = inp
    L = q.shape[1]
    tri = jnp.tril(jnp.ones((L, L), dtype=bool))
    F = jnp.swapaxes(jnp.cumsum(lf, axis=1), 1, 2)
    igh = jnp.swapaxes(ig, 1, 2)
    D = F[..., :, None] - F[..., None, :] + igh[..., None, :]
    D = jnp.where(tri, D, -jnp.inf)
    m_inter = m0[..., None] + F
    m = jnp.maximum(m_inter, jnp.max(D, axis=-1))
    W = jnp.exp(D - m[..., None])
    a = jnp.exp(m_inter - m)
    S = jnp.einsum('bthd,bshd->bhts', q, k) * W
    num = a[..., None] * jnp.einsum('bhvd,bthd->bhtv', C0, q) + jnp.einsum('bhts,bshv->bhtv', S, v)
    den = a * jnp.einsum('bhd,bthd->bht', n0, q) + jnp.sum(S, axis=-1)
    h = num / jnp.maximum(jnp.abs(den), jnp.exp(-m))[..., None]
    w_end = W[:, :, -1, :]
    a_end = a[:, :, -1]
    C1 = a_end[..., None, None] * C0 + jnp.einsum('bhs,bshv,bshd->bhvd', w_end, v, k)
    n1 = a_end[..., None] * n0 + jnp.einsum('bhs,bshd->bhd', w_end, k)
    return (C1, n1, m[:, :, -1]), jnp.swapaxes(h, 1, 2)


def gla_chunk(S0, inp):
    q, k, v, la = inp
    L = q.shape[1]
    tri = jnp.tril(jnp.ones((L, L), dtype=bool))
    b = jnp.cumsum(la, axis=1)
    inter = jnp.einsum('bthd,bhdv->bthv', q * jnp.exp(b), S0)
    diff = b[:, :, None] - b[:, None, :]
    decay = jnp.exp(jnp.where(tri[None, :, :, None, None], diff, -jnp.inf))
    A = jnp.einsum('bthd,bshd,btshd->bhts', q, k, decay)
    o = inter + jnp.einsum('bhts,bshv->bthv', A, v)
    b_end = b[:, -1]
    S1 = jnp.exp(b_end)[..., None] * S0 + jnp.einsum('bshd,bshv->bhdv', k * jnp.exp(b_end[:, None] - b), v)
    return S1, o


def token_mix(h, C0, n0, m0, S0, P):
    B, T, _ = h.shape
    dt = h.dtype
    f32 = jnp.float32
    z = h @ P['w_in']
    idx = np.cumsum(np.array(IN_SPLITS))[:-1].tolist()
    (mq, mk, mv, mo, mi, mf, gq, gk, gv, gr, ga, gate_m, gate_g) = jnp.split(z, idx, axis=-1)
    L = chunk_len(T)
    q = mq.reshape(B, T, M_HEADS, M_DK).astype(f32)
    k = mk.reshape(B, T, M_HEADS, M_DK).astype(f32) * (M_DK ** -0.5)
    v = mv.reshape(B, T, M_HEADS, M_DV).astype(f32)
    b_if = P['b_if'].astype(f32)
    ig = mi.astype(f32) + b_if[:M_HEADS]
    lf = jax.nn.log_sigmoid(mf.astype(f32) + b_if[M_HEADS:])
    (C1, n1, m1), hm = lax.scan(
        mlstm_chunk, (C0.astype(f32), n0.astype(f32), m0.astype(f32)),
        (to_chunks(q, L), to_chunks(k, L), to_chunks(v, L), to_chunks(ig, L), to_chunks(lf, L)))
    hm = head_rmsnorm(from_chunks(hm)).reshape(B, T, M_V)
    hm = (hm * P['mlstm_norm'].astype(f32) * jax.nn.sigmoid(mo.astype(f32))).astype(dt)
    gq_ = gq.reshape(B, T, G_HEADS, G_DK).astype(f32) * (G_DK ** -0.5)
    gk_ = gk.reshape(B, T, G_HEADS, G_DK).astype(f32)
    gv_ = gv.reshape(B, T, G_HEADS, G_DV).astype(f32)
    la = jax.nn.log_sigmoid((ga @ P['gla_wa2'] + P['gla_ba']).astype(f32)) / G_TAU
    la = la.reshape(B, T, G_HEADS, G_DK)
    S1, hg = lax.scan(gla_chunk, S0.astype(f32),
                      (to_chunks(gq_, L), to_chunks(gk_, L), to_chunks(gv_, L), to_chunks(la, L)))
    hg = head_rmsnorm(from_chunks(hg)).reshape(B, T, G_V)
    hg = (hg * P['gla_norm'].astype(f32) * jax.nn.silu(gr.astype(f32))).astype(dt)
    y = jax.nn.sigmoid(gate_m) * (hm @ P['w_br_m']) + jax.nn.sigmoid(gate_g) * (hg @ P['w_br_g'])
    return y @ P['w_out'], (C1, n1, m1, S1)


def mem_kv(mem, g_mem, wk, wv):
    B = mem.shape[0]
    mn = rmsnorm(mem, g_mem)
    return (mn @ wk).reshape(B, N_MEM, C_HEADS, C_HD), (mn @ wv).reshape(B, N_MEM, C_HEADS, C_HD)


def cross_attn(h, mk, mv, wq, wo):
    B, T, _ = h.shape
    q = (h @ wq).reshape(B, T, C_HEADS, C_HD)
    s = jnp.einsum('bthd,bmhd->bhtm', q, mk).astype(jnp.float32) * (C_HD ** -0.5)
    p = jax.nn.softmax(s, axis=-1).astype(h.dtype)
    o = jnp.einsum('bhtm,bmhd->bthd', p, mv).reshape(B, T, D_MODEL)
    return o @ wo


def layer(x, mk, mv, C0, n0, m0, S0, P):
    x = x + 0.5 * swiglu(rmsnorm(x, P['ffn1_norm']), P['ffn1_wg'], P['ffn1_wu'], P['ffn1_wd'])
    mix, st = token_mix(rmsnorm(x, P['mix_norm']), C0, n0, m0, S0, P)
    x = x + mix
    x = x + cross_attn(rmsnorm(x, P['ca_norm']), mk, mv, P['ca_wq'], P['ca_wo'])
    x = x + 0.5 * swiglu(rmsnorm(x, P['ffn2_norm']), P['ffn2_wg'], P['ffn2_wu'], P['ffn2_wd'])
    return x, st


def setup_inputs(seed: int = 0) -> dict:
    key = jax.random.key(seed)
    ks = iter(jax.random.split(key, 48))
    f32 = jnp.float32

    def nrm(shape, scale):
        return jax.random.normal(next(ks), shape, f32) * scale

    def gain(shape):
        return 1.0 + nrm(shape, 0.02)

    Dp = DEPTH
    b_i = -1.0 + nrm((Dp, M_HEADS), 0.1)
    b_f = 3.0 + nrm((Dp, M_HEADS), 0.5)
    return {
        'x_prompt': nrm((BATCH, SEQ, D_MODEL), 1.0),
        'x_sample': nrm((DEC_BATCH, DEC_SEQ, D_MODEL), 1.0),
        'mem_prompt': nrm((BATCH, N_MEM, D_MODEL), 1.0),
        'state_mlstm_C': nrm((Dp, DEC_BATCH, M_HEADS, M_DV, M_DK), 0.1),
        'state_mlstm_n': nrm((Dp, DEC_BATCH, M_HEADS, M_DK), 0.1),
        'state_mlstm_m': nrm((Dp, DEC_BATCH, M_HEADS), 1.0),
        'state_gla_S': nrm((Dp, DEC_BATCH, G_HEADS, G_DK, G_DV), 0.1),
        'cache_mem_k': nrm((Dp, DEC_BATCH, N_MEM, C_HEADS, C_HD), 1.0),
        'cache_mem_v': nrm((Dp, DEC_BATCH, N_MEM, C_HEADS, C_HD), 1.0),
        'ffn1_norm': gain((Dp, D_MODEL)),
        'ffn1_wg': nrm((Dp, D_MODEL, D_FF), D_MODEL ** -0.5),
        'ffn1_wu': nrm((Dp, D_MODEL, D_FF), D_MODEL ** -0.5),
        'ffn1_wd': nrm((Dp, D_FF, D_MODEL), D_FF ** -0.5),
        'mix_norm': gain((Dp, D_MODEL)),
        'w_in': nrm((Dp, D_MODEL, IN_WIDTH), D_MODEL ** -0.5),
        'b_if': jnp.concatenate([b_i, b_f], axis=-1),
        'gla_wa2': nrm((Dp, G_RANK, G_QK), G_RANK ** -0.5),
        'gla_ba': nrm((Dp, G_QK), 0.1),
        'mlstm_norm': gain((Dp, M_V)),
        'gla_norm': gain((Dp, G_V)),
        'w_br_m': nrm((Dp, M_V, D_MODEL), M_V ** -0.5),
        'w_br_g': nrm((Dp, G_V, D_MODEL), G_V ** -0.5),
        'w_out': nrm((Dp, D_MODEL, D_MODEL), D_MODEL ** -0.5),
        'ca_norm': gain((Dp, D_MODEL)),
        'mem_norm': gain((Dp, D_MODEL)),
        'ca_wq': nrm((Dp, D_MODEL, D_MODEL), D_MODEL ** -0.5),
        'ca_wk': nrm((Dp, D_MODEL, D_MODEL), D_MODEL ** -0.5),
        'ca_wv': nrm((Dp, D_MODEL, D_MODEL), D_MODEL ** -0.5),
        'ca_wo': nrm((Dp, D_MODEL, D_MODEL), D_MODEL ** -0.5),
        'ffn2_norm': gain((Dp, D_MODEL)),
        'ffn2_wg': nrm((Dp, D_MODEL, D_FF), D_MODEL ** -0.5),
        'ffn2_wu': nrm((Dp, D_MODEL, D_FF), D_MODEL ** -0.5),
        'ffn2_wd': nrm((Dp, D_FF, D_MODEL), D_FF ** -0.5),
        'final_norm': gain((D_MODEL,)),
    }


def reference(x_prompt, x_sample, mem_prompt, state_mlstm_C, state_mlstm_n, state_mlstm_m, state_gla_S,
              cache_mem_k, cache_mem_v, ffn1_norm, ffn1_wg, ffn1_wu, ffn1_wd, mix_norm, w_in, b_if,
              gla_wa2, gla_ba, mlstm_norm, gla_norm, w_br_m, w_br_g, w_out, ca_norm, mem_norm,
              ca_wq, ca_wk, ca_wv, ca_wo, ffn2_norm, ffn2_wg, ffn2_wu, ffn2_wd, final_norm):
    f32 = jnp.float32
    Bp = x_prompt.shape[0]
    sdt = state_mlstm_C.dtype
    xp, xs = x_prompt, x_sample
    Cp_l, np_l, mp_l, Sp_l, mkp_l, mvp_l = [], [], [], [], [], []
    Cs_l, ns_l, ms_l, Ss_l = [], [], [], []
    for l in range(DEPTH):
        P = {
            'ffn1_norm': ffn1_norm[l], 'ffn1_wg': ffn1_wg[l], 'ffn1_wu': ffn1_wu[l], 'ffn1_wd': ffn1_wd[l],
            'mix_norm': mix_norm[l], 'w_in': w_in[l], 'b_if': b_if[l], 'gla_wa2': gla_wa2[l],
            'gla_ba': gla_ba[l], 'mlstm_norm': mlstm_norm[l], 'gla_norm': gla_norm[l],
            'w_br_m': w_br_m[l], 'w_br_g': w_br_g[l], 'w_out': w_out[l], 'ca_norm': ca_norm[l],
            'ca_wq': ca_wq[l], 'ca_wo': ca_wo[l], 'ffn2_norm': ffn2_norm[l], 'ffn2_wg': ffn2_wg[l],
            'ffn2_wu': ffn2_wu[l], 'ffn2_wd': ffn2_wd[l],
        }
        mk_p, mv_p = mem_kv(mem_prompt, mem_norm[l], ca_wk[l], ca_wv[l])
        C0 = jnp.zeros((Bp, M_HEADS, M_DV, M_DK), f32)
        n0 = jnp.zeros((Bp, M_HEADS, M_DK), f32)
        m0 = jnp.zeros((Bp, M_HEADS), f32)
        S0 = jnp.zeros((Bp, G_HEADS, G_DK, G_DV), f32)
        xp, (Cp, npr, mp, Sp) = layer(xp, mk_p, mv_p, C0, n0, m0, S0, P)
        xs, (Cs, ns, ms, Ss) = layer(xs, cache_mem_k[l], cache_mem_v[l], state_mlstm_C[l], state_mlstm_n[l],
                                     state_mlstm_m[l], state_gla_S[l], P)
        Cp_l.append(Cp.astype(sdt)); np_l.append(npr.astype(sdt)); mp_l.append(mp.astype(sdt))
        Sp_l.append(Sp.astype(sdt)); mkp_l.append(mk_p); mvp_l.append(mv_p)
        Cs_l.append(Cs.astype(sdt)); ns_l.append(ns.astype(sdt)); ms_l.append(ms.astype(sdt))
        Ss_l.append(Ss.astype(sdt))
    y_prompt = rmsnorm(xp, final_norm)
    y_sample = rmsnorm(xs, final_norm)
    return (y_prompt, y_sample,
            jnp.stack(Cp_l), jnp.stack(np_l), jnp.stack(mp_l), jnp.stack(Sp_l),
            jnp.stack(mkp_l), jnp.stack(mvp_l),
            jnp.stack(Cs_l), jnp.stack(ns_l), jnp.stack(ms_l), jnp.stack(Ss_l))
```

```cpp
#include <hip/hip_runtime.h>
#include <hip/hip_cooperative_groups.h>
#include <cstdio>
namespace cg = cooperative_groups;
namespace pg8 {
#define PG8_LAS __attribute__((address_space(3)))
typedef unsigned short bf16_t;
typedef short bf16x8 __attribute__((ext_vector_type(8)));
typedef float f32x4 __attribute__((ext_vector_type(4)));
typedef unsigned u32x4 __attribute__((ext_vector_type(4)));
constexpr int BM = 256, BK = 64, HALF = 128, HTB = HALF * BK * 2  , STAGE_BYTES = 8 * HTB, NXCD = 8, WGM = 8;

__host__ __device__ __forceinline__ int lds_byte(int r, int c) { const int st = (r >> 4) * 2 + (c >> 5), rr = r & 15, cc = c & 31, ob = rr * 64 + cc * 2; return st * 1024 + (ob ^ (((ob >> 9) & 1) << 5)); }
__host__ __device__ __forceinline__ void stage_rc(int b, int& R, int& C) { const int st = b / 1024, sb = b % 1024, swz = sb ^ (((sb >> 9) & 1) << 5); R = (st >> 1) * 16 + swz / 64; C = (st & 1) * 32 + (swz % 64) / 2; }
__host__ __device__ __forceinline__ int perm32(int rho) { const int n = rho >> 4, i = rho & 15; return 8 * (i >> 2) + 4 * n + (i & 3); }

struct Unit { int pm, pn; };
struct Gemm { const bf16_t* A; const bf16_t* Bt; int M, N, K, lda, ldb; };
struct StaticOrder {
    int nM, nN, nwg, G, c;
    __host__ __device__ void init(int M, int N, int G_, int c_) { nM = M / BM; nN = N / BM; nwg = nM * nN; G = G_; c = c_; }
    __host__ __device__ bool next(int i, Unit& u) const {
        const long L = (long)i * G + c; if (L >= nwg) return false;
        int wgid = (int)L; { const int q = nwg / NXCD, r = nwg % NXCD, xcd = wgid % NXCD, off = wgid / NXCD; wgid = (xcd < r ? xcd * (q + 1) : r * (q + 1) + (xcd - r) * q) + off; }
        const int nig = WGM * nN, gid = wgid / nig, fm = gid * WGM, gsz = (nM - fm) < WGM ? (nM - fm) : WGM;
        u.pm = fm + ((wgid % nig) % gsz); u.pn = (wgid % nig) / gsz; return true;
    }
    __device__ __forceinline__ void a_ready(const Unit&) const {}
    __device__ __forceinline__ void done(const Unit&) const {}
};
__device__ __forceinline__ unsigned cvt_pk_bf16(float lo, float hi) { unsigned r; asm volatile("v_cvt_pk_bf16_f32 %0, %1, %2" : "=v"(r) : "v"(lo), "v"(hi)); return r; }
template <class Epi, class Sched>
__device__ __forceinline__ void gemm_phase(PG8_LAS unsigned char* lds, const Gemm g, const Sched& S, const Epi& E) {
    const int tid = threadIdx.x, wid = __builtin_amdgcn_readfirstlane(tid >> 6), lane = tid & 63, wr = wid >> 2, wc = wid & 3, fr = lane & 15, fq = lane >> 4;
    const int K = g.K, nt = K / BK;
    unsigned voffA[2], voffB[2];
#pragma unroll
    for (int i = 0; i < 2; ++i) { int R, C; stage_rc(tid * 16 + i * 8192, R, C); const int Rb = Epi::PERM ? ((R & ~31) + perm32(R & 31)) : R;
        voffA[i] = (unsigned)(R * g.lda + C) * 2u; voffB[i] = (unsigned)(Rb * g.ldb + C) * 2u; }
    const size_t kstep = (size_t)(BK * 2);
    const size_t hstepA = (size_t)HALF * g.lda * 2, hstepB = (size_t)HALF * g.ldb * 2;
    const size_t tstepA = 2 * hstepA, tstepB = 2 * hstepB;
    const unsigned ldsw = (unsigned)wid * 1024u;
    const int aoff = lds_byte(wr * 64 + fr, fq * 8), boff = lds_byte(wc * 32 + fr, fq * 8);
#define PG8_SA(b, h) (((b) * 2 + (h)) * HTB)
#define PG8_SB(b, h) ((4 + (b) * 2 + (h)) * HTB)
#define PG8_STAGE(bufoff, gbase, voff) do { _Pragma("unroll") for (int _i = 0; _i < 2; ++_i) \
        __builtin_amdgcn_global_load_lds((const unsigned*)((const char*)(gbase) + (voff)[_i]), (PG8_LAS unsigned*)(lds + (bufoff) + ldsw + _i * 8192), 16, 0, 0); } while (0)
#define PG8_LDA(dst, b, h) do { _Pragma("unroll") for (int m = 0; m < 4; ++m) _Pragma("unroll") for (int k = 0; k < 2; ++k) dst[m][k] = *(const PG8_LAS bf16x8*)(lds + PG8_SA(b, h) + aoff + m * 2048 + k * 1024); } while (0)
#define PG8_LDB(dst, b, h) do { _Pragma("unroll") for (int n = 0; n < 2; ++n) _Pragma("unroll") for (int k = 0; k < 2; ++k) dst[n][k] = *(const PG8_LAS bf16x8*)(lds + PG8_SB(b, h) + boff + n * 2048 + k * 1024); } while (0)
#define PG8_MMA(ai, bj, At, Bt) do { __builtin_amdgcn_s_setprio(1); _Pragma("unroll") for (int m = 0; m < 4; ++m) _Pragma("unroll") for (int n = 0; n < 2; ++n) _Pragma("unroll") for (int k = 0; k < 2; ++k) \
        acc[ai][bj][m][n] = __builtin_amdgcn_mfma_f32_16x16x32_bf16(Bt[n][k], At[m][k], acc[ai][bj][m][n], 0, 0, 0); __builtin_amdgcn_s_setprio(0); } while (0)
#define PG8_WAIT_V(n) asm volatile("s_waitcnt vmcnt(" #n ")" ::: "memory")
#define PG8_WAIT_L(n) asm volatile("s_waitcnt lgkmcnt(" #n ")" ::: "memory")
#define PG8_BAR __builtin_amdgcn_s_barrier()
#define PG8_SCHED __builtin_amdgcn_sched_barrier(0)
    Unit cur, nxt; int ui = 0;
    if (!S.next(0, cur)) return;
    f32x4 acc[2][2][4][2];
#pragma unroll
    for (int a = 0; a < 2; ++a)
#pragma unroll
        for (int b = 0; b < 2; ++b)
#pragma unroll
            for (int m = 0; m < 4; ++m)
#pragma unroll
                for (int n = 0; n < 2; ++n) acc[a][b][m][n] = (f32x4){0.f, 0.f, 0.f, 0.f};
    bf16x8 At[4][2], B0[2][2], B1[2][2];
    const char* cA = (const char*)g.A + (size_t)cur.pm * tstepA; const char* cB = (const char*)g.Bt + (size_t)cur.pn * tstepB;
    S.a_ready(cur);
    PG8_STAGE(PG8_SB(0, 0), cB, voffB); PG8_STAGE(PG8_SA(0, 0), cA, voffA); PG8_STAGE(PG8_SB(0, 1), cB + hstepB, voffB); PG8_STAGE(PG8_SA(0, 1), cA + hstepA, voffA);
    if (wr == 1) PG8_BAR;
    PG8_WAIT_V(4); PG8_BAR;
    PG8_STAGE(PG8_SB(1, 0), cB + kstep, voffB); PG8_STAGE(PG8_SA(1, 0), cA + kstep, voffA); PG8_STAGE(PG8_SB(1, 1), cB + hstepB + kstep, voffB);
    PG8_WAIT_V(6); PG8_BAR;
    for (;;) {
        const bool has_next = S.next(ui + 1, nxt);
        const char* nA = has_next ? (const char*)g.A + (size_t)nxt.pm * tstepA : cA; const char* nB = has_next ? (const char*)g.Bt + (size_t)nxt.pn * tstepB : cB;
        for (int t = 0; t < nt; t += 2) {
            const bool last = (t == nt - 2);
            const char* a1 = cA + (size_t)(t + 1) * kstep;
            const char* a2 = last ? nA : cA + (size_t)(t + 2) * kstep; const char* b2 = last ? nB : cB + (size_t)(t + 2) * kstep;
            const char* a3 = a2 + kstep; const char* b3 = b2 + kstep;
            if (last && has_next) S.a_ready(nxt);
            PG8_LDB(B0, 0, 0); PG8_SCHED; PG8_LDA(At, 0, 0); PG8_STAGE(PG8_SA(1, 1), a1 + hstepA, voffA);
            PG8_WAIT_L(8); PG8_BAR; PG8_WAIT_L(0); PG8_MMA(0, 0, At, B0); PG8_BAR; PG8_SCHED;
            PG8_LDB(B1, 0, 1); PG8_STAGE(PG8_SB(0, 0), b2, voffB);
            PG8_BAR; PG8_WAIT_L(0); PG8_MMA(0, 1, At, B1); PG8_BAR;
            PG8_LDA(At, 0, 1); PG8_STAGE(PG8_SA(0, 0), a2, voffA);
            PG8_BAR; PG8_WAIT_L(0); PG8_MMA(1, 0, At, B0); PG8_BAR; PG8_SCHED;
            PG8_STAGE(PG8_SB(0, 1), b2 + hstepB, voffB);
            PG8_WAIT_V(6); PG8_BAR; PG8_MMA(1, 1, At, B1); PG8_BAR;
            PG8_LDB(B0, 1, 0); PG8_SCHED; PG8_LDA(At, 1, 0); PG8_STAGE(PG8_SA(0, 1), a2 + hstepA, voffA);
            PG8_WAIT_L(8); PG8_BAR; PG8_WAIT_L(0); PG8_MMA(0, 0, At, B0); PG8_BAR; PG8_SCHED;
            PG8_LDB(B1, 1, 1); PG8_STAGE(PG8_SB(1, 0), b3, voffB);
            PG8_BAR; PG8_WAIT_L(0); PG8_MMA(0, 1, At, B1); PG8_BAR;
            PG8_LDA(At, 1, 1); PG8_STAGE(PG8_SA(1, 0), a3, voffA);
            PG8_BAR; PG8_WAIT_L(0); PG8_MMA(1, 0, At, B0); PG8_BAR; PG8_SCHED;
            PG8_STAGE(PG8_SB(1, 1), b3 + hstepB, voffB);
            PG8_WAIT_V(6); PG8_BAR; PG8_MMA(1, 1, At, B1); PG8_BAR;
        }
        if constexpr (!Epi::AFTER_DRAIN) { E(acc, cur, wr, wc, fr, fq); S.done(cur); }
        if (!has_next) break;
#pragma unroll
        for (int a = 0; a < 2; ++a)
#pragma unroll
            for (int b = 0; b < 2; ++b)
#pragma unroll
                for (int m = 0; m < 4; ++m)
#pragma unroll
                    for (int n = 0; n < 2; ++n) acc[a][b][m][n] = (f32x4){0.f, 0.f, 0.f, 0.f};
        cur = nxt; cA = nA; cB = nB; ++ui;
    }
    PG8_WAIT_V(0);
    if (wr == 0) PG8_BAR;
    PG8_BAR;
    if constexpr (Epi::AFTER_DRAIN) { E.fused(acc, cur, wr, wc, fr, fq, lds, wid, lane); S.done(cur); }
#undef PG8_SA
#undef PG8_SB
#undef PG8_STAGE
#undef PG8_LDA
#undef PG8_LDB
#undef PG8_MMA
#undef PG8_WAIT_V
#undef PG8_WAIT_L
#undef PG8_BAR
#undef PG8_SCHED
}
}
using pg8::bf16_t; using pg8::bf16x8; using pg8::f32x4; using pg8::u32x4;
typedef short s16x4 __attribute__((ext_vector_type(4)));
typedef unsigned u32x2 __attribute__((ext_vector_type(2)));
#define LAS __attribute__((address_space(3)))

constexpr int MP = 16384, MS = 512, MT = MP + MS, DM = 1024, DFF = 2816, ZLD = 8192, ZSLD = 32;
constexpr int NTHREADS = 512;
constexpr float EPSV = 1e-6f;
constexpr size_t SZ_WGU = 5632ull * 1024 * 2, SZ_WD = 1024ull * 2816 * 2, SZ_WIN = 8448ull * 1024 * 2, SZ_W1K = 1024ull * 1024 * 2;
constexpr size_t WS_WGU1 = 0;
constexpr size_t WS_WD1 = WS_WGU1 + SZ_WGU;
constexpr size_t WS_WIN = WS_WD1 + SZ_WD;
constexpr size_t WS_WBRM = WS_WIN + SZ_WIN;
constexpr size_t WS_WBRG = WS_WBRM + SZ_W1K;
constexpr size_t WS_WOUT = WS_WBRG + SZ_W1K;
constexpr size_t WS_WQ = WS_WOUT + SZ_W1K;
constexpr size_t WS_WO = WS_WQ + SZ_W1K;
constexpr size_t WS_WKV = WS_WO + SZ_W1K;
constexpr size_t WS_WGU2 = WS_WKV + 2 * SZ_W1K;
constexpr size_t WS_WD2 = WS_WGU2 + SZ_WGU;
constexpr size_t WS_ABUF = WS_WD2 + SZ_WD;
constexpr size_t WS_MEMA = WS_ABUF + (size_t)MT * DM * 2;
constexpr size_t WS_MEMKV = WS_MEMA + 2048ull * 1024 * 2;
constexpr size_t WS_XRES = WS_MEMKV + 2048ull * 2048 * 2;
constexpr size_t WS_ZS = WS_XRES + (size_t)MT * DM * 4;
constexpr size_t WS_SS = WS_ZS + (size_t)MT * ZSLD * 4;
constexpr size_t WS_SSQ = WS_SS + 4ull * MT * 16 * 4;
constexpr size_t WS_BEND = WS_SSQ + (size_t)MP * 32 * 4;
constexpr size_t WS_Z = WS_BEND + 1024ull * 128 * 4;
constexpr size_t WS_ABUF2 = WS_Z + (64ull << 20);
constexpr size_t WS_QBUF = WS_Z + (128ull << 20);
constexpr size_t WS_OBUF = WS_Z + (192ull << 20);
constexpr size_t WS_BAR = WS_Z + (size_t)MT * ZLD * 2;
constexpr size_t WS_END = WS_BAR + 16384;
constexpr size_t O_YP = 0, O_YS = 16777216, O_CP = 17301504, O_NP = 18350080, O_MPP = 18354176, O_SP = 18354208, O_MKP = 19402784, O_MVP = 21499936,
                 O_CS = 23597088, O_NS = 40374304, O_MSS = 40439840, O_SS = 40440352, O_END = 57217568;
constexpr int LDS_BYTES = 156 * 1024;

struct Params { const float* in[34]; float* out; unsigned char* ws; int ph_lo, ph_hi; };

typedef float f32x2_t __attribute__((ext_vector_type(2)));
typedef __bf16 bf16x2_t __attribute__((ext_vector_type(2)));
__device__ __forceinline__ unsigned cvt_pk(float lo, float hi) { f32x2_t v = {lo, hi}; bf16x2_t b = __builtin_convertvector(v, bf16x2_t); return __builtin_bit_cast(unsigned, b); }
__device__ __forceinline__ bf16_t f2bf(float x) { return (bf16_t)(cvt_pk(x, 0.f) & 0xffffu); }
__device__ __forceinline__ float bf2f(bf16_t x) { return __uint_as_float(((unsigned)x) << 16); }
__device__ __forceinline__ float bflo(unsigned w) { return __uint_as_float(w << 16); }
__device__ __forceinline__ float bfhi(unsigned w) { return __uint_as_float(w & 0xffff0000u); }
__device__ __forceinline__ float sigmoidf_(float x) { return __builtin_amdgcn_rcpf(1.f + __expf(-x)); }
__device__ __forceinline__ float logsigf_(float x) { return fminf(x, 0.f) - __logf(1.f + __expf(-fabsf(x))); }
__device__ __forceinline__ float rs_of(float ss) { return rsqrtf(ss * (1.f / 1024.f) + EPSV); }
__device__ __forceinline__ float rs_row(const float* ssp, int row) {
    const f32x4* q = (const f32x4*)(ssp + (size_t)row * 16); const f32x4 a = q[0], b = q[1], c = q[2], d = q[3];
    const f32x4 s = (a + b) + (c + d); return rs_of((s[0] + s[1]) + (s[2] + s[3])); }
__device__ __forceinline__ f32x4 mfma16(bf16x8 a, bf16x8 b, f32x4 c) { return __builtin_amdgcn_mfma_f32_16x16x32_bf16(a, b, c, 0, 0, 0); }
__device__ __forceinline__ bf16x8 pack8(f32x4 a, f32x4 b) {
    u32x4 w; w.x = cvt_pk(a[0], a[1]); w.y = cvt_pk(a[2], a[3]); w.z = cvt_pk(b[0], b[1]); w.w = cvt_pk(b[2], b[3]);
    return __builtin_bit_cast(bf16x8, w);
}
__device__ __forceinline__ u32x2 pack4(f32x4 a) { u32x2 w; w.x = cvt_pk(a[0], a[1]); w.y = cvt_pk(a[2], a[3]); return w; }
__device__ __forceinline__ bf16x8 tr_frag(unsigned a0, unsigned a1) {
    s16x4 r0, r1;
    asm volatile("ds_read_b64_tr_b16 %0, %2\n\tds_read_b64_tr_b16 %1, %3\n\ts_waitcnt lgkmcnt(0)" : "=&v"(r0), "=&v"(r1) : "v"(a0), "v"(a1) : "memory");
    return __builtin_shufflevector(r0, r1, 0, 1, 2, 3, 4, 5, 6, 7);
}
__device__ __forceinline__ void tr_frag2(unsigned a0, unsigned a1, unsigned b0, unsigned b1, bf16x8& fa, bf16x8& fb) {
    s16x4 r0, r1, r2, r3;
    asm volatile("ds_read_b64_tr_b16 %0, %4\n\tds_read_b64_tr_b16 %1, %5\n\tds_read_b64_tr_b16 %2, %6\n\tds_read_b64_tr_b16 %3, %7\n\ts_waitcnt lgkmcnt(0)"
                 : "=&v"(r0), "=&v"(r1), "=&v"(r2), "=&v"(r3) : "v"(a0), "v"(a1), "v"(b0), "v"(b1) : "memory");
    fa = __builtin_shufflevector(r0, r1, 0, 1, 2, 3, 4, 5, 6, 7); fb = __builtin_shufflevector(r2, r3, 0, 1, 2, 3, 4, 5, 6, 7);
}
__device__ __forceinline__ void tr_frag4(unsigned a0, unsigned a1, unsigned b0, unsigned b1, unsigned c0, unsigned c1, unsigned d0, unsigned d1, bf16x8& fa, bf16x8& fb, bf16x8& fc, bf16x8& fd) {
    s16x4 r0, r1, r2, r3, r4, r5, r6, r7;
    asm volatile("ds_read_b64_tr_b16 %0, %8\n\tds_read_b64_tr_b16 %1, %9\n\tds_read_b64_tr_b16 %2, %10\n\tds_read_b64_tr_b16 %3, %11\n\t"
                 "ds_read_b64_tr_b16 %4, %12\n\tds_read_b64_tr_b16 %5, %13\n\tds_read_b64_tr_b16 %6, %14\n\tds_read_b64_tr_b16 %7, %15\n\ts_waitcnt lgkmcnt(0)"
                 : "=&v"(r0), "=&v"(r1), "=&v"(r2), "=&v"(r3), "=&v"(r4), "=&v"(r5), "=&v"(r6), "=&v"(r7)
                 : "v"(a0), "v"(a1), "v"(b0), "v"(b1), "v"(c0), "v"(c1), "v"(d0), "v"(d1) : "memory");
    fa = __builtin_shufflevector(r0, r1, 0, 1, 2, 3, 4, 5, 6, 7); fb = __builtin_shufflevector(r2, r3, 0, 1, 2, 3, 4, 5, 6, 7);
    fc = __builtin_shufflevector(r4, r5, 0, 1, 2, 3, 4, 5, 6, 7); fd = __builtin_shufflevector(r6, r7, 0, 1, 2, 3, 4, 5, 6, 7);
}
__device__ __forceinline__ float xsum16_32(float v) { v += __shfl_xor(v, 16); v += __shfl_xor(v, 32); return v; }
__device__ __forceinline__ float xmax16_32(float v) { v = fmaxf(v, __shfl_xor(v, 16)); v = fmaxf(v, __shfl_xor(v, 32)); return v; }
__device__ __forceinline__ float wave_sum(float v) { for (int o = 32; o > 0; o >>= 1) v += __shfl_xor(v, o); return v; }
__device__ __forceinline__ float wave_max(float v) { for (int o = 32; o > 0; o >>= 1) v = fmaxf(v, __shfl_xor(v, o)); return v; }

#define XB_TMO      128
#define XB_XCNT(j)  (256  + 64 * (j))
#define XB_XSUB(j)  (1280 + 64 * (j))
#define XB_XGEN(j)  (2304 + 64 * (j))
#define XB_TOP      3328
#define XB_TOPGEN   3392
#define XCD_BAR_WORDS 3456
#define XB_SPIN_CAP (1u << 18)

__device__ __forceinline__ unsigned xb_ld(unsigned* p)              { return __hip_atomic_load(p, __ATOMIC_RELAXED, __HIP_MEMORY_SCOPE_AGENT); }
__device__ __forceinline__ unsigned xb_add(unsigned* p, unsigned v) { return __hip_atomic_fetch_add(p, v, __ATOMIC_RELAXED, __HIP_MEMORY_SCOPE_AGENT); }
__device__ __forceinline__ unsigned xb_xcc_id() { return (unsigned)__builtin_amdgcn_s_getreg((3 << 11) | 20) & 0xFu; }
#define XB_SPIN(cond, bar) do { unsigned _sp = 0; while (cond) { __builtin_amdgcn_s_sleep(1); \
    if ((++_sp & 255u) == 0u) { if (xb_ld(&(bar)[XB_TMO])) break; if (_sp > XB_SPIN_CAP) { atomicAdd(&(bar)[XB_TMO], 1u); break; } } } } while (0)

struct XcdBarrier {
    unsigned* bar; unsigned x;
    volatile LAS unsigned* st;
};

__device__ __forceinline__ XcdBarrier xcd_barrier_post(unsigned* bar, volatile LAS unsigned* st) {
    XcdBarrier b; b.bar = bar; b.x = xb_xcc_id(); b.st = st;
    if (threadIdx.x == 0) (void)xb_add(&bar[XB_XCNT(b.x)], 1u);
    return b;
}
__device__ __forceinline__ void xcd_barrier_complete(unsigned* bar, unsigned x, unsigned& nloc, unsigned& nx) {
    const unsigned G = gridDim.x * gridDim.y * gridDim.z;
    unsigned sum, cnt, mine, sp = 0u;
    for (;;) {
        sum = 0u; cnt = 0u; mine = 0u;
#pragma unroll
        for (unsigned j = 0; j < 16; ++j) { const unsigned c = xb_ld(&bar[XB_XCNT(j)]); sum += c; cnt += (c > 0u) ? 1u : 0u; mine = (j == x) ? c : mine; }
        if (sum == G) break;
        __builtin_amdgcn_s_sleep(1);
        if ((++sp & 255u) == 0u) { if (xb_ld(&bar[XB_TMO])) break; if (sp > XB_SPIN_CAP) { atomicAdd(&bar[XB_TMO], 1u); break; } }
    }
    nloc = mine > 0u ? mine : 1u; nx = cnt > 0u ? cnt : 1u;
}

__device__ __forceinline__ void xcd_barrier(const XcdBarrier& b) {
    asm volatile("s_waitcnt vmcnt(0)" ::: "memory");
    __syncthreads();
    if (threadIdx.x == 0) {
        unsigned* bar = b.bar;
        __builtin_amdgcn_s_waitcnt(0);
        unsigned nloc = b.st[0], nx = b.st[1];
        if (nloc == 0u) { xcd_barrier_complete(bar, b.x, nloc, nx); b.st[0] = nloc; b.st[1] = nx; }
        const unsigned old = xb_add(&bar[XB_XSUB(b.x)], 1u);
        const unsigned gen = old / nloc;
        if (old + 1u == (gen + 1u) * nloc) {
            __builtin_amdgcn_fence(__ATOMIC_RELEASE, "agent");
            asm volatile("s_waitcnt vmcnt(0)" ::: "memory");
            const unsigned og = xb_add(&bar[XB_TOP], 1u);
            const unsigned tg = og / nx;
            if (og + 1u == (tg + 1u) * nx) xb_add(&bar[XB_TOPGEN], 1u);
            else XB_SPIN(xb_ld(&bar[XB_TOPGEN]) == tg, bar);
            __builtin_amdgcn_fence(__ATOMIC_ACQUIRE, "agent");
            xb_add(&bar[XB_XGEN(b.x)], 1u);
            asm volatile("s_waitcnt vmcnt(0)" ::: "memory");
        } else {
            XB_SPIN(xb_ld(&bar[XB_XGEN(b.x)]) == gen, bar);
            __builtin_amdgcn_fence(__ATOMIC_ACQUIRE, "agent");
            asm volatile("s_waitcnt vmcnt(0)" ::: "memory");
        }
    }
    __syncthreads();
}


constexpr int PREP_EARLY_MASK = 0x060f, PREP_LATE_MASK = 0x39f0;
__device__ __forceinline__ int win_src_col(int r) {
    if (r < 3072) return r; if (r < 6144) return r + 8; if (r < 8192) return r + 24;
    if (r < 8200) return 3072 + (r - 8192); if (r < 8216) return 6152 + (r - 8200); return -1;
}
__device__ __forceinline__ void prep_transposes(const Params& p, unsigned char* lds, int dmask, int vb, int nvb) {
    float* tile = (float*)lds;
    const int tid = threadIdx.x;
    unsigned char* ws = p.ws;
    for (int d = 0; d < 14; ++d) {
        if (!((dmask >> d) & 1)) continue;
        const float* src; bf16_t* dst; int K, ldsrc, ntn, mode = 0, rowoff = 0; float scale = 1.f;
        switch (d) {
            case 0: src = p.in[10]; dst = (bf16_t*)(ws + WS_WGU1); K = 1024; ldsrc = 2816; ntn = 44; mode = 2; rowoff = 0; break;
            case 1: src = p.in[11]; dst = (bf16_t*)(ws + WS_WGU1); K = 1024; ldsrc = 2816; ntn = 44; mode = 2; rowoff = 128; break;
            case 2: src = p.in[12]; dst = (bf16_t*)(ws + WS_WD1); K = 2816; ldsrc = 1024; ntn = 16; break;
            case 3: src = p.in[14]; dst = (bf16_t*)(ws + WS_WIN); K = 1024; ldsrc = 8216; ntn = 132; mode = 1; break;
            case 4: src = p.in[20]; dst = (bf16_t*)(ws + WS_WBRM); K = 1024; ldsrc = 1024; ntn = 16; break;
            case 5: src = p.in[21]; dst = (bf16_t*)(ws + WS_WBRG); K = 1024; ldsrc = 1024; ntn = 16; break;
            case 6: src = p.in[22]; dst = (bf16_t*)(ws + WS_WOUT); K = 1024; ldsrc = 1024; ntn = 16; break;
            case 7: src = p.in[25]; dst = (bf16_t*)(ws + WS_WQ); K = 1024; ldsrc = 1024; ntn = 16; scale = 0.0625f; break;
            case 8: src = p.in[28]; dst = (bf16_t*)(ws + WS_WO); K = 1024; ldsrc = 1024; ntn = 16; break;
            case 9: src = p.in[26]; dst = (bf16_t*)(ws + WS_WKV); K = 1024; ldsrc = 1024; ntn = 16; break;
            case 10: src = p.in[27]; dst = (bf16_t*)(ws + WS_WKV); K = 1024; ldsrc = 1024; ntn = 16; rowoff = 1024; break;
            case 11: src = p.in[30]; dst = (bf16_t*)(ws + WS_WGU2); K = 1024; ldsrc = 2816; ntn = 44; mode = 2; rowoff = 0; break;
            case 12: src = p.in[31]; dst = (bf16_t*)(ws + WS_WGU2); K = 1024; ldsrc = 2816; ntn = 44; mode = 2; rowoff = 128; break;
            default: src = p.in[32]; dst = (bf16_t*)(ws + WS_WD2); K = 2816; ldsrc = 1024; ntn = 16; break;
        }
        const int nkt = K / 64, ntiles = nkt * ntn;
        for (int t = vb; t < ntiles; t += nvb) {
            const int kt = t % nkt, nt = t / nkt, k0 = kt * 64;
            {
                const int j = tid & 63;
                int srccol; float sc = scale;
                if (mode == 1) { srccol = win_src_col(nt * 64 + j); if ((srccol >= 512 && srccol < 1024) || (srccol >= 3080 && srccol < 3592)) sc = 0.08838834764831845f; }
                else srccol = nt * 64 + j;
#pragma unroll
                for (int ps = 0; ps < 8; ++ps) { const int i = (tid >> 6) + 8 * ps;
                    float v = 0.f; if (srccol >= 0) v = src[(size_t)(k0 + i) * ldsrc + srccol] * sc;
                    tile[i * 65 + j] = v; }
            }
            __syncthreads();
            {
                const int j = tid >> 3, kc = tid & 7;
                int dstrow;
                if (mode == 1) dstrow = nt * 64 + j;
                else { const int sc_ = nt * 64 + j; dstrow = (mode == 2) ? ((sc_ >> 7) * 256 + (sc_ & 127) + rowoff) : (sc_ + rowoff); }
                float v[8];
#pragma unroll
                for (int e = 0; e < 8; ++e) v[e] = tile[(kc * 8 + e) * 65 + j];
                u32x4 w; w.x = cvt_pk(v[0], v[1]); w.y = cvt_pk(v[2], v[3]); w.z = cvt_pk(v[4], v[5]); w.w = cvt_pk(v[6], v[7]);
                *(u32x4*)(dst + (size_t)dstrow * K + k0 + kc * 8) = w;
            }
            __syncthreads();
        }
    }
}
__device__ __forceinline__ void prep_phase(const Params& p, unsigned char* lds) {
    const int tid = threadIdx.x;
    unsigned char* ws = p.ws;
    prep_transposes(p, lds, PREP_EARLY_MASK, (int)blockIdx.x, (int)gridDim.x);
    const int lane = tid & 63, gw = blockIdx.x * 8 + (tid >> 6), nw = gridDim.x * 8;
    for (int r = gw; r < MT + 2048; r += nw) {
        const float* x; const float* g; bf16_t* o;
        if (r < MP) { x = p.in[0] + (size_t)r * DM; g = p.in[9]; o = (bf16_t*)(ws + WS_ABUF) + (size_t)r * DM; }
        else if (r < MT) { x = p.in[1] + (size_t)(r - MP) * DM; g = p.in[9]; o = (bf16_t*)(ws + WS_ABUF) + (size_t)r * DM; }
        else { x = p.in[2] + (size_t)(r - MT) * DM; g = p.in[24]; o = (bf16_t*)(ws + WS_MEMA) + (size_t)(r - MT) * DM; }
        f32x4 v[4]; float ss = 0.f;
#pragma unroll
        for (int i = 0; i < 4; ++i) { v[i] = *(const f32x4*)(x + i * 256 + lane * 4); ss += v[i][0] * v[i][0] + v[i][1] * v[i][1] + v[i][2] * v[i][2] + v[i][3] * v[i][3]; }
        ss = wave_sum(ss); const float rs = rs_of(ss);
#pragma unroll
        for (int i = 0; i < 4; ++i) { const f32x4 gg = *(const f32x4*)(g + i * 256 + lane * 4);
            u32x2 w; w.x = cvt_pk(v[i][0] * rs * gg[0], v[i][1] * rs * gg[1]); w.y = cvt_pk(v[i][2] * rs * gg[2], v[i][3] * rs * gg[3]);
            *(u32x2*)(o + i * 256 + lane * 4) = w; }
    }
}

#define EPI_ROW(ai, m) (u.pm * 256 + (ai) * 128 + wr * 64 + (m) * 16 + fr)
#define EPI_COL(bj) (u.pn * 256 + (bj) * 128 + wc * 32 + fq * 8)
struct EpiGateUp {
    static constexpr bool PERM = true, AFTER_DRAIN = false;
    bf16_t* H; const float* ss;
    __device__ __forceinline__ void operator()(const f32x4 (&acc)[2][2][4][2], const pg8::Unit& u, int wr, int wc, int fr, int fq) const {
        float rsv[2][4];
#pragma unroll
        for (int ai = 0; ai < 2; ++ai)
#pragma unroll
            for (int m = 0; m < 4; ++m) rsv[ai][m] = ss ? rs_row(ss, EPI_ROW(ai, m)) : 1.f;
#pragma unroll
        for (int ai = 0; ai < 2; ++ai)
#pragma unroll
            for (int m = 0; m < 4; ++m) { const int row = EPI_ROW(ai, m); const float rs = rsv[ai][m];
                f32x4 hv[2];
#pragma unroll
                for (int n = 0; n < 2; ++n)
#pragma unroll
                    for (int j = 0; j < 4; ++j) { const float gt = acc[ai][0][m][n][j] * rs, up = acc[ai][1][m][n][j] * rs; hv[n][j] = gt * sigmoidf_(gt) * up; }
                *(u32x4*)(H + (size_t)row * DFF + u.pn * 128 + wc * 32 + fq * 8) = __builtin_bit_cast(u32x4, pack8(hv[0], hv[1])); }
    }
};
struct EpiMemKV {
    static constexpr bool PERM = true, AFTER_DRAIN = false;
    float* ok; float* ov; bf16_t* kv;
    __device__ __forceinline__ void operator()(const f32x4 (&acc)[2][2][4][2], const pg8::Unit& u, int wr, int wc, int fr, int fq) const {
#pragma unroll
        for (int ai = 0; ai < 2; ++ai)
#pragma unroll
            for (int m = 0; m < 4; ++m) { const int row = EPI_ROW(ai, m);
#pragma unroll
                for (int bj = 0; bj < 2; ++bj) { const int col = EPI_COL(bj);
                    float* o = (col < 1024) ? (ok + (size_t)row * 1024 + col) : (ov + (size_t)row * 1024 + (col - 1024));
                    *(f32x4*)o = acc[ai][bj][m][0]; *(f32x4*)(o + 4) = acc[ai][bj][m][1];
                    *(u32x4*)(kv + (size_t)row * 2048 + col) = __builtin_bit_cast(u32x4, pack8(acc[ai][bj][m][0], acc[ai][bj][m][1])); } }
    }
};
struct EpiResid {
    static constexpr bool PERM = true, AFTER_DRAIN = false;
    const float* res0; const float* res1; float* xout; bf16_t* aout; const float* gain; float* ss; float scale;
    __device__ __forceinline__ void operator()(const f32x4 (&acc)[2][2][4][2], const pg8::Unit& u, int wr, int wc, int fr, int fq) const {
        f32x4 gv[2][2];
        if (aout) {
#pragma unroll
            for (int bj = 0; bj < 2; ++bj) { gv[bj][0] = *(const f32x4*)(gain + EPI_COL(bj)); gv[bj][1] = *(const f32x4*)(gain + EPI_COL(bj) + 4); } }
#pragma unroll
        for (int ai = 0; ai < 2; ++ai) {
            f32x4 rv[4][2][2];
#pragma unroll
            for (int m = 0; m < 4; ++m) { const int row = EPI_ROW(ai, m);
                const float* rp = (row < MP) ? (res0 + (size_t)row * DM) : (res1 + (size_t)(row - MP) * DM);
#pragma unroll
                for (int bj = 0; bj < 2; ++bj) { rv[m][bj][0] = *(const f32x4*)(rp + EPI_COL(bj)); rv[m][bj][1] = *(const f32x4*)(rp + EPI_COL(bj) + 4); } }
#pragma unroll
            for (int m = 0; m < 4; ++m) { const int row = EPI_ROW(ai, m);
                float sq = 0.f;
#pragma unroll
                for (int bj = 0; bj < 2; ++bj) { const int col = EPI_COL(bj);
                    const f32x4 x0 = rv[m][bj][0] + acc[ai][bj][m][0] * scale, x1 = rv[m][bj][1] + acc[ai][bj][m][1] * scale;
                    *(f32x4*)(xout + (size_t)row * DM + col) = x0; *(f32x4*)(xout + (size_t)row * DM + col + 4) = x1;
#pragma unroll
                    for (int j = 0; j < 4; ++j) sq += x0[j] * x0[j] + x1[j] * x1[j];
                    if (aout) *(u32x4*)(aout + (size_t)row * DM + col) = __builtin_bit_cast(u32x4, pack8(x0 * gv[bj][0], x1 * gv[bj][1])); }
                sq = xsum16_32(sq);
                if (fq == 0) ss[(size_t)row * 16 + u.pn * 4 + wc] = sq; }
        }
    }
    __device__ __forceinline__ void small(f32x4 acc, int row, int col, int tc, int rt, int ct, int l16, int g, unsigned char* lds) const {
        const f32x4 x = *(const f32x4*)(res1 + (size_t)(row - MP) * DM + col) + acc * scale;
        *(f32x4*)(xout + (size_t)row * DM + col) = x;
        if (aout) { const f32x4 gv4 = *(const f32x4*)(gain + col); *(u32x2*)(aout + (size_t)row * DM + col) = pack4(x * gv4); }
        float sq = x[0] * x[0] + x[1] * x[1] + x[2] * x[2] + x[3] * x[3];
        sq = xsum16_32(sq);
        float* red = (float*)lds;
        if (g == 0) red[(rt * 4 + ct) * 16 + l16] = sq;
        __syncthreads();
        if (ct == 0 && g == 0) ss[(size_t)row * 16 + tc] = (red[(rt * 4) * 16 + l16] + red[(rt * 4 + 1) * 16 + l16]) + (red[(rt * 4 + 2) * 16 + l16] + red[(rt * 4 + 3) * 16 + l16]);
        __syncthreads();
    }
};
struct EpiZ {
    static constexpr bool PERM = true, AFTER_DRAIN = false;
    bf16_t* Z; float* ZS; const float* ss;
    __device__ __forceinline__ void operator()(const f32x4 (&acc)[2][2][4][2], const pg8::Unit& u, int wr, int wc, int fr, int fq) const {
#pragma unroll
        for (int ai = 0; ai < 2; ++ai) {
            float rsv[4];
#pragma unroll
            for (int m = 0; m < 4; ++m) rsv[m] = rs_row(ss, EPI_ROW(ai, m));
#pragma unroll
            for (int m = 0; m < 4; ++m) { const int row = EPI_ROW(ai, m); const float rs = rsv[m];
                if (u.pn < 32) {
#pragma unroll
                    for (int bj = 0; bj < 2; ++bj)
                        *(u32x4*)(Z + (size_t)row * ZLD + EPI_COL(bj)) = __builtin_bit_cast(u32x4, pack8(acc[ai][bj][m][0] * rs, acc[ai][bj][m][1] * rs));
                } else if (wc == 0) {
                    *(f32x4*)(ZS + (size_t)row * ZSLD + fq * 8) = acc[ai][0][m][0] * rs; *(f32x4*)(ZS + (size_t)row * ZSLD + fq * 8 + 4) = acc[ai][0][m][1] * rs;
                } } }
    }
};
template <int MODE> struct EpiMerge {
    static constexpr bool PERM = true, AFTER_DRAIN = false;
    const bf16_t* gate; float* T; bf16_t* Y;
    __device__ __forceinline__ void operator()(const f32x4 (&acc)[2][2][4][2], const pg8::Unit& u, int wr, int wc, int fr, int fq) const {
#pragma unroll
        for (int ai = 0; ai < 2; ++ai)
#pragma unroll
            for (int mh = 0; mh < 2; ++mh) {
                u32x4 gw[2][2]; u32x4 tvb[2][2]; bf16_t* Tb = (bf16_t*)T;
#pragma unroll
                for (int mm = 0; mm < 2; ++mm) { const int row = EPI_ROW(ai, mh * 2 + mm);
#pragma unroll
                    for (int bj = 0; bj < 2; ++bj) { gw[mm][bj] = *(const u32x4*)(gate + (size_t)row * ZLD + EPI_COL(bj));
                        if (MODE == 1) tvb[mm][bj] = *(const u32x4*)(Tb + (size_t)row * DM + EPI_COL(bj)); } }
#pragma unroll
                for (int mm = 0; mm < 2; ++mm) { const int m = mh * 2 + mm, row = EPI_ROW(ai, m);
#pragma unroll
                    for (int bj = 0; bj < 2; ++bj) { const int col = EPI_COL(bj); const u32x4 g4 = gw[mm][bj];
                        f32x4 s0, s1;
                        s0[0] = sigmoidf_(bflo(g4.x)); s0[1] = sigmoidf_(bfhi(g4.x)); s0[2] = sigmoidf_(bflo(g4.y)); s0[3] = sigmoidf_(bfhi(g4.y));
                        s1[0] = sigmoidf_(bflo(g4.z)); s1[1] = sigmoidf_(bfhi(g4.z)); s1[2] = sigmoidf_(bflo(g4.w)); s1[3] = sigmoidf_(bfhi(g4.w));
                        f32x4 v0 = acc[ai][bj][m][0] * s0, v1 = acc[ai][bj][m][1] * s1;
                        if (MODE == 0) *(u32x4*)(Tb + (size_t)row * DM + col) = __builtin_bit_cast(u32x4, pack8(v0, v1));
                        else { const u32x4 t4 = tvb[mm][bj];
                            v0 += (f32x4){bflo(t4.x), bfhi(t4.x), bflo(t4.y), bfhi(t4.y)}; v1 += (f32x4){bflo(t4.z), bfhi(t4.z), bflo(t4.w), bfhi(t4.w)};
                            *(u32x4*)(Y + (size_t)row * DM + col) = __builtin_bit_cast(u32x4, pack8(v0, v1)); } } }
            }
    }
    __device__ __forceinline__ void small(f32x4 acc, int row, int col, int tc, int rt, int ct, int l16, int g, unsigned char* lds) const {
        bf16_t* Tb = (bf16_t*)T;
        const u32x2 g2 = *(const u32x2*)(gate + (size_t)row * ZLD + col);
        f32x4 v = acc * (f32x4){sigmoidf_(bflo(g2.x)), sigmoidf_(bfhi(g2.x)), sigmoidf_(bflo(g2.y)), sigmoidf_(bfhi(g2.y))};
        if (MODE == 0) *(u32x2*)(Tb + (size_t)row * DM + col) = pack4(v);
        else { const u32x2 t2 = *(const u32x2*)(Tb + (size_t)row * DM + col);
            v += (f32x4){bflo(t2.x), bfhi(t2.x), bflo(t2.y), bfhi(t2.y)};
            *(u32x2*)(Y + (size_t)row * DM + col) = pack4(v); }
    }
};
struct EpiQ {
    static constexpr bool PERM = true, AFTER_DRAIN = false;
    bf16_t* Q; const float* ss;
    __device__ __forceinline__ void operator()(const f32x4 (&acc)[2][2][4][2], const pg8::Unit& u, int wr, int wc, int fr, int fq) const {
#pragma unroll
        for (int ai = 0; ai < 2; ++ai) {
            float rsv[4];
#pragma unroll
            for (int m = 0; m < 4; ++m) rsv[m] = rs_row(ss, EPI_ROW(ai, m));
#pragma unroll
            for (int m = 0; m < 4; ++m) { const int row = EPI_ROW(ai, m); const float rs = rsv[m];
#pragma unroll
                for (int bj = 0; bj < 2; ++bj)
                    *(u32x4*)(Q + (size_t)row * DM + EPI_COL(bj)) = __builtin_bit_cast(u32x4, pack8(acc[ai][bj][m][0] * rs, acc[ai][bj][m][1] * rs)); } }
    }
    __device__ __forceinline__ void small(f32x4 acc, int row, int col, int tc, int rt, int ct, int l16, int g, unsigned char* lds) const {
        *(u32x2*)(Q + (size_t)row * DM + col) = pack4(acc * rs_row(ss, row));
    }
};
template <class Epi>
__device__ __forceinline__ void small_gemm(unsigned char* lds, const bf16_t* A, int lda, const bf16_t* Bt, int N, int K, const Epi& E) {
    const int tid = threadIdx.x, w = tid >> 6, lane = tid & 63, g = lane >> 4, l16 = lane & 15;
    const int rt = w >> 2, ct = w & 3, nct = N / 64, ntiles = 16 * nct;
    for (int t = blockIdx.x; t < ntiles; t += gridDim.x) {
        const int tr = t / nct, tc = t - tr * nct;
        const int row = MP + tr * 32 + rt * 16 + l16, colb = tc * 64 + ct * 16;
        const bf16_t* ap = A + (size_t)row * lda + 8 * g;
        const bf16_t* bp = Bt + (size_t)(colb + l16) * K + 8 * g;
        f32x4 acc0 = (f32x4){0.f, 0.f, 0.f, 0.f}, acc1 = acc0;
#pragma unroll 4
        for (int k = 0; k < K; k += 64) {
            acc0 = mfma16(*(const bf16x8*)(bp + k), *(const bf16x8*)(ap + k), acc0);
            acc1 = mfma16(*(const bf16x8*)(bp + k + 32), *(const bf16x8*)(ap + k + 32), acc1);
        }
        E.small(acc0 + acc1, row, colb + 4 * g, tc, rt, ct, l16, g, lds);
    }
}
template <class Epi>
__device__ __forceinline__ void run_gemm(unsigned char* lds, const bf16_t* A, int lda, const bf16_t* Bt, int M, int N, int K, const Epi& E, int rot) {
    pg8::Gemm g; g.A = A; g.Bt = Bt; g.M = M; g.N = N; g.K = K; g.lda = lda; g.ldb = K;
    pg8::StaticOrder S; S.init(M, N, (int)gridDim.x, (int)((blockIdx.x + rot) % gridDim.x));
    pg8::gemm_phase<Epi, pg8::StaticOrder>((PG8_LAS unsigned char*)lds, g, S, E);
    __syncthreads();
}
constexpr int T_STRIDE = 272, V_STRIDE = 528;
constexpr int VQN = 2, VW = 256 / VQN, NVT = VW / 16, NOT = NVT / 2, V2_STRIDE = VW * 2 + 16;
constexpr int M_T0 = 0, M_T1 = 17408, M_TV = 34816, M_TC = M_TV + 64 * V2_STRIDE, M_SM = M_TC + VW * T_STRIDE;
template <int BR>
__device__ __forceinline__ void mixer_prompt(const Params& p, unsigned char* lds, int b, int h, int vq) {
    const int tid = threadIdx.x, w = tid >> 6, lane = tid & 63, g = lane >> 4, l16 = lane & 15, q4 = l16 >> 2, p4 = lane & 3;
    const int tt = w & 3, vh = w >> 2;
    bf16_t* Z = (bf16_t*)(p.ws + WS_Z);
    const float* ZS = (const float*)(p.ws + WS_ZS);
    float* SSQ = (float*)(p.ws + WS_SSQ);
    const float* BEND = (const float*)(p.ws + WS_BEND);
    const int qcol = (BR == 0 ? 0 : 3072) + h * 128, kcol = (BR == 0 ? 512 : 3584) + h * 128;
    const int vcol = (BR == 0 ? 1024 : 4096) + h * 256 + vq * VW, ocol = (BR == 0 ? 2048 : 5120) + h * 256 + vq * VW;
    unsigned char* T0 = lds + M_T0; unsigned char* T1 = lds + M_T1; unsigned char* TV = lds + M_TV; unsigned char* TC = lds + M_TC;
    float* sm = (float*)(lds + M_SM);
    float* gS = sm; float* Mt = sm + 64; float* at = sm + 128; float* emt = sm + 192; float* wsv = sm + 256; float* nvec = sm + 320; float* bend = sm + 448;
    float* misc = sm + 576; float* ssq = sm + 592; float* gaL = sm + 720; float* segtot = sm + 1744; float* waL = sm + 2256;
    const unsigned aT0_ = (unsigned)(size_t)T0, aT1_ = (unsigned)(size_t)T1, aTV_ = (unsigned)(size_t)TV;
    const float* gain = (BR == 0 ? p.in[18] : p.in[19]) + h * 256 + vq * VW;
    const int tloc = 16 * tt + l16;
    f32x4 gn[NOT];
#pragma unroll
    for (int vi = 0; vi < NOT; ++vi) gn[vi] = *(const f32x4*)(gain + (VW / 2) * vh + 16 * vi + 4 * g);
    f32x4 st[NVT];
#pragma unroll
    for (int c = 0; c < NVT; ++c) st[c] = (f32x4){0.f, 0.f, 0.f, 0.f};
    float m0 = 0.f;
    const float bi = (BR == 0) ? p.in[15][h] : 0.f, bfb = (BR == 0) ? p.in[15][4 + h] : 0.f;
    if (tid < 128) nvec[tid] = 0.f;
    u32x4 kreg[2], qreg[2], vreg[2]; bf16x8 qn[4]; float igr = 0.f, lfr = 0.f, gar[2] = {0.f, 0.f};
    const int ks_s0 = tid >> 4, ks_ch = tid & 15;
#define MIX_LOAD_CHUNK(R0) do { const size_t r_ = (size_t)(R0); \
        kreg[0] = *(const u32x4*)(Z + (r_ + ks_s0) * ZLD + kcol + ks_ch * 8); kreg[1] = *(const u32x4*)(Z + (r_ + ks_s0 + 32) * ZLD + kcol + ks_ch * 8); \
        vreg[0] = *(const u32x4*)(Z + (r_ + ks_s0) * ZLD + vcol + ks_ch * 8); vreg[1] = *(const u32x4*)(Z + (r_ + ks_s0 + 32) * ZLD + vcol + ks_ch * 8); \
        if (BR == 0) { _Pragma("unroll") for (int ks = 0; ks < 4; ++ks) qn[ks] = *(const bf16x8*)(Z + (r_ + tloc) * ZLD + qcol + 32 * ks + 8 * g); \
            if (w == 0) { igr = ZS[(r_ + lane) * ZSLD + h]; lfr = ZS[(r_ + lane) * ZSLD + 4 + h]; } } \
        else { qreg[0] = *(const u32x4*)(Z + (r_ + ks_s0) * ZLD + qcol + ks_ch * 8); qreg[1] = *(const u32x4*)(Z + (r_ + ks_s0 + 32) * ZLD + qcol + ks_ch * 8); \
            if (tid < 128) gar[0] = BEND[(r_ >> 6) * 512 + h * 128 + tid]; } } while (0)
    MIX_LOAD_CHUNK(b * 2048);
    __syncthreads();
    for (int c = 0; c < 32; ++c) {
        const int r0 = b * 2048 + c * 64;
        if (c > 0 && tid < 64) { float* sp_ = SSQ + ((size_t)(r0 - 64 + tid) * 8 + BR * 4 + h) * 4 + vq * 2; sp_[0] = ssq[tid] + ssq[64 + tid]; sp_[1] = 0.f; }
        unsigned aT0 = aT0_, aT1 = aT1_, aTV = aTV_;
        asm volatile("" : "+v"(aT0), "+v"(aT1), "+v"(aTV));
        if (BR == 0) {
            if (w == 0) {
                const float ig = igr + bi, lf = logsigf_(lfr + bfb);
                float F = lf;
#pragma unroll
                for (int o = 1; o < 64; o <<= 1) { const float y = __shfl_up(F, o); if (lane >= o) F += y; }
                const float gg = ig - F; float cm = gg;
#pragma unroll
                for (int o = 1; o < 64; o <<= 1) { const float y = __shfl_up(cm, o); if (lane >= o) cm = fmaxf(cm, y); }
                const float M = fmaxf(m0, cm), a = __expf(m0 - M);
                const float ML = __shfl(M, 63), aend = __shfl(a, 63), FL = __shfl(F, 63);
                gS[lane] = gg; Mt[lane] = M; at[lane] = a; emt[lane] = __expf(-(F + M)); wsv[lane] = __expf(gg - ML);
                if (lane == 0) misc[1] = aend;
                m0 = FL + ML;
            }
            __syncthreads();
#pragma unroll
            for (int i = 0; i < 2; ++i) { const int s = ks_s0 + 32 * i; const u32x4 kw = kreg[i];
                *(u32x4*)(T0 + s * T_STRIDE + ks_ch * 16) = kw;
                const float ww = wsv[s]; u32x4 o;
                o.x = cvt_pk(bflo(kw.x) * ww, bfhi(kw.x) * ww); o.y = cvt_pk(bflo(kw.y) * ww, bfhi(kw.y) * ww);
                o.z = cvt_pk(bflo(kw.z) * ww, bfhi(kw.z) * ww); o.w = cvt_pk(bflo(kw.w) * ww, bfhi(kw.w) * ww);
                *(u32x4*)(T1 + s * T_STRIDE + ks_ch * 16) = o; }
        } else {
            if (tid < 128) bend[tid] = gar[0];
#pragma unroll
            for (int i = 0; i < 2; ++i) { const int s = ks_s0 + 32 * i;
                *(u32x4*)(T0 + s * T_STRIDE + ks_ch * 16) = kreg[i]; *(u32x4*)(T1 + s * T_STRIDE + ks_ch * 16) = qreg[i]; }
        }
#pragma unroll
        for (int i = 0; i < 2; ++i) *(u32x4*)(TV + (ks_s0 + 32 * i) * V2_STRIDE + ks_ch * 16) = vreg[i];
#pragma unroll
        for (int c16 = 0; c16 < NVT; ++c16) *(u32x2*)(TC + (16 * c16 + l16) * T_STRIDE + (16 * w + 4 * g) * 2) = pack4(st[c16]);
        __syncthreads();
        bf16x8 qf[4];
#pragma unroll
        for (int ks = 0; ks < 4; ++ks) {
            if (BR == 0) qf[ks] = qn[ks];
            else qf[ks] = *(const bf16x8*)(T1 + tloc * T_STRIDE + (32 * ks + 8 * g) * 2);
        }
        bf16_t* op = Z + (size_t)(r0 + tloc) * ZLD + ocol + (VW / 2) * vh + 4 * g;
        u32x2 gwv[NOT];
#pragma unroll
        for (int vi = 0; vi < NOT; ++vi) gwv[vi] = *(const u32x2*)(op + 16 * vi);
        if (c < 31) MIX_LOAD_CHUNK(r0 + 64);
        f32x4 sacc[4];
#pragma unroll
        for (int si = 0; si < 4; ++si) { sacc[si] = (f32x4){0.f, 0.f, 0.f, 0.f};
#pragma unroll
            for (int ks = 0; ks < 4; ++ks) sacc[si] = mfma16(*(const bf16x8*)(T0 + (16 * si + l16) * T_STRIDE + (32 * ks + 8 * g) * 2), qf[ks], sacc[si]); }
        float den = 0.f;
        {
            const float Mtt = (BR == 0) ? Mt[tloc] : 0.f;
            f32x4 gS4[4];
#pragma unroll
            for (int si = 0; si < 4; ++si) gS4[si] = (BR == 0) ? *(const f32x4*)(gS + 16 * si + 4 * g) : (f32x4){0.f, 0.f, 0.f, 0.f};
#pragma unroll
            for (int si = 0; si < 4; ++si)
#pragma unroll
                for (int r = 0; r < 4; ++r) { const int s = 16 * si + 4 * g + r;
                    float wgt;
                    if (BR == 0) { const float e = __expf(fminf(gS4[si][r] - Mtt, 0.f)); wgt = (s <= tloc) ? e : 0.f; } else wgt = (s <= tloc) ? 1.f : 0.f;
                    sacc[si][r] *= wgt; den += sacc[si][r]; }
        }
        f32x4 oacc[NOT];
#pragma unroll
        for (int vi = 0; vi < NOT; ++vi) { oacc[vi] = (f32x4){0.f, 0.f, 0.f, 0.f};
#pragma unroll
            for (int ks = 0; ks < 4; ++ks) oacc[vi] = mfma16(*(const bf16x8*)(TC + ((VW / 2) * vh + 16 * vi + l16) * T_STRIDE + (32 * ks + 8 * g) * 2), qf[ks], oacc[vi]); }
        if (BR == 0) {
            den = xsum16_32(den);
            const float a_t = at[tloc];
            float nq = 0.f;
#pragma unroll
            for (int ks = 0; ks < 4; ++ks)
#pragma unroll
                for (int j = 0; j < 8; ++j) nq += nvec[32 * ks + 8 * g + j] * bf2f((bf16_t)qf[ks][j]);
            nq = xsum16_32(nq);
            den += a_t * nq;
#pragma unroll
            for (int vi = 0; vi < NOT; ++vi) oacc[vi] *= a_t;
        }
#pragma unroll
        for (int ks = 0; ks < 2; ++ks) {
            const bf16x8 pb = pack8(sacc[2 * ks], sacc[2 * ks + 1]);
#pragma unroll
            for (int vi = 0; vi < NOT; vi += 4) {
                const unsigned a0 = aTV + (32 * ks + 4 * g + q4) * V2_STRIDE + ((VW / 2) * vh + 16 * vi) * 2 + 8 * p4, a1 = a0 + 16 * V2_STRIDE;
                bf16x8 fa, fb, fc, fd; tr_frag4(a0, a1, a0 + 32, a1 + 32, a0 + 64, a1 + 64, a0 + 96, a1 + 96, fa, fb, fc, fd);
                oacc[vi] = mfma16(fa, pb, oacc[vi]); oacc[vi + 1] = mfma16(fb, pb, oacc[vi + 1]); oacc[vi + 2] = mfma16(fc, pb, oacc[vi + 2]); oacc[vi + 3] = mfma16(fd, pb, oacc[vi + 3]); }
        }
        if (BR == 0) { const float inv = 1.f / fmaxf(fabsf(den), emt[tloc]);
#pragma unroll
            for (int vi = 0; vi < NOT; ++vi) oacc[vi] *= inv; }
        float sq = 0.f;
#pragma unroll
        for (int vi = 0; vi < NOT; ++vi)
#pragma unroll
            for (int r = 0; r < 4; ++r) sq += oacc[vi][r] * oacc[vi][r];
        sq = xsum16_32(sq);
        if (g == 0) ssq[vh * 64 + tloc] = sq;
#pragma unroll
        for (int vi = 0; vi < NOT; ++vi) {
            const float gt[4] = {bflo(gwv[vi].x), bfhi(gwv[vi].x), bflo(gwv[vi].y), bfhi(gwv[vi].y)}; f32x4 o;
#pragma unroll
            for (int r = 0; r < 4; ++r) { const float sg = sigmoidf_(gt[r]); o[r] = oacc[vi][r] * gn[vi][r] * (BR == 0 ? sg : gt[r] * sg); }
            *(u32x2*)(op + 16 * vi) = pack4(o); }
        if (BR == 0) { const float aend = misc[1];
#pragma unroll
            for (int c16 = 0; c16 < NVT; ++c16) st[c16] *= aend; }
#pragma unroll
        for (int ks = 0; ks < 2; ++ks) {
            const unsigned ka0 = (BR == 0 ? aT1 : aT0) + (32 * ks + 8 * g + q4) * T_STRIDE + (16 * w) * 2 + 8 * p4;
            const bf16x8 kf = tr_frag(ka0, ka0 + 4 * T_STRIDE);
#pragma unroll
            for (int c16 = 0; c16 < NVT; c16 += 4) {
                const unsigned v0 = aTV + (32 * ks + 8 * g + q4) * V2_STRIDE + (16 * c16) * 2 + 8 * p4, v1 = v0 + 4 * V2_STRIDE;
                bf16x8 fa, fb, fc, fd; tr_frag4(v0, v1, v0 + 32, v1 + 32, v0 + 64, v1 + 64, v0 + 96, v1 + 96, fa, fb, fc, fd);
                st[c16] = mfma16(kf, fa, st[c16]); st[c16 + 1] = mfma16(kf, fb, st[c16 + 1]); st[c16 + 2] = mfma16(kf, fc, st[c16 + 2]); st[c16 + 3] = mfma16(kf, fd, st[c16 + 3]);
            }
        }
        if (BR == 1) {
            float eb[4];
#pragma unroll
            for (int r = 0; r < 4; ++r) eb[r] = __expf(bend[16 * w + 4 * g + r]);
#pragma unroll
            for (int c16 = 0; c16 < NVT; ++c16)
#pragma unroll
                for (int r = 0; r < 4; ++r) st[c16][r] *= eb[r];
        } else {
            const int d = tid & 127, seg = tid >> 7; float a2 = 0.f;
#pragma unroll
            for (int s = 0; s < 16; ++s) a2 += bf2f(*(const bf16_t*)(T1 + (seg * 16 + s) * T_STRIDE + d * 2));
            segtot[seg * 128 + d] = a2;
        }
        __syncthreads();
        if (BR == 0 && tid < 128) nvec[tid] = misc[1] * nvec[tid] + ((segtot[tid] + segtot[128 + tid]) + (segtot[256 + tid] + segtot[384 + tid]));
    }
#undef MIX_LOAD_CHUNK
    if (tid < 64) { float* sp_ = SSQ + ((size_t)(b * 2048 + 31 * 64 + tid) * 8 + BR * 4 + h) * 4 + vq * 2; sp_[0] = ssq[tid] + ssq[64 + tid]; sp_[1] = 0.f; }
    const int bh = b * 4 + h;
    if (BR == 0) {
        float* Co = p.out + O_CP + (size_t)bh * 32768;
#pragma unroll
        for (int c16 = 0; c16 < NVT; ++c16) *(f32x4*)(Co + (size_t)(VW * vq + 16 * c16 + l16) * 128 + 16 * w + 4 * g) = st[c16];
        if (vq == 0) { if (tid < 128) p.out[O_NP + bh * 128 + tid] = nvec[tid];
            if (tid == 0) p.out[O_MPP + bh] = m0; }
    } else {
        float* So = p.out + O_SP + (size_t)bh * 32768;
#pragma unroll
        for (int c16 = 0; c16 < NVT; ++c16)
#pragma unroll
            for (int r = 0; r < 4; ++r) So[(size_t)(16 * w + 4 * g + r) * 256 + VW * vq + 16 * c16 + l16] = st[c16][r];
    }
    __syncthreads();
}

__device__ __forceinline__ void gla_prep(const Params& p, unsigned char* lds, int item) {
    const int tid = threadIdx.x, d = tid & 127, seg = tid >> 7;
    const int h = item & 3, c = (item >> 2) & 31, b = item >> 7;
    bf16_t* Z = (bf16_t*)(p.ws + WS_Z);
    const float* ZS = (const float*)(p.ws + WS_ZS);
    float* BEND = (float*)(p.ws + WS_BEND);
    float* gaL = (float*)lds; float* waL = gaL + 1024; float* segtot = waL + 2048;
    const int r0 = b * 2048 + c * 64, qcol = 3072 + h * 128, kcol = 3584 + h * 128;
    gaL[tid] = ZS[(size_t)(r0 + (tid >> 4)) * ZSLD + 8 + (tid & 15)]; gaL[tid + 512] = ZS[(size_t)(r0 + 32 + (tid >> 4)) * ZSLD + 8 + (tid & 15)];
#pragma unroll
    for (int j = 0; j < 4; ++j) { const int id = tid + 512 * j; waL[id] = p.in[16][(id >> 7) * 512 + h * 128 + (id & 127)]; }
    const float ba = p.in[17][h * 128 + d];
    __syncthreads();
    float wa[16];
#pragma unroll
    for (int j = 0; j < 16; ++j) wa[j] = waL[j * 128 + d];
    float la[16]; float run = 0.f;
#pragma unroll
    for (int i = 0; i < 16; ++i) { const int t = seg * 16 + i; float x = ba;
#pragma unroll
        for (int j = 0; j < 16; ++j) x += gaL[t * 16 + j] * wa[j];
        run += logsigf_(x) * 0.0625f; la[i] = run; }
    segtot[seg * 128 + d] = run;
    __syncthreads();
    float pre = 0.f, tot = 0.f;
#pragma unroll
    for (int s2 = 0; s2 < 4; ++s2) { const float v = segtot[s2 * 128 + d]; tot += v; if (s2 < seg) pre += v; }
    if (seg == 0) BEND[(size_t)(b * 32 + c) * 512 + h * 128 + d] = tot;
    bf16_t qv[16], kv[16];
#pragma unroll
    for (int i = 0; i < 16; ++i) { const int t = seg * 16 + i; qv[i] = Z[(size_t)(r0 + t) * ZLD + qcol + d]; kv[i] = Z[(size_t)(r0 + t) * ZLD + kcol + d]; }
#pragma unroll
    for (int i = 0; i < 16; ++i) { const int t = seg * 16 + i; const float bb = la[i] + pre;
        Z[(size_t)(r0 + t) * ZLD + qcol + d] = f2bf(bf2f(qv[i]) * __expf(bb)); Z[(size_t)(r0 + t) * ZLD + kcol + d] = f2bf(bf2f(kv[i]) * __expf(-bb)); }
    __syncthreads();
}

template <int BR>
__device__ __forceinline__ void mixer_sample(const Params& p, unsigned char* lds, int b, int h) {
    const int tid = threadIdx.x, w = tid >> 6, lane = tid & 63;
    bf16_t* Z = (bf16_t*)(p.ws + WS_Z);
    const float* ZS = (const float*)(p.ws + WS_ZS);
    const int qcol = (BR == 0 ? 0 : 3072) + h * 128, kcol = (BR == 0 ? 512 : 3584) + h * 128, vcol = (BR == 0 ? 1024 : 4096) + h * 256, ocol = (BR == 0 ? 2048 : 5120) + h * 256;
    float* sm = (float*)lds;
    float* qa = sm; float* ka = sm + 512; float* kd = sm + 1024; float* dec = sm + 1536; float* vv = sm + 1664; float* qk = sm + 2688; float* sc = sm + 2704;
    float* part = sm + 2752; float* red = sm + 4800;
    const int r0 = MP + 4 * b, bh = b * 4 + h;
    const float* gain = (BR == 0 ? p.in[18] : p.in[19]) + h * 256;
    float a_t[4] = {1.f, 1.f, 1.f, 1.f}, mt[4] = {0.f, 0.f, 0.f, 0.f}, aend = 1.f;
    {
        const int t = tid >> 7, d = tid & 127;
        const float qraw = bf2f(Z[(size_t)(r0 + t) * ZLD + qcol + d]), kraw = bf2f(Z[(size_t)(r0 + t) * ZLD + kcol + d]);
#pragma unroll
        for (int i = 0; i < 2; ++i) { const int id = tid + 512 * i; vv[id] = bf2f(Z[(size_t)(r0 + (id >> 8)) * ZLD + vcol + (id & 255)]); }
        if (BR == 0) {
            const float m0 = p.in[5][bh], bi = p.in[15][h], bfb = p.in[15][4 + h];
            float F = 0.f, cm = -3.0e38f, gg[4], Mv[4];
#pragma unroll
            for (int s = 0; s < 4; ++s) { const float ig = ZS[(size_t)(r0 + s) * ZSLD + h] + bi, lf = logsigf_(ZS[(size_t)(r0 + s) * ZSLD + 4 + h] + bfb);
                F += lf; gg[s] = ig - F; cm = fmaxf(cm, gg[s]); Mv[s] = fmaxf(m0, cm); a_t[s] = __expf(m0 - Mv[s]); mt[s] = F + Mv[s]; }
            aend = a_t[3];
            float wsel = 0.f;
#pragma unroll
            for (int s = 0; s < 4; ++s) { const float ws_ = __expf(gg[s] - Mv[3]); if (s == t) wsel = ws_; }
            qa[tid] = qraw; ka[tid] = kraw; kd[tid] = wsel * kraw;
            if (tid < 128) dec[tid] = aend;
            if (tid == 0) {
#pragma unroll
                for (int s = 0; s < 4; ++s) { sc[16 + s] = gg[s]; sc[20 + s] = Mv[s]; } }
        } else {
            float la[4];
#pragma unroll
            for (int s = 0; s < 4; ++s) { float x = p.in[17][h * 128 + d];
#pragma unroll
                for (int j = 0; j < 16; ++j) x += ZS[(size_t)(r0 + s) * ZSLD + 8 + j] * p.in[16][j * 512 + h * 128 + d];
                la[s] = logsigf_(x) * 0.0625f; }
            float bt = 0.f, bendv = 0.f;
#pragma unroll
            for (int s = 0; s < 4; ++s) { bendv += la[s]; if (s <= t) bt += la[s]; }
            qa[tid] = qraw * __expf(bt); ka[tid] = kraw * __expf(-bt); kd[tid] = kraw * __expf(bendv - bt);
            if (t == 0) dec[d] = __expf(bendv);
        }
    }
    __syncthreads();
    {
        const int pr = tid >> 5, l = tid & 31, t = pr >> 2, s = pr & 3;
        const f32x4 a = *(const f32x4*)(qa + t * 128 + l * 4), k4 = *(const f32x4*)(ka + s * 128 + l * 4);
        float v = a[0] * k4[0] + a[1] * k4[1] + a[2] * k4[2] + a[3] * k4[3];
#pragma unroll
        for (int o = 16; o > 0; o >>= 1) v += __shfl_xor(v, o);
        if (l == 0) { float wgt; if (BR == 0) wgt = (s <= t) ? __expf(sc[16 + s] - sc[20 + t]) : 0.f; else wgt = (s <= t) ? 1.f : 0.f; qk[pr] = v * wgt; }
        if (BR == 0 && tid < 128) {
            const int t2 = tid >> 5;
            const f32x4 n4 = *(const f32x4*)(p.in[4] + (size_t)bh * 128 + l * 4), q4v = *(const f32x4*)(qa + t2 * 128 + l * 4);
            float v2 = n4[0] * q4v[0] + n4[1] * q4v[1] + n4[2] * q4v[2] + n4[3] * q4v[3];
#pragma unroll
            for (int o = 16; o > 0; o >>= 1) v2 += __shfl_xor(v2, o);
            if (l == 0) sc[12 + t2] = v2;
        }
    }
    __syncthreads();
    float hv[4]; int vown; bool owner;
    if (BR == 0) {
        const int l32 = lane & 31, half = lane >> 5;
        const float* C0 = p.in[3] + (size_t)bh * 32768 + 4 * l32;
        float* C1 = p.out + O_CS + (size_t)bh * 32768 + 4 * l32;
        f32x4 qa4[4], kd4[4]; const f32x4 dec4 = *(const f32x4*)(dec + 4 * l32);
#pragma unroll
        for (int t = 0; t < 4; ++t) { qa4[t] = *(const f32x4*)(qa + t * 128 + 4 * l32); kd4[t] = *(const f32x4*)(kd + t * 128 + 4 * l32); }
#pragma unroll
        for (int ib = 0; ib < 16; ib += 8) {
            f32x4 cv[8];
#pragma unroll
            for (int e = 0; e < 8; ++e) cv[e] = *(const f32x4*)(C0 + (size_t)(w * 32 + 2 * (ib + e) + half) * 128);
#pragma unroll
            for (int e = 0; e < 8; ++e) { const int v = w * 32 + 2 * (ib + e) + half; const f32x4 c = cv[e];
                float wv[4], pt[4];
#pragma unroll
                for (int s = 0; s < 4; ++s) wv[s] = vv[s * 256 + v];
                f32x4 o = dec4 * c;
#pragma unroll
                for (int s = 0; s < 4; ++s) o += kd4[s] * wv[s];
                *(f32x4*)(C1 + (size_t)v * 128) = o;
#pragma unroll
                for (int t = 0; t < 4; ++t) { float x = c[0] * qa4[t][0] + c[1] * qa4[t][1] + c[2] * qa4[t][2] + c[3] * qa4[t][3];
#pragma unroll
                    for (int of = 16; of > 0; of >>= 1) x += __shfl_xor(x, of);
                    pt[t] = x; }
                if (l32 == 0) {
#pragma unroll
                    for (int t = 0; t < 4; ++t) part[t * 256 + v] = pt[t]; }
            }
        }
        if (tid < 128) { float acc = aend * p.in[4][(size_t)bh * 128 + tid];
#pragma unroll
            for (int s = 0; s < 4; ++s) acc += kd[s * 128 + tid];
            p.out[O_NS + (size_t)bh * 128 + tid] = acc; }
        if (tid == 0) p.out[O_MSS + bh] = mt[3];
        __syncthreads();
        vown = tid & 255; owner = (tid < 256);
        {
            float wv2[4];
#pragma unroll
            for (int s = 0; s < 4; ++s) wv2[s] = vv[s * 256 + vown];
#pragma unroll
            for (int t = 0; t < 4; ++t) { float num = a_t[t] * part[t * 256 + vown], den = a_t[t] * sc[12 + t];
#pragma unroll
                for (int s = 0; s < 4; ++s) { num += qk[t * 4 + s] * wv2[s]; den += qk[t * 4 + s]; }
                hv[t] = num / fmaxf(fabsf(den), __expf(-mt[t])); }
        }
    } else {
        const int v4 = lane * 4;
        const float* S0 = p.in[6] + ((size_t)bh * 128 + 16 * w) * 256 + v4;
        float* S1 = p.out + O_SS + ((size_t)bh * 128 + 16 * w) * 256 + v4;
        float* part8 = sm + 4864;
        f32x4 wv4[4], pt4[4];
#pragma unroll
        for (int s = 0; s < 4; ++s) { wv4[s] = *(const f32x4*)(vv + s * 256 + v4); pt4[s] = (f32x4){0.f, 0.f, 0.f, 0.f}; }
#pragma unroll
        for (int jb = 0; jb < 16; jb += 8) {
            f32x4 s0v[8];
#pragma unroll
            for (int e = 0; e < 8; ++e) s0v[e] = *(const f32x4*)(S0 + (size_t)(jb + e) * 256);
#pragma unroll
            for (int e = 0; e < 8; ++e) { const int j = jb + e, d = 16 * w + j; const f32x4 s0 = s0v[e];
                f32x4 acc = s0 * dec[d];
#pragma unroll
                for (int t = 0; t < 4; ++t) pt4[t] += s0 * qa[t * 128 + d];
#pragma unroll
                for (int s2 = 0; s2 < 4; ++s2) acc += wv4[s2] * kd[s2 * 128 + d];
                *(f32x4*)(S1 + (size_t)j * 256) = acc; } }
#pragma unroll
        for (int t = 0; t < 4; ++t) *(f32x4*)(part8 + (w * 4 + t) * 256 + v4) = pt4[t];
        __syncthreads();
        vown = tid & 255; owner = (tid < 256);
#pragma unroll
        for (int t = 0; t < 4; ++t) { float num = 0.f;
#pragma unroll
            for (int w2 = 0; w2 < 8; ++w2) num += part8[(w2 * 4 + t) * 256 + vown];
#pragma unroll
            for (int s2 = 0; s2 < 4; ++s2) num += qk[t * 4 + s2] * vv[s2 * 256 + vown];
            hv[t] = num; }
    }
#pragma unroll
    for (int t = 0; t < 4; ++t) { float q2 = owner ? hv[t] * hv[t] : 0.f; q2 = wave_sum(q2); if (lane == 0) red[w * 4 + t] = q2; }
    __syncthreads();
    if (owner) {
#pragma unroll
        for (int t = 0; t < 4; ++t) { float tot = 0.f;
#pragma unroll
            for (int w2 = 0; w2 < 8; ++w2) tot += red[w2 * 4 + t];
            const float rs = rsqrtf(tot * (1.f / 256.f) + EPSV);
            bf16_t* op = Z + (size_t)(r0 + t) * ZLD + ocol + vown;
            const float gt = bf2f(*op), sg = sigmoidf_(gt);
            *op = f2bf(hv[t] * rs * gain[vown] * (BR == 0 ? sg : gt * sg)); }
    }
    __syncthreads();
}

__device__ __forceinline__ void attn_prompt(const Params& p, unsigned char* lds, int item) {
    const int tid = threadIdx.x, w = tid >> 6, lane = tid & 63, g = lane >> 4, l16 = lane & 15, q4 = l16 >> 2, p4 = lane & 3;
    const int qt = item & 15, h = (item >> 4) & 3, b = item >> 6;
    const bf16_t* KV = (const bf16_t*)(p.ws + WS_MEMKV) + (size_t)b * 256 * 2048 + h * 256;
    const bf16_t* Q = (const bf16_t*)(p.ws + WS_QBUF);
    bf16_t* O = (bf16_t*)(p.ws + WS_OBUF);
    const size_t rq = (size_t)b * 2048 + qt * 128 + 16 * w + l16;
    const unsigned aL = (unsigned)(size_t)lds;
#pragma unroll 4
    for (int i = 0; i < 16; ++i) { const int id = tid + 512 * i, key = id >> 5, ch = id & 31;
        *(u32x4*)(lds + key * V_STRIDE + ch * 16) = *(const u32x4*)(KV + (size_t)key * 2048 + ch * 8); }
    __syncthreads();
    f32x4 s[16];
#pragma unroll
    for (int ki = 0; ki < 16; ++ki) s[ki] = (f32x4){0.f, 0.f, 0.f, 0.f};
#pragma unroll
    for (int ks = 0; ks < 8; ++ks) { const bf16x8 qfk = *(const bf16x8*)(Q + rq * DM + h * 256 + 32 * ks + 8 * g);
#pragma unroll
        for (int ki = 0; ki < 16; ++ki) s[ki] = mfma16(*(const bf16x8*)(lds + (16 * ki + l16) * V_STRIDE + (32 * ks + 8 * g) * 2), qfk, s[ki]); }
    float mx = -3.0e38f;
#pragma unroll
    for (int ki = 0; ki < 16; ++ki)
#pragma unroll
        for (int r = 0; r < 4; ++r) mx = fmaxf(mx, s[ki][r]);
    mx = xmax16_32(mx);
    float sum = 0.f;
#pragma unroll
    for (int ki = 0; ki < 16; ++ki)
#pragma unroll
        for (int r = 0; r < 4; ++r) { const float e = __expf(s[ki][r] - mx); s[ki][r] = e; sum += e; }
    sum = xsum16_32(sum);
    bf16x8 pf[8];
#pragma unroll
    for (int ks = 0; ks < 8; ++ks) pf[ks] = pack8(s[2 * ks], s[2 * ks + 1]);
    __syncthreads();
#pragma unroll 4
    for (int i = 0; i < 16; ++i) { const int id = tid + 512 * i, key = id >> 5, ch = id & 31;
        *(u32x4*)(lds + key * V_STRIDE + ch * 16) = *(const u32x4*)(KV + (size_t)key * 2048 + 1024 + ch * 8); }
    __syncthreads();
    const float inv = 1.f / sum;
#pragma unroll
    for (int hh = 0; hh < 2; ++hh) {
        f32x4 o[8];
#pragma unroll
        for (int hi = 0; hi < 8; ++hi) o[hi] = (f32x4){0.f, 0.f, 0.f, 0.f};
#pragma unroll
        for (int ks = 0; ks < 8; ++ks) {
            unsigned aLk = aL + (32 * ks + 4 * g + q4) * V_STRIDE + 8 * p4 + hh * 256;
            asm volatile("" : "+v"(aLk));
#pragma unroll
            for (int hi = 0; hi < 8; hi += 2) {
                const unsigned a0 = aLk + (16 * hi) * 2;
                bf16x8 fa, fb; tr_frag2(a0, a0 + 16 * V_STRIDE, a0 + 32, a0 + 32 + 16 * V_STRIDE, fa, fb);
                o[hi] = mfma16(fa, pf[ks], o[hi]); o[hi + 1] = mfma16(fb, pf[ks], o[hi + 1]);
            }
        }
#pragma unroll
        for (int hi = 0; hi < 8; ++hi) *(u32x2*)(O + rq * DM + h * 256 + hh * 128 + 16 * hi + 4 * g) = pack4(o[hi] * inv);
    }
    __syncthreads();
}
__device__ __forceinline__ void attn_sample(const Params& p, unsigned char* lds, int item) {
    const int tid = threadIdx.x, w = tid >> 6, lane = tid & 63;
    const int h = item & 3, b = item >> 2;
    const float* Kc = p.in[7] + ((size_t)b * 1024 + h) * 256;
    const float* Vc = p.in[8] + ((size_t)b * 1024 + h) * 256;
    const bf16_t* Q = (const bf16_t*)(p.ws + WS_QBUF);
    bf16_t* O = (bf16_t*)(p.ws + WS_OBUF);
    float* sc = (float*)lds; float* po = sc + 1024;
    const size_t r0 = MP + 4 * b;
    f32x4 q[4];
#pragma unroll
    for (int t = 0; t < 4; ++t) { const u32x2 qw = *(const u32x2*)(Q + (r0 + t) * DM + h * 256 + lane * 4); q[t] = (f32x4){bflo(qw.x), bfhi(qw.x), bflo(qw.y), bfhi(qw.y)}; }
#pragma unroll 4
    for (int kk = 0; kk < 32; ++kk) { const int key = w * 32 + kk;
        const f32x4 kv = *(const f32x4*)(Kc + (size_t)key * 1024 + lane * 4);
#pragma unroll
        for (int t = 0; t < 4; ++t) { float d = kv[0] * q[t][0] + kv[1] * q[t][1] + kv[2] * q[t][2] + kv[3] * q[t][3]; d = wave_sum(d); if (lane == 0) sc[t * 256 + key] = d; } }
    __syncthreads();
    if (w < 4) { float v[4], mx = -3.0e38f;
#pragma unroll
        for (int i = 0; i < 4; ++i) { v[i] = sc[w * 256 + lane + 64 * i]; mx = fmaxf(mx, v[i]); }
        mx = wave_max(mx); float sum = 0.f;
#pragma unroll
        for (int i = 0; i < 4; ++i) { v[i] = __expf(v[i] - mx); sum += v[i]; }
        sum = wave_sum(sum); const float inv = 1.f / sum;
#pragma unroll
        for (int i = 0; i < 4; ++i) sc[w * 256 + lane + 64 * i] = v[i] * inv; }
    __syncthreads();
    {
        const int hd4 = lane * 4; float* po8 = sc + 1024;
        f32x4 acc4[4];
#pragma unroll
        for (int t = 0; t < 4; ++t) acc4[t] = (f32x4){0.f, 0.f, 0.f, 0.f};
#pragma unroll 8
        for (int kk = 0; kk < 32; ++kk) { const int key = w * 32 + kk; const f32x4 v4 = *(const f32x4*)(Vc + (size_t)key * 1024 + hd4);
#pragma unroll
            for (int t = 0; t < 4; ++t) acc4[t] += v4 * sc[t * 256 + key]; }
#pragma unroll
        for (int t = 0; t < 4; ++t) *(f32x4*)(po8 + (w * 4 + t) * 256 + hd4) = acc4[t];
        __syncthreads();
        if (tid < 256) {
#pragma unroll
            for (int t = 0; t < 4; ++t) { float o = 0.f;
#pragma unroll
                for (int w2 = 0; w2 < 8; ++w2) o += po8[(w2 * 4 + t) * 256 + tid];
                O[(r0 + t) * DM + h * 256 + tid] = f2bf(o); } }
    }
    __syncthreads();
}

#ifndef ONLY_PH
#define ONLY_PH -1
#endif
#ifndef MIXEN
#define MIXEN 15
#endif
#ifndef PH_MASK
#define PH_MASK 0xffff
#endif
#define PH_ENABLED(x) ((ONLY_PH < 0 || ONLY_PH == (x)) && ((PH_MASK >> (x)) & 1) && ((KMASK >> (x)) & 1))
__device__ __forceinline__ void grid_barrier(unsigned char* wsb, unsigned char* lds) {
    XcdBarrier b; b.bar = (unsigned*)(wsb + WS_BAR); b.x = xb_xcc_id(); b.st = (volatile LAS unsigned*)(lds + LDS_BYTES - 16);
    xcd_barrier(b);
}
template <int KMASK> __global__ void __launch_bounds__(512, 2) fwd_kernel(Params p) {
    extern __shared__ __attribute__((aligned(16))) unsigned char lds[];
    cg::grid_group grid = cg::this_grid();
    volatile LAS unsigned* xb_st = (volatile LAS unsigned*)(lds + LDS_BYTES - 16);
    if (threadIdx.x == 0) { xb_st[0] = 0u; xb_st[1] = 0u; }
    __syncthreads();
    (void)xcd_barrier_post((unsigned*)(p.ws + WS_BAR), xb_st);
#ifndef DUP_MASK
#define DUP_MASK 0
#endif
#define PH_BEGIN(k) if (PH_ENABLED(k) && p.ph_lo <= (k) && (k) < p.ph_hi) for (int rep_ = 0; rep_ < (((DUP_MASK >> (k)) & 1) ? 2 : 1); ++rep_) { if ((k) > p.ph_lo || rep_) { if (p.ph_hi > 1000) grid.sync(); else grid_barrier(p.ws, lds); } \
        unsigned char* ws; float* outp; { unsigned long long w_ = (unsigned long long)p.ws, o_ = (unsigned long long)p.out; \
        unsigned a0_ = __builtin_amdgcn_readfirstlane((unsigned)w_), a1_ = __builtin_amdgcn_readfirstlane((unsigned)(w_ >> 32)), a2_ = __builtin_amdgcn_readfirstlane((unsigned)o_), a3_ = __builtin_amdgcn_readfirstlane((unsigned)(o_ >> 32)); \
        asm volatile("" : "+s"(a0_), "+s"(a1_), "+s"(a2_), "+s"(a3_)); ws = (unsigned char*)(((unsigned long long)a1_ << 32) | a0_); outp = (float*)(((unsigned long long)a3_ << 32) | a2_); } \
        bf16_t* ABUF = (bf16_t*)(ws + WS_ABUF); bf16_t* Z = (bf16_t*)(ws + WS_Z); float* XRES = (float*)(ws + WS_XRES); float* SS = (float*)(ws + WS_SS); float* TMP = outp + O_YP; \
        (void)ABUF; (void)Z; (void)XRES; (void)SS; (void)TMP;
#define PH_END }
    PH_BEGIN(0) prep_phase(p, lds); PH_END
    PH_BEGIN(1)
        EpiGateUp e1; e1.H = Z; e1.ss = nullptr;
        run_gemm(lds, ABUF, DM, (const bf16_t*)(ws + WS_WGU1), MT, 5632, 1024, e1, 0);
        EpiMemKV e2; e2.ok = outp + O_MKP; e2.ov = outp + O_MVP; e2.kv = (bf16_t*)(ws + WS_MEMKV);
        run_gemm(lds, (const bf16_t*)(ws + WS_MEMA), DM, (const bf16_t*)(ws + WS_WKV), 2048, 2048, 1024, e2, 64);
    PH_END
    PH_BEGIN(2) EpiResid e; e.res0 = p.in[0]; e.res1 = p.in[1]; e.xout = XRES; e.aout = ABUF; e.gain = p.in[13]; e.ss = SS; e.scale = 0.5f;
        run_gemm(lds, Z, DFF, (const bf16_t*)(ws + WS_WD1), MP, 1024, DFF, e, 0); small_gemm(lds, Z, DFF, (const bf16_t*)(ws + WS_WD1), 1024, DFF, e); PH_END
    PH_BEGIN(3) EpiZ e; e.Z = Z; e.ZS = (float*)(ws + WS_ZS); e.ss = SS;
        run_gemm(lds, ABUF, DM, (const bf16_t*)(ws + WS_WIN), MT, 8448, 1024, e, 0); PH_END
    PH_BEGIN(4)
        for (int it = blockIdx.x; it < 1024; it += gridDim.x) gla_prep(p, lds, it);
    PH_END
    PH_BEGIN(5)
        const int bx = (int)blockIdx.x, G = (int)gridDim.x;
        const int NCH = (G >= 256) ? 128 : 0;
        if (bx < NCH || NCH == 0) {
            for (int it0 = bx; it0 < 128; it0 += (NCH ? NCH : G)) { const int it = NCH ? ((((it0 & 7) * 8 + (it0 >> 4)) << 1) | ((it0 >> 3) & 1)) : it0;
                if (it < 64) { if (MIXEN & 1) mixer_prompt<0>(p, lds, it >> 3, (it >> 1) & 3, it & 1); } }
            for (int it0 = bx; it0 < 128; it0 += (NCH ? NCH : G)) { const int it = NCH ? ((((it0 & 7) * 8 + (it0 >> 4)) << 1) | ((it0 >> 3) & 1)) : it0;
                if (it >= 64) { if (MIXEN & 2) mixer_prompt<1>(p, lds, (it - 64) >> 3, (it >> 1) & 3, it & 1); } }
        }
        if (bx >= NCH) {
            for (int it = bx - NCH; it < 512; it += G - NCH) { if (MIXEN & 4) mixer_sample<0>(p, lds, it >> 2, it & 3); }
            for (int it = bx - NCH; it < 512; it += G - NCH) { if (MIXEN & 8) mixer_sample<1>(p, lds, it >> 2, it & 3); }
            prep_transposes(p, lds, PREP_LATE_MASK, bx - NCH, G - NCH);
        }
    PH_END
    PH_BEGIN(6)
        const float* SSQ = (const float*)(ws + WS_SSQ);
        const int lane = threadIdx.x & 63, gw = blockIdx.x * 8 + (threadIdx.x >> 6), nw = gridDim.x * 8;
        for (int i0 = gw; i0 < MP * 8; i0 += 4 * nw) {
            f32x4 sp[4]; u32x2 wv[4];
#pragma unroll
            for (int e = 0; e < 4; ++e) { const int i = i0 + e * nw; if (i < MP * 8) { sp[e] = *(const f32x4*)(SSQ + (size_t)i * 4);
                    wv[e] = *(const u32x2*)(Z + (size_t)(i >> 3) * ZLD + (((i & 7) >> 2) ? 5120 : 2048) + (i & 3) * 256 + lane * 4); } }
#pragma unroll
            for (int e = 0; e < 4; ++e) { const int i = i0 + e * nw; if (i < MP * 8) {
                    const float rs = rsqrtf(((sp[e][0] + sp[e][1]) + (sp[e][2] + sp[e][3])) * (1.f / 256.f) + EPSV);
                    f32x4 o = {bflo(wv[e].x) * rs, bfhi(wv[e].x) * rs, bflo(wv[e].y) * rs, bfhi(wv[e].y) * rs};
                    *(u32x2*)(Z + (size_t)(i >> 3) * ZLD + (((i & 7) >> 2) ? 5120 : 2048) + (i & 3) * 256 + lane * 4) = pack4(o); } }
        }
    PH_END
    PH_BEGIN(7) EpiMerge<0> e; e.gate = Z + 6144; e.T = TMP; e.Y = nullptr;
        run_gemm(lds, Z + 2048, ZLD, (const bf16_t*)(ws + WS_WBRM), MP, 1024, 1024, e, 0); small_gemm(lds, Z + 2048, ZLD, (const bf16_t*)(ws + WS_WBRM), 1024, 1024, e); PH_END
    PH_BEGIN(8) EpiMerge<1> e; e.gate = Z + 7168; e.T = TMP; e.Y = ABUF;
        run_gemm(lds, Z + 5120, ZLD, (const bf16_t*)(ws + WS_WBRG), MP, 1024, 1024, e, 0); small_gemm(lds, Z + 5120, ZLD, (const bf16_t*)(ws + WS_WBRG), 1024, 1024, e); PH_END
    PH_BEGIN(9) EpiResid e; e.res0 = XRES; e.res1 = XRES + (size_t)MP * DM; e.xout = XRES; e.aout = (bf16_t*)(ws + WS_ABUF2); e.gain = p.in[23]; e.ss = SS + (size_t)MT * 16; e.scale = 1.f;
        run_gemm(lds, ABUF, DM, (const bf16_t*)(ws + WS_WOUT), MP, 1024, 1024, e, 0); small_gemm(lds, ABUF, DM, (const bf16_t*)(ws + WS_WOUT), 1024, 1024, e); PH_END
    PH_BEGIN(10) EpiQ e; e.Q = (bf16_t*)(ws + WS_QBUF); e.ss = SS + (size_t)MT * 16;
        run_gemm(lds, (const bf16_t*)(ws + WS_ABUF2), DM, (const bf16_t*)(ws + WS_WQ), MP, 1024, 1024, e, 0); small_gemm(lds, (const bf16_t*)(ws + WS_ABUF2), DM, (const bf16_t*)(ws + WS_WQ), 1024, 1024, e); PH_END
    PH_BEGIN(11)
#pragma unroll 1
        for (int pass = 0; pass < 2; ++pass) {
            if (((blockIdx.x & 1) != 0) == (pass == 0)) { for (int it = blockIdx.x; it < 512; it += gridDim.x) attn_sample(p, lds, it); }
            else { for (int it0 = blockIdx.x; it0 < 512; it0 += gridDim.x) {
                    const int it = (gridDim.x == 256) ? ((((it0 & 7) * 4 + (it0 >> 7)) << 4) | ((it0 >> 3) & 15)) : it0;
                    attn_prompt(p, lds, it); } }
        }
    PH_END
    PH_BEGIN(12) EpiResid e; e.res0 = XRES; e.res1 = XRES + (size_t)MP * DM; e.xout = XRES; e.aout = ABUF; e.gain = p.in[29]; e.ss = SS + (size_t)MT * 32; e.scale = 1.f;
        run_gemm(lds, (const bf16_t*)(ws + WS_OBUF), DM, (const bf16_t*)(ws + WS_WO), MP, 1024, 1024, e, 0); small_gemm(lds, (const bf16_t*)(ws + WS_OBUF), DM, (const bf16_t*)(ws + WS_WO), 1024, 1024, e); PH_END
    PH_BEGIN(13) EpiGateUp e; e.H = Z; e.ss = SS + (size_t)MT * 32;
        run_gemm(lds, ABUF, DM, (const bf16_t*)(ws + WS_WGU2), MT, 5632, 1024, e, 0); PH_END
    PH_BEGIN(14) EpiResid e; e.res0 = XRES; e.res1 = XRES + (size_t)MP * DM; e.xout = TMP; e.aout = nullptr; e.gain = nullptr; e.ss = SS + (size_t)MT * 48; e.scale = 0.5f;
        run_gemm(lds, Z, DFF, (const bf16_t*)(ws + WS_WD2), MP, 1024, DFF, e, 0); small_gemm(lds, Z, DFF, (const bf16_t*)(ws + WS_WD2), 1024, DFF, e); PH_END
    PH_BEGIN(15)
        const int lane = threadIdx.x & 63, gw = blockIdx.x * 8 + (threadIdx.x >> 6), nw = gridDim.x * 8;
        for (int r = gw; r < MT; r += nw) { const float rs = rs_row(SS + (size_t)MT * 48, r); float* y = TMP + (size_t)r * DM;
#pragma unroll
            for (int i = 0; i < 4; ++i) { f32x4 v = *(const f32x4*)(y + i * 256 + lane * 4); const f32x4 gg = *(const f32x4*)(p.in[33] + i * 256 + lane * 4);
                *(f32x4*)(y + i * 256 + lane * 4) = v * rs * gg; } }
    PH_END
}

template <int KMASK> static bool setup_kernel() {
    if (hipFuncSetAttribute((const void*)fwd_kernel<KMASK>, hipFuncAttributeMaxDynamicSharedMemorySize, LDS_BYTES) != hipSuccess) { fprintf(stderr, "kernel_launch: hipFuncSetAttribute failed\n"); return false; }
    int per_cu = 0;
    if (hipOccupancyMaxActiveBlocksPerMultiprocessor(&per_cu, (const void*)fwd_kernel<KMASK>, NTHREADS, LDS_BYTES) != hipSuccess || per_cu < 1) fprintf(stderr, "kernel_launch: occupancy query says %d\n", per_cu);
    (void)hipGetLastError();
    return true;
}
template <int KMASK> static void launch_range(Params p, int lo, int hi, int grid, hipStream_t stream) {
    p.ph_lo = lo; p.ph_hi = hi;
    if (hipMemsetAsync((char*)p.ws + WS_BAR, 0, XCD_BAR_WORDS * 4, stream) != hipSuccess) { fprintf(stderr, "kernel_launch: memset of the barrier words failed\n"); return; }
    void* args[] = {&p};
    hipError_t e = hipLaunchCooperativeKernel((const void*)fwd_kernel<KMASK>, dim3(grid), dim3(NTHREADS), args, LDS_BYTES, stream);
    if (e != hipSuccess) fprintf(stderr, "kernel_launch: cooperative launch [%d,%d) failed: %s (grid %d)\n", lo, hi, hipGetErrorString(e), grid);
}
#ifndef N_LAUNCH
#define N_LAUNCH 1
#endif
extern "C" void kernel_launch(void* const* d_in, const int* in_sizes, int n_in, void* d_out, int out_size, void* d_ws, size_t ws_size, hipStream_t stream) {
    static int grid = 0;
    if (grid == 0) {
        if (n_in != 34 || (size_t)out_size != O_END || ws_size < WS_END) { fprintf(stderr, "kernel_launch: unexpected sizes n_in %d out %d ws %zu (need %zu)\n", n_in, out_size, ws_size, (size_t)WS_END); grid = -1; return; }
        int dev = 0, cus = 0;
        (void)hipGetDevice(&dev); (void)hipDeviceGetAttribute(&cus, hipDeviceAttributeMultiprocessorCount, dev);
        bool ok = true;
#if N_LAUNCH == 1
        ok = setup_kernel<0xffff>();
#else
        ok = setup_kernel<0x3fef>() && setup_kernel<0x0010>();
#endif
        if (!ok) { grid = -1; return; }
        grid = cus;
        if (grid < 64) { fprintf(stderr, "kernel_launch: needs >= 64 CUs\n"); grid = -1; return; }
    }
    if (grid < 0) return;
    Params p{};
    for (int i = 0; i < 34; ++i) p.in[i] = (const float*)d_in[i];
    p.out = (float*)d_out; p.ws = (unsigned char*)d_ws;
#if N_LAUNCH == 1
#ifndef PROBE_K
#define PROBE_K -1
#endif
#ifndef PROBE_BACK
#define PROBE_BACK 0
#endif
    if (PROBE_K >= 0) { launch_range<0xffff>(p, 0, PROBE_K + 1, grid, stream); launch_range<0xffff>(p, PROBE_K - PROBE_BACK, 16, grid, stream); }
    else launch_range<0xffff>(p, 0, 16, grid, stream);
#else
#ifndef DBG_HI
#define DBG_HI 14
#endif
    launch_range<0x3fef>(p, 0, DBG_HI < 4 ? DBG_HI : 4, grid, stream);
    if (DBG_HI > 4) launch_range<0x0010>(p, 4, 5, grid, stream);
    if (DBG_HI > 5) launch_range<0x3fef>(p, 5, DBG_HI, grid, stream);
#endif
}
```

```cpp
#include <hip/hip_runtime.h>
#include <hip/hip_cooperative_groups.h>
#include <cstdio>
namespace cg = cooperative_groups;
namespace pg8 {
#define PG8_LAS __attribute__((address_space(3)))
typedef unsigned short bf16_t;
typedef short bf16x8 __attribute__((ext_vector_type(8)));
typedef float f32x4 __attribute__((ext_vector_type(4)));
typedef unsigned u32x4 __attribute__((ext_vector_type(4)));
constexpr int BM = 256, BK = 64, HALF = 128, HTB = HALF * BK * 2  , STAGE_BYTES = 8 * HTB, NXCD = 8, WGM = 8;

__host__ __device__ __forceinline__ int lds_byte(int r, int c) { const int st = (r >> 4) * 2 + (c >> 5), rr = r & 15, cc = c & 31, ob = rr * 64 + cc * 2; return st * 1024 + (ob ^ (((ob >> 9) & 1) << 5)); }
__host__ __device__ __forceinline__ void stage_rc(int b, int& R, int& C) { const int st = b / 1024, sb = b % 1024, swz = sb ^ (((sb >> 9) & 1) << 5); R = (st >> 1) * 16 + swz / 64; C = (st & 1) * 32 + (swz % 64) / 2; }
__host__ __device__ __forceinline__ int perm32(int rho) { const int n = rho >> 4, i = rho & 15; return 8 * (i >> 2) + 4 * n + (i & 3); }

struct Unit { int pm, pn; };
struct Gemm { const bf16_t* A; const bf16_t* Bt; int M, N, K, lda, ldb; };
struct StaticOrder {
    int nM, nN, nwg, G, c;
    __host__ __device__ void init(int M, int N, int G_, int c_) { nM = M / BM; nN = N / BM; nwg = nM * nN; G = G_; c = c_; }
    __host__ __device__ bool next(int i, Unit& u) const {
        const long L = (long)i * G + c; if (L >= nwg) return false;
        int wgid = (int)L; { const int q = nwg / NXCD, r = nwg % NXCD, xcd = wgid % NXCD, off = wgid / NXCD; wgid = (xcd < r ? xcd * (q + 1) : r * (q + 1) + (xcd - r) * q) + off; }
        const int nig = WGM * nN, gid = wgid / nig, fm = gid * WGM, gsz = (nM - fm) < WGM ? (nM - fm) : WGM;
        u.pm = fm + ((wgid % nig) % gsz); u.pn = (wgid % nig) / gsz; return true;
    }
    __device__ __forceinline__ void a_ready(const Unit&) const {}
    __device__ __forceinline__ void done(const Unit&) const {}
};
__device__ __forceinline__ unsigned cvt_pk_bf16(float lo, float hi) { unsigned r; asm volatile("v_cvt_pk_bf16_f32 %0, %1, %2" : "=v"(r) : "v"(lo), "v"(hi)); return r; }
template <class Epi, class Sched>
__device__ __forceinline__ void gemm_phase(PG8_LAS unsigned char* lds, const Gemm g, const Sched& S, const Epi& E) {
    const int tid = threadIdx.x, wid = __builtin_amdgcn_readfirstlane(tid >> 6), lane = tid & 63, wr = wid >> 2, wc = wid & 3, fr = lane & 15, fq = lane >> 4;
    const int K = g.K, nt = K / BK;
    unsigned voffA[2], voffB[2];
#pragma unroll
    for (int i = 0; i < 2; ++i) { int R, C; stage_rc(tid * 16 + i * 8192, R, C); const int Rb = Epi::PERM ? ((R & ~31) + perm32(R & 31)) : R;
        voffA[i] = (unsigned)(R * g.lda + C) * 2u; voffB[i] = (unsigned)(Rb * g.ldb + C) * 2u; }
    const size_t kstep = (size_t)(BK * 2);
    const size_t hstepA = (size_t)HALF * g.lda * 2, hstepB = (size_t)HALF * g.ldb * 2;
    const size_t tstepA = 2 * hstepA, tstepB = 2 * hstepB;
    const unsigned ldsw = (unsigned)wid * 1024u;
    const int aoff = lds_byte(wr * 64 + fr, fq * 8), boff = lds_byte(wc * 32 + fr, fq * 8);
#define PG8_SA(b, h) (((b) * 2 + (h)) * HTB)
#define PG8_SB(b, h) ((4 + (b) * 2 + (h)) * HTB)
#define PG8_STAGE(bufoff, gbase, voff) do { _Pragma("unroll") for (int _i = 0; _i < 2; ++_i) \
        __builtin_amdgcn_global_load_lds((const unsigned*)((const char*)(gbase) + (voff)[_i]), (PG8_LAS unsigned*)(lds + (bufoff) + ldsw + _i * 8192), 16, 0, 0); } while (0)
#define PG8_LDA(dst, b, h) do { _Pragma("unroll") for (int m = 0; m < 4; ++m) _Pragma("unroll") for (int k = 0; k < 2; ++k) dst[m][k] = *(const PG8_LAS bf16x8*)(lds + PG8_SA(b, h) + aoff + m * 2048 + k * 1024); } while (0)
#define PG8_LDB(dst, b, h) do { _Pragma("unroll") for (int n = 0; n < 2; ++n) _Pragma("unroll") for (int k = 0; k < 2; ++k) dst[n][k] = *(const PG8_LAS bf16x8*)(lds + PG8_SB(b, h) + boff + n * 2048 + k * 1024); } while (0)
#define PG8_MMA(ai, bj, At, Bt) do { __builtin_amdgcn_s_setprio(1); _Pragma("unroll") for (int m = 0; m < 4; ++m) _Pragma("unroll") for (int n = 0; n < 2; ++n) _Pragma("unroll") for (int k = 0; k < 2; ++k) \
        acc[ai][bj][m][n] = __builtin_amdgcn_mfma_f32_16x16x32_bf16(Bt[n][k], At[m][k], acc[ai][bj][m][n], 0, 0, 0); __builtin_amdgcn_s_setprio(0); } while (0)
#define PG8_WAIT_V(n) asm volatile("s_waitcnt vmcnt(" #n ")" ::: "memory")
#define PG8_WAIT_L(n) asm volatile("s_waitcnt lgkmcnt(" #n ")" ::: "memory")
#define PG8_BAR __builtin_amdgcn_s_barrier()
#define PG8_SCHED __builtin_amdgcn_sched_barrier(0)
    Unit cur, nxt; int ui = 0;
    if (!S.next(0, cur)) return;
    f32x4 acc[2][2][4][2];
#pragma unroll
    for (int a = 0; a < 2; ++a)
#pragma unroll
        for (int b = 0; b < 2; ++b)
#pragma unroll
            for (int m = 0; m < 4; ++m)
#pragma unroll
                for (int n = 0; n < 2; ++n) acc[a][b][m][n] = (f32x4){0.f, 0.f, 0.f, 0.f};
    bf16x8 At[4][2], B0[2][2], B1[2][2];
    const char* cA = (const char*)g.A + (size_t)cur.pm * tstepA; const char* cB = (const char*)g.Bt + (size_t)cur.pn * tstepB;
    S.a_ready(cur);
    PG8_STAGE(PG8_SB(0, 0), cB, voffB); PG8_STAGE(PG8_SA(0, 0), cA, voffA); PG8_STAGE(PG8_SB(0, 1), cB + hstepB, voffB); PG8_STAGE(PG8_SA(0, 1), cA + hstepA, voffA);
    if (wr == 1) PG8_BAR;
    PG8_WAIT_V(4); PG8_BAR;
    PG8_STAGE(PG8_SB(1, 0), cB + kstep, voffB); PG8_STAGE(PG8_SA(1, 0), cA + kstep, voffA); PG8_STAGE(PG8_SB(1, 1), cB + hstepB + kstep, voffB);
    PG8_WAIT_V(6); PG8_BAR;
    for (;;) {
        const bool has_next = S.next(ui + 1, nxt);
        const char* nA = has_next ? (const char*)g.A + (size_t)nxt.pm * tstepA : cA; const char* nB = has_next ? (const char*)g.Bt + (size_t)nxt.pn * tstepB : cB;
        for (int t = 0; t < nt; t += 2) {
            const bool last = (t == nt - 2);
            const char* a1 = cA + (size_t)(t + 1) * kstep;
            const char* a2 = last ? nA : cA + (size_t)(t + 2) * kstep; const char* b2 = last ? nB : cB + (size_t)(t + 2) * kstep;
            const char* a3 = a2 + kstep; const char* b3 = b2 + kstep;
            if (last && has_next) S.a_ready(nxt);
            PG8_LDB(B0, 0, 0); PG8_SCHED; PG8_LDA(At, 0, 0); PG8_STAGE(PG8_SA(1, 1), a1 + hstepA, voffA);
            PG8_WAIT_L(8); PG8_BAR; PG8_WAIT_L(0); PG8_MMA(0, 0, At, B0); PG8_BAR; PG8_SCHED;
            PG8_LDB(B1, 0, 1); PG8_STAGE(PG8_SB(0, 0), b2, voffB);
            PG8_BAR; PG8_WAIT_L(0); PG8_MMA(0, 1, At, B1); PG8_BAR;
            PG8_LDA(At, 0, 1); PG8_STAGE(PG8_SA(0, 0), a2, voffA);
            PG8_BAR; PG8_WAIT_L(0); PG8_MMA(1, 0, At, B0); PG8_BAR; PG8_SCHED;
            PG8_STAGE(PG8_SB(0, 1), b2 + hstepB, voffB);
            PG8_WAIT_V(6); PG8_BAR; PG8_MMA(1, 1, At, B1); PG8_BAR;
            PG8_LDB(B0, 1, 0); PG8_SCHED; PG8_LDA(At, 1, 0); PG8_STAGE(PG8_SA(0, 1), a2 + hstepA, voffA);
            PG8_WAIT_L(8); PG8_BAR; PG8_WAIT_L(0); PG8_MMA(0, 0, At, B0); PG8_BAR; PG8_SCHED;
            PG8_LDB(B1, 1, 1); PG8_STAGE(PG8_SB(1, 0), b3, voffB);
            PG8_BAR; PG8_WAIT_L(0); PG8_MMA(0, 1, At, B1); PG8_BAR;
            PG8_LDA(At, 1, 1); PG8_STAGE(PG8_SA(1, 0), a3, voffA);
            PG8_BAR; PG8_WAIT_L(0); PG8_MMA(1, 0, At, B0); PG8_BAR; PG8_SCHED;
            PG8_STAGE(PG8_SB(1, 1), b3 + hstepB, voffB);
            PG8_WAIT_V(6); PG8_BAR; PG8_MMA(1, 1, At, B1); PG8_BAR;
        }
        if constexpr (!Epi::AFTER_DRAIN) { E(acc, cur, wr, wc, fr, fq); S.done(cur); }
        if (!has_next) break;
#pragma unroll
        for (int a = 0; a < 2; ++a)
#pragma unroll
            for (int b = 0; b < 2; ++b)
#pragma unroll
                for (int m = 0; m < 4; ++m)
#pragma unroll
                    for (int n = 0; n < 2; ++n) acc[a][b][m][n] = (f32x4){0.f, 0.f, 0.f, 0.f};
        cur = nxt; cA = nA; cB = nB; ++ui;
    }
    PG8_WAIT_V(0);
    if (wr == 0) PG8_BAR;
    PG8_BAR;
    if constexpr (Epi::AFTER_DRAIN) { E.fused(acc, cur, wr, wc, fr, fq, lds, wid, lane); S.done(cur); }
#undef PG8_SA
#undef PG8_SB
#undef PG8_STAGE
#undef PG8_LDA
#undef PG8_LDB
#undef PG8_MMA
#undef PG8_WAIT_V
#undef PG8_WAIT_L
#undef PG8_BAR
#undef PG8_SCHED
}
}
using pg8::bf16_t; using pg8::bf16x8; using pg8::f32x4; using pg8::u32x4;
typedef short s16x4 __attribute__((ext_vector_type(4)));
typedef unsigned u32x2 __attribute__((ext_vector_type(2)));
#define LAS __attribute__((address_space(3)))

constexpr int MP = 16384, MS = 512, MT = MP + MS, DM = 1024, DFF = 2816, ZLD = 8192, ZSLD = 32;
constexpr int NTHREADS = 512;
constexpr float EPSV = 1e-6f;
constexpr size_t SZ_WGU = 5632ull * 1024 * 2, SZ_WD = 1024ull * 2816 * 2, SZ_WIN = 8448ull * 1024 * 2, SZ_W1K = 1024ull * 1024 * 2;
constexpr size_t WS_WGU1 = 0;
constexpr size_t WS_WD1 = WS_WGU1 + SZ_WGU;
constexpr size_t WS_WIN = WS_WD1 + SZ_WD;
constexpr size_t WS_WBRM = WS_WIN + SZ_WIN;
constexpr size_t WS_WBRG = WS_WBRM + SZ_W1K;
constexpr size_t WS_WOUT = WS_WBRG + SZ_W1K;
constexpr size_t WS_WQ = WS_WOUT + SZ_W1K;
constexpr size_t WS_WO = WS_WQ + SZ_W1K;
constexpr size_t WS_WKV = WS_WO + SZ_W1K;
constexpr size_t WS_WGU2 = WS_WKV + 2 * SZ_W1K;
constexpr size_t WS_WD2 = WS_WGU2 + SZ_WGU;
constexpr size_t WS_ABUF = WS_WD2 + SZ_WD;
constexpr size_t WS_MEMA = WS_ABUF + (size_t)MT * DM * 2;
constexpr size_t WS_MEMKV = WS_MEMA + 2048ull * 1024 * 2;
constexpr size_t WS_XRES = WS_MEMKV + 2048ull * 2048 * 2;
constexpr size_t WS_ZS = WS_XRES + (size_t)MT * DM * 4;
constexpr size_t WS_SS = WS_ZS + (size_t)MT * ZSLD * 4;
constexpr size_t WS_SSQ = WS_SS + 4ull * MT * 16 * 4;
constexpr size_t WS_BEND = WS_SSQ + (size_t)MP * 32 * 4;
constexpr size_t WS_Z = WS_BEND + 1024ull * 128 * 4;
constexpr size_t WS_ABUF2 = WS_Z + (64ull << 20);
constexpr size_t WS_QBUF = WS_Z + (128ull << 20);
constexpr size_t WS_OBUF = WS_Z + (192ull << 20);
constexpr size_t WS_BAR = WS_Z + (size_t)MT * ZLD * 2;
constexpr size_t WS_END = WS_BAR + 16384;
constexpr size_t O_YP = 0, O_YS = 16777216, O_CP = 17301504, O_NP = 18350080, O_MPP = 18354176, O_SP = 18354208, O_MKP = 19402784, O_MVP = 21499936,
                 O_CS = 23597088, O_NS = 40374304, O_MSS = 40439840, O_SS = 40440352, O_END = 57217568;
constexpr int LDS_BYTES = 156 * 1024;

struct Params { const float* in[34]; float* out; unsigned char* ws; int ph_lo, ph_hi; };

typedef float f32x2_t __attribute__((ext_vector_type(2)));
typedef __bf16 bf16x2_t __attribute__((ext_vector_type(2)));
__device__ __forceinline__ unsigned cvt_pk(float lo, float hi) { f32x2_t v = {lo, hi}; bf16x2_t b = __builtin_convertvector(v, bf16x2_t); return __builtin_bit_cast(unsigned, b); }
__device__ __forceinline__ bf16_t f2bf(float x) { return (bf16_t)(cvt_pk(x, 0.f) & 0xffffu); }
__device__ __forceinline__ float bf2f(bf16_t x) { return __uint_as_float(((unsigned)x) << 16); }
__device__ __forceinline__ float bflo(unsigned w) { return __uint_as_float(w << 16); }
__device__ __forceinline__ float bfhi(unsigned w) { return __uint_as_float(w & 0xffff0000u); }
__device__ __forceinline__ float sigmoidf_(float x) { return __builtin_amdgcn_rcpf(1.f + __expf(-x)); }
__device__ __forceinline__ float logsigf_(float x) { return fminf(x, 0.f) - __logf(1.f + __expf(-fabsf(x))); }
__device__ __forceinline__ float rs_of(float ss) { return rsqrtf(ss * (1.f / 1024.f) + EPSV); }
__device__ __forceinline__ float rs_row(const float* ssp, int row) {
    const f32x4* q = (const f32x4*)(ssp + (size_t)row * 16); const f32x4 a = q[0], b = q[1], c = q[2], d = q[3];
    const f32x4 s = (a + b) + (c + d); return rs_of((s[0] + s[1]) + (s[2] + s[3])); }
__device__ __forceinline__ f32x4 mfma16(bf16x8 a, bf16x8 b, f32x4 c) { return __builtin_amdgcn_mfma_f32_16x16x32_bf16(a, b, c, 0, 0, 0); }
__device__ __forceinline__ bf16x8 pack8(f32x4 a, f32x4 b) {
    u32x4 w; w.x = cvt_pk(a[0], a[1]); w.y = cvt_pk(a[2], a[3]); w.z = cvt_pk(b[0], b[1]); w.w = cvt_pk(b[2], b[3]);
    return __builtin_bit_cast(bf16x8, w);
}
__device__ __forceinline__ u32x2 pack4(f32x4 a) { u32x2 w; w.x = cvt_pk(a[0], a[1]); w.y = cvt_pk(a[2], a[3]); return w; }
__device__ __forceinline__ bf16x8 tr_frag(unsigned a0, unsigned a1) {
    s16x4 r0, r1;
    asm volatile("ds_read_b64_tr_b16 %0, %2\n\tds_read_b64_tr_b16 %1, %3\n\ts_waitcnt lgkmcnt(0)" : "=&v"(r0), "=&v"(r1) : "v"(a0), "v"(a1) : "memory");
    return __builtin_shufflevector(r0, r1, 0, 1, 2, 3, 4, 5, 6, 7);
}
__device__ __forceinline__ void tr_frag2(unsigned a0, unsigned a1, unsigned b0, unsigned b1, bf16x8& fa, bf16x8& fb) {
    s16x4 r0, r1, r2, r3;
    asm volatile("ds_read_b64_tr_b16 %0, %4\n\tds_read_b64_tr_b16 %1, %5\n\tds_read_b64_tr_b16 %2, %6\n\tds_read_b64_tr_b16 %3, %7\n\ts_waitcnt lgkmcnt(0)"
                 : "=&v"(r0), "=&v"(r1), "=&v"(r2), "=&v"(r3) : "v"(a0), "v"(a1), "v"(b0), "v"(b1) : "memory");
    fa = __builtin_shufflevector(r0, r1, 0, 1, 2, 3, 4, 5, 6, 7); fb = __builtin_shufflevector(r2, r3, 0, 1, 2, 3, 4, 5, 6, 7);
}
__device__ __forceinline__ void tr_frag4(unsigned a0, unsigned a1, unsigned b0, unsigned b1, unsigned c0, unsigned c1, unsigned d0, unsigned d1, bf16x8& fa, bf16x8& fb, bf16x8& fc, bf16x8& fd) {
    s16x4 r0, r1, r2, r3, r4, r5, r6, r7;
    asm volatile("ds_read_b64_tr_b16 %0, %8\n\tds_read_b64_tr_b16 %1, %9\n\tds_read_b64_tr_b16 %2, %10\n\tds_read_b64_tr_b16 %3, %11\n\t"
                 "ds_read_b64_tr_b16 %4, %12\n\tds_read_b64_tr_b16 %5, %13\n\tds_read_b64_tr_b16 %6, %14\n\tds_read_b64_tr_b16 %7, %15\n\ts_waitcnt lgkmcnt(0)"
                 : "=&v"(r0), "=&v"(r1), "=&v"(r2), "=&v"(r3), "=&v"(r4), "=&v"(r5), "=&v"(r6), "=&v"(r7)
                 : "v"(a0), "v"(a1), "v"(b0), "v"(b1), "v"(c0), "v"(c1), "v"(d0), "v"(d1) : "memory");
    fa = __builtin_shufflevector(r0, r1, 0, 1, 2, 3, 4, 5, 6, 7); fb = __builtin_shufflevector(r2, r3, 0, 1, 2, 3, 4, 5, 6, 7);
    fc = __builtin_shufflevector(r4, r5, 0, 1, 2, 3, 4, 5, 6, 7); fd = __builtin_shufflevector(r6, r7, 0, 1, 2, 3, 4, 5, 6, 7);
}
__device__ __forceinline__ float xsum16_32(float v) { v += __shfl_xor(v, 16); v += __shfl_xor(v, 32); return v; }
__device__ __forceinline__ float xmax16_32(float v) { v = fmaxf(v, __shfl_xor(v, 16)); v = fmaxf(v, __shfl_xor(v, 32)); return v; }
__device__ __forceinline__ float wave_sum(float v) { for (int o = 32; o > 0; o >>= 1) v += __shfl_xor(v, o); return v; }
__device__ __forceinline__ float wave_max(float v) { for (int o = 32; o > 0; o >>= 1) v = fmaxf(v, __shfl_xor(v, o)); return v; }

#define XB_TMO      128
#define XB_XCNT(j)  (256  + 64 * (j))
#define XB_XSUB(j)  (1280 + 64 * (j))
#define XB_XGEN(j)  (2304 + 64 * (j))
#define XB_TOP      3328
#define XB_TOPGEN   3392
#define XCD_BAR_WORDS 3456
#define XB_SPIN_CAP (1u << 18)

__device__ __forceinline__ unsigned xb_ld(unsigned* p)              { return __hip_atomic_load(p, __ATOMIC_RELAXED, __HIP_MEMORY_SCOPE_AGENT); }
__device__ __forceinline__ unsigned xb_add(unsigned* p, unsigned v) { return __hip_atomic_fetch_add(p, v, __ATOMIC_RELAXED, __HIP_MEMORY_SCOPE_AGENT); }
__device__ __forceinline__ unsigned xb_xcc_id() { return (unsigned)__builtin_amdgcn_s_getreg((3 << 11) | 20) & 0xFu; }
#define XB_SPIN(cond, bar) do { unsigned _sp = 0; while (cond) { __builtin_amdgcn_s_sleep(1); \
    if ((++_sp & 255u) == 0u) { if (xb_ld(&(bar)[XB_TMO])) break; if (_sp > XB_SPIN_CAP) { atomicAdd(&(bar)[XB_TMO], 1u); break; } } } } while (0)

struct XcdBarrier {
    unsigned* bar; unsigned x;
    volatile LAS unsigned* st;
};

__device__ __forceinline__ XcdBarrier xcd_barrier_post(unsigned* bar, volatile LAS unsigned* st) {
    XcdBarrier b; b.bar = bar; b.x = xb_xcc_id(); b.st = st;
    if (threadIdx.x == 0) (void)xb_add(&bar[XB_XCNT(b.x)], 1u);
    return b;
}
__device__ __forceinline__ void xcd_barrier_complete(unsigned* bar, unsigned x, unsigned& nloc, unsigned& nx) {
    const unsigned G = gridDim.x * gridDim.y * gridDim.z;
    unsigned sum, cnt, mine, sp = 0u;
    for (;;) {
        sum = 0u; cnt = 0u; mine = 0u;
#pragma unroll
        for (unsigned j = 0; j < 16; ++j) { const unsigned c = xb_ld(&bar[XB_XCNT(j)]); sum += c; cnt += (c > 0u) ? 1u : 0u; mine = (j == x) ? c : mine; }
        if (sum == G) break;
        __builtin_amdgcn_s_sleep(1);
        if ((++sp & 255u) == 0u) { if (xb_ld(&bar[XB_TMO])) break; if (sp > XB_SPIN_CAP) { atomicAdd(&bar[XB_TMO], 1u); break; } }
    }
    nloc = mine > 0u ? mine : 1u; nx = cnt > 0u ? cnt : 1u;
}

__device__ __forceinline__ void xcd_barrier(const XcdBarrier& b) {
    asm volatile("s_waitcnt vmcnt(0)" ::: "memory");
    __syncthreads();
    if (threadIdx.x == 0) {
        unsigned* bar = b.bar;
        __builtin_amdgcn_s_waitcnt(0);
        unsigned nloc = b.st[0], nx = b.st[1];
        if (nloc == 0u) { xcd_barrier_complete(bar, b.x, nloc, nx); b.st[0] = nloc; b.st[1] = nx; }
        const unsigned old = xb_add(&bar[XB_XSUB(b.x)], 1u);
        const unsigned gen = old / nloc;
        if (old + 1u == (gen + 1u) * nloc) {
            __builtin_amdgcn_fence(__ATOMIC_RELEASE, "agent");
            asm volatile("s_waitcnt vmcnt(0)" ::: "memory");
            const unsigned og = xb_add(&bar[XB_TOP], 1u);
            const unsigned tg = og / nx;
            if (og + 1u == (tg + 1u) * nx) xb_add(&bar[XB_TOPGEN], 1u);
            else XB_SPIN(xb_ld(&bar[XB_TOPGEN]) == tg, bar);
            __builtin_amdgcn_fence(__ATOMIC_ACQUIRE, "agent");
            xb_add(&bar[XB_XGEN(b.x)], 1u);
            asm volatile("s_waitcnt vmcnt(0)" ::: "memory");
        } else {
            XB_SPIN(xb_ld(&bar[XB_XGEN(b.x)]) == gen, bar);
            __builtin_amdgcn_fence(__ATOMIC_ACQUIRE, "agent");
            asm volatile("s_waitcnt vmcnt(0)" ::: "memory");
        }
    }
    __syncthreads();
}


constexpr int PREP_EARLY_MASK = 0x060f, PREP_LATE_MASK = 0x39f0;
__device__ __forceinline__ int win_src_col(int r) {
    if (r < 3072) return r; if (r < 6144) return r + 8; if (r < 8192) return r + 24;
    if (r < 8200) return 3072 + (r - 8192); if (r < 8216) return 6152 + (r - 8200); return -1;
}
__device__ __forceinline__ void prep_transposes(const Params& p, unsigned char* lds, int dmask, int vb, int nvb) {
    float* tile = (float*)lds;
    const int tid = threadIdx.x;
    unsigned char* ws = p.ws;
    for (int d = 0; d < 14; ++d) {
        if (!((dmask >> d) & 1)) continue;
        const float* src; bf16_t* dst; int K, ldsrc, ntn, mode = 0, rowoff = 0; float scale = 1.f;
        switch (d) {
            case 0: src = p.in[10]; dst = (bf16_t*)(ws + WS_WGU1); K = 1024; ldsrc = 2816; ntn = 44; mode = 2; rowoff = 0; break;
            case 1: src = p.in[11]; dst = (bf16_t*)(ws + WS_WGU1); K = 1024; ldsrc = 2816; ntn = 44; mode = 2; rowoff = 128; break;
            case 2: src = p.in[12]; dst = (bf16_t*)(ws + WS_WD1); K = 2816; ldsrc = 1024; ntn = 16; break;
            case 3: src = p.in[14]; dst = (bf16_t*)(ws + WS_WIN); K = 1024; ldsrc = 8216; ntn = 132; mode = 1; break;
            case 4: src = p.in[20]; dst = (bf16_t*)(ws + WS_WBRM); K = 1024; ldsrc = 1024; ntn = 16; break;
            case 5: src = p.in[21]; dst = (bf16_t*)(ws + WS_WBRG); K = 1024; ldsrc = 1024; ntn = 16; break;
            case 6: src = p.in[22]; dst = (bf16_t*)(ws + WS_WOUT); K = 1024; ldsrc = 1024; ntn = 16; break;
            case 7: src = p.in[25]; dst = (bf16_t*)(ws + WS_WQ); K = 1024; ldsrc = 1024; ntn = 16; scale = 0.0625f; break;
            case 8: src = p.in[28]; dst = (bf16_t*)(ws + WS_WO); K = 1024; ldsrc = 1024; ntn = 16; break;
            case 9: src = p.in[26]; dst = (bf16_t*)(ws + WS_WKV); K = 1024; ldsrc = 1024; ntn = 16; break;
            case 10: src = p.in[27]; dst = (bf16_t*)(ws + WS_WKV); K = 1024; ldsrc = 1024; ntn = 16; rowoff = 1024; break;
            case 11: src = p.in[30]; dst = (bf16_t*)(ws + WS_WGU2); K = 1024; ldsrc = 2816; ntn = 44; mode = 2; rowoff = 0; break;
            case 12: src = p.in[31]; dst = (bf16_t*)(ws + WS_WGU2); K = 1024; ldsrc = 2816; ntn = 44; mode = 2; rowoff = 128; break;
            default: src = p.in[32]; dst = (bf16_t*)(ws + WS_WD2); K = 2816; ldsrc = 1024; ntn = 16; break;
        }
        const int nkt = K / 64, ntiles = nkt * ntn;
        for (int t = vb; t < ntiles; t += nvb) {
            const int kt = t % nkt, nt = t / nkt, k0 = kt * 64;
            {
                const int j = tid & 63;
                int srccol; float sc = scale;
                if (mode == 1) { srccol = win_src_col(nt * 64 + j); if ((srccol >= 512 && srccol < 1024) || (srccol >= 3080 && srccol < 3592)) sc = 0.08838834764831845f; }
                else srccol = nt * 64 + j;
#pragma unroll
                for (int ps = 0; ps < 8; ++ps) { const int i = (tid >> 6) + 8 * ps;
                    float v = 0.f; if (srccol >= 0) v = __builtin_nontemporal_load(src + (size_t)(k0 + i) * ldsrc + srccol) * sc;
                    tile[i * 65 + j] = v; }
            }
            __syncthreads();
            {
                const int j = tid >> 3, kc = tid & 7;
                int dstrow;
                if (mode == 1) dstrow = nt * 64 + j;
                else { const int sc_ = nt * 64 + j; dstrow = (mode == 2) ? ((sc_ >> 7) * 256 + (sc_ & 127) + rowoff) : (sc_ + rowoff); }
                float v[8];
#pragma unroll
                for (int e = 0; e < 8; ++e) v[e] = tile[(kc * 8 + e) * 65 + j];
                u32x4 w; w.x = cvt_pk(v[0], v[1]); w.y = cvt_pk(v[2], v[3]); w.z = cvt_pk(v[4], v[5]); w.w = cvt_pk(v[6], v[7]);
                *(u32x4*)(dst + (size_t)dstrow * K + k0 + kc * 8) = w;
            }
            __syncthreads();
        }
    }
}
__device__ __forceinline__ void prep_phase(const Params& p, unsigned char* lds) {
    const int tid = threadIdx.x;
    unsigned char* ws = p.ws;
    prep_transposes(p, lds, PREP_EARLY_MASK, (int)blockIdx.x, (int)gridDim.x);
    const int lane = tid & 63, gw = blockIdx.x * 8 + (tid >> 6), nw = gridDim.x * 8;
    for (int r = gw; r < MT + 2048; r += nw) {
        const float* x; const float* g; bf16_t* o;
        if (r < MP) { x = p.in[0] + (size_t)r * DM; g = p.in[9]; o = (bf16_t*)(ws + WS_ABUF) + (size_t)r * DM; }
        else if (r < MT) { x = p.in[1] + (size_t)(r - MP) * DM; g = p.in[9]; o = (bf16_t*)(ws + WS_ABUF) + (size_t)r * DM; }
        else { x = p.in[2] + (size_t)(r - MT) * DM; g = p.in[24]; o = (bf16_t*)(ws + WS_MEMA) + (size_t)(r - MT) * DM; }
        f32x4 v[4]; float ss = 0.f;
#pragma unroll
        for (int i = 0; i < 4; ++i) { v[i] = *(const f32x4*)(x + i * 256 + lane * 4); ss += v[i][0] * v[i][0] + v[i][1] * v[i][1] + v[i][2] * v[i][2] + v[i][3] * v[i][3]; }
        ss = wave_sum(ss); const float rs = rs_of(ss);
#pragma unroll
        for (int i = 0; i < 4; ++i) { const f32x4 gg = *(const f32x4*)(g + i * 256 + lane * 4);
            u32x2 w; w.x = cvt_pk(v[i][0] * rs * gg[0], v[i][1] * rs * gg[1]); w.y = cvt_pk(v[i][2] * rs * gg[2], v[i][3] * rs * gg[3]);
            *(u32x2*)(o + i * 256 + lane * 4) = w; }
    }
}

#define EPI_ROW(ai, m) (u.pm * 256 + (ai) * 128 + wr * 64 + (m) * 16 + fr)
#define EPI_COL(bj) (u.pn * 256 + (bj) * 128 + wc * 32 + fq * 8)
struct EpiGateUp {
    static constexpr bool PERM = true, AFTER_DRAIN = false;
    bf16_t* H; const float* ss;
    __device__ __forceinline__ void operator()(const f32x4 (&acc)[2][2][4][2], const pg8::Unit& u, int wr, int wc, int fr, int fq) const {
        float rsv[2][4];
#pragma unroll
        for (int ai = 0; ai < 2; ++ai)
#pragma unroll
            for (int m = 0; m < 4; ++m) rsv[ai][m] = ss ? rs_row(ss, EPI_ROW(ai, m)) : 1.f;
#pragma unroll
        for (int ai = 0; ai < 2; ++ai)
#pragma unroll
            for (int m = 0; m < 4; ++m) { const int row = EPI_ROW(ai, m); const float rs = rsv[ai][m];
                f32x4 hv[2];
#pragma unroll
                for (int n = 0; n < 2; ++n)
#pragma unroll
                    for (int j = 0; j < 4; ++j) { const float gt = acc[ai][0][m][n][j] * rs, up = acc[ai][1][m][n][j] * rs; hv[n][j] = gt * sigmoidf_(gt) * up; }
                *(u32x4*)(H + (size_t)row * DFF + u.pn * 128 + wc * 32 + fq * 8) = __builtin_bit_cast(u32x4, pack8(hv[0], hv[1])); }
    }
};
struct EpiMemKV {
    static constexpr bool PERM = true, AFTER_DRAIN = false;
    float* ok; float* ov; bf16_t* kv;
    __device__ __forceinline__ void operator()(const f32x4 (&acc)[2][2][4][2], const pg8::Unit& u, int wr, int wc, int fr, int fq) const {
#pragma unroll
        for (int ai = 0; ai < 2; ++ai)
#pragma unroll
            for (int m = 0; m < 4; ++m) { const int row = EPI_ROW(ai, m);
#pragma unroll
                for (int bj = 0; bj < 2; ++bj) { const int col = EPI_COL(bj);
                    float* o = (col < 1024) ? (ok + (size_t)row * 1024 + col) : (ov + (size_t)row * 1024 + (col - 1024));
                    *(f32x4*)o = acc[ai][bj][m][0]; *(f32x4*)(o + 4) = acc[ai][bj][m][1];
                    *(u32x4*)(kv + (size_t)row * 2048 + col) = __builtin_bit_cast(u32x4, pack8(acc[ai][bj][m][0], acc[ai][bj][m][1])); } }
    }
};
struct EpiResid {
    static constexpr bool PERM = true, AFTER_DRAIN = false;
    const float* res0; const float* res1; float* xout; bf16_t* aout; const float* gain; float* ss; float scale;
    __device__ __forceinline__ void operator()(const f32x4 (&acc)[2][2][4][2], const pg8::Unit& u, int wr, int wc, int fr, int fq) const {
        f32x4 gv[2][2];
        if (aout) {
#pragma unroll
            for (int bj = 0; bj < 2; ++bj) { gv[bj][0] = *(const f32x4*)(gain + EPI_COL(bj)); gv[bj][1] = *(const f32x4*)(gain + EPI_COL(bj) + 4); } }
#pragma unroll
        for (int ai = 0; ai < 2; ++ai) {
            f32x4 rv[4][2][2];
#pragma unroll
            for (int m = 0; m < 4; ++m) { const int row = EPI_ROW(ai, m);
                const float* rp = (row < MP) ? (res0 + (size_t)row * DM) : (res1 + (size_t)(row - MP) * DM);
#pragma unroll
                for (int bj = 0; bj < 2; ++bj) { rv[m][bj][0] = *(const f32x4*)(rp + EPI_COL(bj)); rv[m][bj][1] = *(const f32x4*)(rp + EPI_COL(bj) + 4); } }
#pragma unroll
            for (int m = 0; m < 4; ++m) { const int row = EPI_ROW(ai, m);
                float sq = 0.f;
#pragma unroll
                for (int bj = 0; bj < 2; ++bj) { const int col = EPI_COL(bj);
                    const f32x4 x0 = rv[m][bj][0] + acc[ai][bj][m][0] * scale, x1 = rv[m][bj][1] + acc[ai][bj][m][1] * scale;
                    *(f32x4*)(xout + (size_t)row * DM + col) = x0; *(f32x4*)(xout + (size_t)row * DM + col + 4) = x1;
#pragma unroll
                    for (int j = 0; j < 4; ++j) sq += x0[j] * x0[j] + x1[j] * x1[j];
                    if (aout) *(u32x4*)(aout + (size_t)row * DM + col) = __builtin_bit_cast(u32x4, pack8(x0 * gv[bj][0], x1 * gv[bj][1])); }
                sq = xsum16_32(sq);
                if (fq == 0) ss[(size_t)row * 16 + u.pn * 4 + wc] = sq; }
        }
    }
    __device__ __forceinline__ void small(f32x4 acc, int row, int col, int tc, int rt, int ct, int l16, int g, unsigned char* lds) const {
        const f32x4 x = *(const f32x4*)(res1 + (size_t)(row - MP) * DM + col) + acc * scale;
        *(f32x4*)(xout + (size_t)row * DM + col) = x;
        if (aout) { const f32x4 gv4 = *(const f32x4*)(gain + col); *(u32x2*)(aout + (size_t)row * DM + col) = pack4(x * gv4); }
        float sq = x[0] * x[0] + x[1] * x[1] + x[2] * x[2] + x[3] * x[3];
        sq = xsum16_32(sq);
        float* red = (float*)lds;
        if (g == 0) red[(rt * 4 + ct) * 16 + l16] = sq;
        __syncthreads();
        if (ct == 0 && g == 0) ss[(size_t)row * 16 + tc] = (red[(rt * 4) * 16 + l16] + red[(rt * 4 + 1) * 16 + l16]) + (red[(rt * 4 + 2) * 16 + l16] + red[(rt * 4 + 3) * 16 + l16]);
        __syncthreads();
    }
};
struct EpiZ {
    static constexpr bool PERM = true, AFTER_DRAIN = false;
    bf16_t* Z; float* ZS; const float* ss;
    __device__ __forceinline__ void operator()(const f32x4 (&acc)[2][2][4][2], const pg8::Unit& u, int wr, int wc, int fr, int fq) const {
#pragma unroll
        for (int ai = 0; ai < 2; ++ai) {
            float rsv[4];
#pragma unroll
            for (int m = 0; m < 4; ++m) rsv[m] = rs_row(ss, EPI_ROW(ai, m));
#pragma unroll
            for (int m = 0; m < 4; ++m) { const int row = EPI_ROW(ai, m); const float rs = rsv[m];
                if (u.pn < 32) {
#pragma unroll
                    for (int bj = 0; bj < 2; ++bj)
                        *(u32x4*)(Z + (size_t)row * ZLD + EPI_COL(bj)) = __builtin_bit_cast(u32x4, pack8(acc[ai][bj][m][0] * rs, acc[ai][bj][m][1] * rs));
                } else if (wc == 0) {
                    *(f32x4*)(ZS + (size_t)row * ZSLD + fq * 8) = acc[ai][0][m][0] * rs; *(f32x4*)(ZS + (size_t)row * ZSLD + fq * 8 + 4) = acc[ai][0][m][1] * rs;
                } } }
    }
};
template <int MODE> struct EpiMerge {
    static constexpr bool PERM = true, AFTER_DRAIN = false;
    const bf16_t* gate; float* T; bf16_t* Y;
    __device__ __forceinline__ void operator()(const f32x4 (&acc)[2][2][4][2], const pg8::Unit& u, int wr, int wc, int fr, int fq) const {
#pragma unroll
        for (int ai = 0; ai < 2; ++ai)
#pragma unroll
            for (int mh = 0; mh < 2; ++mh) {
                u32x4 gw[2][2]; u32x4 tvb[2][2]; bf16_t* Tb = (bf16_t*)T;
#pragma unroll
                for (int mm = 0; mm < 2; ++mm) { const int row = EPI_ROW(ai, mh * 2 + mm);
#pragma unroll
                    for (int bj = 0; bj < 2; ++bj) { gw[mm][bj] = *(const u32x4*)(gate + (size_t)row * ZLD + EPI_COL(bj));
                        if (MODE == 1) tvb[mm][bj] = *(const u32x4*)(Tb + (size_t)row * DM + EPI_COL(bj)); } }
#pragma unroll
                for (int mm = 0; mm < 2; ++mm) { const int m = mh * 2 + mm, row = EPI_ROW(ai, m);
#pragma unroll
                    for (int bj = 0; bj < 2; ++bj) { const int col = EPI_COL(bj); const u32x4 g4 = gw[mm][bj];
                        f32x4 s0, s1;
                        s0[0] = sigmoidf_(bflo(g4.x)); s0[1] = sigmoidf_(bfhi(g4.x)); s0[2] = sigmoidf_(bflo(g4.y)); s0[3] = sigmoidf_(bfhi(g4.y));
                        s1[0] = sigmoidf_(bflo(g4.z)); s1[1] = sigmoidf_(bfhi(g4.z)); s1[2] = sigmoidf_(bflo(g4.w)); s1[3] = sigmoidf_(bfhi(g4.w));
                        f32x4 v0 = acc[ai][bj][m][0] * s0, v1 = acc[ai][bj][m][1] * s1;
                        if (MODE == 0) *(u32x4*)(Tb + (size_t)row * DM + col) = __builtin_bit_cast(u32x4, pack8(v0, v1));
                        else { const u32x4 t4 = tvb[mm][bj];
                            v0 += (f32x4){bflo(t4.x), bfhi(t4.x), bflo(t4.y), bfhi(t4.y)}; v1 += (f32x4){bflo(t4.z), bfhi(t4.z), bflo(t4.w), bfhi(t4.w)};
                            *(u32x4*)(Y + (size_t)row * DM + col) = __builtin_bit_cast(u32x4, pack8(v0, v1)); } } }
            }
    }
    __device__ __forceinline__ void small(f32x4 acc, int row, int col, int tc, int rt, int ct, int l16, int g, unsigned char* lds) const {
        bf16_t* Tb = (bf16_t*)T;
        const u32x2 g2 = *(const u32x2*)(gate + (size_t)row * ZLD + col);
        f32x4 v = acc * (f32x4){sigmoidf_(bflo(g2.x)), sigmoidf_(bfhi(g2.x)), sigmoidf_(bflo(g2.y)), sigmoidf_(bfhi(g2.y))};
        if (MODE == 0) *(u32x2*)(Tb + (size_t)row * DM + col) = pack4(v);
        else { const u32x2 t2 = *(const u32x2*)(Tb + (size_t)row * DM + col);
            v += (f32x4){bflo(t2.x), bfhi(t2.x), bflo(t2.y), bfhi(t2.y)};
            *(u32x2*)(Y + (size_t)row * DM + col) = pack4(v); }
    }
};
struct EpiQ {
    static constexpr bool PERM = true, AFTER_DRAIN = false;
    bf16_t* Q; const float* ss;
    __device__ __forceinline__ void operator()(const f32x4 (&acc)[2][2][4][2], const pg8::Unit& u, int wr, int wc, int fr, int fq) const {
#pragma unroll
        for (int ai = 0; ai < 2; ++ai) {
            float rsv[4];
#pragma unroll
            for (int m = 0; m < 4; ++m) rsv[m] = rs_row(ss, EPI_ROW(ai, m));
#pragma unroll
            for (int m = 0; m < 4; ++m) { const int row = EPI_ROW(ai, m); const float rs = rsv[m];
#pragma unroll
                for (int bj = 0; bj < 2; ++bj)
                    *(u32x4*)(Q + (size_t)row * DM + EPI_COL(bj)) = __builtin_bit_cast(u32x4, pack8(acc[ai][bj][m][0] * rs, acc[ai][bj][m][1] * rs)); } }
    }
    __device__ __forceinline__ void small(f32x4 acc, int row, int col, int tc, int rt, int ct, int l16, int g, unsigned char* lds) const {
        *(u32x2*)(Q + (size_t)row * DM + col) = pack4(acc * rs_row(ss, row));
    }
};
template <class Epi>
__device__ __forceinline__ void small_gemm(unsigned char* lds, const bf16_t* A, int lda, const bf16_t* Bt, int N, int K, const Epi& E) {
    const int tid = threadIdx.x, w = tid >> 6, lane = tid & 63, g = lane >> 4, l16 = lane & 15;
    const int rt = w >> 2, ct = w & 3, nct = N / 64, ntiles = 16 * nct;
    for (int t = blockIdx.x; t < ntiles; t += gridDim.x) {
        const int tr = t / nct, tc = t - tr * nct;
        const int row = MP + tr * 32 + rt * 16 + l16, colb = tc * 64 + ct * 16;
        const bf16_t* ap = A + (size_t)row * lda + 8 * g;
        const bf16_t* bp = Bt + (size_t)(colb + l16) * K + 8 * g;
        f32x4 acc0 = (f32x4){0.f, 0.f, 0.f, 0.f}, acc1 = acc0;
#pragma unroll 4
        for (int k = 0; k < K; k += 64) {
            acc0 = mfma16(*(const bf16x8*)(bp + k), *(const bf16x8*)(ap + k), acc0);
            acc1 = mfma16(*(const bf16x8*)(bp + k + 32), *(const bf16x8*)(ap + k + 32), acc1);
        }
        E.small(acc0 + acc1, row, colb + 4 * g, tc, rt, ct, l16, g, lds);
    }
}
template <class Epi>
__device__ __forceinline__ void run_gemm(unsigned char* lds, const bf16_t* A, int lda, const bf16_t* Bt, int M, int N, int K, const Epi& E, int rot) {
    pg8::Gemm g; g.A = A; g.Bt = Bt; g.M = M; g.N = N; g.K = K; g.lda = lda; g.ldb = K;
    pg8::StaticOrder S; S.init(M, N, (int)gridDim.x, (int)((blockIdx.x + rot) % gridDim.x));
    pg8::gemm_phase<Epi, pg8::StaticOrder>((PG8_LAS unsigned char*)lds, g, S, E);
    __syncthreads();
}
constexpr int T_STRIDE = 272, V_STRIDE = 528;
constexpr int VQN = 2, VW = 256 / VQN, NVT = VW / 16, NOT = NVT / 2, V2_STRIDE = VW * 2 + 16;
constexpr int M_T0 = 0, M_T1 = 17408, M_TV = 34816, M_TC = M_TV + 64 * V2_STRIDE, M_SM = M_TC + VW * T_STRIDE;
template <int BR>
__device__ __forceinline__ void mixer_prompt(const Params& p, unsigned char* lds, int b, int h, int vq) {
    const int tid = threadIdx.x, w = tid >> 6, lane = tid & 63, g = lane >> 4, l16 = lane & 15, q4 = l16 >> 2, p4 = lane & 3;
    const int tt = w & 3, vh = w >> 2;
    bf16_t* Z = (bf16_t*)(p.ws + WS_Z);
    const float* ZS = (const float*)(p.ws + WS_ZS);
    float* SSQ = (float*)(p.ws + WS_SSQ);
    const float* BEND = (const float*)(p.ws + WS_BEND);
    const int qcol = (BR == 0 ? 0 : 3072) + h * 128, kcol = (BR == 0 ? 512 : 3584) + h * 128;
    const int vcol = (BR == 0 ? 1024 : 4096) + h * 256 + vq * VW, ocol = (BR == 0 ? 2048 : 5120) + h * 256 + vq * VW;
    unsigned char* T0 = lds + M_T0; unsigned char* T1 = lds + M_T1; unsigned char* TV = lds + M_TV; unsigned char* TC = lds + M_TC;
    float* sm = (float*)(lds + M_SM);
    float* gS = sm; float* Mt = sm + 64; float* at = sm + 128; float* emt = sm + 192; float* wsv = sm + 256; float* nvec = sm + 320; float* bend = sm + 448;
    float* misc = sm + 576; float* ssq = sm + 592; float* gaL = sm + 720; float* segtot = sm + 1744; float* waL = sm + 2256;
    const unsigned aT0_ = (unsigned)(size_t)T0, aT1_ = (unsigned)(size_t)T1, aTV_ = (unsigned)(size_t)TV;
    const float* gain = (BR == 0 ? p.in[18] : p.in[19]) + h * 256 + vq * VW;
    const int tloc = 16 * tt + l16;
    f32x4 gn[NOT];
#pragma unroll
    for (int vi = 0; vi < NOT; ++vi) gn[vi] = *(const f32x4*)(gain + (VW / 2) * vh + 16 * vi + 4 * g);
    f32x4 st[NVT];
#pragma unroll
    for (int c = 0; c < NVT; ++c) st[c] = (f32x4){0.f, 0.f, 0.f, 0.f};
    float m0 = 0.f;
    const float bi = (BR == 0) ? p.in[15][h] : 0.f, bfb = (BR == 0) ? p.in[15][4 + h] : 0.f;
    if (tid < 128) nvec[tid] = 0.f;
    u32x4 kreg[2], qreg[2], vreg[2]; bf16x8 qn[4]; float igr = 0.f, lfr = 0.f, gar[2] = {0.f, 0.f};
    const int ks_s0 = tid >> 4, ks_ch = tid & 15;
#define MIX_LOAD_CHUNK(R0) do { const size_t r_ = (size_t)(R0); \
        kreg[0] = *(const u32x4*)(Z + (r_ + ks_s0) * ZLD + kcol + ks_ch * 8); kreg[1] = *(const u32x4*)(Z + (r_ + ks_s0 + 32) * ZLD + kcol + ks_ch * 8); \
        vreg[0] = *(const u32x4*)(Z + (r_ + ks_s0) * ZLD + vcol + ks_ch * 8); vreg[1] = *(const u32x4*)(Z + (r_ + ks_s0 + 32) * ZLD + vcol + ks_ch * 8); \
        if (BR == 0) { _Pragma("unroll") for (int ks = 0; ks < 4; ++ks) qn[ks] = *(const bf16x8*)(Z + (r_ + tloc) * ZLD + qcol + 32 * ks + 8 * g); \
            if (w == 0) { igr = ZS[(r_ + lane) * ZSLD + h]; lfr = ZS[(r_ + lane) * ZSLD + 4 + h]; } } \
        else { qreg[0] = *(const u32x4*)(Z + (r_ + ks_s0) * ZLD + qcol + ks_ch * 8); qreg[1] = *(const u32x4*)(Z + (r_ + ks_s0 + 32) * ZLD + qcol + ks_ch * 8); \
            if (tid < 128) gar[0] = BEND[(r_ >> 6) * 512 + h * 128 + tid]; } } while (0)
    MIX_LOAD_CHUNK(b * 2048);
    __syncthreads();
    for (int c = 0; c < 32; ++c) {
        const int r0 = b * 2048 + c * 64;
        if (c > 0 && tid < 64) { float* sp_ = SSQ + ((size_t)(r0 - 64 + tid) * 8 + BR * 4 + h) * 4 + vq * 2; sp_[0] = ssq[tid] + ssq[64 + tid]; sp_[1] = 0.f; }
        unsigned aT0 = aT0_, aT1 = aT1_, aTV = aTV_;
        asm volatile("" : "+v"(aT0), "+v"(aT1), "+v"(aTV));
        if (BR == 0) {
            if (w == 0) {
                const float ig = igr + bi, lf = logsigf_(lfr + bfb);
                float F = lf;
#pragma unroll
                for (int o = 1; o < 64; o <<= 1) { const float y = __shfl_up(F, o); if (lane >= o) F += y; }
                const float gg = ig - F; float cm = gg;
#pragma unroll
                for (int o = 1; o < 64; o <<= 1) { const float y = __shfl_up(cm, o); if (lane >= o) cm = fmaxf(cm, y); }
                const float M = fmaxf(m0, cm), a = __expf(m0 - M);
                const float ML = __shfl(M, 63), aend = __shfl(a, 63), FL = __shfl(F, 63);
                gS[lane] = gg; Mt[lane] = M; at[lane] = a; emt[lane] = __expf(-(F + M)); wsv[lane] = __expf(gg - ML);
                if (lane == 0) misc[1] = aend;
                m0 = FL + ML;
            }
            __syncthreads();
#pragma unroll
            for (int i = 0; i < 2; ++i) { const int s = ks_s0 + 32 * i; const u32x4 kw = kreg[i];
                *(u32x4*)(T0 + s * T_STRIDE + ks_ch * 16) = kw;
                const float ww = wsv[s]; u32x4 o;
                o.x = cvt_pk(bflo(kw.x) * ww, bfhi(kw.x) * ww); o.y = cvt_pk(bflo(kw.y) * ww, bfhi(kw.y) * ww);
                o.z = cvt_pk(bflo(kw.z) * ww, bfhi(kw.z) * ww); o.w = cvt_pk(bflo(kw.w) * ww, bfhi(kw.w) * ww);
                *(u32x4*)(T1 + s * T_STRIDE + ks_ch * 16) = o; }
        } else {
            if (tid < 128) bend[tid] = gar[0];
#pragma unroll
            for (int i = 0; i < 2; ++i) { const int s = ks_s0 + 32 * i;
                *(u32x4*)(T0 + s * T_STRIDE + ks_ch * 16) = kreg[i]; *(u32x4*)(T1 + s * T_STRIDE + ks_ch * 16) = qreg[i]; }
        }
#pragma unroll
        for (int i = 0; i < 2; ++i) *(u32x4*)(TV + (ks_s0 + 32 * i) * V2_STRIDE + ks_ch * 16) = vreg[i];
#pragma unroll
        for (int c16 = 0; c16 < NVT; ++c16) *(u32x2*)(TC + (16 * c16 + l16) * T_STRIDE + (16 * w + 4 * g) * 2) = pack4(st[c16]);
        __syncthreads();
        bf16x8 qf[4];
#pragma unroll
        for (int ks = 0; ks < 4; ++ks) {
            if (BR == 0) qf[ks] = qn[ks];
            else qf[ks] = *(const bf16x8*)(T1 + tloc * T_STRIDE + (32 * ks + 8 * g) * 2);
        }
        bf16_t* op = Z + (size_t)(r0 + tloc) * ZLD + ocol + (VW / 2) * vh + 4 * g;
        u32x2 gwv[NOT];
#pragma unroll
        for (int vi = 0; vi < NOT; ++vi) gwv[vi] = *(const u32x2*)(op + 16 * vi);
        if (c < 31) MIX_LOAD_CHUNK(r0 + 64);
        f32x4 sacc[4];
#pragma unroll
        for (int si = 0; si < 4; ++si) { sacc[si] = (f32x4){0.f, 0.f, 0.f, 0.f};
#pragma unroll
            for (int ks = 0; ks < 4; ++ks) sacc[si] = mfma16(*(const bf16x8*)(T0 + (16 * si + l16) * T_STRIDE + (32 * ks + 8 * g) * 2), qf[ks], sacc[si]); }
        float den = 0.f;
        {
            const float Mtt = (BR == 0) ? Mt[tloc] : 0.f;
            f32x4 gS4[4];
#pragma unroll
            for (int si = 0; si < 4; ++si) gS4[si] = (BR == 0) ? *(const f32x4*)(gS + 16 * si + 4 * g) : (f32x4){0.f, 0.f, 0.f, 0.f};
#pragma unroll
            for (int si = 0; si < 4; ++si)
#pragma unroll
                for (int r = 0; r < 4; ++r) { const int s = 16 * si + 4 * g + r;
                    float wgt;
                    if (BR == 0) { const float e = __expf(fminf(gS4[si][r] - Mtt, 0.f)); wgt = (s <= tloc) ? e : 0.f; } else wgt = (s <= tloc) ? 1.f : 0.f;
                    sacc[si][r] *= wgt; den += sacc[si][r]; }
        }
        f32x4 oacc[NOT];
#pragma unroll
        for (int vi = 0; vi < NOT; ++vi) { oacc[vi] = (f32x4){0.f, 0.f, 0.f, 0.f};
#pragma unroll
            for (int ks = 0; ks < 4; ++ks) oacc[vi] = mfma16(*(const bf16x8*)(TC + ((VW / 2) * vh + 16 * vi + l16) * T_STRIDE + (32 * ks + 8 * g) * 2), qf[ks], oacc[vi]); }
        if (BR == 0) {
            den = xsum16_32(den);
            const float a_t = at[tloc];
            float nq = 0.f;
#pragma unroll
            for (int ks = 0; ks < 4; ++ks)
#pragma unroll
                for (int j = 0; j < 8; ++j) nq += nvec[32 * ks + 8 * g + j] * bf2f((bf16_t)qf[ks][j]);
            nq = xsum16_32(nq);
            den += a_t * nq;
#pragma unroll
            for (int vi = 0; vi < NOT; ++vi) oacc[vi] *= a_t;
        }
#pragma unroll
        for (int ks = 0; ks < 2; ++ks) {
            const bf16x8 pb = pack8(sacc[2 * ks], sacc[2 * ks + 1]);
#pragma unroll
            for (int vi = 0; vi < NOT; vi += 4) {
                const unsigned a0 = aTV + (32 * ks + 4 * g + q4) * V2_STRIDE + ((VW / 2) * vh + 16 * vi) * 2 + 8 * p4, a1 = a0 + 16 * V2_STRIDE;
                bf16x8 fa, fb, fc, fd; tr_frag4(a0, a1, a0 + 32, a1 + 32, a0 + 64, a1 + 64, a0 + 96, a1 + 96, fa, fb, fc, fd);
                oacc[vi] = mfma16(fa, pb, oacc[vi]); oacc[vi + 1] = mfma16(fb, pb, oacc[vi + 1]); oacc[vi + 2] = mfma16(fc, pb, oacc[vi + 2]); oacc[vi + 3] = mfma16(fd, pb, oacc[vi + 3]); }
        }
        if (BR == 0) { const float inv = 1.f / fmaxf(fabsf(den), emt[tloc]);
#pragma unroll
            for (int vi = 0; vi < NOT; ++vi) oacc[vi] *= inv; }
        float sq = 0.f;
#pragma unroll
        for (int vi = 0; vi < NOT; ++vi)
#pragma unroll
            for (int r = 0; r < 4; ++r) sq += oacc[vi][r] * oacc[vi][r];
        sq = xsum16_32(sq);
        if (g == 0) ssq[vh * 64 + tloc] = sq;
#pragma unroll
        for (int vi = 0; vi < NOT; ++vi) {
            const float gt[4] = {bflo(gwv[vi].x), bfhi(gwv[vi].x), bflo(gwv[vi].y), bfhi(gwv[vi].y)}; f32x4 o;
#pragma unroll
            for (int r = 0; r < 4; ++r) { const float sg = sigmoidf_(gt[r]); o[r] = oacc[vi][r] * gn[vi][r] * (BR == 0 ? sg : gt[r] * sg); }
            *(u32x2*)(op + 16 * vi) = pack4(o); }
        if (BR == 0) { const float aend = misc[1];
#pragma unroll
            for (int c16 = 0; c16 < NVT; ++c16) st[c16] *= aend; }
#pragma unroll
        for (int ks = 0; ks < 2; ++ks) {
            const unsigned ka0 = (BR == 0 ? aT1 : aT0) + (32 * ks + 8 * g + q4) * T_STRIDE + (16 * w) * 2 + 8 * p4;
            const bf16x8 kf = tr_frag(ka0, ka0 + 4 * T_STRIDE);
#pragma unroll
            for (int c16 = 0; c16 < NVT; c16 += 4) {
                const unsigned v0 = aTV + (32 * ks + 8 * g + q4) * V2_STRIDE + (16 * c16) * 2 + 8 * p4, v1 = v0 + 4 * V2_STRIDE;
                bf16x8 fa, fb, fc, fd; tr_frag4(v0, v1, v0 + 32, v1 + 32, v0 + 64, v1 + 64, v0 + 96, v1 + 96, fa, fb, fc, fd);
                st[c16] = mfma16(kf, fa, st[c16]); st[c16 + 1] = mfma16(kf, fb, st[c16 + 1]); st[c16 + 2] = mfma16(kf, fc, st[c16 + 2]); st[c16 + 3] = mfma16(kf, fd, st[c16 + 3]);
            }
        }
        if (BR == 1) {
            float eb[4];
#pragma unroll
            for (int r = 0; r < 4; ++r) eb[r] = __expf(bend[16 * w + 4 * g + r]);
#pragma unroll
            for (int c16 = 0; c16 < NVT; ++c16)
#pragma unroll
                for (int r = 0; r < 4; ++r) st[c16][r] *= eb[r];
        } else {
            const int d = tid & 127, seg = tid >> 7; float a2 = 0.f;
#pragma unroll
            for (int s = 0; s < 16; ++s) a2 += bf2f(*(const bf16_t*)(T1 + (seg * 16 + s) * T_STRIDE + d * 2));
            segtot[seg * 128 + d] = a2;
        }
        __syncthreads();
        if (BR == 0 && tid < 128) nvec[tid] = misc[1] * nvec[tid] + ((segtot[tid] + segtot[128 + tid]) + (segtot[256 + tid] + segtot[384 + tid]));
    }
#undef MIX_LOAD_CHUNK
    if (tid < 64) { float* sp_ = SSQ + ((size_t)(b * 2048 + 31 * 64 + tid) * 8 + BR * 4 + h) * 4 + vq * 2; sp_[0] = ssq[tid] + ssq[64 + tid]; sp_[1] = 0.f; }
    const int bh = b * 4 + h;
    if (BR == 0) {
        float* Co = p.out + O_CP + (size_t)bh * 32768;
#pragma unroll
        for (int c16 = 0; c16 < NVT; ++c16) *(f32x4*)(Co + (size_t)(VW * vq + 16 * c16 + l16) * 128 + 16 * w + 4 * g) = st[c16];
        if (vq == 0) { if (tid < 128) p.out[O_NP + bh * 128 + tid] = nvec[tid];
            if (tid == 0) p.out[O_MPP + bh] = m0; }
    } else {
        float* So = p.out + O_SP + (size_t)bh * 32768;
#pragma unroll
        for (int c16 = 0; c16 < NVT; ++c16)
#pragma unroll
            for (int r = 0; r < 4; ++r) So[(size_t)(16 * w + 4 * g + r) * 256 + VW * vq + 16 * c16 + l16] = st[c16][r];
    }
    __syncthreads();
}

__device__ __forceinline__ void gla_prep(const Params& p, unsigned char* lds, int item) {
    const int tid = threadIdx.x, d = tid & 127, seg = tid >> 7;
    const int h = item & 3, c = (item >> 2) & 31, b = item >> 7;
    bf16_t* Z = (bf16_t*)(p.ws + WS_Z);
    const float* ZS = (const float*)(p.ws + WS_ZS);
    float* BEND = (float*)(p.ws + WS_BEND);
    float* gaL = (float*)lds; float* waL = gaL + 1024; float* segtot = waL + 2048;
    const int r0 = b * 2048 + c * 64, qcol = 3072 + h * 128, kcol = 3584 + h * 128;
    gaL[tid] = ZS[(size_t)(r0 + (tid >> 4)) * ZSLD + 8 + (tid & 15)]; gaL[tid + 512] = ZS[(size_t)(r0 + 32 + (tid >> 4)) * ZSLD + 8 + (tid & 15)];
#pragma unroll
    for (int j = 0; j < 4; ++j) { const int id = tid + 512 * j; waL[id] = p.in[16][(id >> 7) * 512 + h * 128 + (id & 127)]; }
    const float ba = p.in[17][h * 128 + d];
    __syncthreads();
    float wa[16];
#pragma unroll
    for (int j = 0; j < 16; ++j) wa[j] = waL[j * 128 + d];
    float la[16]; float run = 0.f;
#pragma unroll
    for (int i = 0; i < 16; ++i) { const int t = seg * 16 + i; float x = ba;
#pragma unroll
        for (int j = 0; j < 16; ++j) x += gaL[t * 16 + j] * wa[j];
        run += logsigf_(x) * 0.0625f; la[i] = run; }
    segtot[seg * 128 + d] = run;
    __syncthreads();
    float pre = 0.f, tot = 0.f;
#pragma unroll
    for (int s2 = 0; s2 < 4; ++s2) { const float v = segtot[s2 * 128 + d]; tot += v; if (s2 < seg) pre += v; }
    if (seg == 0) BEND[(size_t)(b * 32 + c) * 512 + h * 128 + d] = tot;
    bf16_t qv[16], kv[16];
#pragma unroll
    for (int i = 0; i < 16; ++i) { const int t = seg * 16 + i; qv[i] = Z[(size_t)(r0 + t) * ZLD + qcol + d]; kv[i] = Z[(size_t)(r0 + t) * ZLD + kcol + d]; }
#pragma unroll
    for (int i = 0; i < 16; ++i) { const int t = seg * 16 + i; const float bb = la[i] + pre;
        Z[(size_t)(r0 + t) * ZLD + qcol + d] = f2bf(bf2f(qv[i]) * __expf(bb)); Z[(size_t)(r0 + t) * ZLD + kcol + d] = f2bf(bf2f(kv[i]) * __expf(-bb)); }
    __syncthreads();
}

template <int BR>
__device__ __forceinline__ void mixer_sample(const Params& p, unsigned char* lds, int b, int h) {
    const int tid = threadIdx.x, w = tid >> 6, lane = tid & 63;
    bf16_t* Z = (bf16_t*)(p.ws + WS_Z);
    const float* ZS = (const float*)(p.ws + WS_ZS);
    const int qcol = (BR == 0 ? 0 : 3072) + h * 128, kcol = (BR == 0 ? 512 : 3584) + h * 128, vcol = (BR == 0 ? 1024 : 4096) + h * 256, ocol = (BR == 0 ? 2048 : 5120) + h * 256;
    float* sm = (float*)lds;
    float* qa = sm; float* ka = sm + 512; float* kd = sm + 1024; float* dec = sm + 1536; float* vv = sm + 1664; float* qk = sm + 2688; float* sc = sm + 2704;
    float* part = sm + 2752; float* red = sm + 4800;
    const int r0 = MP + 4 * b, bh = b * 4 + h;
    const float* gain = (BR == 0 ? p.in[18] : p.in[19]) + h * 256;
    float a_t[4] = {1.f, 1.f, 1.f, 1.f}, mt[4] = {0.f, 0.f, 0.f, 0.f}, aend = 1.f;
    {
        const int t = tid >> 7, d = tid & 127;
        const float qraw = bf2f(Z[(size_t)(r0 + t) * ZLD + qcol + d]), kraw = bf2f(Z[(size_t)(r0 + t) * ZLD + kcol + d]);
#pragma unroll
        for (int i = 0; i < 2; ++i) { const int id = tid + 512 * i; vv[id] = bf2f(Z[(size_t)(r0 + (id >> 8)) * ZLD + vcol + (id & 255)]); }
        if (BR == 0) {
            const float m0 = p.in[5][bh], bi = p.in[15][h], bfb = p.in[15][4 + h];
            float F = 0.f, cm = -3.0e38f, gg[4], Mv[4];
#pragma unroll
            for (int s = 0; s < 4; ++s) { const float ig = ZS[(size_t)(r0 + s) * ZSLD + h] + bi, lf = logsigf_(ZS[(size_t)(r0 + s) * ZSLD + 4 + h] + bfb);
                F += lf; gg[s] = ig - F; cm = fmaxf(cm, gg[s]); Mv[s] = fmaxf(m0, cm); a_t[s] = __expf(m0 - Mv[s]); mt[s] = F + Mv[s]; }
            aend = a_t[3];
            float wsel = 0.f;
#pragma unroll
            for (int s = 0; s < 4; ++s) { const float ws_ = __expf(gg[s] - Mv[3]); if (s == t) wsel = ws_; }
            qa[tid] = qraw; ka[tid] = kraw; kd[tid] = wsel * kraw;
            if (tid < 128) dec[tid] = aend;
            if (tid == 0) {
#pragma unroll
                for (int s = 0; s < 4; ++s) { sc[16 + s] = gg[s]; sc[20 + s] = Mv[s]; } }
        } else {
            float la[4];
#pragma unroll
            for (int s = 0; s < 4; ++s) { float x = p.in[17][h * 128 + d];
#pragma unroll
                for (int j = 0; j < 16; ++j) x += ZS[(size_t)(r0 + s) * ZSLD + 8 + j] * p.in[16][j * 512 + h * 128 + d];
                la[s] = logsigf_(x) * 0.0625f; }
            float bt = 0.f, bendv = 0.f;
#pragma unroll
            for (int s = 0; s < 4; ++s) { bendv += la[s]; if (s <= t) bt += la[s]; }
            qa[tid] = qraw * __expf(bt); ka[tid] = kraw * __expf(-bt); kd[tid] = kraw * __expf(bendv - bt);
            if (t == 0) dec[d] = __expf(bendv);
        }
    }
    __syncthreads();
    {
        const int pr = tid >> 5, l = tid & 31, t = pr >> 2, s = pr & 3;
        const f32x4 a = *(const f32x4*)(qa + t * 128 + l * 4), k4 = *(const f32x4*)(ka + s * 128 + l * 4);
        float v = a[0] * k4[0] + a[1] * k4[1] + a[2] * k4[2] + a[3] * k4[3];
#pragma unroll
        for (int o = 16; o > 0; o >>= 1) v += __shfl_xor(v, o);
        if (l == 0) { float wgt; if (BR == 0) wgt = (s <= t) ? __expf(sc[16 + s] - sc[20 + t]) : 0.f; else wgt = (s <= t) ? 1.f : 0.f; qk[pr] = v * wgt; }
        if (BR == 0 && tid < 128) {
            const int t2 = tid >> 5;
            const f32x4 n4 = *(const f32x4*)(p.in[4] + (size_t)bh * 128 + l * 4), q4v = *(const f32x4*)(qa + t2 * 128 + l * 4);
            float v2 = n4[0] * q4v[0] + n4[1] * q4v[1] + n4[2] * q4v[2] + n4[3] * q4v[3];
#pragma unroll
            for (int o = 16; o > 0; o >>= 1) v2 += __shfl_xor(v2, o);
            if (l == 0) sc[12 + t2] = v2;
        }
    }
    __syncthreads();
    float hv[4]; int vown; bool owner;
    if (BR == 0) {
        const int l32 = lane & 31, half = lane >> 5;
        const float* C0 = p.in[3] + (size_t)bh * 32768 + 4 * l32;
        float* C1 = p.out + O_CS + (size_t)bh * 32768 + 4 * l32;
        f32x4 qa4[4], kd4[4]; const f32x4 dec4 = *(const f32x4*)(dec + 4 * l32);
#pragma unroll
        for (int t = 0; t < 4; ++t) { qa4[t] = *(const f32x4*)(qa + t * 128 + 4 * l32); kd4[t] = *(const f32x4*)(kd + t * 128 + 4 * l32); }
#pragma unroll
        for (int ib = 0; ib < 16; ib += 8) {
            f32x4 cv[8];
#pragma unroll
            for (int e = 0; e < 8; ++e) cv[e] = __builtin_nontemporal_load((const f32x4*)(C0 + (size_t)(w * 32 + 2 * (ib + e) + half) * 128));
#pragma unroll
            for (int e = 0; e < 8; ++e) { const int v = w * 32 + 2 * (ib + e) + half; const f32x4 c = cv[e];
                float wv[4], pt[4];
#pragma unroll
                for (int s = 0; s < 4; ++s) wv[s] = vv[s * 256 + v];
                f32x4 o = dec4 * c;
#pragma unroll
                for (int s = 0; s < 4; ++s) o += kd4[s] * wv[s];
                __builtin_nontemporal_store(o, (f32x4*)(C1 + (size_t)v * 128));
#pragma unroll
                for (int t = 0; t < 4; ++t) { float x = c[0] * qa4[t][0] + c[1] * qa4[t][1] + c[2] * qa4[t][2] + c[3] * qa4[t][3];
#pragma unroll
                    for (int of = 16; of > 0; of >>= 1) x += __shfl_xor(x, of);
                    pt[t] = x; }
                if (l32 == 0) {
#pragma unroll
                    for (int t = 0; t < 4; ++t) part[t * 256 + v] = pt[t]; }
            }
        }
        if (tid < 128) { float acc = aend * p.in[4][(size_t)bh * 128 + tid];
#pragma unroll
            for (int s = 0; s < 4; ++s) acc += kd[s * 128 + tid];
            p.out[O_NS + (size_t)bh * 128 + tid] = acc; }
        if (tid == 0) p.out[O_MSS + bh] = mt[3];
        __syncthreads();
        vown = tid & 255; owner = (tid < 256);
        {
            float wv2[4];
#pragma unroll
            for (int s = 0; s < 4; ++s) wv2[s] = vv[s * 256 + vown];
#pragma unroll
            for (int t = 0; t < 4; ++t) { float num = a_t[t] * part[t * 256 + vown], den = a_t[t] * sc[12 + t];
#pragma unroll
                for (int s = 0; s < 4; ++s) { num += qk[t * 4 + s] * wv2[s]; den += qk[t * 4 + s]; }
                hv[t] = num / fmaxf(fabsf(den), __expf(-mt[t])); }
        }
    } else {
        const int v4 = lane * 4;
        const float* S0 = p.in[6] + ((size_t)bh * 128 + 16 * w) * 256 + v4;
        float* S1 = p.out + O_SS + ((size_t)bh * 128 + 16 * w) * 256 + v4;
        float* part8 = sm + 4864;
        f32x4 wv4[4], pt4[4];
#pragma unroll
        for (int s = 0; s < 4; ++s) { wv4[s] = *(const f32x4*)(vv + s * 256 + v4); pt4[s] = (f32x4){0.f, 0.f, 0.f, 0.f}; }
#pragma unroll
        for (int jb = 0; jb < 16; jb += 8) {
            f32x4 s0v[8];
#pragma unroll
            for (int e = 0; e < 8; ++e) s0v[e] = __builtin_nontemporal_load((const f32x4*)(S0 + (size_t)(jb + e) * 256));
#pragma unroll
            for (int e = 0; e < 8; ++e) { const int j = jb + e, d = 16 * w + j; const f32x4 s0 = s0v[e];
                f32x4 acc = s0 * dec[d];
#pragma unroll
                for (int t = 0; t < 4; ++t) pt4[t] += s0 * qa[t * 128 + d];
#pragma unroll
                for (int s2 = 0; s2 < 4; ++s2) acc += wv4[s2] * kd[s2 * 128 + d];
                __builtin_nontemporal_store(acc, (f32x4*)(S1 + (size_t)j * 256)); } }
#pragma unroll
        for (int t = 0; t < 4; ++t) *(f32x4*)(part8 + (w * 4 + t) * 256 + v4) = pt4[t];
        __syncthreads();
        vown = tid & 255; owner = (tid < 256);
#pragma unroll
        for (int t = 0; t < 4; ++t) { float num = 0.f;
#pragma unroll
            for (int w2 = 0; w2 < 8; ++w2) num += part8[(w2 * 4 + t) * 256 + vown];
#pragma unroll
            for (int s2 = 0; s2 < 4; ++s2) num += qk[t * 4 + s2] * vv[s2 * 256 + vown];
            hv[t] = num; }
    }
#pragma unroll
    for (int t = 0; t < 4; ++t) { float q2 = owner ? hv[t] * hv[t] : 0.f; q2 = wave_sum(q2); if (lane == 0) red[w * 4 + t] = q2; }
    __syncthreads();
    if (owner) {
#pragma unroll
        for (int t = 0; t < 4; ++t) { float tot = 0.f;
#pragma unroll
            for (int w2 = 0; w2 < 8; ++w2) tot += red[w2 * 4 + t];
            const float rs = rsqrtf(tot * (1.f / 256.f) + EPSV);
            bf16_t* op = Z + (size_t)(r0 + t) * ZLD + ocol + vown;
            const float gt = bf2f(*op), sg = sigmoidf_(gt);
            *op = f2bf(hv[t] * rs * gain[vown] * (BR == 0 ? sg : gt * sg)); }
    }
    __syncthreads();
}

__device__ __forceinline__ void attn_prompt(const Params& p, unsigned char* lds, int item) {
    const int tid = threadIdx.x, w = tid >> 6, lane = tid & 63, g = lane >> 4, l16 = lane & 15, q4 = l16 >> 2, p4 = lane & 3;
    const int qt = item & 15, h = (item >> 4) & 3, b = item >> 6;
    const bf16_t* KV = (const bf16_t*)(p.ws + WS_MEMKV) + (size_t)b * 256 * 2048 + h * 256;
    const bf16_t* Q = (const bf16_t*)(p.ws + WS_QBUF);
    bf16_t* O = (bf16_t*)(p.ws + WS_OBUF);
    const size_t rq = (size_t)b * 2048 + qt * 128 + 16 * w + l16;
    const unsigned aL = (unsigned)(size_t)lds;
#pragma unroll 4
    for (int i = 0; i < 16; ++i) { const int id = tid + 512 * i, key = id >> 5, ch = id & 31;
        *(u32x4*)(lds + key * V_STRIDE + ch * 16) = *(const u32x4*)(KV + (size_t)key * 2048 + ch * 8); }
    __syncthreads();
    f32x4 s[16];
#pragma unroll
    for (int ki = 0; ki < 16; ++ki) s[ki] = (f32x4){0.f, 0.f, 0.f, 0.f};
#pragma unroll
    for (int ks = 0; ks < 8; ++ks) { const bf16x8 qfk = *(const bf16x8*)(Q + rq * DM + h * 256 + 32 * ks + 8 * g);
#pragma unroll
        for (int ki = 0; ki < 16; ++ki) s[ki] = mfma16(*(const bf16x8*)(lds + (16 * ki + l16) * V_STRIDE + (32 * ks + 8 * g) * 2), qfk, s[ki]); }
    float mx = -3.0e38f;
#pragma unroll
    for (int ki = 0; ki < 16; ++ki)
#pragma unroll
        for (int r = 0; r < 4; ++r) mx = fmaxf(mx, s[ki][r]);
    mx = xmax16_32(mx);
    float sum = 0.f;
#pragma unroll
    for (int ki = 0; ki < 16; ++ki)
#pragma unroll
        for (int r = 0; r < 4; ++r) { const float e = __expf(s[ki][r] - mx); s[ki][r] = e; sum += e; }
    sum = xsum16_32(sum);
    bf16x8 pf[8];
#pragma unroll
    for (int ks = 0; ks < 8; ++ks) pf[ks] = pack8(s[2 * ks], s[2 * ks + 1]);
    __syncthreads();
#pragma unroll 4
    for (int i = 0; i < 16; ++i) { const int id = tid + 512 * i, key = id >> 5, ch = id & 31;
        *(u32x4*)(lds + key * V_STRIDE + ch * 16) = *(const u32x4*)(KV + (size_t)key * 2048 + 1024 + ch * 8); }
    __syncthreads();
    const float inv = 1.f / sum;
#pragma unroll
    for (int hh = 0; hh < 2; ++hh) {
        f32x4 o[8];
#pragma unroll
        for (int hi = 0; hi < 8; ++hi) o[hi] = (f32x4){0.f, 0.f, 0.f, 0.f};
#pragma unroll
        for (int ks = 0; ks < 8; ++ks) {
            unsigned aLk = aL + (32 * ks + 4 * g + q4) * V_STRIDE + 8 * p4 + hh * 256;
            asm volatile("" : "+v"(aLk));
#pragma unroll
            for (int hi = 0; hi < 8; hi += 2) {
                const unsigned a0 = aLk + (16 * hi) * 2;
                bf16x8 fa, fb; tr_frag2(a0, a0 + 16 * V_STRIDE, a0 + 32, a0 + 32 + 16 * V_STRIDE, fa, fb);
                o[hi] = mfma16(fa, pf[ks], o[hi]); o[hi + 1] = mfma16(fb, pf[ks], o[hi + 1]);
            }
        }
#pragma unroll
        for (int hi = 0; hi < 8; ++hi) *(u32x2*)(O + rq * DM + h * 256 + hh * 128 + 16 * hi + 4 * g) = pack4(o[hi] * inv);
    }
    __syncthreads();
}
__device__ __forceinline__ void attn_sample(const Params& p, unsigned char* lds, int item) {
    const int tid = threadIdx.x, w = tid >> 6, lane = tid & 63;
    const int h = item & 3, b = item >> 2;
    const float* Kc = p.in[7] + ((size_t)b * 1024 + h) * 256;
    const float* Vc = p.in[8] + ((size_t)b * 1024 + h) * 256;
    const bf16_t* Q = (const bf16_t*)(p.ws + WS_QBUF);
    bf16_t* O = (bf16_t*)(p.ws + WS_OBUF);
    float* sc = (float*)lds; float* po = sc + 1024;
    const size_t r0 = MP + 4 * b;
    f32x4 q[4];
#pragma unroll
    for (int t = 0; t < 4; ++t) { const u32x2 qw = *(const u32x2*)(Q + (r0 + t) * DM + h * 256 + lane * 4); q[t] = (f32x4){bflo(qw.x), bfhi(qw.x), bflo(qw.y), bfhi(qw.y)}; }
#pragma unroll 4
    for (int kk = 0; kk < 32; ++kk) { const int key = w * 32 + kk;
        const f32x4 kv = __builtin_nontemporal_load((const f32x4*)(Kc + (size_t)key * 1024 + lane * 4));
#pragma unroll
        for (int t = 0; t < 4; ++t) { float d = kv[0] * q[t][0] + kv[1] * q[t][1] + kv[2] * q[t][2] + kv[3] * q[t][3]; d = wave_sum(d); if (lane == 0) sc[t * 256 + key] = d; } }
    __syncthreads();
    if (w < 4) { float v[4], mx = -3.0e38f;
#pragma unroll
        for (int i = 0; i < 4; ++i) { v[i] = sc[w * 256 + lane + 64 * i]; mx = fmaxf(mx, v[i]); }
        mx = wave_max(mx); float sum = 0.f;
#pragma unroll
        for (int i = 0; i < 4; ++i) { v[i] = __expf(v[i] - mx); sum += v[i]; }
        sum = wave_sum(sum); const float inv = 1.f / sum;
#pragma unroll
        for (int i = 0; i < 4; ++i) sc[w * 256 + lane + 64 * i] = v[i] * inv; }
    __syncthreads();
    {
        const int hd4 = lane * 4; float* po8 = sc + 1024;
        f32x4 acc4[4];
#pragma unroll
        for (int t = 0; t < 4; ++t) acc4[t] = (f32x4){0.f, 0.f, 0.f, 0.f};
#pragma unroll 8
        for (int kk = 0; kk < 32; ++kk) { const int key = w * 32 + kk; const f32x4 v4 = __builtin_nontemporal_load((const f32x4*)(Vc + (size_t)key * 1024 + hd4));
#pragma unroll
            for (int t = 0; t < 4; ++t) acc4[t] += v4 * sc[t * 256 + key]; }
#pragma unroll
        for (int t = 0; t < 4; ++t) *(f32x4*)(po8 + (w * 4 + t) * 256 + hd4) = acc4[t];
        __syncthreads();
        if (tid < 256) {
#pragma unroll
            for (int t = 0; t < 4; ++t) { float o = 0.f;
#pragma unroll
                for (int w2 = 0; w2 < 8; ++w2) o += po8[(w2 * 4 + t) * 256 + tid];
                O[(r0 + t) * DM + h * 256 + tid] = f2bf(o); } }
    }
    __syncthreads();
}

#ifndef ONLY_PH
#define ONLY_PH -1
#endif
#ifndef MIXEN
#define MIXEN 15
#endif
#ifndef PH_MASK
#define PH_MASK 0xffff
#endif
#define PH_ENABLED(x) ((ONLY_PH < 0 || ONLY_PH == (x)) && ((PH_MASK >> (x)) & 1) && ((KMASK >> (x)) & 1))
__device__ __forceinline__ void grid_barrier(unsigned char* wsb, unsigned char* lds) {
    XcdBarrier b; b.bar = (unsigned*)(wsb + WS_BAR); b.x = xb_xcc_id(); b.st = (volatile LAS unsigned*)(lds + LDS_BYTES - 16);
    xcd_barrier(b);
}
template <int KMASK> __global__ void __launch_bounds__(512, 2) fwd_kernel(Params p) {
    extern __shared__ __attribute__((aligned(16))) unsigned char lds[];
    cg::grid_group grid = cg::this_grid();
    volatile LAS unsigned* xb_st = (volatile LAS unsigned*)(lds + LDS_BYTES - 16);
    if (threadIdx.x == 0) { xb_st[0] = 0u; xb_st[1] = 0u; }
    __syncthreads();
    (void)xcd_barrier_post((unsigned*)(p.ws + WS_BAR), xb_st);
#ifndef DUP_MASK
#define DUP_MASK 0
#endif
#define PH_BEGIN(k) if (PH_ENABLED(k) && p.ph_lo <= (k) && (k) < p.ph_hi) for (int rep_ = 0; rep_ < (((DUP_MASK >> (k)) & 1) ? 2 : 1); ++rep_) { if ((k) > p.ph_lo || rep_) { if (p.ph_hi > 1000) grid.sync(); else grid_barrier(p.ws, lds); } \
        unsigned char* ws; float* outp; { unsigned long long w_ = (unsigned long long)p.ws, o_ = (unsigned long long)p.out; \
        unsigned a0_ = __builtin_amdgcn_readfirstlane((unsigned)w_), a1_ = __builtin_amdgcn_readfirstlane((unsigned)(w_ >> 32)), a2_ = __builtin_amdgcn_readfirstlane((unsigned)o_), a3_ = __builtin_amdgcn_readfirstlane((unsigned)(o_ >> 32)); \
        asm volatile("" : "+s"(a0_), "+s"(a1_), "+s"(a2_), "+s"(a3_)); ws = (unsigned char*)(((unsigned long long)a1_ << 32) | a0_); outp = (float*)(((unsigned long long)a3_ << 32) | a2_); } \
        bf16_t* ABUF = (bf16_t*)(ws + WS_ABUF); bf16_t* Z = (bf16_t*)(ws + WS_Z); float* XRES = (float*)(ws + WS_XRES); float* SS = (float*)(ws + WS_SS); float* TMP = outp + O_YP; \
        (void)ABUF; (void)Z; (void)XRES; (void)SS; (void)TMP;
#define PH_END }
    PH_BEGIN(0) prep_phase(p, lds); PH_END
    PH_BEGIN(1)
        EpiGateUp e1; e1.H = Z; e1.ss = nullptr;
        run_gemm(lds, ABUF, DM, (const bf16_t*)(ws + WS_WGU1), MT, 5632, 1024, e1, 0);
        EpiMemKV e2; e2.ok = outp + O_MKP; e2.ov = outp + O_MVP; e2.kv = (bf16_t*)(ws + WS_MEMKV);
        run_gemm(lds, (const bf16_t*)(ws + WS_MEMA), DM, (const bf16_t*)(ws + WS_WKV), 2048, 2048, 1024, e2, 64);
    PH_END
    PH_BEGIN(2) EpiResid e; e.res0 = p.in[0]; e.res1 = p.in[1]; e.xout = XRES; e.aout = ABUF; e.gain = p.in[13]; e.ss = SS; e.scale = 0.5f;
        run_gemm(lds, Z, DFF, (const bf16_t*)(ws + WS_WD1), MP, 1024, DFF, e, 0); small_gemm(lds, Z, DFF, (const bf16_t*)(ws + WS_WD1), 1024, DFF, e); PH_END
    PH_BEGIN(3) EpiZ e; e.Z = Z; e.ZS = (float*)(ws + WS_ZS); e.ss = SS;
        run_gemm(lds, ABUF, DM, (const bf16_t*)(ws + WS_WIN), MT, 8448, 1024, e, 0); PH_END
    PH_BEGIN(4)
        for (int it = blockIdx.x; it < 1024; it += gridDim.x) gla_prep(p, lds, it);
    PH_END
    PH_BEGIN(5)
        const int bx = (int)blockIdx.x, G = (int)gridDim.x;
        const int NCH = (G >= 256) ? 128 : 0;
        if (bx < NCH || NCH == 0) {
            for (int it0 = bx; it0 < 128; it0 += (NCH ? NCH : G)) { const int it = NCH ? ((((it0 & 7) * 8 + (it0 >> 4)) << 1) | ((it0 >> 3) & 1)) : it0;
                if (it < 64) { if (MIXEN & 1) mixer_prompt<0>(p, lds, it >> 3, (it >> 1) & 3, it & 1); } }
            for (int it0 = bx; it0 < 128; it0 += (NCH ? NCH : G)) { const int it = NCH ? ((((it0 & 7) * 8 + (it0 >> 4)) << 1) | ((it0 >> 3) & 1)) : it0;
                if (it >= 64) { if (MIXEN & 2) mixer_prompt<1>(p, lds, (it - 64) >> 3, (it >> 1) & 3, it & 1); } }
        }
        if (bx >= NCH) {
            for (int it = bx - NCH; it < 512; it += G - NCH) { if (MIXEN & 4) mixer_sample<0>(p, lds, it >> 2, it & 3); }
            for (int it = bx - NCH; it < 512; it += G - NCH) { if (MIXEN & 8) mixer_sample<1>(p, lds, it >> 2, it & 3); }
            prep_transposes(p, lds, PREP_LATE_MASK, bx - NCH, G - NCH);
        }
    PH_END
    PH_BEGIN(6)
        const float* SSQ = (const float*)(ws + WS_SSQ);
        const int lane = threadIdx.x & 63, gw = blockIdx.x * 8 + (threadIdx.x >> 6), nw = gridDim.x * 8;
        for (int i0 = gw; i0 < MP * 8; i0 += 4 * nw) {
            f32x4 sp[4]; u32x2 wv[4];
#pragma unroll
            for (int e = 0; e < 4; ++e) { const int i = i0 + e * nw; if (i < MP * 8) { sp[e] = *(const f32x4*)(SSQ + (size_t)i * 4);
                    wv[e] = *(const u32x2*)(Z + (size_t)(i >> 3) * ZLD + (((i & 7) >> 2) ? 5120 : 2048) + (i & 3) * 256 + lane * 4); } }
#pragma unroll
            for (int e = 0; e < 4; ++e) { const int i = i0 + e * nw; if (i < MP * 8) {
                    const float rs = rsqrtf(((sp[e][0] + sp[e][1]) + (sp[e][2] + sp[e][3])) * (1.f / 256.f) + EPSV);
                    f32x4 o = {bflo(wv[e].x) * rs, bfhi(wv[e].x) * rs, bflo(wv[e].y) * rs, bfhi(wv[e].y) * rs};
                    *(u32x2*)(Z + (size_t)(i >> 3) * ZLD + (((i & 7) >> 2) ? 5120 : 2048) + (i & 3) * 256 + lane * 4) = pack4(o); } }
        }
    PH_END
    PH_BEGIN(7) EpiMerge<0> e; e.gate = Z + 6144; e.T = TMP; e.Y = nullptr;
        run_gemm(lds, Z + 2048, ZLD, (const bf16_t*)(ws + WS_WBRM), MP, 1024, 1024, e, 0); small_gemm(lds, Z + 2048, ZLD, (const bf16_t*)(ws + WS_WBRM), 1024, 1024, e); PH_END
    PH_BEGIN(8) EpiMerge<1> e; e.gate = Z + 7168; e.T = TMP; e.Y = ABUF;
        run_gemm(lds, Z + 5120, ZLD, (const bf16_t*)(ws + WS_WBRG), MP, 1024, 1024, e, 0); small_gemm(lds, Z + 5120, ZLD, (const bf16_t*)(ws + WS_WBRG), 1024, 1024, e); PH_END
    PH_BEGIN(9) EpiResid e; e.res0 = XRES; e.res1 = XRES + (size_t)MP * DM; e.xout = XRES; e.aout = (bf16_t*)(ws + WS_ABUF2); e.gain = p.in[23]; e.ss = SS + (size_t)MT * 16; e.scale = 1.f;
        run_gemm(lds, ABUF, DM, (const bf16_t*)(ws + WS_WOUT), MP, 1024, 1024, e, 0); small_gemm(lds, ABUF, DM, (const bf16_t*)(ws + WS_WOUT), 1024, 1024, e); PH_END
    PH_BEGIN(10) EpiQ e; e.Q = (bf16_t*)(ws + WS_QBUF); e.ss = SS + (size_t)MT * 16;
        run_gemm(lds, (const bf16_t*)(ws + WS_ABUF2), DM, (const bf16_t*)(ws + WS_WQ), MP, 1024, 1024, e, 0); small_gemm(lds, (const bf16_t*)(ws + WS_ABUF2), DM, (const bf16_t*)(ws + WS_WQ), 1024, 1024, e); PH_END
    PH_BEGIN(11)
#pragma unroll 1
        for (int pass = 0; pass < 2; ++pass) {
            if (((blockIdx.x & 1) != 0) == (pass == 0)) { for (int it = blockIdx.x; it < 512; it += gridDim.x) attn_sample(p, lds, it); }
            else { for (int it = blockIdx.x; it < 512; it += gridDim.x) attn_prompt(p, lds, it); }
        }
    PH_END
    PH_BEGIN(12) EpiResid e; e.res0 = XRES; e.res1 = XRES + (size_t)MP * DM; e.xout = XRES; e.aout = ABUF; e.gain = p.in[29]; e.ss = SS + (size_t)MT * 32; e.scale = 1.f;
        run_gemm(lds, (const bf16_t*)(ws + WS_OBUF), DM, (const bf16_t*)(ws + WS_WO), MP, 1024, 1024, e, 0); small_gemm(lds, (const bf16_t*)(ws + WS_OBUF), DM, (const bf16_t*)(ws + WS_WO), 1024, 1024, e); PH_END
    PH_BEGIN(13) EpiGateUp e; e.H = Z; e.ss = SS + (size_t)MT * 32;
        run_gemm(lds, ABUF, DM, (const bf16_t*)(ws + WS_WGU2), MT, 5632, 1024, e, 0); PH_END
    PH_BEGIN(14) EpiResid e; e.res0 = XRES; e.res1 = XRES + (size_t)MP * DM; e.xout = TMP; e.aout = nullptr; e.gain = nullptr; e.ss = SS + (size_t)MT * 48; e.scale = 0.5f;
        run_gemm(lds, Z, DFF, (const bf16_t*)(ws + WS_WD2), MP, 1024, DFF, e, 0); small_gemm(lds, Z, DFF, (const bf16_t*)(ws + WS_WD2), 1024, DFF, e); PH_END
    PH_BEGIN(15)
        const int lane = threadIdx.x & 63, gw = blockIdx.x * 8 + (threadIdx.x >> 6), nw = gridDim.x * 8;
        for (int r = gw; r < MT; r += nw) { const float rs = rs_row(SS + (size_t)MT * 48, r); float* y = TMP + (size_t)r * DM;
#pragma unroll
            for (int i = 0; i < 4; ++i) { f32x4 v = *(const f32x4*)(y + i * 256 + lane * 4); const f32x4 gg = *(const f32x4*)(p.in[33] + i * 256 + lane * 4);
                *(f32x4*)(y + i * 256 + lane * 4) = v * rs * gg; } }
    PH_END
}

template <int KMASK> static bool setup_kernel() {
    if (hipFuncSetAttribute((const void*)fwd_kernel<KMASK>, hipFuncAttributeMaxDynamicSharedMemorySize, LDS_BYTES) != hipSuccess) { fprintf(stderr, "kernel_launch: hipFuncSetAttribute failed\n"); return false; }
    int per_cu = 0;
    if (hipOccupancyMaxActiveBlocksPerMultiprocessor(&per_cu, (const void*)fwd_kernel<KMASK>, NTHREADS, LDS_BYTES) != hipSuccess || per_cu < 1) fprintf(stderr, "kernel_launch: occupancy query says %d\n", per_cu);
    (void)hipGetLastError();
    return true;
}
template <int KMASK> static void launch_range(Params p, int lo, int hi, int grid, hipStream_t stream) {
    p.ph_lo = lo; p.ph_hi = hi;
    if (hipMemsetAsync((char*)p.ws + WS_BAR, 0, XCD_BAR_WORDS * 4, stream) != hipSuccess) { fprintf(stderr, "kernel_launch: memset of the barrier words failed\n"); return; }
    void* args[] = {&p};
    hipError_t e = hipLaunchCooperativeKernel((const void*)fwd_kernel<KMASK>, dim3(grid), dim3(NTHREADS), args, LDS_BYTES, stream);
    if (e != hipSuccess) fprintf(stderr, "kernel_launch: cooperative launch [%d,%d) failed: %s (grid %d)\n", lo, hi, hipGetErrorString(e), grid);
}
#ifndef N_LAUNCH
#define N_LAUNCH 1
#endif
extern "C" void kernel_launch(void* const* d_in, const int* in_sizes, int n_in, void* d_out, int out_size, void* d_ws, size_t ws_size, hipStream_t stream) {
    static int grid = 0;
    if (grid == 0) {
        if (n_in != 34 || (size_t)out_size != O_END || ws_size < WS_END) { fprintf(stderr, "kernel_launch: unexpected sizes n_in %d out %d ws %zu (need %zu)\n", n_in, out_size, ws_size, (size_t)WS_END); grid = -1; return; }
        int dev = 0, cus = 0;
        (void)hipGetDevice(&dev); (void)hipDeviceGetAttribute(&cus, hipDeviceAttributeMultiprocessorCount, dev);
        bool ok = true;
#if N_LAUNCH == 1
        ok = setup_kernel<0xffff>();
#else
        ok = setup_kernel<0x3fef>() && setup_kernel<0x0010>();
#endif
        if (!ok) { grid = -1; return; }
        grid = cus;
        if (grid < 64) { fprintf(stderr, "kernel_launch: needs >= 64 CUs\n"); grid = -1; return; }
    }
    if (grid < 0) return;
    Params p{};
    for (int i = 0; i < 34; ++i) p.in[i] = (const float*)d_in[i];
    p.out = (float*)d_out; p.ws = (unsigned char*)d_ws;
#if N_LAUNCH == 1
#ifndef PROBE_K
#define PROBE_K -1
#endif
#ifndef PROBE_BACK
#define PROBE_BACK 0
#endif
    if (PROBE_K >= 0) { launch_range<0xffff>(p, 0, PROBE_K + 1, grid, stream); launch_range<0xffff>(p, PROBE_K - PROBE_BACK, 16, grid, stream); }
    else launch_range<0xffff>(p, 0, 16, grid, stream);
#else
#ifndef DBG_HI
#define DBG_HI 14
#endif
    launch_range<0x3fef>(p, 0, DBG_HI < 4 ? DBG_HI : 4, grid, stream);
    if (DBG_HI > 4) launch_range<0x0010>(p, 4, 5, grid, stream);
    if (DBG_HI > 5) launch_range<0x3fef>(p, 5, DBG_HI, grid, stream);
#endif
}
```

```cpp
#include <hip/hip_runtime.h>
#include <hip/hip_cooperative_groups.h>
#include <cstdio>
namespace cg = cooperative_groups;
namespace pg8 {
#define PG8_LAS __attribute__((address_space(3)))
typedef unsigned short bf16_t;
typedef short bf16x8 __attribute__((ext_vector_type(8)));
typedef float f32x4 __attribute__((ext_vector_type(4)));
typedef unsigned u32x4 __attribute__((ext_vector_type(4)));
constexpr int BM = 256, BK = 64, HALF = 128, HTB = HALF * BK * 2  , STAGE_BYTES = 8 * HTB, NXCD = 8, WGM = 8;

__host__ __device__ __forceinline__ int lds_byte(int r, int c) { const int st = (r >> 4) * 2 + (c >> 5), rr = r & 15, cc = c & 31, ob = rr * 64 + cc * 2; return st * 1024 + (ob ^ (((ob >> 9) & 1) << 5)); }
__host__ __device__ __forceinline__ void stage_rc(int b, int& R, int& C) { const int st = b / 1024, sb = b % 1024, swz = sb ^ (((sb >> 9) & 1) << 5); R = (st >> 1) * 16 + swz / 64; C = (st & 1) * 32 + (swz % 64) / 2; }
__host__ __device__ __forceinline__ int perm32(int rho) { const int n = rho >> 4, i = rho & 15; return 8 * (i >> 2) + 4 * n + (i & 3); }

struct Unit { int pm, pn; };
struct Gemm { const bf16_t* A; const bf16_t* Bt; int M, N, K, lda, ldb; };
struct StaticOrder {
    int nM, nN, nwg, G, c;
    __host__ __device__ void init(int M, int N, int G_, int c_) { nM = M / BM; nN = N / BM; nwg = nM * nN; G = G_; c = c_; }
    __host__ __device__ bool next(int i, Unit& u) const {
        const long L = (long)i * G + c; if (L >= nwg) return false;
        int wgid = (int)L; { const int q = nwg / NXCD, r = nwg % NXCD, xcd = wgid % NXCD, off = wgid / NXCD; wgid = (xcd < r ? xcd * (q + 1) : r * (q + 1) + (xcd - r) * q) + off; }
        const int nig = WGM * nN, gid = wgid / nig, fm = gid * WGM, gsz = (nM - fm) < WGM ? (nM - fm) : WGM;
        u.pm = fm + ((wgid % nig) % gsz); u.pn = (wgid % nig) / gsz; return true;
    }
    __device__ __forceinline__ void a_ready(const Unit&) const {}
    __device__ __forceinline__ void done(const Unit&) const {}
};
__device__ __forceinline__ unsigned cvt_pk_bf16(float lo, float hi) { unsigned r; asm volatile("v_cvt_pk_bf16_f32 %0, %1, %2" : "=v"(r) : "v"(lo), "v"(hi)); return r; }
template <class Epi, class Sched>
__device__ __forceinline__ void gemm_phase(PG8_LAS unsigned char* lds, const Gemm g, const Sched& S, const Epi& E) {
    const int tid = threadIdx.x, wid = __builtin_amdgcn_readfirstlane(tid >> 6), lane = tid & 63, wr = wid >> 2, wc = wid & 3, fr = lane & 15, fq = lane >> 4;
    const int K = g.K, nt = K / BK;
    unsigned voffA[2], voffB[2];
#pragma unroll
    for (int i = 0; i < 2; ++i) { int R, C; stage_rc(tid * 16 + i * 8192, R, C); const int Rb = Epi::PERM ? ((R & ~31) + perm32(R & 31)) : R;
        voffA[i] = (unsigned)(R * g.lda + C) * 2u; voffB[i] = (unsigned)(Rb * g.ldb + C) * 2u; }
    const size_t kstep = (size_t)(BK * 2);
    const size_t hstepA = (size_t)HALF * g.lda * 2, hstepB = (size_t)HALF * g.ldb * 2;
    const size_t tstepA = 2 * hstepA, tstepB = 2 * hstepB;
    const unsigned ldsw = (unsigned)wid * 1024u;
    const int aoff = lds_byte(wr * 64 + fr, fq * 8), boff = lds_byte(wc * 32 + fr, fq * 8);
#define PG8_SA(b, h) (((b) * 2 + (h)) * HTB)
#define PG8_SB(b, h) ((4 + (b) * 2 + (h)) * HTB)
#define PG8_STAGE(bufoff, gbase, voff) do { _Pragma("unroll") for (int _i = 0; _i < 2; ++_i) \
        __builtin_amdgcn_global_load_lds((const unsigned*)((const char*)(gbase) + (voff)[_i]), (PG8_LAS unsigned*)(lds + (bufoff) + ldsw + _i * 8192), 16, 0, 0); } while (0)
#define PG8_LDA(dst, b, h) do { _Pragma("unroll") for (int m = 0; m < 4; ++m) _Pragma("unroll") for (int k = 0; k < 2; ++k) dst[m][k] = *(const PG8_LAS bf16x8*)(lds + PG8_SA(b, h) + aoff + m * 2048 + k * 1024); } while (0)
#define PG8_LDB(dst, b, h) do { _Pragma("unroll") for (int n = 0; n < 2; ++n) _Pragma("unroll") for (int k = 0; k < 2; ++k) dst[n][k] = *(const PG8_LAS bf16x8*)(lds + PG8_SB(b, h) + boff + n * 2048 + k * 1024); } while (0)
#define PG8_MMA(ai, bj, At, Bt) do { __builtin_amdgcn_s_setprio(1); _Pragma("unroll") for (int m = 0; m < 4; ++m) _Pragma("unroll") for (int n = 0; n < 2; ++n) _Pragma("unroll") for (int k = 0; k < 2; ++k) \
        acc[ai][bj][m][n] = __builtin_amdgcn_mfma_f32_16x16x32_bf16(Bt[n][k], At[m][k], acc[ai][bj][m][n], 0, 0, 0); __builtin_amdgcn_s_setprio(0); } while (0)
#define PG8_WAIT_V(n) asm volatile("s_waitcnt vmcnt(" #n ")" ::: "memory")
#define PG8_WAIT_L(n) asm volatile("s_waitcnt lgkmcnt(" #n ")" ::: "memory")
#define PG8_BAR __builtin_amdgcn_s_barrier()
#define PG8_SCHED __builtin_amdgcn_sched_barrier(0)
    Unit cur, nxt; int ui = 0;
    if (!S.next(0, cur)) return;
    f32x4 acc[2][2][4][2];
#pragma unroll
    for (int a = 0; a < 2; ++a)
#pragma unroll
        for (int b = 0; b < 2; ++b)
#pragma unroll
            for (int m = 0; m < 4; ++m)
#pragma unroll
                for (int n = 0; n < 2; ++n) acc[a][b][m][n] = (f32x4){0.f, 0.f, 0.f, 0.f};
    bf16x8 At[4][2], B0[2][2], B1[2][2];
    const char* cA = (const char*)g.A + (size_t)cur.pm * tstepA; const char* cB = (const char*)g.Bt + (size_t)cur.pn * tstepB;
    S.a_ready(cur);
    PG8_STAGE(PG8_SB(0, 0), cB, voffB); PG8_STAGE(PG8_SA(0, 0), cA, voffA); PG8_STAGE(PG8_SB(0, 1), cB + hstepB, voffB); PG8_STAGE(PG8_SA(0, 1), cA + hstepA, voffA);
    if (wr == 1) PG8_BAR;
    PG8_WAIT_V(4); PG8_BAR;
    PG8_STAGE(PG8_SB(1, 0), cB + kstep, voffB); PG8_STAGE(PG8_SA(1, 0), cA + kstep, voffA); PG8_STAGE(PG8_SB(1, 1), cB + hstepB + kstep, voffB);
    PG8_WAIT_V(6); PG8_BAR;
    for (;;) {
        const bool has_next = S.next(ui + 1, nxt);
        const char* nA = has_next ? (const char*)g.A + (size_t)nxt.pm * tstepA : cA; const char* nB = has_next ? (const char*)g.Bt + (size_t)nxt.pn * tstepB : cB;
        for (int t = 0; t < nt; t += 2) {
            const bool last = (t == nt - 2);
            const char* a1 = cA + (size_t)(t + 1) * kstep;
            const char* a2 = last ? nA : cA + (size_t)(t + 2) * kstep; const char* b2 = last ? nB : cB + (size_t)(t + 2) * kstep;
            const char* a3 = a2 + kstep; const char* b3 = b2 + kstep;
            if (last && has_next) S.a_ready(nxt);
            PG8_LDB(B0, 0, 0); PG8_SCHED; PG8_LDA(At, 0, 0); PG8_STAGE(PG8_SA(1, 1), a1 + hstepA, voffA);
            PG8_WAIT_L(8); PG8_BAR; PG8_WAIT_L(0); PG8_MMA(0, 0, At, B0); PG8_BAR; PG8_SCHED;
            PG8_LDB(B1, 0, 1); PG8_STAGE(PG8_SB(0, 0), b2, voffB);
            PG8_BAR; PG8_WAIT_L(0); PG8_MMA(0, 1, At, B1); PG8_BAR;
            PG8_LDA(At, 0, 1); PG8_STAGE(PG8_SA(0, 0), a2, voffA);
            PG8_BAR; PG8_WAIT_L(0); PG8_MMA(1, 0, At, B0); PG8_BAR; PG8_SCHED;
            PG8_STAGE(PG8_SB(0, 1), b2 + hstepB, voffB);
            PG8_WAIT_V(6); PG8_BAR; PG8_MMA(1, 1, At, B1); PG8_BAR;
            PG8_LDB(B0, 1, 0); PG8_SCHED; PG8_LDA(At, 1, 0); PG8_STAGE(PG8_SA(0, 1), a2 + hstepA, voffA);
            PG8_WAIT_L(8); PG8_BAR; PG8_WAIT_L(0); PG8_MMA(0, 0, At, B0); PG8_BAR; PG8_SCHED;
            PG8_LDB(B1, 1, 1); PG8_STAGE(PG8_SB(1, 0), b3, voffB);
            PG8_BAR; PG8_WAIT_L(0); PG8_MMA(0, 1, At, B1); PG8_BAR;
            PG8_LDA(At, 1, 1); PG8_STAGE(PG8_SA(1, 0), a3, voffA);
            PG8_BAR; PG8_WAIT_L(0); PG8_MMA(1, 0, At, B0); PG8_BAR; PG8_SCHED;
            PG8_STAGE(PG8_SB(1, 1), b3 + hstepB, voffB);
            PG8_WAIT_V(6); PG8_BAR; PG8_MMA(1, 1, At, B1); PG8_BAR;
        }
        if constexpr (!Epi::AFTER_DRAIN) { E(acc, cur, wr, wc, fr, fq); S.done(cur); }
        if (!has_next) break;
#pragma unroll
        for (int a = 0; a < 2; ++a)
#pragma unroll
            for (int b = 0; b < 2; ++b)
#pragma unroll
                for (int m = 0; m < 4; ++m)
#pragma unroll
                    for (int n = 0; n < 2; ++n) acc[a][b][m][n] = (f32x4){0.f, 0.f, 0.f, 0.f};
        cur = nxt; cA = nA; cB = nB; ++ui;
    }
    PG8_WAIT_V(0);
    if (wr == 0) PG8_BAR;
    PG8_BAR;
    if constexpr (Epi::AFTER_DRAIN) { E.fused(acc, cur, wr, wc, fr, fq, lds, wid, lane); S.done(cur); }
#undef PG8_SA
#undef PG8_SB
#undef PG8_STAGE
#undef PG8_LDA
#undef PG8_LDB
#undef PG8_MMA
#undef PG8_WAIT_V
#undef PG8_WAIT_L
#undef PG8_BAR
#undef PG8_SCHED
}
}
using pg8::bf16_t; using pg8::bf16x8; using pg8::f32x4; using pg8::u32x4;
typedef short s16x4 __attribute__((ext_vector_type(4)));
typedef unsigned u32x2 __attribute__((ext_vector_type(2)));
#define LAS __attribute__((address_space(3)))

constexpr int MP = 16384, MS = 512, MT = MP + MS, DM = 1024, DFF = 2816, ZLD = 8192, ZSLD = 32;
constexpr int NTHREADS = 512;
constexpr float EPSV = 1e-6f;
constexpr size_t SZ_WGU = 5632ull * 1024 * 2, SZ_WD = 1024ull * 2816 * 2, SZ_WIN = 8448ull * 1024 * 2, SZ_W1K = 1024ull * 1024 * 2;
constexpr size_t WS_WGU1 = 0;
constexpr size_t WS_WD1 = WS_WGU1 + SZ_WGU;
constexpr size_t WS_WIN = WS_WD1 + SZ_WD;
constexpr size_t WS_WBRM = WS_WIN + SZ_WIN;
constexpr size_t WS_WBRG = WS_WBRM + SZ_W1K;
constexpr size_t WS_WOUT = WS_WBRG + SZ_W1K;
constexpr size_t WS_WQ = WS_WOUT + SZ_W1K;
constexpr size_t WS_WO = WS_WQ + SZ_W1K;
constexpr size_t WS_WKV = WS_WO + SZ_W1K;
constexpr size_t WS_WGU2 = WS_WKV + 2 * SZ_W1K;
constexpr size_t WS_WD2 = WS_WGU2 + SZ_WGU;
constexpr size_t WS_ABUF = WS_WD2 + SZ_WD;
constexpr size_t WS_MEMA = WS_ABUF + (size_t)MT * DM * 2;
constexpr size_t WS_MEMKV = WS_MEMA + 2048ull * 1024 * 2;
constexpr size_t WS_XRES = WS_MEMKV + 2048ull * 2048 * 2;
constexpr size_t WS_ZS = WS_XRES + (size_t)MT * DM * 4;
constexpr size_t WS_SS = WS_ZS + (size_t)MT * ZSLD * 4;
constexpr size_t WS_SSQ = WS_SS + 4ull * MT * 16 * 4;
constexpr size_t WS_BEND = WS_SSQ + (size_t)MP * 32 * 4;
constexpr size_t WS_Z = WS_BEND + 1024ull * 128 * 4;
constexpr size_t WS_ABUF2 = WS_Z + (64ull << 20);
constexpr size_t WS_QBUF = WS_Z + (128ull << 20);
constexpr size_t WS_OBUF = WS_Z + (192ull << 20);
constexpr size_t WS_BAR = WS_Z + (size_t)MT * ZLD * 2;
constexpr size_t WS_END = WS_BAR + 16384;
constexpr size_t O_YP = 0, O_YS = 16777216, O_CP = 17301504, O_NP = 18350080, O_MPP = 18354176, O_SP = 18354208, O_MKP = 19402784, O_MVP = 21499936,
                 O_CS = 23597088, O_NS = 40374304, O_MSS = 40439840, O_SS = 40440352, O_END = 57217568;
constexpr int LDS_BYTES = 156 * 1024;

struct Params { const float* in[34]; float* out; unsigned char* ws; int ph_lo, ph_hi; };

typedef float f32x2_t __attribute__((ext_vector_type(2)));
typedef __bf16 bf16x2_t __attribute__((ext_vector_type(2)));
__device__ __forceinline__ unsigned cvt_pk(float lo, float hi) { f32x2_t v = {lo, hi}; bf16x2_t b = __builtin_convertvector(v, bf16x2_t); return __builtin_bit_cast(unsigned, b); }
__device__ __forceinline__ bf16_t f2bf(float x) { return (bf16_t)(cvt_pk(x, 0.f) & 0xffffu); }
__device__ __forceinline__ float bf2f(bf16_t x) { return __uint_as_float(((unsigned)x) << 16); }
__device__ __forceinline__ float bflo(unsigned w) { return __uint_as_float(w << 16); }
__device__ __forceinline__ float bfhi(unsigned w) { return __uint_as_float(w & 0xffff0000u); }
__device__ __forceinline__ float sigmoidf_(float x) { return __builtin_amdgcn_rcpf(1.f + __expf(-x)); }
__device__ __forceinline__ float logsigf_(float x) { return fminf(x, 0.f) - __logf(1.f + __expf(-fabsf(x))); }
__device__ __forceinline__ float rs_of(float ss) { return rsqrtf(ss * (1.f / 1024.f) + EPSV); }
__device__ __forceinline__ float rs_row(const float* ssp, int row) {
    const f32x4* q = (const f32x4*)(ssp + (size_t)row * 16); const f32x4 a = q[0], b = q[1], c = q[2], d = q[3];
    const f32x4 s = (a + b) + (c + d); return rs_of((s[0] + s[1]) + (s[2] + s[3])); }
__device__ __forceinline__ f32x4 mfma16(bf16x8 a, bf16x8 b, f32x4 c) { return __builtin_amdgcn_mfma_f32_16x16x32_bf16(a, b, c, 0, 0, 0); }
__device__ __forceinline__ bf16x8 pack8(f32x4 a, f32x4 b) {
    u32x4 w; w.x = cvt_pk(a[0], a[1]); w.y = cvt_pk(a[2], a[3]); w.z = cvt_pk(b[0], b[1]); w.w = cvt_pk(b[2], b[3]);
    return __builtin_bit_cast(bf16x8, w);
}
__device__ __forceinline__ u32x2 pack4(f32x4 a) { u32x2 w; w.x = cvt_pk(a[0], a[1]); w.y = cvt_pk(a[2], a[3]); return w; }
__device__ __forceinline__ bf16x8 tr_frag(unsigned a0, unsigned a1) {
    s16x4 r0, r1;
    asm volatile("ds_read_b64_tr_b16 %0, %2\n\tds_read_b64_tr_b16 %1, %3\n\ts_waitcnt lgkmcnt(0)" : "=&v"(r0), "=&v"(r1) : "v"(a0), "v"(a1) : "memory");
    return __builtin_shufflevector(r0, r1, 0, 1, 2, 3, 4, 5, 6, 7);
}
__device__ __forceinline__ void tr_frag2(unsigned a0, unsigned a1, unsigned b0, unsigned b1, bf16x8& fa, bf16x8& fb) {
    s16x4 r0, r1, r2, r3;
    asm volatile("ds_read_b64_tr_b16 %0, %4\n\tds_read_b64_tr_b16 %1, %5\n\tds_read_b64_tr_b16 %2, %6\n\tds_read_b64_tr_b16 %3, %7\n\ts_waitcnt lgkmcnt(0)"
                 : "=&v"(r0), "=&v"(r1), "=&v"(r2), "=&v"(r3) : "v"(a0), "v"(a1), "v"(b0), "v"(b1) : "memory");
    fa = __builtin_shufflevector(r0, r1, 0, 1, 2, 3, 4, 5, 6, 7); fb = __builtin_shufflevector(r2, r3, 0, 1, 2, 3, 4, 5, 6, 7);
}
__device__ __forceinline__ void tr_frag4(unsigned a0, unsigned a1, unsigned b0, unsigned b1, unsigned c0, unsigned c1, unsigned d0, unsigned d1, bf16x8& fa, bf16x8& fb, bf16x8& fc, bf16x8& fd) {
    s16x4 r0, r1, r2, r3, r4, r5, r6, r7;
    asm volatile("ds_read_b64_tr_b16 %0, %8\n\tds_read_b64_tr_b16 %1, %9\n\tds_read_b64_tr_b16 %2, %10\n\tds_read_b64_tr_b16 %3, %11\n\t"
                 "ds_read_b64_tr_b16 %4, %12\n\tds_read_b64_tr_b16 %5, %13\n\tds_read_b64_tr_b16 %6, %14\n\tds_read_b64_tr_b16 %7, %15\n\ts_waitcnt lgkmcnt(0)"
                 : "=&v"(r0), "=&v"(r1), "=&v"(r2), "=&v"(r3), "=&v"(r4), "=&v"(r5), "=&v"(r6), "=&v"(r7)
                 : "v"(a0), "v"(a1), "v"(b0), "v"(b1), "v"(c0), "v"(c1), "v"(d0), "v"(d1) : "memory");
    fa = __builtin_shufflevector(r0, r1, 0, 1, 2, 3, 4, 5, 6, 7); fb = __builtin_shufflevector(r2, r3, 0, 1, 2, 3, 4, 5, 6, 7);
    fc = __builtin_shufflevector(r4, r5, 0, 1, 2, 3, 4, 5, 6, 7); fd = __builtin_shufflevector(r6, r7, 0, 1, 2, 3, 4, 5, 6, 7);
}
__device__ __forceinline__ float xsum16_32(float v) { v += __shfl_xor(v, 16); v += __shfl_xor(v, 32); return v; }
__device__ __forceinline__ float xmax16_32(float v) { v = fmaxf(v, __shfl_xor(v, 16)); v = fmaxf(v, __shfl_xor(v, 32)); return v; }
__device__ __forceinline__ float wave_sum(float v) { for (int o = 32; o > 0; o >>= 1) v += __shfl_xor(v, o); return v; }
__device__ __forceinline__ float wave_max(float v) { for (int o = 32; o > 0; o >>= 1) v = fmaxf(v, __shfl_xor(v, o)); return v; }

#define XB_TMO      128
#define XB_XCNT(j)  (256  + 64 * (j))
#define XB_XSUB(j)  (1280 + 64 * (j))
#define XB_XGEN(j)  (2304 + 64 * (j))
#define XB_TOP      3328
#define XB_TOPGEN   3392
#define XCD_BAR_WORDS 3456
#define XB_SPIN_CAP (1u << 18)

__device__ __forceinline__ unsigned xb_ld(unsigned* p)              { return __hip_atomic_load(p, __ATOMIC_RELAXED, __HIP_MEMORY_SCOPE_AGENT); }
__device__ __forceinline__ unsigned xb_add(unsigned* p, unsigned v) { return __hip_atomic_fetch_add(p, v, __ATOMIC_RELAXED, __HIP_MEMORY_SCOPE_AGENT); }
__device__ __forceinline__ unsigned xb_xcc_id() { return (unsigned)__builtin_amdgcn_s_getreg((3 << 11) | 20) & 0xFu; }
#define XB_SPIN(cond, bar) do { unsigned _sp = 0; while (cond) { __builtin_amdgcn_s_sleep(1); \
    if ((++_sp & 255u) == 0u) { if (xb_ld(&(bar)[XB_TMO])) break; if (_sp > XB_SPIN_CAP) { atomicAdd(&(bar)[XB_TMO], 1u); break; } } } } while (0)

struct XcdBarrier {
    unsigned* bar; unsigned x;
    volatile LAS unsigned* st;
};

__device__ __forceinline__ XcdBarrier xcd_barrier_post(unsigned* bar, volatile LAS unsigned* st) {
    XcdBarrier b; b.bar = bar; b.x = xb_xcc_id(); b.st = st;
    if (threadIdx.x == 0) (void)xb_add(&bar[XB_XCNT(b.x)], 1u);
    return b;
}
__device__ __forceinline__ void xcd_barrier_complete(unsigned* bar, unsigned x, unsigned& nloc, unsigned& nx) {
    const unsigned G = gridDim.x * gridDim.y * gridDim.z;
    unsigned sum, cnt, mine, sp = 0u;
    for (;;) {
        sum = 0u; cnt = 0u; mine = 0u;
#pragma unroll
        for (unsigned j = 0; j < 16; ++j) { const unsigned c = xb_ld(&bar[XB_XCNT(j)]); sum += c; cnt += (c > 0u) ? 1u : 0u; mine = (j == x) ? c : mine; }
        if (sum == G) break;
        __builtin_amdgcn_s_sleep(1);
        if ((++sp & 255u) == 0u) { if (xb_ld(&bar[XB_TMO])) break; if (sp > XB_SPIN_CAP) { atomicAdd(&bar[XB_TMO], 1u); break; } }
    }
    nloc = mine > 0u ? mine : 1u; nx = cnt > 0u ? cnt : 1u;
}

__device__ __forceinline__ void xcd_barrier(const XcdBarrier& b) {
    asm volatile("s_waitcnt vmcnt(0)" ::: "memory");
    __syncthreads();
    if (threadIdx.x == 0) {
        unsigned* bar = b.bar;
        __builtin_amdgcn_s_waitcnt(0);
        unsigned nloc = b.st[0], nx = b.st[1];
        if (nloc == 0u) { xcd_barrier_complete(bar, b.x, nloc, nx); b.st[0] = nloc; b.st[1] = nx; }
        const unsigned old = xb_add(&bar[XB_XSUB(b.x)], 1u);
        const unsigned gen = old / nloc;
        if (old + 1u == (gen + 1u) * nloc) {
            __builtin_amdgcn_fence(__ATOMIC_RELEASE, "agent");
            asm volatile("s_waitcnt vmcnt(0)" ::: "memory");
            const unsigned og = xb_add(&bar[XB_TOP], 1u);
            const unsigned tg = og / nx;
            if (og + 1u == (tg + 1u) * nx) xb_add(&bar[XB_TOPGEN], 1u);
            else XB_SPIN(xb_ld(&bar[XB_TOPGEN]) == tg, bar);
            __builtin_amdgcn_fence(__ATOMIC_ACQUIRE, "agent");
            xb_add(&bar[XB_XGEN(b.x)], 1u);
            asm volatile("s_waitcnt vmcnt(0)" ::: "memory");
        } else {
            XB_SPIN(xb_ld(&bar[XB_XGEN(b.x)]) == gen, bar);
            __builtin_amdgcn_fence(__ATOMIC_ACQUIRE, "agent");
            asm volatile("s_waitcnt vmcnt(0)" ::: "memory");
        }
    }
    __syncthreads();
}


constexpr int PREP_EARLY_MASK = 0x060f, PREP_LATE_MASK = 0x39f0;
__device__ __forceinline__ int win_src_col(int r) {
    if (r < 3072) return r; if (r < 6144) return r + 8; if (r < 8192) return r + 24;
    if (r < 8200) return 3072 + (r - 8192); if (r < 8216) return 6152 + (r - 8200); return -1;
}
__device__ __forceinline__ void prep_transposes(const Params& p, unsigned char* lds, int dmask, int vb, int nvb) {
    float* tile = (float*)lds;
    const int tid = threadIdx.x;
    unsigned char* ws = p.ws;
    for (int d = 0; d < 14; ++d) {
        if (!((dmask >> d) & 1)) continue;
        const float* src; bf16_t* dst; int K, ldsrc, ntn, mode = 0, rowoff = 0; float scale = 1.f;
        switch (d) {
            case 0: src = p.in[10]; dst = (bf16_t*)(ws + WS_WGU1); K = 1024; ldsrc = 2816; ntn = 44; mode = 2; rowoff = 0; break;
            case 1: src = p.in[11]; dst = (bf16_t*)(ws + WS_WGU1); K = 1024; ldsrc = 2816; ntn = 44; mode = 2; rowoff = 128; break;
            case 2: src = p.in[12]; dst = (bf16_t*)(ws + WS_WD1); K = 2816; ldsrc = 1024; ntn = 16; break;
            case 3: src = p.in[14]; dst = (bf16_t*)(ws + WS_WIN); K = 1024; ldsrc = 8216; ntn = 132; mode = 1; break;
            case 4: src = p.in[20]; dst = (bf16_t*)(ws + WS_WBRM); K = 1024; ldsrc = 1024; ntn = 16; break;
            case 5: src = p.in[21]; dst = (bf16_t*)(ws + WS_WBRG); K = 1024; ldsrc = 1024; ntn = 16; break;
            case 6: src = p.in[22]; dst = (bf16_t*)(ws + WS_WOUT); K = 1024; ldsrc = 1024; ntn = 16; break;
            case 7: src = p.in[25]; dst = (bf16_t*)(ws + WS_WQ); K = 1024; ldsrc = 1024; ntn = 16; scale = 0.0625f; break;
            case 8: src = p.in[28]; dst = (bf16_t*)(ws + WS_WO); K = 1024; ldsrc = 1024; ntn = 16; break;
            case 9: src = p.in[26]; dst = (bf16_t*)(ws + WS_WKV); K = 1024; ldsrc = 1024; ntn = 16; break;
            case 10: src = p.in[27]; dst = (bf16_t*)(ws + WS_WKV); K = 1024; ldsrc = 1024; ntn = 16; rowoff = 1024; break;
            case 11: src = p.in[30]; dst = (bf16_t*)(ws + WS_WGU2); K = 1024; ldsrc = 2816; ntn = 44; mode = 2; rowoff = 0; break;
            case 12: src = p.in[31]; dst = (bf16_t*)(ws + WS_WGU2); K = 1024; ldsrc = 2816; ntn = 44; mode = 2; rowoff = 128; break;
            default: src = p.in[32]; dst = (bf16_t*)(ws + WS_WD2); K = 2816; ldsrc = 1024; ntn = 16; break;
        }
        const int nkt = K / 64, ntiles = nkt * ntn;
        for (int t = vb; t < ntiles; t += nvb) {
            const int kt = t % nkt, nt = t / nkt, k0 = kt * 64;
            {
                const int j = tid & 63;
                int srccol; float sc = scale;
                if (mode == 1) { srccol = win_src_col(nt * 64 + j); if ((srccol >= 512 && srccol < 1024) || (srccol >= 3080 && srccol < 3592)) sc = 0.08838834764831845f; }
                else srccol = nt * 64 + j;
#pragma unroll
                for (int ps = 0; ps < 8; ++ps) { const int i = (tid >> 6) + 8 * ps;
                    float v = 0.f; if (srccol >= 0) v = __builtin_nontemporal_load(src + (size_t)(k0 + i) * ldsrc + srccol) * sc;
                    tile[i * 65 + j] = v; }
            }
            __syncthreads();
            {
                const int j = tid >> 3, kc = tid & 7;
                int dstrow;
                if (mode == 1) dstrow = nt * 64 + j;
                else { const int sc_ = nt * 64 + j; dstrow = (mode == 2) ? ((sc_ >> 7) * 256 + (sc_ & 127) + rowoff) : (sc_ + rowoff); }
                float v[8];
#pragma unroll
                for (int e = 0; e < 8; ++e) v[e] = tile[(kc * 8 + e) * 65 + j];
                u32x4 w; w.x = cvt_pk(v[0], v[1]); w.y = cvt_pk(v[2], v[3]); w.z = cvt_pk(v[4], v[5]); w.w = cvt_pk(v[6], v[7]);
                *(u32x4*)(dst + (size_t)dstrow * K + k0 + kc * 8) = w;
            }
            __syncthreads();
        }
    }
}
__device__ __forceinline__ void prep_phase(const Params& p, unsigned char* lds) {
    const int tid = threadIdx.x;
    unsigned char* ws = p.ws;
    prep_transposes(p, lds, PREP_EARLY_MASK, (int)blockIdx.x, (int)gridDim.x);
    const int lane = tid & 63, gw = blockIdx.x * 8 + (tid >> 6), nw = gridDim.x * 8;
    for (int r = gw; r < MT + 2048; r += nw) {
        const float* x; const float* g; bf16_t* o;
        if (r < MP) { x = p.in[0] + (size_t)r * DM; g = p.in[9]; o = (bf16_t*)(ws + WS_ABUF) + (size_t)r * DM; }
        else if (r < MT) { x = p.in[1] + (size_t)(r - MP) * DM; g = p.in[9]; o = (bf16_t*)(ws + WS_ABUF) + (size_t)r * DM; }
        else { x = p.in[2] + (size_t)(r - MT) * DM; g = p.in[24]; o = (bf16_t*)(ws + WS_MEMA) + (size_t)(r - MT) * DM; }
        f32x4 v[4]; float ss = 0.f;
#pragma unroll
        for (int i = 0; i < 4; ++i) { v[i] = *(const f32x4*)(x + i * 256 + lane * 4); ss += v[i][0] * v[i][0] + v[i][1] * v[i][1] + v[i][2] * v[i][2] + v[i][3] * v[i][3]; }
        ss = wave_sum(ss); const float rs = rs_of(ss);
#pragma unroll
        for (int i = 0; i < 4; ++i) { const f32x4 gg = *(const f32x4*)(g + i * 256 + lane * 4);
            u32x2 w; w.x = cvt_pk(v[i][0] * rs * gg[0], v[i][1] * rs * gg[1]); w.y = cvt_pk(v[i][2] * rs * gg[2], v[i][3] * rs * gg[3]);
            *(u32x2*)(o + i * 256 + lane * 4) = w; }
    }
}

#define EPI_ROW(ai, m) (u.pm * 256 + (ai) * 128 + wr * 64 + (m) * 16 + fr)
#define EPI_COL(bj) (u.pn * 256 + (bj) * 128 + wc * 32 + fq * 8)
struct EpiGateUp {
    static constexpr bool PERM = true, AFTER_DRAIN = false;
    bf16_t* H; const float* ss;
    __device__ __forceinline__ void operator()(const f32x4 (&acc)[2][2][4][2], const pg8::Unit& u, int wr, int wc, int fr, int fq) const {
        float rsv[2][4];
#pragma unroll
        for (int ai = 0; ai < 2; ++ai)
#pragma unroll
            for (int m = 0; m < 4; ++m) rsv[ai][m] = ss ? rs_row(ss, EPI_ROW(ai, m)) : 1.f;
#pragma unroll
        for (int ai = 0; ai < 2; ++ai)
#pragma unroll
            for (int m = 0; m < 4; ++m) { const int row = EPI_ROW(ai, m); const float rs = rsv[ai][m];
                f32x4 hv[2];
#pragma unroll
                for (int n = 0; n < 2; ++n)
#pragma unroll
                    for (int j = 0; j < 4; ++j) { const float gt = acc[ai][0][m][n][j] * rs, up = acc[ai][1][m][n][j] * rs; hv[n][j] = gt * sigmoidf_(gt) * up; }
                *(u32x4*)(H + (size_t)row * DFF + u.pn * 128 + wc * 32 + fq * 8) = __builtin_bit_cast(u32x4, pack8(hv[0], hv[1])); }
    }
};
struct EpiMemKV {
    static constexpr bool PERM = true, AFTER_DRAIN = false;
    float* ok; float* ov; bf16_t* kv;
    __device__ __forceinline__ void operator()(const f32x4 (&acc)[2][2][4][2], const pg8::Unit& u, int wr, int wc, int fr, int fq) const {
#pragma unroll
        for (int ai = 0; ai < 2; ++ai)
#pragma unroll
            for (int m = 0; m < 4; ++m) { const int row = EPI_ROW(ai, m);
#pragma unroll
                for (int bj = 0; bj < 2; ++bj) { const int col = EPI_COL(bj);
                    float* o = (col < 1024) ? (ok + (size_t)row * 1024 + col) : (ov + (size_t)row * 1024 + (col - 1024));
                    __builtin_nontemporal_store(acc[ai][bj][m][0], (f32x4*)o); __builtin_nontemporal_store(acc[ai][bj][m][1], (f32x4*)(o + 4));
                    *(u32x4*)(kv + (size_t)row * 2048 + col) = __builtin_bit_cast(u32x4, pack8(acc[ai][bj][m][0], acc[ai][bj][m][1])); } }
    }
};
struct EpiResid {
    static constexpr bool PERM = true, AFTER_DRAIN = false;
    const float* res0; const float* res1; float* xout; bf16_t* aout; const float* gain; float* ss; float scale;
    __device__ __forceinline__ void operator()(const f32x4 (&acc)[2][2][4][2], const pg8::Unit& u, int wr, int wc, int fr, int fq) const {
        f32x4 gv[2][2];
        if (aout) {
#pragma unroll
            for (int bj = 0; bj < 2; ++bj) { gv[bj][0] = *(const f32x4*)(gain + EPI_COL(bj)); gv[bj][1] = *(const f32x4*)(gain + EPI_COL(bj) + 4); } }
#pragma unroll
        for (int ai = 0; ai < 2; ++ai) {
            f32x4 rv[4][2][2];
#pragma unroll
            for (int m = 0; m < 4; ++m) { const int row = EPI_ROW(ai, m);
                const float* rp = (row < MP) ? (res0 + (size_t)row * DM) : (res1 + (size_t)(row - MP) * DM);
#pragma unroll
                for (int bj = 0; bj < 2; ++bj) { rv[m][bj][0] = *(const f32x4*)(rp + EPI_COL(bj)); rv[m][bj][1] = *(const f32x4*)(rp + EPI_COL(bj) + 4); } }
#pragma unroll
            for (int m = 0; m < 4; ++m) { const int row = EPI_ROW(ai, m);
                float sq = 0.f;
#pragma unroll
                for (int bj = 0; bj < 2; ++bj) { const int col = EPI_COL(bj);
                    const f32x4 x0 = rv[m][bj][0] + acc[ai][bj][m][0] * scale, x1 = rv[m][bj][1] + acc[ai][bj][m][1] * scale;
                    *(f32x4*)(xout + (size_t)row * DM + col) = x0; *(f32x4*)(xout + (size_t)row * DM + col + 4) = x1;
#pragma unroll
                    for (int j = 0; j < 4; ++j) sq += x0[j] * x0[j] + x1[j] * x1[j];
                    if (aout) *(u32x4*)(aout + (size_t)row * DM + col) = __builtin_bit_cast(u32x4, pack8(x0 * gv[bj][0], x1 * gv[bj][1])); }
                sq = xsum16_32(sq);
                if (fq == 0) ss[(size_t)row * 16 + u.pn * 4 + wc] = sq; }
        }
    }
    __device__ __forceinline__ void small(f32x4 acc, int row, int col, int tc, int rt, int ct, int l16, int g, unsigned char* lds) const {
        const f32x4 x = *(const f32x4*)(res1 + (size_t)(row - MP) * DM + col) + acc * scale;
        *(f32x4*)(xout + (size_t)row * DM + col) = x;
        if (aout) { const f32x4 gv4 = *(const f32x4*)(gain + col); *(u32x2*)(aout + (size_t)row * DM + col) = pack4(x * gv4); }
        float sq = x[0] * x[0] + x[1] * x[1] + x[2] * x[2] + x[3] * x[3];
        sq = xsum16_32(sq);
        float* red = (float*)lds;
        if (g == 0) red[(rt * 4 + ct) * 16 + l16] = sq;
        __syncthreads();
        if (ct == 0 && g == 0) ss[(size_t)row * 16 + tc] = (red[(rt * 4) * 16 + l16] + red[(rt * 4 + 1) * 16 + l16]) + (red[(rt * 4 + 2) * 16 + l16] + red[(rt * 4 + 3) * 16 + l16]);
        __syncthreads();
    }
};
struct EpiZ {
    static constexpr bool PERM = true, AFTER_DRAIN = false;
    bf16_t* Z; float* ZS; const float* ss;
    __device__ __forceinline__ void operator()(const f32x4 (&acc)[2][2][4][2], const pg8::Unit& u, int wr, int wc, int fr, int fq) const {
#pragma unroll
        for (int ai = 0; ai < 2; ++ai) {
            float rsv[4];
#pragma unroll
            for (int m = 0; m < 4; ++m) rsv[m] = rs_row(ss, EPI_ROW(ai, m));
#pragma unroll
            for (int m = 0; m < 4; ++m) { const int row = EPI_ROW(ai, m); const float rs = rsv[m];
                if (u.pn < 32) {
#pragma unroll
                    for (int bj = 0; bj < 2; ++bj)
                        *(u32x4*)(Z + (size_t)row * ZLD + EPI_COL(bj)) = __builtin_bit_cast(u32x4, pack8(acc[ai][bj][m][0] * rs, acc[ai][bj][m][1] * rs));
                } else if (wc == 0) {
                    *(f32x4*)(ZS + (size_t)row * ZSLD + fq * 8) = acc[ai][0][m][0] * rs; *(f32x4*)(ZS + (size_t)row * ZSLD + fq * 8 + 4) = acc[ai][0][m][1] * rs;
                } } }
    }
};
template <int MODE> struct EpiMerge {
    static constexpr bool PERM = true, AFTER_DRAIN = false;
    const bf16_t* gate; float* T; bf16_t* Y;
    __device__ __forceinline__ void operator()(const f32x4 (&acc)[2][2][4][2], const pg8::Unit& u, int wr, int wc, int fr, int fq) const {
#pragma unroll
        for (int ai = 0; ai < 2; ++ai)
#pragma unroll
            for (int mh = 0; mh < 2; ++mh) {
                u32x4 gw[2][2]; u32x4 tvb[2][2]; bf16_t* Tb = (bf16_t*)T;
#pragma unroll
                for (int mm = 0; mm < 2; ++mm) { const int row = EPI_ROW(ai, mh * 2 + mm);
#pragma unroll
                    for (int bj = 0; bj < 2; ++bj) { gw[mm][bj] = *(const u32x4*)(gate + (size_t)row * ZLD + EPI_COL(bj));
                        if (MODE == 1) tvb[mm][bj] = *(const u32x4*)(Tb + (size_t)row * DM + EPI_COL(bj)); } }
#pragma unroll
                for (int mm = 0; mm < 2; ++mm) { const int m = mh * 2 + mm, row = EPI_ROW(ai, m);
#pragma unroll
                    for (int bj = 0; bj < 2; ++bj) { const int col = EPI_COL(bj); const u32x4 g4 = gw[mm][bj];
                        f32x4 s0, s1;
                        s0[0] = sigmoidf_(bflo(g4.x)); s0[1] = sigmoidf_(bfhi(g4.x)); s0[2] = sigmoidf_(bflo(g4.y)); s0[3] = sigmoidf_(bfhi(g4.y));
                        s1[0] = sigmoidf_(bflo(g4.z)); s1[1] = sigmoidf_(bfhi(g4.z)); s1[2] = sigmoidf_(bflo(g4.w)); s1[3] = sigmoidf_(bfhi(g4.w));
                        f32x4 v0 = acc[ai][bj][m][0] * s0, v1 = acc[ai][bj][m][1] * s1;
                        if (MODE == 0) *(u32x4*)(Tb + (size_t)row * DM + col) = __builtin_bit_cast(u32x4, pack8(v0, v1));
                        else { const u32x4 t4 = tvb[mm][bj];
                            v0 += (f32x4){bflo(t4.x), bfhi(t4.x), bflo(t4.y), bfhi(t4.y)}; v1 += (f32x4){bflo(t4.z), bfhi(t4.z), bflo(t4.w), bfhi(t4.w)};
                            *(u32x4*)(Y + (size_t)row * DM + col) = __builtin_bit_cast(u32x4, pack8(v0, v1)); } } }
            }
    }
    __device__ __forceinline__ void small(f32x4 acc, int row, int col, int tc, int rt, int ct, int l16, int g, unsigned char* lds) const {
        bf16_t* Tb = (bf16_t*)T;
        const u32x2 g2 = *(const u32x2*)(gate + (size_t)row * ZLD + col);
        f32x4 v = acc * (f32x4){sigmoidf_(bflo(g2.x)), sigmoidf_(bfhi(g2.x)), sigmoidf_(bflo(g2.y)), sigmoidf_(bfhi(g2.y))};
        if (MODE == 0) *(u32x2*)(Tb + (size_t)row * DM + col) = pack4(v);
        else { const u32x2 t2 = *(const u32x2*)(Tb + (size_t)row * DM + col);
            v += (f32x4){bflo(t2.x), bfhi(t2.x), bflo(t2.y), bfhi(t2.y)};
            *(u32x2*)(Y + (size_t)row * DM + col) = pack4(v); }
    }
};
struct EpiQ {
    static constexpr bool PERM = true, AFTER_DRAIN = false;
    bf16_t* Q; const float* ss;
    __device__ __forceinline__ void operator()(const f32x4 (&acc)[2][2][4][2], const pg8::Unit& u, int wr, int wc, int fr, int fq) const {
#pragma unroll
        for (int ai = 0; ai < 2; ++ai) {
            float rsv[4];
#pragma unroll
            for (int m = 0; m < 4; ++m) rsv[m] = rs_row(ss, EPI_ROW(ai, m));
#pragma unroll
            for (int m = 0; m < 4; ++m) { const int row = EPI_ROW(ai, m); const float rs = rsv[m];
#pragma unroll
                for (int bj = 0; bj < 2; ++bj)
                    *(u32x4*)(Q + (size_t)row * DM + EPI_COL(bj)) = __builtin_bit_cast(u32x4, pack8(acc[ai][bj][m][0] * rs, acc[ai][bj][m][1] * rs)); } }
    }
    __device__ __forceinline__ void small(f32x4 acc, int row, int col, int tc, int rt, int ct, int l16, int g, unsigned char* lds) const {
        *(u32x2*)(Q + (size_t)row * DM + col) = pack4(acc * rs_row(ss, row));
    }
};
template <class Epi>
__device__ __forceinline__ void small_gemm(unsigned char* lds, const bf16_t* A, int lda, const bf16_t* Bt, int N, int K, const Epi& E) {
    const int tid = threadIdx.x, w = tid >> 6, lane = tid & 63, g = lane >> 4, l16 = lane & 15;
    const int rt = w >> 2, ct = w & 3, nct = N / 64, ntiles = 16 * nct;
    for (int t = blockIdx.x; t < ntiles; t += gridDim.x) {
        const int tr = t / nct, tc = t - tr * nct;
        const int row = MP + tr * 32 + rt * 16 + l16, colb = tc * 64 + ct * 16;
        const bf16_t* ap = A + (size_t)row * lda + 8 * g;
        const bf16_t* bp = Bt + (size_t)(colb + l16) * K + 8 * g;
        f32x4 acc0 = (f32x4){0.f, 0.f, 0.f, 0.f}, acc1 = acc0;
#pragma unroll 4
        for (int k = 0; k < K; k += 64) {
            acc0 = mfma16(*(const bf16x8*)(bp + k), *(const bf16x8*)(ap + k), acc0);
            acc1 = mfma16(*(const bf16x8*)(bp + k + 32), *(const bf16x8*)(ap + k + 32), acc1);
        }
        E.small(acc0 + acc1, row, colb + 4 * g, tc, rt, ct, l16, g, lds);
    }
}
template <class Epi>
__device__ __forceinline__ void run_gemm(unsigned char* lds, const bf16_t* A, int lda, const bf16_t* Bt, int M, int N, int K, const Epi& E, int rot) {
    pg8::Gemm g; g.A = A; g.Bt = Bt; g.M = M; g.N = N; g.K = K; g.lda = lda; g.ldb = K;
    pg8::StaticOrder S; S.init(M, N, (int)gridDim.x, (int)((blockIdx.x + rot) % gridDim.x));
    pg8::gemm_phase<Epi, pg8::StaticOrder>((PG8_LAS unsigned char*)lds, g, S, E);
    __syncthreads();
}
constexpr int T_STRIDE = 272, V_STRIDE = 528;
constexpr int VQN = 2, VW = 256 / VQN, NVT = VW / 16, NOT = NVT / 2, V2_STRIDE = VW * 2 + 16;
constexpr int M_T0 = 0, M_T1 = 17408, M_TV = 34816, M_TC = M_TV + 64 * V2_STRIDE, M_SM = M_TC + VW * T_STRIDE;
template <int BR>
__device__ __forceinline__ void mixer_prompt(const Params& p, unsigned char* lds, int b, int h, int vq) {
    const int tid = threadIdx.x, w = tid >> 6, lane = tid & 63, g = lane >> 4, l16 = lane & 15, q4 = l16 >> 2, p4 = lane & 3;
    const int tt = w & 3, vh = w >> 2;
    bf16_t* Z = (bf16_t*)(p.ws + WS_Z);
    const float* ZS = (const float*)(p.ws + WS_ZS);
    float* SSQ = (float*)(p.ws + WS_SSQ);
    const float* BEND = (const float*)(p.ws + WS_BEND);
    const int qcol = (BR == 0 ? 0 : 3072) + h * 128, kcol = (BR == 0 ? 512 : 3584) + h * 128;
    const int vcol = (BR == 0 ? 1024 : 4096) + h * 256 + vq * VW, ocol = (BR == 0 ? 2048 : 5120) + h * 256 + vq * VW;
    unsigned char* T0 = lds + M_T0; unsigned char* T1 = lds + M_T1; unsigned char* TV = lds + M_TV; unsigned char* TC = lds + M_TC;
    float* sm = (float*)(lds + M_SM);
    float* gS = sm; float* Mt = sm + 64; float* at = sm + 128; float* emt = sm + 192; float* wsv = sm + 256; float* nvec = sm + 320; float* bend = sm + 448;
    float* misc = sm + 576; float* ssq = sm + 592; float* gaL = sm + 720; float* segtot = sm + 1744; float* waL = sm + 2256;
    const unsigned aT0_ = (unsigned)(size_t)T0, aT1_ = (unsigned)(size_t)T1, aTV_ = (unsigned)(size_t)TV;
    const float* gain = (BR == 0 ? p.in[18] : p.in[19]) + h * 256 + vq * VW;
    const int tloc = 16 * tt + l16;
    f32x4 gn[NOT];
#pragma unroll
    for (int vi = 0; vi < NOT; ++vi) gn[vi] = *(const f32x4*)(gain + (VW / 2) * vh + 16 * vi + 4 * g);
    f32x4 st[NVT];
#pragma unroll
    for (int c = 0; c < NVT; ++c) st[c] = (f32x4){0.f, 0.f, 0.f, 0.f};
    float m0 = 0.f;
    const float bi = (BR == 0) ? p.in[15][h] : 0.f, bfb = (BR == 0) ? p.in[15][4 + h] : 0.f;
    if (tid < 128) nvec[tid] = 0.f;
    u32x4 kreg[2], qreg[2], vreg[2]; bf16x8 qn[4]; float igr = 0.f, lfr = 0.f, gar[2] = {0.f, 0.f};
    const int ks_s0 = tid >> 4, ks_ch = tid & 15;
#define MIX_LOAD_CHUNK(R0) do { const size_t r_ = (size_t)(R0); \
        kreg[0] = *(const u32x4*)(Z + (r_ + ks_s0) * ZLD + kcol + ks_ch * 8); kreg[1] = *(const u32x4*)(Z + (r_ + ks_s0 + 32) * ZLD + kcol + ks_ch * 8); \
        vreg[0] = *(const u32x4*)(Z + (r_ + ks_s0) * ZLD + vcol + ks_ch * 8); vreg[1] = *(const u32x4*)(Z + (r_ + ks_s0 + 32) * ZLD + vcol + ks_ch * 8); \
        if (BR == 0) { _Pragma("unroll") for (int ks = 0; ks < 4; ++ks) qn[ks] = *(const bf16x8*)(Z + (r_ + tloc) * ZLD + qcol + 32 * ks + 8 * g); \
            if (w == 0) { igr = ZS[(r_ + lane) * ZSLD + h]; lfr = ZS[(r_ + lane) * ZSLD + 4 + h]; } } \
        else { qreg[0] = *(const u32x4*)(Z + (r_ + ks_s0) * ZLD + qcol + ks_ch * 8); qreg[1] = *(const u32x4*)(Z + (r_ + ks_s0 + 32) * ZLD + qcol + ks_ch * 8); \
            if (tid < 128) gar[0] = BEND[(r_ >> 6) * 512 + h * 128 + tid]; } } while (0)
    MIX_LOAD_CHUNK(b * 2048);
    __syncthreads();
    for (int c = 0; c < 32; ++c) {
        const int r0 = b * 2048 + c * 64;
        if (c > 0 && tid < 64) { float* sp_ = SSQ + ((size_t)(r0 - 64 + tid) * 8 + BR * 4 + h) * 4 + vq * 2; sp_[0] = ssq[tid] + ssq[64 + tid]; sp_[1] = 0.f; }
        unsigned aT0 = aT0_, aT1 = aT1_, aTV = aTV_;
        asm volatile("" : "+v"(aT0), "+v"(aT1), "+v"(aTV));
        if (BR == 0) {
            if (w == 0) {
                const float ig = igr + bi, lf = logsigf_(lfr + bfb);
                float F = lf;
#pragma unroll
                for (int o = 1; o < 64; o <<= 1) { const float y = __shfl_up(F, o); if (lane >= o) F += y; }
                const float gg = ig - F; float cm = gg;
#pragma unroll
                for (int o = 1; o < 64; o <<= 1) { const float y = __shfl_up(cm, o); if (lane >= o) cm = fmaxf(cm, y); }
                const float M = fmaxf(m0, cm), a = __expf(m0 - M);
                const float ML = __shfl(M, 63), aend = __shfl(a, 63), FL = __shfl(F, 63);
                gS[lane] = gg; Mt[lane] = M; at[lane] = a; emt[lane] = __expf(-(F + M)); wsv[lane] = __expf(gg - ML);
                if (lane == 0) misc[1] = aend;
                m0 = FL + ML;
            }
            __syncthreads();
#pragma unroll
            for (int i = 0; i < 2; ++i) { const int s = ks_s0 + 32 * i; const u32x4 kw = kreg[i];
                *(u32x4*)(T0 + s * T_STRIDE + ks_ch * 16) = kw;
                const float ww = wsv[s]; u32x4 o;
                o.x = cvt_pk(bflo(kw.x) * ww, bfhi(kw.x) * ww); o.y = cvt_pk(bflo(kw.y) * ww, bfhi(kw.y) * ww);
                o.z = cvt_pk(bflo(kw.z) * ww, bfhi(kw.z) * ww); o.w = cvt_pk(bflo(kw.w) * ww, bfhi(kw.w) * ww);
                *(u32x4*)(T1 + s * T_STRIDE + ks_ch * 16) = o; }
        } else {
            if (tid < 128) bend[tid] = gar[0];
#pragma unroll
            for (int i = 0; i < 2; ++i) { const int s = ks_s0 + 32 * i;
                *(u32x4*)(T0 + s * T_STRIDE + ks_ch * 16) = kreg[i]; *(u32x4*)(T1 + s * T_STRIDE + ks_ch * 16) = qreg[i]; }
        }
#pragma unroll
        for (int i = 0; i < 2; ++i) *(u32x4*)(TV + (ks_s0 + 32 * i) * V2_STRIDE + ks_ch * 16) = vreg[i];
#pragma unroll
        for (int c16 = 0; c16 < NVT; ++c16) *(u32x2*)(TC + (16 * c16 + l16) * T_STRIDE + (16 * w + 4 * g) * 2) = pack4(st[c16]);
        __syncthreads();
        bf16x8 qf[4];
#pragma unroll
        for (int ks = 0; ks < 4; ++ks) {
            if (BR == 0) qf[ks] = qn[ks];
            else qf[ks] = *(const bf16x8*)(T1 + tloc * T_STRIDE + (32 * ks + 8 * g) * 2);
        }
        bf16_t* op = Z + (size_t)(r0 + tloc) * ZLD + ocol + (VW / 2) * vh + 4 * g;
        u32x2 gwv[NOT];
#pragma unroll
        for (int vi = 0; vi < NOT; ++vi) gwv[vi] = *(const u32x2*)(op + 16 * vi);
        if (c < 31) MIX_LOAD_CHUNK(r0 + 64);
        f32x4 sacc[4];
#pragma unroll
        for (int si = 0; si < 4; ++si) { sacc[si] = (f32x4){0.f, 0.f, 0.f, 0.f};
#pragma unroll
            for (int ks = 0; ks < 4; ++ks) sacc[si] = mfma16(*(const bf16x8*)(T0 + (16 * si + l16) * T_STRIDE + (32 * ks + 8 * g) * 2), qf[ks], sacc[si]); }
        float den = 0.f;
        {
            const float Mtt = (BR == 0) ? Mt[tloc] : 0.f;
            f32x4 gS4[4];
#pragma unroll
            for (int si = 0; si < 4; ++si) gS4[si] = (BR == 0) ? *(const f32x4*)(gS + 16 * si + 4 * g) : (f32x4){0.f, 0.f, 0.f, 0.f};
#pragma unroll
            for (int si = 0; si < 4; ++si)
#pragma unroll
                for (int r = 0; r < 4; ++r) { const int s = 16 * si + 4 * g + r;
                    float wgt;
                    if (BR == 0) { const float e = __expf(fminf(gS4[si][r] - Mtt, 0.f)); wgt = (s <= tloc) ? e : 0.f; } else wgt = (s <= tloc) ? 1.f : 0.f;
                    sacc[si][r] *= wgt; den += sacc[si][r]; }
        }
        f32x4 oacc[NOT];
#pragma unroll
        for (int vi = 0; vi < NOT; ++vi) { oacc[vi] = (f32x4){0.f, 0.f, 0.f, 0.f};
#pragma unroll
            for (int ks = 0; ks < 4; ++ks) oacc[vi] = mfma16(*(const bf16x8*)(TC + ((VW / 2) * vh + 16 * vi + l16) * T_STRIDE + (32 * ks + 8 * g) * 2), qf[ks], oacc[vi]); }
        if (BR == 0) {
            den = xsum16_32(den);
            const float a_t = at[tloc];
            float nq = 0.f;
#pragma unroll
            for (int ks = 0; ks < 4; ++ks)
#pragma unroll
                for (int j = 0; j < 8; ++j) nq += nvec[32 * ks + 8 * g + j] * bf2f((bf16_t)qf[ks][j]);
            nq = xsum16_32(nq);
            den += a_t * nq;
#pragma unroll
            for (int vi = 0; vi < NOT; ++vi) oacc[vi] *= a_t;
        }
#pragma unroll
        for (int ks = 0; ks < 2; ++ks) {
            const bf16x8 pb = pack8(sacc[2 * ks], sacc[2 * ks + 1]);
#pragma unroll
            for (int vi = 0; vi < NOT; vi += 4) {
                const unsigned a0 = aTV + (32 * ks + 4 * g + q4) * V2_STRIDE + ((VW / 2) * vh + 16 * vi) * 2 + 8 * p4, a1 = a0 + 16 * V2_STRIDE;
                bf16x8 fa, fb, fc, fd; tr_frag4(a0, a1, a0 + 32, a1 + 32, a0 + 64, a1 + 64, a0 + 96, a1 + 96, fa, fb, fc, fd);
                oacc[vi] = mfma16(fa, pb, oacc[vi]); oacc[vi + 1] = mfma16(fb, pb, oacc[vi + 1]); oacc[vi + 2] = mfma16(fc, pb, oacc[vi + 2]); oacc[vi + 3] = mfma16(fd, pb, oacc[vi + 3]); }
        }
        if (BR == 0) { const float inv = 1.f / fmaxf(fabsf(den), emt[tloc]);
#pragma unroll
            for (int vi = 0; vi < NOT; ++vi) oacc[vi] *= inv; }
        float sq = 0.f;
#pragma unroll
        for (int vi = 0; vi < NOT; ++vi)
#pragma unroll
            for (int r = 0; r < 4; ++r) sq += oacc[vi][r] * oacc[vi][r];
        sq = xsum16_32(sq);
        if (g == 0) ssq[vh * 64 + tloc] = sq;
#pragma unroll
        for (int vi = 0; vi < NOT; ++vi) {
            const float gt[4] = {bflo(gwv[vi].x), bfhi(gwv[vi].x), bflo(gwv[vi].y), bfhi(gwv[vi].y)}; f32x4 o;
#pragma unroll
            for (int r = 0; r < 4; ++r) { const float sg = sigmoidf_(gt[r]); o[r] = oacc[vi][r] * gn[vi][r] * (BR == 0 ? sg : gt[r] * sg); }
            *(u32x2*)(op + 16 * vi) = pack4(o); }
        if (BR == 0) { const float aend = misc[1];
#pragma unroll
            for (int c16 = 0; c16 < NVT; ++c16) st[c16] *= aend; }
#pragma unroll
        for (int ks = 0; ks < 2; ++ks) {
            const unsigned ka0 = (BR == 0 ? aT1 : aT0) + (32 * ks + 8 * g + q4) * T_STRIDE + (16 * w) * 2 + 8 * p4;
            const bf16x8 kf = tr_frag(ka0, ka0 + 4 * T_STRIDE);
#pragma unroll
            for (int c16 = 0; c16 < NVT; c16 += 4) {
                const unsigned v0 = aTV + (32 * ks + 8 * g + q4) * V2_STRIDE + (16 * c16) * 2 + 8 * p4, v1 = v0 + 4 * V2_STRIDE;
                bf16x8 fa, fb, fc, fd; tr_frag4(v0, v1, v0 + 32, v1 + 32, v0 + 64, v1 + 64, v0 + 96, v1 + 96, fa, fb, fc, fd);
                st[c16] = mfma16(kf, fa, st[c16]); st[c16 + 1] = mfma16(kf, fb, st[c16 + 1]); st[c16 + 2] = mfma16(kf, fc, st[c16 + 2]); st[c16 + 3] = mfma16(kf, fd, st[c16 + 3]);
            }
        }
        if (BR == 1) {
            float eb[4];
#pragma unroll
            for (int r = 0; r < 4; ++r) eb[r] = __expf(bend[16 * w + 4 * g + r]);
#pragma unroll
            for (int c16 = 0; c16 < NVT; ++c16)
#pragma unroll
                for (int r = 0; r < 4; ++r) st[c16][r] *= eb[r];
        } else {
            const int d = tid & 127, seg = tid >> 7; float a2 = 0.f;
#pragma unroll
            for (int s = 0; s < 16; ++s) a2 += bf2f(*(const bf16_t*)(T1 + (seg * 16 + s) * T_STRIDE + d * 2));
            segtot[seg * 128 + d] = a2;
        }
        __syncthreads();
        if (BR == 0 && tid < 128) nvec[tid] = misc[1] * nvec[tid] + ((segtot[tid] + segtot[128 + tid]) + (segtot[256 + tid] + segtot[384 + tid]));
    }
#undef MIX_LOAD_CHUNK
    if (tid < 64) { float* sp_ = SSQ + ((size_t)(b * 2048 + 31 * 64 + tid) * 8 + BR * 4 + h) * 4 + vq * 2; sp_[0] = ssq[tid] + ssq[64 + tid]; sp_[1] = 0.f; }
    const int bh = b * 4 + h;
    if (BR == 0) {
        float* Co = p.out + O_CP + (size_t)bh * 32768;
#pragma unroll
        for (int c16 = 0; c16 < NVT; ++c16) __builtin_nontemporal_store(st[c16], (f32x4*)(Co + (size_t)(VW * vq + 16 * c16 + l16) * 128 + 16 * w + 4 * g));
        if (vq == 0) { if (tid < 128) p.out[O_NP + bh * 128 + tid] = nvec[tid];
            if (tid == 0) p.out[O_MPP + bh] = m0; }
    } else {
        float* So = p.out + O_SP + (size_t)bh * 32768;
#pragma unroll
        for (int c16 = 0; c16 < NVT; ++c16)
#pragma unroll
            for (int r = 0; r < 4; ++r) So[(size_t)(16 * w + 4 * g + r) * 256 + VW * vq + 16 * c16 + l16] = st[c16][r];
    }
    __syncthreads();
}

__device__ __forceinline__ void gla_prep(const Params& p, unsigned char* lds, int item) {
    const int tid = threadIdx.x, d = tid & 127, seg = tid >> 7;
    const int h = item & 3, c = (item >> 2) & 31, b = item >> 7;
    bf16_t* Z = (bf16_t*)(p.ws + WS_Z);
    const float* ZS = (const float*)(p.ws + WS_ZS);
    float* BEND = (float*)(p.ws + WS_BEND);
    float* gaL = (float*)lds; float* waL = gaL + 1024; float* segtot = waL + 2048;
    const int r0 = b * 2048 + c * 64, qcol = 3072 + h * 128, kcol = 3584 + h * 128;
    gaL[tid] = ZS[(size_t)(r0 + (tid >> 4)) * ZSLD + 8 + (tid & 15)]; gaL[tid + 512] = ZS[(size_t)(r0 + 32 + (tid >> 4)) * ZSLD + 8 + (tid & 15)];
#pragma unroll
    for (int j = 0; j < 4; ++j) { const int id = tid + 512 * j; waL[id] = p.in[16][(id >> 7) * 512 + h * 128 + (id & 127)]; }
    const float ba = p.in[17][h * 128 + d];
    __syncthreads();
    float wa[16];
#pragma unroll
    for (int j = 0; j < 16; ++j) wa[j] = waL[j * 128 + d];
    float la[16]; float run = 0.f;
#pragma unroll
    for (int i = 0; i < 16; ++i) { const int t = seg * 16 + i; float x = ba;
#pragma unroll
        for (int j = 0; j < 16; ++j) x += gaL[t * 16 + j] * wa[j];
        run += logsigf_(x) * 0.0625f; la[i] = run; }
    segtot[seg * 128 + d] = run;
    __syncthreads();
    float pre = 0.f, tot = 0.f;
#pragma unroll
    for (int s2 = 0; s2 < 4; ++s2) { const float v = segtot[s2 * 128 + d]; tot += v; if (s2 < seg) pre += v; }
    if (seg == 0) BEND[(size_t)(b * 32 + c) * 512 + h * 128 + d] = tot;
    bf16_t qv[16], kv[16];
#pragma unroll
    for (int i = 0; i < 16; ++i) { const int t = seg * 16 + i; qv[i] = Z[(size_t)(r0 + t) * ZLD + qcol + d]; kv[i] = Z[(size_t)(r0 + t) * ZLD + kcol + d]; }
#pragma unroll
    for (int i = 0; i < 16; ++i) { const int t = seg * 16 + i; const float bb = la[i] + pre;
        Z[(size_t)(r0 + t) * ZLD + qcol + d] = f2bf(bf2f(qv[i]) * __expf(bb)); Z[(size_t)(r0 + t) * ZLD + kcol + d] = f2bf(bf2f(kv[i]) * __expf(-bb)); }
    __syncthreads();
}

template <int BR>
__device__ __forceinline__ void mixer_sample(const Params& p, unsigned char* lds, int b, int h) {
    const int tid = threadIdx.x, w = tid >> 6, lane = tid & 63;
    bf16_t* Z = (bf16_t*)(p.ws + WS_Z);
    const float* ZS = (const float*)(p.ws + WS_ZS);
    const int qcol = (BR == 0 ? 0 : 3072) + h * 128, kcol = (BR == 0 ? 512 : 3584) + h * 128, vcol = (BR == 0 ? 1024 : 4096) + h * 256, ocol = (BR == 0 ? 2048 : 5120) + h * 256;
    float* sm = (float*)lds;
    float* qa = sm; float* ka = sm + 512; float* kd = sm + 1024; float* dec = sm + 1536; float* vv = sm + 1664; float* qk = sm + 2688; float* sc = sm + 2704;
    float* part = sm + 2752; float* red = sm + 4800;
    const int r0 = MP + 4 * b, bh = b * 4 + h;
    const float* gain = (BR == 0 ? p.in[18] : p.in[19]) + h * 256;
    float a_t[4] = {1.f, 1.f, 1.f, 1.f}, mt[4] = {0.f, 0.f, 0.f, 0.f}, aend = 1.f;
    {
        const int t = tid >> 7, d = tid & 127;
        const float qraw = bf2f(Z[(size_t)(r0 + t) * ZLD + qcol + d]), kraw = bf2f(Z[(size_t)(r0 + t) * ZLD + kcol + d]);
#pragma unroll
        for (int i = 0; i < 2; ++i) { const int id = tid + 512 * i; vv[id] = bf2f(Z[(size_t)(r0 + (id >> 8)) * ZLD + vcol + (id & 255)]); }
        if (BR == 0) {
            const float m0 = p.in[5][bh], bi = p.in[15][h], bfb = p.in[15][4 + h];
            float F = 0.f, cm = -3.0e38f, gg[4], Mv[4];
#pragma unroll
            for (int s = 0; s < 4; ++s) { const float ig = ZS[(size_t)(r0 + s) * ZSLD + h] + bi, lf = logsigf_(ZS[(size_t)(r0 + s) * ZSLD + 4 + h] + bfb);
                F += lf; gg[s] = ig - F; cm = fmaxf(cm, gg[s]); Mv[s] = fmaxf(m0, cm); a_t[s] = __expf(m0 - Mv[s]); mt[s] = F + Mv[s]; }
            aend = a_t[3];
            float wsel = 0.f;
#pragma unroll
            for (int s = 0; s < 4; ++s) { const float ws_ = __expf(gg[s] - Mv[3]); if (s == t) wsel = ws_; }
            qa[tid] = qraw; ka[tid] = kraw; kd[tid] = wsel * kraw;
            if (tid < 128) dec[tid] = aend;
            if (tid == 0) {
#pragma unroll
                for (int s = 0; s < 4; ++s) { sc[16 + s] = gg[s]; sc[20 + s] = Mv[s]; } }
        } else {
            float la[4];
#pragma unroll
            for (int s = 0; s < 4; ++s) { float x = p.in[17][h * 128 + d];
#pragma unroll
                for (int j = 0; j < 16; ++j) x += ZS[(size_t)(r0 + s) * ZSLD + 8 + j] * p.in[16][j * 512 + h * 128 + d];
                la[s] = logsigf_(x) * 0.0625f; }
            float bt = 0.f, bendv = 0.f;
#pragma unroll
            for (int s = 0; s < 4; ++s) { bendv += la[s]; if (s <= t) bt += la[s]; }
            qa[tid] = qraw * __expf(bt); ka[tid] = kraw * __expf(-bt); kd[tid] = kraw * __expf(bendv - bt);
            if (t == 0) dec[d] = __expf(bendv);
        }
    }
    __syncthreads();
    {
        const int pr = tid >> 5, l = tid & 31, t = pr >> 2, s = pr & 3;
        const f32x4 a = *(const f32x4*)(qa + t * 128 + l * 4), k4 = *(const f32x4*)(ka + s * 128 + l * 4);
        float v = a[0] * k4[0] + a[1] * k4[1] + a[2] * k4[2] + a[3] * k4[3];
#pragma unroll
        for (int o = 16; o > 0; o >>= 1) v += __shfl_xor(v, o);
        if (l == 0) { float wgt; if (BR == 0) wgt = (s <= t) ? __expf(sc[16 + s] - sc[20 + t]) : 0.f; else wgt = (s <= t) ? 1.f : 0.f; qk[pr] = v * wgt; }
        if (BR == 0 && tid < 128) {
            const int t2 = tid >> 5;
            const f32x4 n4 = *(const f32x4*)(p.in[4] + (size_t)bh * 128 + l * 4), q4v = *(const f32x4*)(qa + t2 * 128 + l * 4);
            float v2 = n4[0] * q4v[0] + n4[1] * q4v[1] + n4[2] * q4v[2] + n4[3] * q4v[3];
#pragma unroll
            for (int o = 16; o > 0; o >>= 1) v2 += __shfl_xor(v2, o);
            if (l == 0) sc[12 + t2] = v2;
        }
    }
    __syncthreads();
    float hv[4]; int vown; bool owner;
    if (BR == 0) {
        const int l32 = lane & 31, half = lane >> 5;
        const float* C0 = p.in[3] + (size_t)bh * 32768 + 4 * l32;
        float* C1 = p.out + O_CS + (size_t)bh * 32768 + 4 * l32;
        f32x4 qa4[4], kd4[4]; const f32x4 dec4 = *(const f32x4*)(dec + 4 * l32);
#pragma unroll
        for (int t = 0; t < 4; ++t) { qa4[t] = *(const f32x4*)(qa + t * 128 + 4 * l32); kd4[t] = *(const f32x4*)(kd + t * 128 + 4 * l32); }
#pragma unroll
        for (int ib = 0; ib < 16; ib += 8) {
            f32x4 cv[8];
#pragma unroll
            for (int e = 0; e < 8; ++e) cv[e] = __builtin_nontemporal_load((const f32x4*)(C0 + (size_t)(w * 32 + 2 * (ib + e) + half) * 128));
#pragma unroll
            for (int e = 0; e < 8; ++e) { const int v = w * 32 + 2 * (ib + e) + half; const f32x4 c = cv[e];
                float wv[4], pt[4];
#pragma unroll
                for (int s = 0; s < 4; ++s) wv[s] = vv[s * 256 + v];
                f32x4 o = dec4 * c;
#pragma unroll
                for (int s = 0; s < 4; ++s) o += kd4[s] * wv[s];
                __builtin_nontemporal_store(o, (f32x4*)(C1 + (size_t)v * 128));
#pragma unroll
                for (int t = 0; t < 4; ++t) { float x = c[0] * qa4[t][0] + c[1] * qa4[t][1] + c[2] * qa4[t][2] + c[3] * qa4[t][3];
#pragma unroll
                    for (int of = 16; of > 0; of >>= 1) x += __shfl_xor(x, of);
                    pt[t] = x; }
                if (l32 == 0) {
#pragma unroll
                    for (int t = 0; t < 4; ++t) part[t * 256 + v] = pt[t]; }
            }
        }
        if (tid < 128) { float acc = aend * p.in[4][(size_t)bh * 128 + tid];
#pragma unroll
            for (int s = 0; s < 4; ++s) acc += kd[s * 128 + tid];
            p.out[O_NS + (size_t)bh * 128 + tid] = acc; }
        if (tid == 0) p.out[O_MSS + bh] = mt[3];
        __syncthreads();
        vown = tid & 255; owner = (tid < 256);
        {
            float wv2[4];
#pragma unroll
            for (int s = 0; s < 4; ++s) wv2[s] = vv[s * 256 + vown];
#pragma unroll
            for (int t = 0; t < 4; ++t) { float num = a_t[t] * part[t * 256 + vown], den = a_t[t] * sc[12 + t];
#pragma unroll
                for (int s = 0; s < 4; ++s) { num += qk[t * 4 + s] * wv2[s]; den += qk[t * 4 + s]; }
                hv[t] = num / fmaxf(fabsf(den), __expf(-mt[t])); }
        }
    } else {
        const int v4 = lane * 4;
        const float* S0 = p.in[6] + ((size_t)bh * 128 + 16 * w) * 256 + v4;
        float* S1 = p.out + O_SS + ((size_t)bh * 128 + 16 * w) * 256 + v4;
        float* part8 = sm + 4864;
        f32x4 wv4[4], pt4[4];
#pragma unroll
        for (int s = 0; s < 4; ++s) { wv4[s] = *(const f32x4*)(vv + s * 256 + v4); pt4[s] = (f32x4){0.f, 0.f, 0.f, 0.f}; }
#pragma unroll
        for (int jb = 0; jb < 16; jb += 8) {
            f32x4 s0v[8];
#pragma unroll
            for (int e = 0; e < 8; ++e) s0v[e] = __builtin_nontemporal_load((const f32x4*)(S0 + (size_t)(jb + e) * 256));
#pragma unroll
            for (int e = 0; e < 8; ++e) { const int j = jb + e, d = 16 * w + j; const f32x4 s0 = s0v[e];
                f32x4 acc = s0 * dec[d];
#pragma unroll
                for (int t = 0; t < 4; ++t) pt4[t] += s0 * qa[t * 128 + d];
#pragma unroll
                for (int s2 = 0; s2 < 4; ++s2) acc += wv4[s2] * kd[s2 * 128 + d];
                __builtin_nontemporal_store(acc, (f32x4*)(S1 + (size_t)j * 256)); } }
#pragma unroll
        for (int t = 0; t < 4; ++t) *(f32x4*)(part8 + (w * 4 + t) * 256 + v4) = pt4[t];
        __syncthreads();
        vown = tid & 255; owner = (tid < 256);
#pragma unroll
        for (int t = 0; t < 4; ++t) { float num = 0.f;
#pragma unroll
            for (int w2 = 0; w2 < 8; ++w2) num += part8[(w2 * 4 + t) * 256 + vown];
#pragma unroll
            for (int s2 = 0; s2 < 4; ++s2) num += qk[t * 4 + s2] * vv[s2 * 256 + vown];
            hv[t] = num; }
    }
#pragma unroll
    for (int t = 0; t < 4; ++t) { float q2 = owner ? hv[t] * hv[t] : 0.f; q2 = wave_sum(q2); if (lane == 0) red[w * 4 + t] = q2; }
    __syncthreads();
    if (owner) {
#pragma unroll
        for (int t = 0; t < 4; ++t) { float tot = 0.f;
#pragma unroll
            for (int w2 = 0; w2 < 8; ++w2) tot += red[w2 * 4 + t];
            const float rs = rsqrtf(tot * (1.f / 256.f) + EPSV);
            bf16_t* op = Z + (size_t)(r0 + t) * ZLD + ocol + vown;
            const float gt = bf2f(*op), sg = sigmoidf_(gt);
            *op = f2bf(hv[t] * rs * gain[vown] * (BR == 0 ? sg : gt * sg)); }
    }
    __syncthreads();
}

__device__ __forceinline__ void attn_prompt(const Params& p, unsigned char* lds, int item) {
    const int tid = threadIdx.x, w = tid >> 6, lane = tid & 63, g = lane >> 4, l16 = lane & 15, q4 = l16 >> 2, p4 = lane & 3;
    const int qt = item & 15, h = (item >> 4) & 3, b = item >> 6;
    const bf16_t* KV = (const bf16_t*)(p.ws + WS_MEMKV) + (size_t)b * 256 * 2048 + h * 256;
    const bf16_t* Q = (const bf16_t*)(p.ws + WS_QBUF);
    bf16_t* O = (bf16_t*)(p.ws + WS_OBUF);
    const size_t rq = (size_t)b * 2048 + qt * 128 + 16 * w + l16;
    const unsigned aL = (unsigned)(size_t)lds;
#pragma unroll 4
    for (int i = 0; i < 16; ++i) { const int id = tid + 512 * i, key = id >> 5, ch = id & 31;
        *(u32x4*)(lds + key * V_STRIDE + ch * 16) = *(const u32x4*)(KV + (size_t)key * 2048 + ch * 8); }
    __syncthreads();
    f32x4 s[16];
#pragma unroll
    for (int ki = 0; ki < 16; ++ki) s[ki] = (f32x4){0.f, 0.f, 0.f, 0.f};
#pragma unroll
    for (int ks = 0; ks < 8; ++ks) { const bf16x8 qfk = *(const bf16x8*)(Q + rq * DM + h * 256 + 32 * ks + 8 * g);
#pragma unroll
        for (int ki = 0; ki < 16; ++ki) s[ki] = mfma16(*(const bf16x8*)(lds + (16 * ki + l16) * V_STRIDE + (32 * ks + 8 * g) * 2), qfk, s[ki]); }
    float mx = -3.0e38f;
#pragma unroll
    for (int ki = 0; ki < 16; ++ki)
#pragma unroll
        for (int r = 0; r < 4; ++r) mx = fmaxf(mx, s[ki][r]);
    mx = xmax16_32(mx);
    float sum = 0.f;
#pragma unroll
    for (int ki = 0; ki < 16; ++ki)
#pragma unroll
        for (int r = 0; r < 4; ++r) { const float e = __expf(s[ki][r] - mx); s[ki][r] = e; sum += e; }
    sum = xsum16_32(sum);
    bf16x8 pf[8];
#pragma unroll
    for (int ks = 0; ks < 8; ++ks) pf[ks] = pack8(s[2 * ks], s[2 * ks + 1]);
    __syncthreads();
#pragma unroll 4
    for (int i = 0; i < 16; ++i) { const int id = tid + 512 * i, key = id >> 5, ch = id & 31;
        *(u32x4*)(lds + key * V_STRIDE + ch * 16) = *(const u32x4*)(KV + (size_t)key * 2048 + 1024 + ch * 8); }
    __syncthreads();
    const float inv = 1.f / sum;
#pragma unroll
    for (int hh = 0; hh < 2; ++hh) {
        f32x4 o[8];
#pragma unroll
        for (int hi = 0; hi < 8; ++hi) o[hi] = (f32x4){0.f, 0.f, 0.f, 0.f};
#pragma unroll
        for (int ks = 0; ks < 8; ++ks) {
            unsigned aLk = aL + (32 * ks + 4 * g + q4) * V_STRIDE + 8 * p4 + hh * 256;
            asm volatile("" : "+v"(aLk));
#pragma unroll
            for (int hi = 0; hi < 8; hi += 2) {
                const unsigned a0 = aLk + (16 * hi) * 2;
                bf16x8 fa, fb; tr_frag2(a0, a0 + 16 * V_STRIDE, a0 + 32, a0 + 32 + 16 * V_STRIDE, fa, fb);
                o[hi] = mfma16(fa, pf[ks], o[hi]); o[hi + 1] = mfma16(fb, pf[ks], o[hi + 1]);
            }
        }
#pragma unroll
        for (int hi = 0; hi < 8; ++hi) *(u32x2*)(O + rq * DM + h * 256 + hh * 128 + 16 * hi + 4 * g) = pack4(o[hi] * inv);
    }
    __syncthreads();
}
__device__ __forceinline__ void attn_sample(const Params& p, unsigned char* lds, int item) {
    const int tid = threadIdx.x, w = tid >> 6, lane = tid & 63;
    const int h = item & 3, b = item >> 2;
    const float* Kc = p.in[7] + ((size_t)b * 1024 + h) * 256;
    const float* Vc = p.in[8] + ((size_t)b * 1024 + h) * 256;
    const bf16_t* Q = (const bf16_t*)(p.ws + WS_QBUF);
    bf16_t* O = (bf16_t*)(p.ws + WS_OBUF);
    float* sc = (float*)lds; float* po = sc + 1024;
    const size_t r0 = MP + 4 * b;
    f32x4 q[4];
#pragma unroll
    for (int t = 0; t < 4; ++t) { const u32x2 qw = *(const u32x2*)(Q + (r0 + t) * DM + h * 256 + lane * 4); q[t] = (f32x4){bflo(qw.x), bfhi(qw.x), bflo(qw.y), bfhi(qw.y)}; }
#pragma unroll 4
    for (int kk = 0; kk < 32; ++kk) { const int key = w * 32 + kk;
        const f32x4 kv = __builtin_nontemporal_load((const f32x4*)(Kc + (size_t)key * 1024 + lane * 4));
#pragma unroll
        for (int t = 0; t < 4; ++t) { float d = kv[0] * q[t][0] + kv[1] * q[t][1] + kv[2] * q[t][2] + kv[3] * q[t][3]; d = wave_sum(d); if (lane == 0) sc[t * 256 + key] = d; } }
    __syncthreads();
    if (w < 4) { float v[4], mx = -3.0e38f;
#pragma unroll
        for (int i = 0; i < 4; ++i) { v[i] = sc[w * 256 + lane + 64 * i]; mx = fmaxf(mx, v[i]); }
        mx = wave_max(mx); float sum = 0.f;
#pragma unroll
        for (int i = 0; i < 4; ++i) { v[i] = __expf(v[i] - mx); sum += v[i]; }
        sum = wave_sum(sum); const float inv = 1.f / sum;
#pragma unroll
        for (int i = 0; i < 4; ++i) sc[w * 256 + lane + 64 * i] = v[i] * inv; }
    __syncthreads();
    {
        const int hd4 = lane * 4; float* po8 = sc + 1024;
        f32x4 acc4[4];
#pragma unroll
        for (int t = 0; t < 4; ++t) acc4[t] = (f32x4){0.f, 0.f, 0.f, 0.f};
#pragma unroll 8
        for (int kk = 0; kk < 32; ++kk) { const int key = w * 32 + kk; const f32x4 v4 = __builtin_nontemporal_load((const f32x4*)(Vc + (size_t)key * 1024 + hd4));
#pragma unroll
            for (int t = 0; t < 4; ++t) acc4[t] += v4 * sc[t * 256 + key]; }
#pragma unroll
        for (int t = 0; t < 4; ++t) *(f32x4*)(po8 + (w * 4 + t) * 256 + hd4) = acc4[t];
        __syncthreads();
        if (tid < 256) {
#pragma unroll
            for (int t = 0; t < 4; ++t) { float o = 0.f;
#pragma unroll
                for (int w2 = 0; w2 < 8; ++w2) o += po8[(w2 * 4 + t) * 256 + tid];
                O[(r0 + t) * DM + h * 256 + tid] = f2bf(o); } }
    }
    __syncthreads();
}

#ifndef ONLY_PH
#define ONLY_PH -1
#endif
#ifndef MIXEN
#define MIXEN 15
#endif
#ifndef PH_MASK
#define PH_MASK 0xffff
#endif
#define PH_ENABLED(x) ((ONLY_PH < 0 || ONLY_PH == (x)) && ((PH_MASK >> (x)) & 1) && ((KMASK >> (x)) & 1))
__device__ __forceinline__ void grid_barrier(unsigned char* wsb, unsigned char* lds) {
    XcdBarrier b; b.bar = (unsigned*)(wsb + WS_BAR); b.x = xb_xcc_id(); b.st = (volatile LAS unsigned*)(lds + LDS_BYTES - 16);
    xcd_barrier(b);
}
template <int KMASK> __global__ void __launch_bounds__(512, 2) fwd_kernel(Params p) {
    extern __shared__ __attribute__((aligned(16))) unsigned char lds[];
    cg::grid_group grid = cg::this_grid();
    volatile LAS unsigned* xb_st = (volatile LAS unsigned*)(lds + LDS_BYTES - 16);
    if (threadIdx.x == 0) { xb_st[0] = 0u; xb_st[1] = 0u; }
    __syncthreads();
    (void)xcd_barrier_post((unsigned*)(p.ws + WS_BAR), xb_st);
#ifndef DUP_MASK
#define DUP_MASK 0
#endif
#define PH_BEGIN(k) if (PH_ENABLED(k) && p.ph_lo <= (k) && (k) < p.ph_hi) for (int rep_ = 0; rep_ < (((DUP_MASK >> (k)) & 1) ? 2 : 1); ++rep_) { if ((k) > p.ph_lo || rep_) { if (p.ph_hi > 1000) grid.sync(); else grid_barrier(p.ws, lds); } \
        unsigned char* ws; float* outp; { unsigned long long w_ = (unsigned long long)p.ws, o_ = (unsigned long long)p.out; \
        unsigned a0_ = __builtin_amdgcn_readfirstlane((unsigned)w_), a1_ = __builtin_amdgcn_readfirstlane((unsigned)(w_ >> 32)), a2_ = __builtin_amdgcn_readfirstlane((unsigned)o_), a3_ = __builtin_amdgcn_readfirstlane((unsigned)(o_ >> 32)); \
        asm volatile("" : "+s"(a0_), "+s"(a1_), "+s"(a2_), "+s"(a3_)); ws = (unsigned char*)(((unsigned long long)a1_ << 32) | a0_); outp = (float*)(((unsigned long long)a3_ << 32) | a2_); } \
        bf16_t* ABUF = (bf16_t*)(ws + WS_ABUF); bf16_t* Z = (bf16_t*)(ws + WS_Z); float* XRES = (float*)(ws + WS_XRES); float* SS = (float*)(ws + WS_SS); float* TMP = outp + O_YP; \
        (void)ABUF; (void)Z; (void)XRES; (void)SS; (void)TMP;
#define PH_END }
    PH_BEGIN(0) prep_phase(p, lds); PH_END
    PH_BEGIN(1)
        EpiGateUp e1; e1.H = Z; e1.ss = nullptr;
        run_gemm(lds, ABUF, DM, (const bf16_t*)(ws + WS_WGU1), MT, 5632, 1024, e1, 0);
        EpiMemKV e2; e2.ok = outp + O_MKP; e2.ov = outp + O_MVP; e2.kv = (bf16_t*)(ws + WS_MEMKV);
        run_gemm(lds, (const bf16_t*)(ws + WS_MEMA), DM, (const bf16_t*)(ws + WS_WKV), 2048, 2048, 1024, e2, 64);
    PH_END
    PH_BEGIN(2) EpiResid e; e.res0 = p.in[0]; e.res1 = p.in[1]; e.xout = XRES; e.aout = ABUF; e.gain = p.in[13]; e.ss = SS; e.scale = 0.5f;
        run_gemm(lds, Z, DFF, (const bf16_t*)(ws + WS_WD1), MP, 1024, DFF, e, 0); small_gemm(lds, Z, DFF, (const bf16_t*)(ws + WS_WD1), 1024, DFF, e); PH_END
    PH_BEGIN(3) EpiZ e; e.Z = Z; e.ZS = (float*)(ws + WS_ZS); e.ss = SS;
        run_gemm(lds, ABUF, DM, (const bf16_t*)(ws + WS_WIN), MT, 8448, 1024, e, 0); PH_END
    PH_BEGIN(4)
        for (int it = blockIdx.x; it < 1024; it += gridDim.x) gla_prep(p, lds, it);
    PH_END
    PH_BEGIN(5)
        const int bx = (int)blockIdx.x, G = (int)gridDim.x;
        const int NCH = (G >= 256) ? 128 : 0;
        if (bx < NCH || NCH == 0) {
            for (int it0 = bx; it0 < 128; it0 += (NCH ? NCH : G)) { const int it = NCH ? ((((it0 & 7) * 8 + (it0 >> 4)) << 1) | ((it0 >> 3) & 1)) : it0;
                if (it < 64) { if (MIXEN & 1) mixer_prompt<0>(p, lds, it >> 3, (it >> 1) & 3, it & 1); } }
            for (int it0 = bx; it0 < 128; it0 += (NCH ? NCH : G)) { const int it = NCH ? ((((it0 & 7) * 8 + (it0 >> 4)) << 1) | ((it0 >> 3) & 1)) : it0;
                if (it >= 64) { if (MIXEN & 2) mixer_prompt<1>(p, lds, (it - 64) >> 3, (it >> 1) & 3, it & 1); } }
        }
        if (bx >= NCH) {
            for (int it = bx - NCH; it < 512; it += G - NCH) { if (MIXEN & 4) mixer_sample<0>(p, lds, it >> 2, it & 3); }
            for (int it = bx - NCH; it < 512; it += G - NCH) { if (MIXEN & 8) mixer_sample<1>(p, lds, it >> 2, it & 3); }
            prep_transposes(p, lds, PREP_LATE_MASK, bx - NCH, G - NCH);
        }
    PH_END
    PH_BEGIN(6)
        const float* SSQ = (const float*)(ws + WS_SSQ);
        const int lane = threadIdx.x & 63, gw = blockIdx.x * 8 + (threadIdx.x >> 6), nw = gridDim.x * 8;
        for (int i0 = gw; i0 < MP * 8; i0 += 4 * nw) {
            f32x4 sp[4]; u32x2 wv[4];
#pragma unroll
            for (int e = 0; e < 4; ++e) { const int i = i0 + e * nw; if (i < MP * 8) { sp[e] = *(const f32x4*)(SSQ + (size_t)i * 4);
                    wv[e] = *(const u32x2*)(Z + (size_t)(i >> 3) * ZLD + (((i & 7) >> 2) ? 5120 : 2048) + (i & 3) * 256 + lane * 4); } }
#pragma unroll
            for (int e = 0; e < 4; ++e) { const int i = i0 + e * nw; if (i < MP * 8) {
                    const float rs = rsqrtf(((sp[e][0] + sp[e][1]) + (sp[e][2] + sp[e][3])) * (1.f / 256.f) + EPSV);
                    f32x4 o = {bflo(wv[e].x) * rs, bfhi(wv[e].x) * rs, bflo(wv[e].y) * rs, bfhi(wv[e].y) * rs};
                    *(u32x2*)(Z + (size_t)(i >> 3) * ZLD + (((i & 7) >> 2) ? 5120 : 2048) + (i & 3) * 256 + lane * 4) = pack4(o); } }
        }
    PH_END
    PH_BEGIN(7) EpiMerge<0> e; e.gate = Z + 6144; e.T = TMP; e.Y = nullptr;
        run_gemm(lds, Z + 2048, ZLD, (const bf16_t*)(ws + WS_WBRM), MP, 1024, 1024, e, 0); small_gemm(lds, Z + 2048, ZLD, (const bf16_t*)(ws + WS_WBRM), 1024, 1024, e); PH_END
    PH_BEGIN(8) EpiMerge<1> e; e.gate = Z + 7168; e.T = TMP; e.Y = ABUF;
        run_gemm(lds, Z + 5120, ZLD, (const bf16_t*)(ws + WS_WBRG), MP, 1024, 1024, e, 0); small_gemm(lds, Z + 5120, ZLD, (const bf16_t*)(ws + WS_WBRG), 1024, 1024, e); PH_END
    PH_BEGIN(9) EpiResid e; e.res0 = XRES; e.res1 = XRES + (size_t)MP * DM; e.xout = XRES; e.aout = (bf16_t*)(ws + WS_ABUF2); e.gain = p.in[23]; e.ss = SS + (size_t)MT * 16; e.scale = 1.f;
        run_gemm(lds, ABUF, DM, (const bf16_t*)(ws + WS_WOUT), MP, 1024, 1024, e, 0); small_gemm(lds, ABUF, DM, (const bf16_t*)(ws + WS_WOUT), 1024, 1024, e); PH_END
    PH_BEGIN(10) EpiQ e; e.Q = (bf16_t*)(ws + WS_QBUF); e.ss = SS + (size_t)MT * 16;
        run_gemm(lds, (const bf16_t*)(ws + WS_ABUF2), DM, (const bf16_t*)(ws + WS_WQ), MP, 1024, 1024, e, 0); small_gemm(lds, (const bf16_t*)(ws + WS_ABUF2), DM, (const bf16_t*)(ws + WS_WQ), 1024, 1024, e); PH_END
    PH_BEGIN(11)
#pragma unroll 1
        for (int pass = 0; pass < 2; ++pass) {
            if (((blockIdx.x & 1) != 0) == (pass == 0)) { for (int it = blockIdx.x; it < 512; it += gridDim.x) attn_sample(p, lds, it); }
            else { for (int it = blockIdx.x; it < 512; it += gridDim.x) attn_prompt(p, lds, it); }
        }
    PH_END
    PH_BEGIN(12) EpiResid e; e.res0 = XRES; e.res1 = XRES + (size_t)MP * DM; e.xout = XRES; e.aout = ABUF; e.gain = p.in[29]; e.ss = SS + (size_t)MT * 32; e.scale = 1.f;
        run_gemm(lds, (const bf16_t*)(ws + WS_OBUF), DM, (const bf16_t*)(ws + WS_WO), MP, 1024, 1024, e, 0); small_gemm(lds, (const bf16_t*)(ws + WS_OBUF), DM, (const bf16_t*)(ws + WS_WO), 1024, 1024, e); PH_END
    PH_BEGIN(13) EpiGateUp e; e.H = Z; e.ss = SS + (size_t)MT * 32;
        run_gemm(lds, ABUF, DM, (const bf16_t*)(ws + WS_WGU2), MT, 5632, 1024, e, 0); PH_END
    PH_BEGIN(14) EpiResid e; e.res0 = XRES; e.res1 = XRES + (size_t)MP * DM; e.xout = TMP; e.aout = nullptr; e.gain = nullptr; e.ss = SS + (size_t)MT * 48; e.scale = 0.5f;
        run_gemm(lds, Z, DFF, (const bf16_t*)(ws + WS_WD2), MP, 1024, DFF, e, 0); small_gemm(lds, Z, DFF, (const bf16_t*)(ws + WS_WD2), 1024, DFF, e); PH_END
    PH_BEGIN(15)
        const int lane = threadIdx.x & 63, gw = blockIdx.x * 8 + (threadIdx.x >> 6), nw = gridDim.x * 8;
        for (int r = gw; r < MT; r += nw) { const float rs = rs_row(SS + (size_t)MT * 48, r); float* y = TMP + (size_t)r * DM;
#pragma unroll
            for (int i = 0; i < 4; ++i) { f32x4 v = *(const f32x4*)(y + i * 256 + lane * 4); const f32x4 gg = *(const f32x4*)(p.in[33] + i * 256 + lane * 4);
                __builtin_nontemporal_store(v * rs * gg, (f32x4*)(y + i * 256 + lane * 4)); } }
    PH_END
}

template <int KMASK> static bool setup_kernel() {
    if (hipFuncSetAttribute((const void*)fwd_kernel<KMASK>, hipFuncAttributeMaxDynamicSharedMemorySize, LDS_BYTES) != hipSuccess) { fprintf(stderr, "kernel_launch: hipFuncSetAttribute failed\n"); return false; }
    int per_cu = 0;
    if (hipOccupancyMaxActiveBlocksPerMultiprocessor(&per_cu, (const void*)fwd_kernel<KMASK>, NTHREADS, LDS_BYTES) != hipSuccess || per_cu < 1) fprintf(stderr, "kernel_launch: occupancy query says %d\n", per_cu);
    (void)hipGetLastError();
    return true;
}
template <int KMASK> static void launch_range(Params p, int lo, int hi, int grid, hipStream_t stream) {
    p.ph_lo = lo; p.ph_hi = hi;
    if (hipMemsetAsync((char*)p.ws + WS_BAR, 0, XCD_BAR_WORDS * 4, stream) != hipSuccess) { fprintf(stderr, "kernel_launch: memset of the barrier words failed\n"); return; }
    void* args[] = {&p};
    hipError_t e = hipLaunchCooperativeKernel((const void*)fwd_kernel<KMASK>, dim3(grid), dim3(NTHREADS), args, LDS_BYTES, stream);
    if (e != hipSuccess) fprintf(stderr, "kernel_launch: cooperative launch [%d,%d) failed: %s (grid %d)\n", lo, hi, hipGetErrorString(e), grid);
}
#ifndef N_LAUNCH
#define N_LAUNCH 1
#endif
extern "C" void kernel_launch(void* const* d_in, const int* in_sizes, int n_in, void* d_out, int out_size, void* d_ws, size_t ws_size, hipStream_t stream) {
    static int grid = 0;
    if (grid == 0) {
        if (n_in != 34 || (size_t)out_size != O_END || ws_size < WS_END) { fprintf(stderr, "kernel_launch: unexpected sizes n_in %d out %d ws %zu (need %zu)\n", n_in, out_size, ws_size, (size_t)WS_END); grid = -1; return; }
        int dev = 0, cus = 0;
        (void)hipGetDevice(&dev); (void)hipDeviceGetAttribute(&cus, hipDeviceAttributeMultiprocessorCount, dev);
        bool ok = true;
#if N_LAUNCH == 1
        ok = setup_kernel<0xffff>();
#else
        ok = setup_kernel<0x3fef>() && setup_kernel<0x0010>();
#endif
        if (!ok) { grid = -1; return; }
        grid = cus;
        if (grid < 64) { fprintf(stderr, "kernel_launch: needs >= 64 CUs\n"); grid = -1; return; }
    }
    if (grid < 0) return;
    Params p{};
    for (int i = 0; i < 34; ++i) p.in[i] = (const float*)d_in[i];
    p.out = (float*)d_out; p.ws = (unsigned char*)d_ws;
#if N_LAUNCH == 1
#ifndef PROBE_K
#define PROBE_K -1
#endif
#ifndef PROBE_BACK
#define PROBE_BACK 0
#endif
    if (PROBE_K >= 0) { launch_range<0xffff>(p, 0, PROBE_K + 1, grid, stream); launch_range<0xffff>(p, PROBE_K - PROBE_BACK, 16, grid, stream); }
    else launch_range<0xffff>(p, 0, 16, grid, stream);
#else
#ifndef DBG_HI
#define DBG_HI 14
#endif
    launch_range<0x3fef>(p, 0, DBG_HI < 4 ? DBG_HI : 4, grid, stream);
    if (DBG_HI > 4) launch_range<0x0010>(p, 4, 5, grid, stream);
    if (DBG_HI > 5) launch_range<0x3fef>(p, 5, DBG_HI, grid, stream);
#endif
}
```

```cpp
#include <hip/hip_runtime.h>
#include <hip/hip_cooperative_groups.h>
#include <cstdio>
namespace cg = cooperative_groups;
namespace pg8 {
#define PG8_LAS __attribute__((address_space(3)))
typedef unsigned short bf16_t;
typedef short bf16x8 __attribute__((ext_vector_type(8)));
typedef float f32x4 __attribute__((ext_vector_type(4)));
typedef unsigned u32x4 __attribute__((ext_vector_type(4)));
constexpr int BM = 256, BK = 64, HALF = 128, HTB = HALF * BK * 2  , STAGE_BYTES = 8 * HTB, NXCD = 8, WGM = 8;

__host__ __device__ __forceinline__ int lds_byte(int r, int c) { const int st = (r >> 4) * 2 + (c >> 5), rr = r & 15, cc = c & 31, ob = rr * 64 + cc * 2; return st * 1024 + (ob ^ (((ob >> 9) & 1) << 5)); }
__host__ __device__ __forceinline__ void stage_rc(int b, int& R, int& C) { const int st = b / 1024, sb = b % 1024, swz = sb ^ (((sb >> 9) & 1) << 5); R = (st >> 1) * 16 + swz / 64; C = (st & 1) * 32 + (swz % 64) / 2; }
__host__ __device__ __forceinline__ int perm32(int rho) { const int n = rho >> 4, i = rho & 15; return 8 * (i >> 2) + 4 * n + (i & 3); }

struct Unit { int pm, pn; };
struct Gemm { const bf16_t* A; const bf16_t* Bt; int M, N, K, lda, ldb; };
struct StaticOrder {
    int nM, nN, nwg, G, c;
    __host__ __device__ void init(int M, int N, int G_, int c_) { nM = M / BM; nN = N / BM; nwg = nM * nN; G = G_; c = c_; }
    __host__ __device__ bool next(int i, Unit& u) const {
        const long L = (long)i * G + c; if (L >= nwg) return false;
        int wgid = (int)L; { const int q = nwg / NXCD, r = nwg % NXCD, xcd = wgid % NXCD, off = wgid / NXCD; wgid = (xcd < r ? xcd * (q + 1) : r * (q + 1) + (xcd - r) * q) + off; }
        const int nig = WGM * nN, gid = wgid / nig, fm = gid * WGM, gsz = (nM - fm) < WGM ? (nM - fm) : WGM;
        u.pm = fm + ((wgid % nig) % gsz); u.pn = (wgid % nig) / gsz; return true;
    }
    __device__ __forceinline__ void a_ready(const Unit&) const {}
    __device__ __forceinline__ void done(const Unit&) const {}
};
__device__ __forceinline__ unsigned cvt_pk_bf16(float lo, float hi) { unsigned r; asm volatile("v_cvt_pk_bf16_f32 %0, %1, %2" : "=v"(r) : "v"(lo), "v"(hi)); return r; }
template <class Epi, class Sched>
__device__ __forceinline__ void gemm_phase(PG8_LAS unsigned char* lds, const Gemm g, const Sched& S, const Epi& E) {
    const int tid = threadIdx.x, wid = __builtin_amdgcn_readfirstlane(tid >> 6), lane = tid & 63, wr = wid >> 2, wc = wid & 3, fr = lane & 15, fq = lane >> 4;
    const int K = g.K, nt = K / BK;
    unsigned voffA[2], voffB[2];
#pragma unroll
    for (int i = 0; i < 2; ++i) { int R, C; stage_rc(tid * 16 + i * 8192, R, C); const int Rb = Epi::PERM ? ((R & ~31) + perm32(R & 31)) : R;
        voffA[i] = (unsigned)(R * g.lda + C) * 2u; voffB[i] = (unsigned)(Rb * g.ldb + C) * 2u; }
    const size_t kstep = (size_t)(BK * 2);
    const size_t hstepA = (size_t)HALF * g.lda * 2, hstepB = (size_t)HALF * g.ldb * 2;
    const size_t tstepA = 2 * hstepA, tstepB = 2 * hstepB;
    const unsigned ldsw = (unsigned)wid * 1024u;
    const int aoff = lds_byte(wr * 64 + fr, fq * 8), boff = lds_byte(wc * 32 + fr, fq * 8);
#define PG8_SA(b, h) (((b) * 2 + (h)) * HTB)
#define PG8_SB(b, h) ((4 + (b) * 2 + (h)) * HTB)
#define PG8_STAGE(bufoff, gbase, voff) do { _Pragma("unroll") for (int _i = 0; _i < 2; ++_i) \
        __builtin_amdgcn_global_load_lds((const unsigned*)((const char*)(gbase) + (voff)[_i]), (PG8_LAS unsigned*)(lds + (bufoff) + ldsw + _i * 8192), 16, 0, 0); } while (0)
#define PG8_LDA(dst, b, h) do { _Pragma("unroll") for (int m = 0; m < 4; ++m) _Pragma("unroll") for (int k = 0; k < 2; ++k) dst[m][k] = *(const PG8_LAS bf16x8*)(lds + PG8_SA(b, h) + aoff + m * 2048 + k * 1024); } while (0)
#define PG8_LDB(dst, b, h) do { _Pragma("unroll") for (int n = 0; n < 2; ++n) _Pragma("unroll") for (int k = 0; k < 2; ++k) dst[n][k] = *(const PG8_LAS bf16x8*)(lds + PG8_SB(b, h) + boff + n * 2048 + k * 1024); } while (0)
#define PG8_MMA(ai, bj, At, Bt) do { __builtin_amdgcn_s_setprio(1); _Pragma("unroll") for (int m = 0; m < 4; ++m) _Pragma("unroll") for (int n = 0; n < 2; ++n) _Pragma("unroll") for (int k = 0; k < 2; ++k) \
        acc[ai][bj][m][n] = __builtin_amdgcn_mfma_f32_16x16x32_bf16(Bt[n][k], At[m][k], acc[ai][bj][m][n], 0, 0, 0); __builtin_amdgcn_s_setprio(0); } while (0)
#define PG8_WAIT_V(n) asm volatile("s_waitcnt vmcnt(" #n ")" ::: "memory")
#define PG8_WAIT_L(n) asm volatile("s_waitcnt lgkmcnt(" #n ")" ::: "memory")
#define PG8_BAR __builtin_amdgcn_s_barrier()
#define PG8_SCHED __builtin_amdgcn_sched_barrier(0)
    Unit cur, nxt; int ui = 0;
    if (!S.next(0, cur)) return;
    f32x4 acc[2][2][4][2];
#pragma unroll
    for (int a = 0; a < 2; ++a)
#pragma unroll
        for (int b = 0; b < 2; ++b)
#pragma unroll
            for (int m = 0; m < 4; ++m)
#pragma unroll
                for (int n = 0; n < 2; ++n) acc[a][b][m][n] = (f32x4){0.f, 0.f, 0.f, 0.f};
    bf16x8 At[4][2], B0[2][2], B1[2][2];
    const char* cA = (const char*)g.A + (size_t)cur.pm * tstepA; const char* cB = (const char*)g.Bt + (size_t)cur.pn * tstepB;
    S.a_ready(cur);
    PG8_STAGE(PG8_SB(0, 0), cB, voffB); PG8_STAGE(PG8_SA(0, 0), cA, voffA); PG8_STAGE(PG8_SB(0, 1), cB + hstepB, voffB); PG8_STAGE(PG8_SA(0, 1), cA + hstepA, voffA);
    if (wr == 1) PG8_BAR;
    PG8_WAIT_V(4); PG8_BAR;
    PG8_STAGE(PG8_SB(1, 0), cB + kstep, voffB); PG8_STAGE(PG8_SA(1, 0), cA + kstep, voffA); PG8_STAGE(PG8_SB(1, 1), cB + hstepB + kstep, voffB);
    PG8_WAIT_V(6); PG8_BAR;
    for (;;) {
        const bool has_next = S.next(ui + 1, nxt);
        const char* nA = has_next ? (const char*)g.A + (size_t)nxt.pm * tstepA : cA; const char* nB = has_next ? (const char*)g.Bt + (size_t)nxt.pn * tstepB : cB;
        for (int t = 0; t < nt; t += 2) {
            const bool last = (t == nt - 2);
            const char* a1 = cA + (size_t)(t + 1) * kstep;
            const char* a2 = last ? nA : cA + (size_t)(t + 2) * kstep; const char* b2 = last ? nB : cB + (size_t)(t + 2) * kstep;
            const char* a3 = a2 + kstep; const char* b3 = b2 + kstep;
            if (last && has_next) S.a_ready(nxt);
            PG8_LDB(B0, 0, 0); PG8_SCHED; PG8_LDA(At, 0, 0); PG8_STAGE(PG8_SA(1, 1), a1 + hstepA, voffA);
            PG8_WAIT_L(8); PG8_BAR; PG8_WAIT_L(0); PG8_MMA(0, 0, At, B0); PG8_BAR; PG8_SCHED;
            PG8_LDB(B1, 0, 1); PG8_STAGE(PG8_SB(0, 0), b2, voffB);
            PG8_BAR; PG8_WAIT_L(0); PG8_MMA(0, 1, At, B1); PG8_BAR;
            PG8_LDA(At, 0, 1); PG8_STAGE(PG8_SA(0, 0), a2, voffA);
            PG8_BAR; PG8_WAIT_L(0); PG8_MMA(1, 0, At, B0); PG8_BAR; PG8_SCHED;
            PG8_STAGE(PG8_SB(0, 1), b2 + hstepB, voffB);
            PG8_WAIT_V(6); PG8_BAR; PG8_MMA(1, 1, At, B1); PG8_BAR;
            PG8_LDB(B0, 1, 0); PG8_SCHED; PG8_LDA(At, 1, 0); PG8_STAGE(PG8_SA(0, 1), a2 + hstepA, voffA);
            PG8_WAIT_L(8); PG8_BAR; PG8_WAIT_L(0); PG8_MMA(0, 0, At, B0); PG8_BAR; PG8_SCHED;
            PG8_LDB(B1, 1, 1); PG8_STAGE(PG8_SB(1, 0), b3, voffB);
            PG8_BAR; PG8_WAIT_L(0); PG8_MMA(0, 1, At, B1); PG8_BAR;
            PG8_LDA(At, 1, 1); PG8_STAGE(PG8_SA(1, 0), a3, voffA);
            PG8_BAR; PG8_WAIT_L(0); PG8_MMA(1, 0, At, B0); PG8_BAR; PG8_SCHED;
            PG8_STAGE(PG8_SB(1, 1), b3 + hstepB, voffB);
            PG8_WAIT_V(6); PG8_BAR; PG8_MMA(1, 1, At, B1); PG8_BAR;
        }
        if constexpr (!Epi::AFTER_DRAIN) { E(acc, cur, wr, wc, fr, fq); S.done(cur); }
        if (!has_next) break;
#pragma unroll
        for (int a = 0; a < 2; ++a)
#pragma unroll
            for (int b = 0; b < 2; ++b)
#pragma unroll
                for (int m = 0; m < 4; ++m)
#pragma unroll
                    for (int n = 0; n < 2; ++n) acc[a][b][m][n] = (f32x4){0.f, 0.f, 0.f, 0.f};
        cur = nxt; cA = nA; cB = nB; ++ui;
    }
    PG8_WAIT_V(0);
    if (wr == 0) PG8_BAR;
    PG8_BAR;
    if constexpr (Epi::AFTER_DRAIN) { E.fused(acc, cur, wr, wc, fr, fq, lds, wid, lane); S.done(cur); }
#undef PG8_SA
#undef PG8_SB
#undef PG8_STAGE
#undef PG8_LDA
#undef PG8_LDB
#undef PG8_MMA
#undef PG8_WAIT_V
#undef PG8_WAIT_L
#undef PG8_BAR
#undef PG8_SCHED
}
}
using pg8::bf16_t; using pg8::bf16x8; using pg8::f32x4; using pg8::u32x4;
typedef short s16x4 __attribute__((ext_vector_type(4)));
typedef unsigned u32x2 __attribute__((ext_vector_type(2)));
#define LAS __attribute__((address_space(3)))

constexpr int MP = 16384, MS = 512, MT = MP + MS, DM = 1024, DFF = 2816, ZLD = 8192, ZSLD = 32;
constexpr int NTHREADS = 512;
constexpr float EPSV = 1e-6f;
constexpr size_t SZ_WGU = 5632ull * 1024 * 2, SZ_WD = 1024ull * 2816 * 2, SZ_WIN = 8448ull * 1024 * 2, SZ_W1K = 1024ull * 1024 * 2;
constexpr size_t WS_WGU1 = 0;
constexpr size_t WS_WD1 = WS_WGU1 + SZ_WGU;
constexpr size_t WS_WIN = WS_WD1 + SZ_WD;
constexpr size_t WS_WBRM = WS_WIN + SZ_WIN;
constexpr size_t WS_WBRG = WS_WBRM + SZ_W1K;
constexpr size_t WS_WOUT = WS_WBRG + SZ_W1K;
constexpr size_t WS_WQ = WS_WOUT + SZ_W1K;
constexpr size_t WS_WO = WS_WQ + SZ_W1K;
constexpr size_t WS_WKV = WS_WO + SZ_W1K;
constexpr size_t WS_WGU2 = WS_WKV + 2 * SZ_W1K;
constexpr size_t WS_WD2 = WS_WGU2 + SZ_WGU;
constexpr size_t WS_ABUF = WS_WD2 + SZ_WD;
constexpr size_t WS_MEMA = WS_ABUF + (size_t)MT * DM * 2;
constexpr size_t WS_MEMKV = WS_MEMA + 2048ull * 1024 * 2;
constexpr size_t WS_XRES = WS_MEMKV + 2048ull * 2048 * 2;
constexpr size_t WS_ZS = WS_XRES + (size_t)MT * DM * 4;
constexpr size_t WS_SS = WS_ZS + (size_t)MT * ZSLD * 4;
constexpr size_t WS_SSQ = WS_SS + 4ull * MT * 16 * 4;
constexpr size_t WS_BEND = WS_SSQ + (size_t)MP * 32 * 4;
constexpr size_t WS_Z = WS_BEND + 1024ull * 128 * 4;
constexpr size_t WS_ABUF2 = WS_Z + (64ull << 20);
constexpr size_t WS_QBUF = WS_Z + (128ull << 20);
constexpr size_t WS_OBUF = WS_Z + (192ull << 20);
constexpr size_t WS_BAR = WS_Z + (size_t)MT * ZLD * 2;
constexpr size_t WS_END = WS_BAR + 16384;
constexpr size_t O_YP = 0, O_YS = 16777216, O_CP = 17301504, O_NP = 18350080, O_MPP = 18354176, O_SP = 18354208, O_MKP = 19402784, O_MVP = 21499936,
                 O_CS = 23597088, O_NS = 40374304, O_MSS = 40439840, O_SS = 40440352, O_END = 57217568;
constexpr int LDS_BYTES = 156 * 1024;

struct Params { const float* in[34]; float* out; unsigned char* ws; int ph_lo, ph_hi; };

typedef float f32x2_t __attribute__((ext_vector_type(2)));
typedef __bf16 bf16x2_t __attribute__((ext_vector_type(2)));
__device__ __forceinline__ unsigned cvt_pk(float lo, float hi) { f32x2_t v = {lo, hi}; bf16x2_t b = __builtin_convertvector(v, bf16x2_t); return __builtin_bit_cast(unsigned, b); }
__device__ __forceinline__ bf16_t f2bf(float x) { return (bf16_t)(cvt_pk(x, 0.f) & 0xffffu); }
__device__ __forceinline__ float bf2f(bf16_t x) { return __uint_as_float(((unsigned)x) << 16); }
__device__ __forceinline__ float bflo(unsigned w) { return __uint_as_float(w << 16); }
__device__ __forceinline__ float bfhi(unsigned w) { return __uint_as_float(w & 0xffff0000u); }
__device__ __forceinline__ float sigmoidf_(float x) { return __builtin_amdgcn_rcpf(1.f + __expf(-x)); }
__device__ __forceinline__ float logsigf_(float x) { return fminf(x, 0.f) - __logf(1.f + __expf(-fabsf(x))); }
__device__ __forceinline__ float rs_of(float ss) { return rsqrtf(ss * (1.f / 1024.f) + EPSV); }
__device__ __forceinline__ float rs_row(const float* ssp, int row) {
    const f32x4* q = (const f32x4*)(ssp + (size_t)row * 16); const f32x4 a = q[0], b = q[1], c = q[2], d = q[3];
    const f32x4 s = (a + b) + (c + d); return rs_of((s[0] + s[1]) + (s[2] + s[3])); }
__device__ __forceinline__ f32x4 mfma16(bf16x8 a, bf16x8 b, f32x4 c) { return __builtin_amdgcn_mfma_f32_16x16x32_bf16(a, b, c, 0, 0, 0); }
__device__ __forceinline__ bf16x8 pack8(f32x4 a, f32x4 b) {
    u32x4 w; w.x = cvt_pk(a[0], a[1]); w.y = cvt_pk(a[2], a[3]); w.z = cvt_pk(b[0], b[1]); w.w = cvt_pk(b[2], b[3]);
    return __builtin_bit_cast(bf16x8, w);
}
__device__ __forceinline__ u32x2 pack4(f32x4 a) { u32x2 w; w.x = cvt_pk(a[0], a[1]); w.y = cvt_pk(a[2], a[3]); return w; }
__device__ __forceinline__ bf16x8 tr_frag(unsigned a0, unsigned a1) {
    s16x4 r0, r1;
    asm volatile("ds_read_b64_tr_b16 %0, %2\n\tds_read_b64_tr_b16 %1, %3\n\ts_waitcnt lgkmcnt(0)" : "=&v"(r0), "=&v"(r1) : "v"(a0), "v"(a1) : "memory");
    return __builtin_shufflevector(r0, r1, 0, 1, 2, 3, 4, 5, 6, 7);
}
__device__ __forceinline__ void tr_frag2(unsigned a0, unsigned a1, unsigned b0, unsigned b1, bf16x8& fa, bf16x8& fb) {
    s16x4 r0, r1, r2, r3;
    asm volatile("ds_read_b64_tr_b16 %0, %4\n\tds_read_b64_tr_b16 %1, %5\n\tds_read_b64_tr_b16 %2, %6\n\tds_read_b64_tr_b16 %3, %7\n\ts_waitcnt lgkmcnt(0)"
                 : "=&v"(r0), "=&v"(r1), "=&v"(r2), "=&v"(r3) : "v"(a0), "v"(a1), "v"(b0), "v"(b1) : "memory");
    fa = __builtin_shufflevector(r0, r1, 0, 1, 2, 3, 4, 5, 6, 7); fb = __builtin_shufflevector(r2, r3, 0, 1, 2, 3, 4, 5, 6, 7);
}
__device__ __forceinline__ void tr_frag4(unsigned a0, unsigned a1, unsigned b0, unsigned b1, unsigned c0, unsigned c1, unsigned d0, unsigned d1, bf16x8& fa, bf16x8& fb, bf16x8& fc, bf16x8& fd) {
    s16x4 r0, r1, r2, r3, r4, r5, r6, r7;
    asm volatile("ds_read_b64_tr_b16 %0, %8\n\tds_read_b64_tr_b16 %1, %9\n\tds_read_b64_tr_b16 %2, %10\n\tds_read_b64_tr_b16 %3, %11\n\t"
                 "ds_read_b64_tr_b16 %4, %12\n\tds_read_b64_tr_b16 %5, %13\n\tds_read_b64_tr_b16 %6, %14\n\tds_read_b64_tr_b16 %7, %15\n\ts_waitcnt lgkmcnt(0)"
                 : "=&v"(r0), "=&v"(r1), "=&v"(r2), "=&v"(r3), "=&v"(r4), "=&v"(r5), "=&v"(r6), "=&v"(r7)
                 : "v"(a0), "v"(a1), "v"(b0), "v"(b1), "v"(c0), "v"(c1), "v"(d0), "v"(d1) : "memory");
    fa = __builtin_shufflevector(r0, r1, 0, 1, 2, 3, 4, 5, 6, 7); fb = __builtin_shufflevector(r2, r3, 0, 1, 2, 3, 4, 5, 6, 7);
    fc = __builtin_shufflevector(r4, r5, 0, 1, 2, 3, 4, 5, 6, 7); fd = __builtin_shufflevector(r6, r7, 0, 1, 2, 3, 4, 5, 6, 7);
}
__device__ __forceinline__ float xsum16_32(float v) { v += __shfl_xor(v, 16); v += __shfl_xor(v, 32); return v; }
__device__ __forceinline__ float xmax16_32(float v) { v = fmaxf(v, __shfl_xor(v, 16)); v = fmaxf(v, __shfl_xor(v, 32)); return v; }
__device__ __forceinline__ float wave_sum(float v) { for (int o = 32; o > 0; o >>= 1) v += __shfl_xor(v, o); return v; }
__device__ __forceinline__ float wave_max(float v) { for (int o = 32; o > 0; o >>= 1) v = fmaxf(v, __shfl_xor(v, o)); return v; }

#define XB_TMO      128
#define XB_XCNT(j)  (256  + 64 * (j))
#define XB_XSUB(j)  (1280 + 64 * (j))
#define XB_XGEN(j)  (2304 + 64 * (j))
#define XB_TOP      3328
#define XB_TOPGEN   3392
#define XCD_BAR_WORDS 3456
#define XB_SPIN_CAP (1u << 18)

__device__ __forceinline__ unsigned xb_ld(unsigned* p)              { return __hip_atomic_load(p, __ATOMIC_RELAXED, __HIP_MEMORY_SCOPE_AGENT); }
__device__ __forceinline__ unsigned xb_add(unsigned* p, unsigned v) { return __hip_atomic_fetch_add(p, v, __ATOMIC_RELAXED, __HIP_MEMORY_SCOPE_AGENT); }
__device__ __forceinline__ unsigned xb_xcc_id() { return (unsigned)__builtin_amdgcn_s_getreg((3 << 11) | 20) & 0xFu; }
#define XB_SPIN(cond, bar) do { unsigned _sp = 0; while (cond) { __builtin_amdgcn_s_sleep(1); \
    if ((++_sp & 255u) == 0u) { if (xb_ld(&(bar)[XB_TMO])) break; if (_sp > XB_SPIN_CAP) { atomicAdd(&(bar)[XB_TMO], 1u); break; } } } } while (0)

struct XcdBarrier {
    unsigned* bar; unsigned x;
    volatile LAS unsigned* st;
};

__device__ __forceinline__ XcdBarrier xcd_barrier_post(unsigned* bar, volatile LAS unsigned* st) {
    XcdBarrier b; b.bar = bar; b.x = xb_xcc_id(); b.st = st;
    if (threadIdx.x == 0) (void)xb_add(&bar[XB_XCNT(b.x)], 1u);
    return b;
}
__device__ __forceinline__ void xcd_barrier_complete(unsigned* bar, unsigned x, unsigned& nloc, unsigned& nx) {
    const unsigned G = gridDim.x * gridDim.y * gridDim.z;
    unsigned sum, cnt, mine, sp = 0u;
    for (;;) {
        sum = 0u; cnt = 0u; mine = 0u;
#pragma unroll
        for (unsigned j = 0; j < 16; ++j) { const unsigned c = xb_ld(&bar[XB_XCNT(j)]); sum += c; cnt += (c > 0u) ? 1u : 0u; mine = (j == x) ? c : mine; }
        if (sum == G) break;
        __builtin_amdgcn_s_sleep(1);
        if ((++sp & 255u) == 0u) { if (xb_ld(&bar[XB_TMO])) break; if (sp > XB_SPIN_CAP) { atomicAdd(&bar[XB_TMO], 1u); break; } }
    }
    nloc = mine > 0u ? mine : 1u; nx = cnt > 0u ? cnt : 1u;
}

__device__ __forceinline__ void xcd_barrier(const XcdBarrier& b) {
    asm volatile("s_waitcnt vmcnt(0)" ::: "memory");
    __syncthreads();
    if (threadIdx.x == 0) {
        unsigned* bar = b.bar;
        __builtin_amdgcn_s_waitcnt(0);
        unsigned nloc = b.st[0], nx = b.st[1];
        if (nloc == 0u) { xcd_barrier_complete(bar, b.x, nloc, nx); b.st[0] = nloc; b.st[1] = nx; }
        const unsigned old = xb_add(&bar[XB_XSUB(b.x)], 1u);
        const unsigned gen = old / nloc;
        if (old + 1u == (gen + 1u) * nloc) {
            __builtin_amdgcn_fence(__ATOMIC_RELEASE, "agent");
            asm volatile("s_waitcnt vmcnt(0)" ::: "memory");
            const unsigned og = xb_add(&bar[XB_TOP], 1u);
            const unsigned tg = og / nx;
            if (og + 1u == (tg + 1u) * nx) xb_add(&bar[XB_TOPGEN], 1u);
            else XB_SPIN(xb_ld(&bar[XB_TOPGEN]) == tg, bar);
            __builtin_amdgcn_fence(__ATOMIC_ACQUIRE, "agent");
            xb_add(&bar[XB_XGEN(b.x)], 1u);
            asm volatile("s_waitcnt vmcnt(0)" ::: "memory");
        } else {
            XB_SPIN(xb_ld(&bar[XB_XGEN(b.x)]) == gen, bar);
            __builtin_amdgcn_fence(__ATOMIC_ACQUIRE, "agent");
            asm volatile("s_waitcnt vmcnt(0)" ::: "memory");
        }
    }
    __syncthreads();
}


constexpr int PREP_EARLY_MASK = 0x060f, PREP_LATE_MASK = 0x39f0;
__device__ __forceinline__ int win_src_col(int r) {
    if (r < 3072) return r; if (r < 6144) return r + 8; if (r < 8192) return r + 24;
    if (r < 8200) return 3072 + (r - 8192); if (r < 8216) return 6152 + (r - 8200); return -1;
}
__device__ __forceinline__ void prep_transposes(const Params& p, unsigned char* lds, int dmask, int vb, int nvb) {
    float* tile = (float*)lds;
    const int tid = threadIdx.x;
    unsigned char* ws = p.ws;
    for (int d = 0; d < 14; ++d) {
        if (!((dmask >> d) & 1)) continue;
        const float* src; bf16_t* dst; int K, ldsrc, ntn, mode = 0, rowoff = 0; float scale = 1.f;
        switch (d) {
            case 0: src = p.in[10]; dst = (bf16_t*)(ws + WS_WGU1); K = 1024; ldsrc = 2816; ntn = 44; mode = 2; rowoff = 0; break;
            case 1: src = p.in[11]; dst = (bf16_t*)(ws + WS_WGU1); K = 1024; ldsrc = 2816; ntn = 44; mode = 2; rowoff = 128; break;
            case 2: src = p.in[12]; dst = (bf16_t*)(ws + WS_WD1); K = 2816; ldsrc = 1024; ntn = 16; break;
            case 3: src = p.in[14]; dst = (bf16_t*)(ws + WS_WIN); K = 1024; ldsrc = 8216; ntn = 132; mode = 1; break;
            case 4: src = p.in[20]; dst = (bf16_t*)(ws + WS_WBRM); K = 1024; ldsrc = 1024; ntn = 16; break;
            case 5: src = p.in[21]; dst = (bf16_t*)(ws + WS_WBRG); K = 1024; ldsrc = 1024; ntn = 16; break;
            case 6: src = p.in[22]; dst = (bf16_t*)(ws + WS_WOUT); K = 1024; ldsrc = 1024; ntn = 16; break;
            case 7: src = p.in[25]; dst = (bf16_t*)(ws + WS_WQ); K = 1024; ldsrc = 1024; ntn = 16; scale = 0.0625f; break;
            case 8: src = p.in[28]; dst = (bf16_t*)(ws + WS_WO); K = 1024; ldsrc = 1024; ntn = 16; break;
            case 9: src = p.in[26]; dst = (bf16_t*)(ws + WS_WKV); K = 1024; ldsrc = 1024; ntn = 16; break;
            case 10: src = p.in[27]; dst = (bf16_t*)(ws + WS_WKV); K = 1024; ldsrc = 1024; ntn = 16; rowoff = 1024; break;
            case 11: src = p.in[30]; dst = (bf16_t*)(ws + WS_WGU2); K = 1024; ldsrc = 2816; ntn = 44; mode = 2; rowoff = 0; break;
            case 12: src = p.in[31]; dst = (bf16_t*)(ws + WS_WGU2); K = 1024; ldsrc = 2816; ntn = 44; mode = 2; rowoff = 128; break;
            default: src = p.in[32]; dst = (bf16_t*)(ws + WS_WD2); K = 2816; ldsrc = 1024; ntn = 16; break;
        }
        const int nkt = K / 64, ntiles = nkt * ntn;
        for (int t = vb; t < ntiles; t += nvb) {
            const int kt = t % nkt, nt = t / nkt, k0 = kt * 64;
            {
                const int j = tid & 63;
                int srccol; float sc = scale;
                if (mode == 1) { srccol = win_src_col(nt * 64 + j); if ((srccol >= 512 && srccol < 1024) || (srccol >= 3080 && srccol < 3592)) sc = 0.08838834764831845f; }
                else srccol = nt * 64 + j;
#pragma unroll
                for (int ps = 0; ps < 8; ++ps) { const int i = (tid >> 6) + 8 * ps;
                    float v = 0.f; if (srccol >= 0) v = __builtin_nontemporal_load(src + (size_t)(k0 + i) * ldsrc + srccol) * sc;
                    tile[i * 65 + j] = v; }
            }
            __syncthreads();
            {
                const int j = tid >> 3, kc = tid & 7;
                int dstrow;
                if (mode == 1) dstrow = nt * 64 + j;
                else { const int sc_ = nt * 64 + j; dstrow = (mode == 2) ? ((sc_ >> 7) * 256 + (sc_ & 127) + rowoff) : (sc_ + rowoff); }
                float v[8];
#pragma unroll
                for (int e = 0; e < 8; ++e) v[e] = tile[(kc * 8 + e) * 65 + j];
                u32x4 w; w.x = cvt_pk(v[0], v[1]); w.y = cvt_pk(v[2], v[3]); w.z = cvt_pk(v[4], v[5]); w.w = cvt_pk(v[6], v[7]);
                *(u32x4*)(dst + (size_t)dstrow * K + k0 + kc * 8) = w;
            }
            __syncthreads();
        }
    }
}
__device__ __forceinline__ void prep_phase(const Params& p, unsigned char* lds) {
    const int tid = threadIdx.x;
    unsigned char* ws = p.ws;
    prep_transposes(p, lds, PREP_EARLY_MASK, (int)blockIdx.x, (int)gridDim.x);
    const int lane = tid & 63, gw = blockIdx.x * 8 + (tid >> 6), nw = gridDim.x * 8;
    for (int r = gw; r < MT + 2048; r += nw) {
        const float* x; const float* g; bf16_t* o;
        if (r < MP) { x = p.in[0] + (size_t)r * DM; g = p.in[9]; o = (bf16_t*)(ws + WS_ABUF) + (size_t)r * DM; }
        else if (r < MT) { x = p.in[1] + (size_t)(r - MP) * DM; g = p.in[9]; o = (bf16_t*)(ws + WS_ABUF) + (size_t)r * DM; }
        else { x = p.in[2] + (size_t)(r - MT) * DM; g = p.in[24]; o = (bf16_t*)(ws + WS_MEMA) + (size_t)(r - MT) * DM; }
        f32x4 v[4]; float ss = 0.f;
#pragma unroll
        for (int i = 0; i < 4; ++i) { v[i] = *(const f32x4*)(x + i * 256 + lane * 4); ss += v[i][0] * v[i][0] + v[i][1] * v[i][1] + v[i][2] * v[i][2] + v[i][3] * v[i][3]; }
        ss = wave_sum(ss); const float rs = rs_of(ss);
#pragma unroll
        for (int i = 0; i < 4; ++i) { const f32x4 gg = *(const f32x4*)(g + i * 256 + lane * 4);
            u32x2 w; w.x = cvt_pk(v[i][0] * rs * gg[0], v[i][1] * rs * gg[1]); w.y = cvt_pk(v[i][2] * rs * gg[2], v[i][3] * rs * gg[3]);
            *(u32x2*)(o + i * 256 + lane * 4) = w; }
    }
}

#define EPI_ROW(ai, m) (u.pm * 256 + (ai) * 128 + wr * 64 + (m) * 16 + fr)
#define EPI_COL(bj) (u.pn * 256 + (bj) * 128 + wc * 32 + fq * 8)
struct EpiGateUp {
    static constexpr bool PERM = true, AFTER_DRAIN = false;
    bf16_t* H; const float* ss;
    __device__ __forceinline__ void operator()(const f32x4 (&acc)[2][2][4][2], const pg8::Unit& u, int wr, int wc, int fr, int fq) const {
        float rsv[2][4];
#pragma unroll
        for (int ai = 0; ai < 2; ++ai)
#pragma unroll
            for (int m = 0; m < 4; ++m) rsv[ai][m] = ss ? rs_row(ss, EPI_ROW(ai, m)) : 1.f;
#pragma unroll
        for (int ai = 0; ai < 2; ++ai)
#pragma unroll
            for (int m = 0; m < 4; ++m) { const int row = EPI_ROW(ai, m); const float rs = rsv[ai][m];
                f32x4 hv[2];
#pragma unroll
                for (int n = 0; n < 2; ++n)
#pragma unroll
                    for (int j = 0; j < 4; ++j) { const float gt = acc[ai][0][m][n][j] * rs, up = acc[ai][1][m][n][j] * rs; hv[n][j] = gt * sigmoidf_(gt) * up; }
                *(u32x4*)(H + (size_t)row * DFF + u.pn * 128 + wc * 32 + fq * 8) = __builtin_bit_cast(u32x4, pack8(hv[0], hv[1])); }
    }
};
struct EpiMemKV {
    static constexpr bool PERM = true, AFTER_DRAIN = false;
    float* ok; float* ov; bf16_t* kv;
    __device__ __forceinline__ void operator()(const f32x4 (&acc)[2][2][4][2], const pg8::Unit& u, int wr, int wc, int fr, int fq) const {
#pragma unroll
        for (int ai = 0; ai < 2; ++ai)
#pragma unroll
            for (int m = 0; m < 4; ++m) { const int row = EPI_ROW(ai, m);
#pragma unroll
                for (int bj = 0; bj < 2; ++bj) { const int col = EPI_COL(bj);
                    float* o = (col < 1024) ? (ok + (size_t)row * 1024 + col) : (ov + (size_t)row * 1024 + (col - 1024));
                    __builtin_nontemporal_store(acc[ai][bj][m][0], (f32x4*)o); __builtin_nontemporal_store(acc[ai][bj][m][1], (f32x4*)(o + 4));
                    *(u32x4*)(kv + (size_t)row * 2048 + col) = __builtin_bit_cast(u32x4, pack8(acc[ai][bj][m][0], acc[ai][bj][m][1])); } }
    }
};
struct EpiResid {
    static constexpr bool PERM = true, AFTER_DRAIN = false;
    const float* res0; const float* res1; float* xout; bf16_t* aout; const float* gain; float* ss; float scale;
    __device__ __forceinline__ void operator()(const f32x4 (&acc)[2][2][4][2], const pg8::Unit& u, int wr, int wc, int fr, int fq) const {
        f32x4 gv[2][2];
        if (aout) {
#pragma unroll
            for (int bj = 0; bj < 2; ++bj) { gv[bj][0] = *(const f32x4*)(gain + EPI_COL(bj)); gv[bj][1] = *(const f32x4*)(gain + EPI_COL(bj) + 4); } }
#pragma unroll
        for (int ai = 0; ai < 2; ++ai) {
            f32x4 rv[4][2][2];
#pragma unroll
            for (int m = 0; m < 4; ++m) { const int row = EPI_ROW(ai, m);
                const float* rp = (row < MP) ? (res0 + (size_t)row * DM) : (res1 + (size_t)(row - MP) * DM);
#pragma unroll
                for (int bj = 0; bj < 2; ++bj) { rv[m][bj][0] = *(const f32x4*)(rp + EPI_COL(bj)); rv[m][bj][1] = *(const f32x4*)(rp + EPI_COL(bj) + 4); } }
#pragma unroll
            for (int m = 0; m < 4; ++m) { const int row = EPI_ROW(ai, m);
                float sq = 0.f;
#pragma unroll
                for (int bj = 0; bj < 2; ++bj) { const int col = EPI_COL(bj);
                    const f32x4 x0 = rv[m][bj][0] + acc[ai][bj][m][0] * scale, x1 = rv[m][bj][1] + acc[ai][bj][m][1] * scale;
                    *(f32x4*)(xout + (size_t)row * DM + col) = x0; *(f32x4*)(xout + (size_t)row * DM + col + 4) = x1;
#pragma unroll
                    for (int j = 0; j < 4; ++j) sq += x0[j] * x0[j] + x1[j] * x1[j];
                    if (aout) *(u32x4*)(aout + (size_t)row * DM + col) = __builtin_bit_cast(u32x4, pack8(x0 * gv[bj][0], x1 * gv[bj][1])); }
                sq = xsum16_32(sq);
                if (fq == 0) ss[(size_t)row * 16 + u.pn * 4 + wc] = sq; }
        }
    }
    __device__ __forceinline__ void small(f32x4 acc, int row, int col, int tc, int rt, int ct, int l16, int g, unsigned char* lds) const {
        const f32x4 x = *(const f32x4*)(res1 + (size_t)(row - MP) * DM + col) + acc * scale;
        *(f32x4*)(xout + (size_t)row * DM + col) = x;
        if (aout) { const f32x4 gv4 = *(const f32x4*)(gain + col); *(u32x2*)(aout + (size_t)row * DM + col) = pack4(x * gv4); }
        float sq = x[0] * x[0] + x[1] * x[1] + x[2] * x[2] + x[3] * x[3];
        sq = xsum16_32(sq);
        float* red = (float*)lds;
        if (g == 0) red[(rt * 4 + ct) * 16 + l16] = sq;
        __syncthreads();
        if (ct == 0 && g == 0) ss[(size_t)row * 16 + tc] = (red[(rt * 4) * 16 + l16] + red[(rt * 4 + 1) * 16 + l16]) + (red[(rt * 4 + 2) * 16 + l16] + red[(rt * 4 + 3) * 16 + l16]);
        __syncthreads();
    }
};
struct EpiZ {
    static constexpr bool PERM = true, AFTER_DRAIN = false;
    bf16_t* Z; float* ZS; const float* ss;
    __device__ __forceinline__ void operator()(const f32x4 (&acc)[2][2][4][2], const pg8::Unit& u, int wr, int wc, int fr, int fq) const {
#pragma unroll
        for (int ai = 0; ai < 2; ++ai) {
            float rsv[4];
#pragma unroll
            for (int m = 0; m < 4; ++m) rsv[m] = rs_row(ss, EPI_ROW(ai, m));
#pragma unroll
            for (int m = 0; m < 4; ++m) { const int row = EPI_ROW(ai, m); const float rs = rsv[m];
                if (u.pn < 32) {
#pragma unroll
                    for (int bj = 0; bj < 2; ++bj)
                        *(u32x4*)(Z + (size_t)row * ZLD + EPI_COL(bj)) = __builtin_bit_cast(u32x4, pack8(acc[ai][bj][m][0] * rs, acc[ai][bj][m][1] * rs));
                } else if (wc == 0) {
                    *(f32x4*)(ZS + (size_t)row * ZSLD + fq * 8) = acc[ai][0][m][0] * rs; *(f32x4*)(ZS + (size_t)row * ZSLD + fq * 8 + 4) = acc[ai][0][m][1] * rs;
                } } }
    }
};
template <int MODE> struct EpiMerge {
    static constexpr bool PERM = true, AFTER_DRAIN = false;
    const bf16_t* gate; float* T; bf16_t* Y;
    __device__ __forceinline__ void operator()(const f32x4 (&acc)[2][2][4][2], const pg8::Unit& u, int wr, int wc, int fr, int fq) const {
#pragma unroll
        for (int ai = 0; ai < 2; ++ai)
#pragma unroll
            for (int mh = 0; mh < 2; ++mh) {
                u32x4 gw[2][2]; u32x4 tvb[2][2]; bf16_t* Tb = (bf16_t*)T;
#pragma unroll
                for (int mm = 0; mm < 2; ++mm) { const int row = EPI_ROW(ai, mh * 2 + mm);
#pragma unroll
                    for (int bj = 0; bj < 2; ++bj) { gw[mm][bj] = *(const u32x4*)(gate + (size_t)row * ZLD + EPI_COL(bj));
                        if (MODE == 1) tvb[mm][bj] = *(const u32x4*)(Tb + (size_t)row * DM + EPI_COL(bj)); } }
#pragma unroll
                for (int mm = 0; mm < 2; ++mm) { const int m = mh * 2 + mm, row = EPI_ROW(ai, m);
#pragma unroll
                    for (int bj = 0; bj < 2; ++bj) { const int col = EPI_COL(bj); const u32x4 g4 = gw[mm][bj];
                        f32x4 s0, s1;
                        s0[0] = sigmoidf_(bflo(g4.x)); s0[1] = sigmoidf_(bfhi(g4.x)); s0[2] = sigmoidf_(bflo(g4.y)); s0[3] = sigmoidf_(bfhi(g4.y));
                        s1[0] = sigmoidf_(bflo(g4.z)); s1[1] = sigmoidf_(bfhi(g4.z)); s1[2] = sigmoidf_(bflo(g4.w)); s1[3] = sigmoidf_(bfhi(g4.w));
                        f32x4 v0 = acc[ai][bj][m][0] * s0, v1 = acc[ai][bj][m][1] * s1;
                        if (MODE == 0) *(u32x4*)(Tb + (size_t)row * DM + col) = __builtin_bit_cast(u32x4, pack8(v0, v1));
                        else { const u32x4 t4 = tvb[mm][bj];
                            v0 += (f32x4){bflo(t4.x), bfhi(t4.x), bflo(t4.y), bfhi(t4.y)}; v1 += (f32x4){bflo(t4.z), bfhi(t4.z), bflo(t4.w), bfhi(t4.w)};
                            *(u32x4*)(Y + (size_t)row * DM + col) = __builtin_bit_cast(u32x4, pack8(v0, v1)); } } }
            }
    }
    __device__ __forceinline__ void small(f32x4 acc, int row, int col, int tc, int rt, int ct, int l16, int g, unsigned char* lds) const {
        bf16_t* Tb = (bf16_t*)T;
        const u32x2 g2 = *(const u32x2*)(gate + (size_t)row * ZLD + col);
        f32x4 v = acc * (f32x4){sigmoidf_(bflo(g2.x)), sigmoidf_(bfhi(g2.x)), sigmoidf_(bflo(g2.y)), sigmoidf_(bfhi(g2.y))};
        if (MODE == 0) *(u32x2*)(Tb + (size_t)row * DM + col) = pack4(v);
        else { const u32x2 t2 = *(const u32x2*)(Tb + (size_t)row * DM + col);
            v += (f32x4){bflo(t2.x), bfhi(t2.x), bflo(t2.y), bfhi(t2.y)};
            *(u32x2*)(Y + (size_t)row * DM + col) = pack4(v); }
    }
};
struct EpiQ {
    static constexpr bool PERM = true, AFTER_DRAIN = false;
    bf16_t* Q; const float* ss;
    __device__ __forceinline__ void operator()(const f32x4 (&acc)[2][2][4][2], const pg8::Unit& u, int wr, int wc, int fr, int fq) const {
#pragma unroll
        for (int ai = 0; ai < 2; ++ai) {
            float rsv[4];
#pragma unroll
            for (int m = 0; m < 4; ++m) rsv[m] = rs_row(ss, EPI_ROW(ai, m));
#pragma unroll
            for (int m = 0; m < 4; ++m) { const int row = EPI_ROW(ai, m); const float rs = rsv[m];
#pragma unroll
                for (int bj = 0; bj < 2; ++bj)
                    *(u32x4*)(Q + (size_t)row * DM + EPI_COL(bj)) = __builtin_bit_cast(u32x4, pack8(acc[ai][bj][m][0] * rs, acc[ai][bj][m][1] * rs)); } }
    }
    __device__ __forceinline__ void small(f32x4 acc, int row, int col, int tc, int rt, int ct, int l16, int g, unsigned char* lds) const {
        *(u32x2*)(Q + (size_t)row * DM + col) = pack4(acc * rs_row(ss, row));
    }
};
template <class Epi>
__device__ __forceinline__ void small_gemm(unsigned char* lds, const bf16_t* A, int lda, const bf16_t* Bt, int N, int K, const Epi& E) {
    const int tid = threadIdx.x, w = tid >> 6, lane = tid & 63, g = lane >> 4, l16 = lane & 15;
    const int rt = w >> 2, ct = w & 3, nct = N / 64, ntiles = 16 * nct;
    for (int t = blockIdx.x; t < ntiles; t += gridDim.x) {
        const int tr = t / nct, tc = t - tr * nct;
        const int row = MP + tr * 32 + rt * 16 + l16, colb = tc * 64 + ct * 16;
        const bf16_t* ap = A + (size_t)row * lda + 8 * g;
        const bf16_t* bp = Bt + (size_t)(colb + l16) * K + 8 * g;
        f32x4 acc0 = (f32x4){0.f, 0.f, 0.f, 0.f}, acc1 = acc0;
#pragma unroll 4
        for (int k = 0; k < K; k += 64) {
            acc0 = mfma16(*(const bf16x8*)(bp + k), *(const bf16x8*)(ap + k), acc0);
            acc1 = mfma16(*(const bf16x8*)(bp + k + 32), *(const bf16x8*)(ap + k + 32), acc1);
        }
        E.small(acc0 + acc1, row, colb + 4 * g, tc, rt, ct, l16, g, lds);
    }
}
template <class Epi>
__device__ __forceinline__ void run_gemm(unsigned char* lds, const bf16_t* A, int lda, const bf16_t* Bt, int M, int N, int K, const Epi& E, int rot) {
    pg8::Gemm g; g.A = A; g.Bt = Bt; g.M = M; g.N = N; g.K = K; g.lda = lda; g.ldb = K;
    pg8::StaticOrder S; S.init(M, N, (int)gridDim.x, (int)((blockIdx.x + rot) % gridDim.x));
    pg8::gemm_phase<Epi, pg8::StaticOrder>((PG8_LAS unsigned char*)lds, g, S, E);
    __syncthreads();
}
constexpr int T_STRIDE = 272, V_STRIDE = 528;
constexpr int VQN = 2, VW = 256 / VQN, NVT = VW / 16, NOT = NVT / 2, V2_STRIDE = VW * 2 + 16;
constexpr int M_T0 = 0, M_T1 = 17408, M_TV = 34816, M_TC = M_TV + 64 * V2_STRIDE, M_SM = M_TC + VW * T_STRIDE;
template <int BR>
__device__ __forceinline__ void mixer_prompt(const Params& p, unsigned char* lds, int b, int h, int vq) {
    const int tid = threadIdx.x, w = tid >> 6, lane = tid & 63, g = lane >> 4, l16 = lane & 15, q4 = l16 >> 2, p4 = lane & 3;
    const int tt = w & 3, vh = w >> 2;
    bf16_t* Z = (bf16_t*)(p.ws + WS_Z);
    const float* ZS = (const float*)(p.ws + WS_ZS);
    float* SSQ = (float*)(p.ws + WS_SSQ);
    const float* BEND = (const float*)(p.ws + WS_BEND);
    const int qcol = (BR == 0 ? 0 : 3072) + h * 128, kcol = (BR == 0 ? 512 : 3584) + h * 128;
    const int vcol = (BR == 0 ? 1024 : 4096) + h * 256 + vq * VW, ocol = (BR == 0 ? 2048 : 5120) + h * 256 + vq * VW;
    unsigned char* T0 = lds + M_T0; unsigned char* T1 = lds + M_T1; unsigned char* TV = lds + M_TV; unsigned char* TC = lds + M_TC;
    float* sm = (float*)(lds + M_SM);
    float* gS = sm; float* Mt = sm + 64; float* at = sm + 128; float* emt = sm + 192; float* wsv = sm + 256; float* nvec = sm + 320; float* bend = sm + 448;
    float* misc = sm + 576; float* ssq = sm + 592; float* gaL = sm + 720; float* segtot = sm + 1744; float* waL = sm + 2256;
    const unsigned aT0_ = (unsigned)(size_t)T0, aT1_ = (unsigned)(size_t)T1, aTV_ = (unsigned)(size_t)TV;
    const float* gain = (BR == 0 ? p.in[18] : p.in[19]) + h * 256 + vq * VW;
    const int tloc = 16 * tt + l16;
    f32x4 gn[NOT];
#pragma unroll
    for (int vi = 0; vi < NOT; ++vi) gn[vi] = *(const f32x4*)(gain + (VW / 2) * vh + 16 * vi + 4 * g);
    f32x4 st[NVT];
#pragma unroll
    for (int c = 0; c < NVT; ++c) st[c] = (f32x4){0.f, 0.f, 0.f, 0.f};
    float m0 = 0.f;
    const float bi = (BR == 0) ? p.in[15][h] : 0.f, bfb = (BR == 0) ? p.in[15][4 + h] : 0.f;
    if (tid < 128) nvec[tid] = 0.f;
    u32x4 kreg[2], qreg[2], vreg[2]; bf16x8 qn[4]; float igr = 0.f, lfr = 0.f, gar[2] = {0.f, 0.f};
    const int ks_s0 = tid >> 4, ks_ch = tid & 15;
#define MIX_LOAD_CHUNK(R0) do { const size_t r_ = (size_t)(R0); \
        kreg[0] = *(const u32x4*)(Z + (r_ + ks_s0) * ZLD + kcol + ks_ch * 8); kreg[1] = *(const u32x4*)(Z + (r_ + ks_s0 + 32) * ZLD + kcol + ks_ch * 8); \
        vreg[0] = *(const u32x4*)(Z + (r_ + ks_s0) * ZLD + vcol + ks_ch * 8); vreg[1] = *(const u32x4*)(Z + (r_ + ks_s0 + 32) * ZLD + vcol + ks_ch * 8); \
        if (BR == 0) { _Pragma("unroll") for (int ks = 0; ks < 4; ++ks) qn[ks] = *(const bf16x8*)(Z + (r_ + tloc) * ZLD + qcol + 32 * ks + 8 * g); \
            if (w == 0) { igr = ZS[(r_ + lane) * ZSLD + h]; lfr = ZS[(r_ + lane) * ZSLD + 4 + h]; } } \
        else { qreg[0] = *(const u32x4*)(Z + (r_ + ks_s0) * ZLD + qcol + ks_ch * 8); qreg[1] = *(const u32x4*)(Z + (r_ + ks_s0 + 32) * ZLD + qcol + ks_ch * 8); \
            if (tid < 128) gar[0] = BEND[(r_ >> 6) * 512 + h * 128 + tid]; } } while (0)
    MIX_LOAD_CHUNK(b * 2048);
    __syncthreads();
    for (int c = 0; c < 32; ++c) {
        const int r0 = b * 2048 + c * 64;
        if (c > 0 && tid < 64) { float* sp_ = SSQ + ((size_t)(r0 - 64 + tid) * 8 + BR * 4 + h) * 4 + vq * 2; sp_[0] = ssq[tid] + ssq[64 + tid]; sp_[1] = 0.f; }
        unsigned aT0 = aT0_, aT1 = aT1_, aTV = aTV_;
        asm volatile("" : "+v"(aT0), "+v"(aT1), "+v"(aTV));
        if (BR == 0) {
            if (w == 0) {
                const float ig = igr + bi, lf = logsigf_(lfr + bfb);
                float F = lf;
#pragma unroll
                for (int o = 1; o < 64; o <<= 1) { const float y = __shfl_up(F, o); if (lane >= o) F += y; }
                const float gg = ig - F; float cm = gg;
#pragma unroll
                for (int o = 1; o < 64; o <<= 1) { const float y = __shfl_up(cm, o); if (lane >= o) cm = fmaxf(cm, y); }
                const float M = fmaxf(m0, cm), a = __expf(m0 - M);
                const float ML = __shfl(M, 63), aend = __shfl(a, 63), FL = __shfl(F, 63);
                gS[lane] = gg; Mt[lane] = M; at[lane] = a; emt[lane] = __expf(-(F + M)); wsv[lane] = __expf(gg - ML);
                if (lane == 0) misc[1] = aend;
                m0 = FL + ML;
            }
            __syncthreads();
#pragma unroll
            for (int i = 0; i < 2; ++i) { const int s = ks_s0 + 32 * i; const u32x4 kw = kreg[i];
                *(u32x4*)(T0 + s * T_STRIDE + ks_ch * 16) = kw;
                const float ww = wsv[s]; u32x4 o;
                o.x = cvt_pk(bflo(kw.x) * ww, bfhi(kw.x) * ww); o.y = cvt_pk(bflo(kw.y) * ww, bfhi(kw.y) * ww);
                o.z = cvt_pk(bflo(kw.z) * ww, bfhi(kw.z) * ww); o.w = cvt_pk(bflo(kw.w) * ww, bfhi(kw.w) * ww);
                *(u32x4*)(T1 + s * T_STRIDE + ks_ch * 16) = o; }
        } else {
            if (tid < 128) bend[tid] = gar[0];
#pragma unroll
            for (int i = 0; i < 2; ++i) { const int s = ks_s0 + 32 * i;
                *(u32x4*)(T0 + s * T_STRIDE + ks_ch * 16) = kreg[i]; *(u32x4*)(T1 + s * T_STRIDE + ks_ch * 16) = qreg[i]; }
        }
#pragma unroll
        for (int i = 0; i < 2; ++i) *(u32x4*)(TV + (ks_s0 + 32 * i) * V2_STRIDE + ks_ch * 16) = vreg[i];
#pragma unroll
        for (int c16 = 0; c16 < NVT; ++c16) *(u32x2*)(TC + (16 * c16 + l16) * T_STRIDE + (16 * w + 4 * g) * 2) = pack4(st[c16]);
        __syncthreads();
        bf16x8 qf[4];
#pragma unroll
        for (int ks = 0; ks < 4; ++ks) {
            if (BR == 0) qf[ks] = qn[ks];
            else qf[ks] = *(const bf16x8*)(T1 + tloc * T_STRIDE + (32 * ks + 8 * g) * 2);
        }
        bf16_t* op = Z + (size_t)(r0 + tloc) * ZLD + ocol + (VW / 2) * vh + 4 * g;
        u32x2 gwv[NOT];
#pragma unroll
        for (int vi = 0; vi < NOT; ++vi) gwv[vi] = *(const u32x2*)(op + 16 * vi);
        if (c < 31) MIX_LOAD_CHUNK(r0 + 64);
        f32x4 sacc[4];
#pragma unroll
        for (int si = 0; si < 4; ++si) { sacc[si] = (f32x4){0.f, 0.f, 0.f, 0.f};
#pragma unroll
            for (int ks = 0; ks < 4; ++ks) sacc[si] = mfma16(*(const bf16x8*)(T0 + (16 * si + l16) * T_STRIDE + (32 * ks + 8 * g) * 2), qf[ks], sacc[si]); }
        float den = 0.f;
        {
            const float Mtt = (BR == 0) ? Mt[tloc] : 0.f;
            f32x4 gS4[4];
#pragma unroll
            for (int si = 0; si < 4; ++si) gS4[si] = (BR == 0) ? *(const f32x4*)(gS + 16 * si + 4 * g) : (f32x4){0.f, 0.f, 0.f, 0.f};
#pragma unroll
            for (int si = 0; si < 4; ++si)
#pragma unroll
                for (int r = 0; r < 4; ++r) { const int s = 16 * si + 4 * g + r;
                    float wgt;
                    if (BR == 0) { const float e = __expf(fminf(gS4[si][r] - Mtt, 0.f)); wgt = (s <= tloc) ? e : 0.f; } else wgt = (s <= tloc) ? 1.f : 0.f;
                    sacc[si][r] *= wgt; den += sacc[si][r]; }
        }
        f32x4 oacc[NOT];
#pragma unroll
        for (int vi = 0; vi < NOT; ++vi) { oacc[vi] = (f32x4){0.f, 0.f, 0.f, 0.f};
#pragma unroll
            for (int ks = 0; ks < 4; ++ks) oacc[vi] = mfma16(*(const bf16x8*)(TC + ((VW / 2) * vh + 16 * vi + l16) * T_STRIDE + (32 * ks + 8 * g) * 2), qf[ks], oacc[vi]); }
        if (BR == 0) {
            den = xsum16_32(den);
            const float a_t = at[tloc];
            float nq = 0.f;
#pragma unroll
            for (int ks = 0; ks < 4; ++ks)
#pragma unroll
                for (int j = 0; j < 8; ++j) nq += nvec[32 * ks + 8 * g + j] * bf2f((bf16_t)qf[ks][j]);
            nq = xsum16_32(nq);
            den += a_t * nq;
#pragma unroll
            for (int vi = 0; vi < NOT; ++vi) oacc[vi] *= a_t;
        }
#pragma unroll
        for (int ks = 0; ks < 2; ++ks) {
            const bf16x8 pb = pack8(sacc[2 * ks], sacc[2 * ks + 1]);
#pragma unroll
            for (int vi = 0; vi < NOT; vi += 4) {
                const unsigned a0 = aTV + (32 * ks + 4 * g + q4) * V2_STRIDE + ((VW / 2) * vh + 16 * vi) * 2 + 8 * p4, a1 = a0 + 16 * V2_STRIDE;
                bf16x8 fa, fb, fc, fd; tr_frag4(a0, a1, a0 + 32, a1 + 32, a0 + 64, a1 + 64, a0 + 96, a1 + 96, fa, fb, fc, fd);
                oacc[vi] = mfma16(fa, pb, oacc[vi]); oacc[vi + 1] = mfma16(fb, pb, oacc[vi + 1]); oacc[vi + 2] = mfma16(fc, pb, oacc[vi + 2]); oacc[vi + 3] = mfma16(fd, pb, oacc[vi + 3]); }
        }
        if (BR == 0) { const float inv = 1.f / fmaxf(fabsf(den), emt[tloc]);
#pragma unroll
            for (int vi = 0; vi < NOT; ++vi) oacc[vi] *= inv; }
        float sq = 0.f;
#pragma unroll
        for (int vi = 0; vi < NOT; ++vi)
#pragma unroll
            for (int r = 0; r < 4; ++r) sq += oacc[vi][r] * oacc[vi][r];
        sq = xsum16_32(sq);
        if (g == 0) ssq[vh * 64 + tloc] = sq;
#pragma unroll
        for (int vi = 0; vi < NOT; ++vi) {
            const float gt[4] = {bflo(gwv[vi].x), bfhi(gwv[vi].x), bflo(gwv[vi].y), bfhi(gwv[vi].y)}; f32x4 o;
#pragma unroll
            for (int r = 0; r < 4; ++r) { const float sg = sigmoidf_(gt[r]); o[r] = oacc[vi][r] * gn[vi][r] * (BR == 0 ? sg : gt[r] * sg); }
            *(u32x2*)(op + 16 * vi) = pack4(o); }
        if (BR == 0) { const float aend = misc[1];
#pragma unroll
            for (int c16 = 0; c16 < NVT; ++c16) st[c16] *= aend; }
#pragma unroll
        for (int ks = 0; ks < 2; ++ks) {
            const unsigned ka0 = (BR == 0 ? aT1 : aT0) + (32 * ks + 8 * g + q4) * T_STRIDE + (16 * w) * 2 + 8 * p4;
            const bf16x8 kf = tr_frag(ka0, ka0 + 4 * T_STRIDE);
#pragma unroll
            for (int c16 = 0; c16 < NVT; c16 += 4) {
                const unsigned v0 = aTV + (32 * ks + 8 * g + q4) * V2_STRIDE + (16 * c16) * 2 + 8 * p4, v1 = v0 + 4 * V2_STRIDE;
                bf16x8 fa, fb, fc, fd; tr_frag4(v0, v1, v0 + 32, v1 + 32, v0 + 64, v1 + 64, v0 + 96, v1 + 96, fa, fb, fc, fd);
                st[c16] = mfma16(kf, fa, st[c16]); st[c16 + 1] = mfma16(kf, fb, st[c16 + 1]); st[c16 + 2] = mfma16(kf, fc, st[c16 + 2]); st[c16 + 3] = mfma16(kf, fd, st[c16 + 3]);
            }
        }
        if (BR == 1) {
            float eb[4];
#pragma unroll
            for (int r = 0; r < 4; ++r) eb[r] = __expf(bend[16 * w + 4 * g + r]);
#pragma unroll
            for (int c16 = 0; c16 < NVT; ++c16)
#pragma unroll
                for (int r = 0; r < 4; ++r) st[c16][r] *= eb[r];
        } else {
            const int d = tid & 127, seg = tid >> 7; float a2 = 0.f;
#pragma unroll
            for (int s = 0; s < 16; ++s) a2 += bf2f(*(const bf16_t*)(T1 + (seg * 16 + s) * T_STRIDE + d * 2));
            segtot[seg * 128 + d] = a2;
        }
        __syncthreads();
        if (BR == 0 && tid < 128) nvec[tid] = misc[1] * nvec[tid] + ((segtot[tid] + segtot[128 + tid]) + (segtot[256 + tid] + segtot[384 + tid]));
    }
#undef MIX_LOAD_CHUNK
    if (tid < 64) { float* sp_ = SSQ + ((size_t)(b * 2048 + 31 * 64 + tid) * 8 + BR * 4 + h) * 4 + vq * 2; sp_[0] = ssq[tid] + ssq[64 + tid]; sp_[1] = 0.f; }
    const int bh = b * 4 + h;
    if (BR == 0) {
        float* Co = p.out + O_CP + (size_t)bh * 32768;
#pragma unroll
        for (int c16 = 0; c16 < NVT; ++c16) __builtin_nontemporal_store(st[c16], (f32x4*)(Co + (size_t)(VW * vq + 16 * c16 + l16) * 128 + 16 * w + 4 * g));
        if (vq == 0) { if (tid < 128) p.out[O_NP + bh * 128 + tid] = nvec[tid];
            if (tid == 0) p.out[O_MPP + bh] = m0; }
    } else {
        float* So = p.out + O_SP + (size_t)bh * 32768;
#pragma unroll
        for (int c16 = 0; c16 < NVT; ++c16)
#pragma unroll
            for (int r = 0; r < 4; ++r) So[(size_t)(16 * w + 4 * g + r) * 256 + VW * vq + 16 * c16 + l16] = st[c16][r];
    }
    __syncthreads();
}

__device__ __forceinline__ void gla_prep(const Params& p, unsigned char* lds, int item) {
    const int tid = threadIdx.x, d = tid & 127, seg = tid >> 7;
    const int h = item & 3, c = (item >> 2) & 31, b = item >> 7;
    bf16_t* Z = (bf16_t*)(p.ws + WS_Z);
    const float* ZS = (const float*)(p.ws + WS_ZS);
    float* BEND = (float*)(p.ws + WS_BEND);
    float* gaL = (float*)lds; float* waL = gaL + 1024; float* segtot = waL + 2048;
    const int r0 = b * 2048 + c * 64, qcol = 3072 + h * 128, kcol = 3584 + h * 128;
    gaL[tid] = ZS[(size_t)(r0 + (tid >> 4)) * ZSLD + 8 + (tid & 15)]; gaL[tid + 512] = ZS[(size_t)(r0 + 32 + (tid >> 4)) * ZSLD + 8 + (tid & 15)];
#pragma unroll
    for (int j = 0; j < 4; ++j) { const int id = tid + 512 * j; waL[id] = p.in[16][(id >> 7) * 512 + h * 128 + (id & 127)]; }
    const float ba = p.in[17][h * 128 + d];
    __syncthreads();
    float wa[16];
#pragma unroll
    for (int j = 0; j < 16; ++j) wa[j] = waL[j * 128 + d];
    float la[16]; float run = 0.f;
#pragma unroll
    for (int i = 0; i < 16; ++i) { const int t = seg * 16 + i; float x = ba;
#pragma unroll
        for (int j = 0; j < 16; ++j) x += gaL[t * 16 + j] * wa[j];
        run += logsigf_(x) * 0.0625f; la[i] = run; }
    segtot[seg * 128 + d] = run;
    __syncthreads();
    float pre = 0.f, tot = 0.f;
#pragma unroll
    for (int s2 = 0; s2 < 4; ++s2) { const float v = segtot[s2 * 128 + d]; tot += v; if (s2 < seg) pre += v; }
    if (seg == 0) BEND[(size_t)(b * 32 + c) * 512 + h * 128 + d] = tot;
    bf16_t qv[16], kv[16];
#pragma unroll
    for (int i = 0; i < 16; ++i) { const int t = seg * 16 + i; qv[i] = Z[(size_t)(r0 + t) * ZLD + qcol + d]; kv[i] = Z[(size_t)(r0 + t) * ZLD + kcol + d]; }
#pragma unroll
    for (int i = 0; i < 16; ++i) { const int t = seg * 16 + i; const float bb = la[i] + pre;
        Z[(size_t)(r0 + t) * ZLD + qcol + d] = f2bf(bf2f(qv[i]) * __expf(bb)); Z[(size_t)(r0 + t) * ZLD + kcol + d] = f2bf(bf2f(kv[i]) * __expf(-bb)); }
    __syncthreads();
}

template <int BR>
__device__ __forceinline__ void mixer_sample(const Params& p, unsigned char* lds, int b, int h) {
    const int tid = threadIdx.x, w = tid >> 6, lane = tid & 63;
    bf16_t* Z = (bf16_t*)(p.ws + WS_Z);
    const float* ZS = (const float*)(p.ws + WS_ZS);
    const int qcol = (BR == 0 ? 0 : 3072) + h * 128, kcol = (BR == 0 ? 512 : 3584) + h * 128, vcol = (BR == 0 ? 1024 : 4096) + h * 256, ocol = (BR == 0 ? 2048 : 5120) + h * 256;
    float* sm = (float*)lds;
    float* qa = sm; float* ka = sm + 512; float* kd = sm + 1024; float* dec = sm + 1536; float* vv = sm + 1664; float* qk = sm + 2688; float* sc = sm + 2704;
    float* part = sm + 2752; float* red = sm + 4800;
    const int r0 = MP + 4 * b, bh = b * 4 + h;
    const float* gain = (BR == 0 ? p.in[18] : p.in[19]) + h * 256;
    float a_t[4] = {1.f, 1.f, 1.f, 1.f}, mt[4] = {0.f, 0.f, 0.f, 0.f}, aend = 1.f;
    {
        const int t = tid >> 7, d = tid & 127;
        const float qraw = bf2f(Z[(size_t)(r0 + t) * ZLD + qcol + d]), kraw = bf2f(Z[(size_t)(r0 + t) * ZLD + kcol + d]);
#pragma unroll
        for (int i = 0; i < 2; ++i) { const int id = tid + 512 * i; vv[id] = bf2f(Z[(size_t)(r0 + (id >> 8)) * ZLD + vcol + (id & 255)]); }
        if (BR == 0) {
            const float m0 = p.in[5][bh], bi = p.in[15][h], bfb = p.in[15][4 + h];
            float F = 0.f, cm = -3.0e38f, gg[4], Mv[4];
#pragma unroll
            for (int s = 0; s < 4; ++s) { const float ig = ZS[(size_t)(r0 + s) * ZSLD + h] + bi, lf = logsigf_(ZS[(size_t)(r0 + s) * ZSLD + 4 + h] + bfb);
                F += lf; gg[s] = ig - F; cm = fmaxf(cm, gg[s]); Mv[s] = fmaxf(m0, cm); a_t[s] = __expf(m0 - Mv[s]); mt[s] = F + Mv[s]; }
            aend = a_t[3];
            float wsel = 0.f;
#pragma unroll
            for (int s = 0; s < 4; ++s) { const float ws_ = __expf(gg[s] - Mv[3]); if (s == t) wsel = ws_; }
            qa[tid] = qraw; ka[tid] = kraw; kd[tid] = wsel * kraw;
            if (tid < 128) dec[tid] = aend;
            if (tid == 0) {
#pragma unroll
                for (int s = 0; s < 4; ++s) { sc[16 + s] = gg[s]; sc[20 + s] = Mv[s]; } }
        } else {
            float la[4];
#pragma unroll
            for (int s = 0; s < 4; ++s) { float x = p.in[17][h * 128 + d];
#pragma unroll
                for (int j = 0; j < 16; ++j) x += ZS[(size_t)(r0 + s) * ZSLD + 8 + j] * p.in[16][j * 512 + h * 128 + d];
                la[s] = logsigf_(x) * 0.0625f; }
            float bt = 0.f, bendv = 0.f;
#pragma unroll
            for (int s = 0; s < 4; ++s) { bendv += la[s]; if (s <= t) bt += la[s]; }
            qa[tid] = qraw * __expf(bt); ka[tid] = kraw * __expf(-bt); kd[tid] = kraw * __expf(bendv - bt);
            if (t == 0) dec[d] = __expf(bendv);
        }
    }
    __syncthreads();
    {
        const int pr = tid >> 5, l = tid & 31, t = pr >> 2, s = pr & 3;
        const f32x4 a = *(const f32x4*)(qa + t * 128 + l * 4), k4 = *(const f32x4*)(ka + s * 128 + l * 4);
        float v = a[0] * k4[0] + a[1] * k4[1] + a[2] * k4[2] + a[3] * k4[3];
#pragma unroll
        for (int o = 16; o > 0; o >>= 1) v += __shfl_xor(v, o);
        if (l == 0) { float wgt; if (BR == 0) wgt = (s <= t) ? __expf(sc[16 + s] - sc[20 + t]) : 0.f; else wgt = (s <= t) ? 1.f : 0.f; qk[pr] = v * wgt; }
        if (BR == 0 && tid < 128) {
            const int t2 = tid >> 5;
            const f32x4 n4 = *(const f32x4*)(p.in[4] + (size_t)bh * 128 + l * 4), q4v = *(const f32x4*)(qa + t2 * 128 + l * 4);
            float v2 = n4[0] * q4v[0] + n4[1] * q4v[1] + n4[2] * q4v[2] + n4[3] * q4v[3];
#pragma unroll
            for (int o = 16; o > 0; o >>= 1) v2 += __shfl_xor(v2, o);
            if (l == 0) sc[12 + t2] = v2;
        }
    }
    __syncthreads();
    float hv[4]; int vown; bool owner;
    if (BR == 0) {
        const int l32 = lane & 31, half = lane >> 5;
        const float* C0 = p.in[3] + (size_t)bh * 32768 + 4 * l32;
        float* C1 = p.out + O_CS + (size_t)bh * 32768 + 4 * l32;
        f32x4 qa4[4], kd4[4]; const f32x4 dec4 = *(const f32x4*)(dec + 4 * l32);
#pragma unroll
        for (int t = 0; t < 4; ++t) { qa4[t] = *(const f32x4*)(qa + t * 128 + 4 * l32); kd4[t] = *(const f32x4*)(kd + t * 128 + 4 * l32); }
#pragma unroll
        for (int ib = 0; ib < 16; ib += 8) {
            f32x4 cv[8];
#pragma unroll
            for (int e = 0; e < 8; ++e) cv[e] = __builtin_nontemporal_load((const f32x4*)(C0 + (size_t)(w * 32 + 2 * (ib + e) + half) * 128));
#pragma unroll
            for (int e = 0; e < 8; ++e) { const int v = w * 32 + 2 * (ib + e) + half; const f32x4 c = cv[e];
                float wv[4], pt[4];
#pragma unroll
                for (int s = 0; s < 4; ++s) wv[s] = vv[s * 256 + v];
                f32x4 o = dec4 * c;
#pragma unroll
                for (int s = 0; s < 4; ++s) o += kd4[s] * wv[s];
                __builtin_nontemporal_store(o, (f32x4*)(C1 + (size_t)v * 128));
#pragma unroll
                for (int t = 0; t < 4; ++t) { float x = c[0] * qa4[t][0] + c[1] * qa4[t][1] + c[2] * qa4[t][2] + c[3] * qa4[t][3];
#pragma unroll
                    for (int of = 16; of > 0; of >>= 1) x += __shfl_xor(x, of);
                    pt[t] = x; }
                if (l32 == 0) {
#pragma unroll
                    for (int t = 0; t < 4; ++t) part[t * 256 + v] = pt[t]; }
            }
        }
        if (tid < 128) { float acc = aend * p.in[4][(size_t)bh * 128 + tid];
#pragma unroll
            for (int s = 0; s < 4; ++s) acc += kd[s * 128 + tid];
            p.out[O_NS + (size_t)bh * 128 + tid] = acc; }
        if (tid == 0) p.out[O_MSS + bh] = mt[3];
        __syncthreads();
        vown = tid & 255; owner = (tid < 256);
        {
            float wv2[4];
#pragma unroll
            for (int s = 0; s < 4; ++s) wv2[s] = vv[s * 256 + vown];
#pragma unroll
            for (int t = 0; t < 4; ++t) { float num = a_t[t] * part[t * 256 + vown], den = a_t[t] * sc[12 + t];
#pragma unroll
                for (int s = 0; s < 4; ++s) { num += qk[t * 4 + s] * wv2[s]; den += qk[t * 4 + s]; }
                hv[t] = num / fmaxf(fabsf(den), __expf(-mt[t])); }
        }
    } else {
        const int v4 = lane * 4;
        const float* S0 = p.in[6] + ((size_t)bh * 128 + 16 * w) * 256 + v4;
        float* S1 = p.out + O_SS + ((size_t)bh * 128 + 16 * w) * 256 + v4;
        float* part8 = sm + 4864;
        f32x4 wv4[4], pt4[4];
#pragma unroll
        for (int s = 0; s < 4; ++s) { wv4[s] = *(const f32x4*)(vv + s * 256 + v4); pt4[s] = (f32x4){0.f, 0.f, 0.f, 0.f}; }
#pragma unroll
        for (int jb = 0; jb < 16; jb += 8) {
            f32x4 s0v[8];
#pragma unroll
            for (int e = 0; e < 8; ++e) s0v[e] = __builtin_nontemporal_load((const f32x4*)(S0 + (size_t)(jb + e) * 256));
#pragma unroll
            for (int e = 0; e < 8; ++e) { const int j = jb + e, d = 16 * w + j; const f32x4 s0 = s0v[e];
                f32x4 acc = s0 * dec[d];
#pragma unroll
                for (int t = 0; t < 4; ++t) pt4[t] += s0 * qa[t * 128 + d];
#pragma unroll
                for (int s2 = 0; s2 < 4; ++s2) acc += wv4[s2] * kd[s2 * 128 + d];
                __builtin_nontemporal_store(acc, (f32x4*)(S1 + (size_t)j * 256)); } }
#pragma unroll
        for (int t = 0; t < 4; ++t) *(f32x4*)(part8 + (w * 4 + t) * 256 + v4) = pt4[t];
        __syncthreads();
        vown = tid & 255; owner = (tid < 256);
#pragma unroll
        for (int t = 0; t < 4; ++t) { float num = 0.f;
#pragma unroll
            for (int w2 = 0; w2 < 8; ++w2) num += part8[(w2 * 4 + t) * 256 + vown];
#pragma unroll
            for (int s2 = 0; s2 < 4; ++s2) num += qk[t * 4 + s2] * vv[s2 * 256 + vown];
            hv[t] = num; }
    }
#pragma unroll
    for (int t = 0; t < 4; ++t) { float q2 = owner ? hv[t] * hv[t] : 0.f; q2 = wave_sum(q2); if (lane == 0) red[w * 4 + t] = q2; }
    __syncthreads();
    if (owner) {
#pragma unroll
        for (int t = 0; t < 4; ++t) { float tot = 0.f;
#pragma unroll
            for (int w2 = 0; w2 < 8; ++w2) tot += red[w2 * 4 + t];
            const float rs = rsqrtf(tot * (1.f / 256.f) + EPSV);
            bf16_t* op = Z + (size_t)(r0 + t) * ZLD + ocol + vown;
            const float gt = bf2f(*op), sg = sigmoidf_(gt);
            *op = f2bf(hv[t] * rs * gain[vown] * (BR == 0 ? sg : gt * sg)); }
    }
    __syncthreads();
}

__device__ __forceinline__ void attn_prompt(const Params& p, unsigned char* lds, int item) {
    const int tid = threadIdx.x, w = tid >> 6, lane = tid & 63, g = lane >> 4, l16 = lane & 15, q4 = l16 >> 2, p4 = lane & 3;
    const int qt = item & 15, h = (item >> 4) & 3, b = item >> 6;
    const bf16_t* KV = (const bf16_t*)(p.ws + WS_MEMKV) + (size_t)b * 256 * 2048 + h * 256;
    const bf16_t* Q = (const bf16_t*)(p.ws + WS_QBUF);
    bf16_t* O = (bf16_t*)(p.ws + WS_OBUF);
    const size_t rq = (size_t)b * 2048 + qt * 128 + 16 * w + l16;
    const unsigned aL = (unsigned)(size_t)lds;
#pragma unroll 4
    for (int i = 0; i < 16; ++i) { const int id = tid + 512 * i, key = id >> 5, ch = id & 31;
        *(u32x4*)(lds + key * V_STRIDE + ch * 16) = *(const u32x4*)(KV + (size_t)key * 2048 + ch * 8); }
    __syncthreads();
    f32x4 s[16];
#pragma unroll
    for (int ki = 0; ki < 16; ++ki) s[ki] = (f32x4){0.f, 0.f, 0.f, 0.f};
#pragma unroll
    for (int ks = 0; ks < 8; ++ks) { const bf16x8 qfk = *(const bf16x8*)(Q + rq * DM + h * 256 + 32 * ks + 8 * g);
#pragma unroll
        for (int ki = 0; ki < 16; ++ki) s[ki] = mfma16(*(const bf16x8*)(lds + (16 * ki + l16) * V_STRIDE + (32 * ks + 8 * g) * 2), qfk, s[ki]); }
    float mx = -3.0e38f;
#pragma unroll
    for (int ki = 0; ki < 16; ++ki)
#pragma unroll
        for (int r = 0; r < 4; ++r) mx = fmaxf(mx, s[ki][r]);
    mx = xmax16_32(mx);
    float sum = 0.f;
#pragma unroll
    for (int ki = 0; ki < 16; ++ki)
#pragma unroll
        for (int r = 0; r < 4; ++r) { const float e = __expf(s[ki][r] - mx); s[ki][r] = e; sum += e; }
    sum = xsum16_32(sum);
    bf16x8 pf[8];
#pragma unroll
    for (int ks = 0; ks < 8; ++ks) pf[ks] = pack8(s[2 * ks], s[2 * ks + 1]);
    __syncthreads();
#pragma unroll 4
    for (int i = 0; i < 16; ++i) { const int id = tid + 512 * i, key = id >> 5, ch = id & 31;
        *(u32x4*)(lds + key * V_STRIDE + ch * 16) = *(const u32x4*)(KV + (size_t)key * 2048 + 1024 + ch * 8); }
    __syncthreads();
    const float inv = 1.f / sum;
#pragma unroll
    for (int hh = 0; hh < 2; ++hh) {
        f32x4 o[8];
#pragma unroll
        for (int hi = 0; hi < 8; ++hi) o[hi] = (f32x4){0.f, 0.f, 0.f, 0.f};
#pragma unroll
        for (int ks = 0; ks < 8; ++ks) {
            unsigned aLk = aL + (32 * ks + 4 * g + q4) * V_STRIDE + 8 * p4 + hh * 256;
            asm volatile("" : "+v"(aLk));
#pragma unroll
            for (int hi = 0; hi < 8; hi += 2) {
                const unsigned a0 = aLk + (16 * hi) * 2;
                bf16x8 fa, fb; tr_frag2(a0, a0 + 16 * V_STRIDE, a0 + 32, a0 + 32 + 16 * V_STRIDE, fa, fb);
                o[hi] = mfma16(fa, pf[ks], o[hi]); o[hi + 1] = mfma16(fb, pf[ks], o[hi + 1]);
            }
        }
#pragma unroll
        for (int hi = 0; hi < 8; ++hi) *(u32x2*)(O + rq * DM + h * 256 + hh * 128 + 16 * hi + 4 * g) = pack4(o[hi] * inv);
    }
    __syncthreads();
}
__device__ __forceinline__ void attn_sample(const Params& p, unsigned char* lds, int item) {
    const int tid = threadIdx.x, w = tid >> 6, lane = tid & 63;
    const int h = item & 3, b = item >> 2;
    const float* Kc = p.in[7] + ((size_t)b * 1024 + h) * 256;
    const float* Vc = p.in[8] + ((size_t)b * 1024 + h) * 256;
    const bf16_t* Q = (const bf16_t*)(p.ws + WS_QBUF);
    bf16_t* O = (bf16_t*)(p.ws + WS_OBUF);
    float* sc = (float*)lds; float* po = sc + 1024;
    const size_t r0 = MP + 4 * b;
    f32x4 q[4];
#pragma unroll
    for (int t = 0; t < 4; ++t) { const u32x2 qw = *(const u32x2*)(Q + (r0 + t) * DM + h * 256 + lane * 4); q[t] = (f32x4){bflo(qw.x), bfhi(qw.x), bflo(qw.y), bfhi(qw.y)}; }
    {
        const bool b5 = (lane & 32) != 0, b4 = (lane & 16) != 0, b3 = (lane & 8) != 0, b2 = (lane & 4) != 0;
#pragma unroll 2
        for (int kg = 0; kg < 8; ++kg) { const int key0 = w * 32 + kg * 4;
            f32x4 kv[4];
#pragma unroll
            for (int k = 0; k < 4; ++k) kv[k] = __builtin_nontemporal_load((const f32x4*)(Kc + (size_t)(key0 + k) * 1024 + lane * 4));
            float v[16];
#pragma unroll
            for (int k = 0; k < 4; ++k)
#pragma unroll
                for (int t = 0; t < 4; ++t) v[k * 4 + t] = kv[k][0] * q[t][0] + kv[k][1] * q[t][1] + kv[k][2] * q[t][2] + kv[k][3] * q[t][3];
            float a8[8], a4[4], a2[2];
#pragma unroll
            for (int i = 0; i < 8; ++i) { const float keep = b5 ? v[i + 8] : v[i], send = b5 ? v[i] : v[i + 8]; a8[i] = keep + __shfl_xor(send, 32); }
#pragma unroll
            for (int i = 0; i < 4; ++i) { const float keep = b4 ? a8[i + 4] : a8[i], send = b4 ? a8[i] : a8[i + 4]; a4[i] = keep + __shfl_xor(send, 16); }
#pragma unroll
            for (int i = 0; i < 2; ++i) { const float keep = b3 ? a4[i + 2] : a4[i], send = b3 ? a4[i] : a4[i + 2]; a2[i] = keep + __shfl_xor(send, 8); }
            float d = (b2 ? a2[1] : a2[0]) + __shfl_xor(b2 ? a2[0] : a2[1], 4);
            d += __shfl_xor(d, 2); d += __shfl_xor(d, 1);
            if ((lane & 3) == 0) { const int j = (lane >> 2) & 15; sc[(j & 3) * 256 + key0 + (j >> 2)] = d; }
        }
    }
    __syncthreads();
    if (w < 4) { float v[4], mx = -3.0e38f;
#pragma unroll
        for (int i = 0; i < 4; ++i) { v[i] = sc[w * 256 + lane + 64 * i]; mx = fmaxf(mx, v[i]); }
        mx = wave_max(mx); float sum = 0.f;
#pragma unroll
        for (int i = 0; i < 4; ++i) { v[i] = __expf(v[i] - mx); sum += v[i]; }
        sum = wave_sum(sum); const float inv = 1.f / sum;
#pragma unroll
        for (int i = 0; i < 4; ++i) sc[w * 256 + lane + 64 * i] = v[i] * inv; }
    __syncthreads();
    {
        const int hd4 = lane * 4; float* po8 = sc + 1024;
        f32x4 acc4[4];
#pragma unroll
        for (int t = 0; t < 4; ++t) acc4[t] = (f32x4){0.f, 0.f, 0.f, 0.f};
#pragma unroll 8
        for (int kk = 0; kk < 32; ++kk) { const int key = w * 32 + kk; const f32x4 v4 = __builtin_nontemporal_load((const f32x4*)(Vc + (size_t)key * 1024 + hd4));
#pragma unroll
            for (int t = 0; t < 4; ++t) acc4[t] += v4 * sc[t * 256 + key]; }
#pragma unroll
        for (int t = 0; t < 4; ++t) *(f32x4*)(po8 + (w * 4 + t) * 256 + hd4) = acc4[t];
        __syncthreads();
        if (tid < 256) {
#pragma unroll
            for (int t = 0; t < 4; ++t) { float o = 0.f;
#pragma unroll
                for (int w2 = 0; w2 < 8; ++w2) o += po8[(w2 * 4 + t) * 256 + tid];
                O[(r0 + t) * DM + h * 256 + tid] = f2bf(o); } }
    }
    __syncthreads();
}

#ifndef ONLY_PH
#define ONLY_PH -1
#endif
#ifndef MIXEN
#define MIXEN 15
#endif
#ifndef PH_MASK
#define PH_MASK 0xffff
#endif
#define PH_ENABLED(x) ((ONLY_PH < 0 || ONLY_PH == (x)) && ((PH_MASK >> (x)) & 1) && ((KMASK >> (x)) & 1))
__device__ __forceinline__ void grid_barrier(unsigned char* wsb, unsigned char* lds) {
    XcdBarrier b; b.bar = (unsigned*)(wsb + WS_BAR); b.x = xb_xcc_id(); b.st = (volatile LAS unsigned*)(lds + LDS_BYTES - 16);
    xcd_barrier(b);
}
template <int KMASK> __global__ void __launch_bounds__(512, 2) fwd_kernel(Params p) {
    extern __shared__ __attribute__((aligned(16))) unsigned char lds[];
    cg::grid_group grid = cg::this_grid();
    volatile LAS unsigned* xb_st = (volatile LAS unsigned*)(lds + LDS_BYTES - 16);
    if (threadIdx.x == 0) { xb_st[0] = 0u; xb_st[1] = 0u; }
    __syncthreads();
    (void)xcd_barrier_post((unsigned*)(p.ws + WS_BAR), xb_st);
#ifndef DUP_MASK
#define DUP_MASK 0
#endif
#define PH_BEGIN(k) if (PH_ENABLED(k) && p.ph_lo <= (k) && (k) < p.ph_hi) for (int rep_ = 0; rep_ < (((DUP_MASK >> (k)) & 1) ? 2 : 1); ++rep_) { if ((k) > p.ph_lo || rep_) { if (p.ph_hi > 1000) grid.sync(); else grid_barrier(p.ws, lds); } \
        unsigned char* ws; float* outp; { unsigned long long w_ = (unsigned long long)p.ws, o_ = (unsigned long long)p.out; \
        unsigned a0_ = __builtin_amdgcn_readfirstlane((unsigned)w_), a1_ = __builtin_amdgcn_readfirstlane((unsigned)(w_ >> 32)), a2_ = __builtin_amdgcn_readfirstlane((unsigned)o_), a3_ = __builtin_amdgcn_readfirstlane((unsigned)(o_ >> 32)); \
        asm volatile("" : "+s"(a0_), "+s"(a1_), "+s"(a2_), "+s"(a3_)); ws = (unsigned char*)(((unsigned long long)a1_ << 32) | a0_); outp = (float*)(((unsigned long long)a3_ << 32) | a2_); } \
        bf16_t* ABUF = (bf16_t*)(ws + WS_ABUF); bf16_t* Z = (bf16_t*)(ws + WS_Z); float* XRES = (float*)(ws + WS_XRES); float* SS = (float*)(ws + WS_SS); float* TMP = outp + O_YP; \
        (void)ABUF; (void)Z; (void)XRES; (void)SS; (void)TMP;
#define PH_END }
    PH_BEGIN(0) prep_phase(p, lds); PH_END
    PH_BEGIN(1)
        EpiGateUp e1; e1.H = Z; e1.ss = nullptr;
        run_gemm(lds, ABUF, DM, (const bf16_t*)(ws + WS_WGU1), MT, 5632, 1024, e1, 0);
        EpiMemKV e2; e2.ok = outp + O_MKP; e2.ov = outp + O_MVP; e2.kv = (bf16_t*)(ws + WS_MEMKV);
        run_gemm(lds, (const bf16_t*)(ws + WS_MEMA), DM, (const bf16_t*)(ws + WS_WKV), 2048, 2048, 1024, e2, 64);
    PH_END
    PH_BEGIN(2) EpiResid e; e.res0 = p.in[0]; e.res1 = p.in[1]; e.xout = XRES; e.aout = ABUF; e.gain = p.in[13]; e.ss = SS; e.scale = 0.5f;
        run_gemm(lds, Z, DFF, (const bf16_t*)(ws + WS_WD1), MP, 1024, DFF, e, 0); small_gemm(lds, Z, DFF, (const bf16_t*)(ws + WS_WD1), 1024, DFF, e); PH_END
    PH_BEGIN(3) EpiZ e; e.Z = Z; e.ZS = (float*)(ws + WS_ZS); e.ss = SS;
        run_gemm(lds, ABUF, DM, (const bf16_t*)(ws + WS_WIN), MT, 8448, 1024, e, 0); PH_END
    PH_BEGIN(4)
        for (int it = blockIdx.x; it < 1024; it += gridDim.x) gla_prep(p, lds, it);
    PH_END
    PH_BEGIN(5)
        const int bx = (int)blockIdx.x, G = (int)gridDim.x;
        const int NCH = (G >= 256) ? 128 : 0;
        if (bx < NCH || NCH == 0) {
            for (int it0 = bx; it0 < 128; it0 += (NCH ? NCH : G)) { const int it = NCH ? ((((it0 & 7) * 8 + (it0 >> 4)) << 1) | ((it0 >> 3) & 1)) : it0;
                if (it < 64) { if (MIXEN & 1) mixer_prompt<0>(p, lds, it >> 3, (it >> 1) & 3, it & 1); } }
            for (int it0 = bx; it0 < 128; it0 += (NCH ? NCH : G)) { const int it = NCH ? ((((it0 & 7) * 8 + (it0 >> 4)) << 1) | ((it0 >> 3) & 1)) : it0;
                if (it >= 64) { if (MIXEN & 2) mixer_prompt<1>(p, lds, (it - 64) >> 3, (it >> 1) & 3, it & 1); } }
        }
        if (bx >= NCH) {
            for (int it = bx - NCH; it < 512; it += G - NCH) { if (MIXEN & 4) mixer_sample<0>(p, lds, it >> 2, it & 3); }
            for (int it = bx - NCH; it < 512; it += G - NCH) { if (MIXEN & 8) mixer_sample<1>(p, lds, it >> 2, it & 3); }
            prep_transposes(p, lds, PREP_LATE_MASK, bx - NCH, G - NCH);
        }
    PH_END
    PH_BEGIN(6)
        const float* SSQ = (const float*)(ws + WS_SSQ);
        const int lane = threadIdx.x & 63, gw = blockIdx.x * 8 + (threadIdx.x >> 6), nw = gridDim.x * 8;
        for (int i0 = gw; i0 < MP * 8; i0 += 4 * nw) {
            f32x4 sp[4]; u32x2 wv[4];
#pragma unroll
            for (int e = 0; e < 4; ++e) { const int i = i0 + e * nw; if (i < MP * 8) { sp[e] = *(const f32x4*)(SSQ + (size_t)i * 4);
                    wv[e] = *(const u32x2*)(Z + (size_t)(i >> 3) * ZLD + (((i & 7) >> 2) ? 5120 : 2048) + (i & 3) * 256 + lane * 4); } }
#pragma unroll
            for (int e = 0; e < 4; ++e) { const int i = i0 + e * nw; if (i < MP * 8) {
                    const float rs = rsqrtf(((sp[e][0] + sp[e][1]) + (sp[e][2] + sp[e][3])) * (1.f / 256.f) + EPSV);
                    f32x4 o = {bflo(wv[e].x) * rs, bfhi(wv[e].x) * rs, bflo(wv[e].y) * rs, bfhi(wv[e].y) * rs};
                    *(u32x2*)(Z + (size_t)(i >> 3) * ZLD + (((i & 7) >> 2) ? 5120 : 2048) + (i & 3) * 256 + lane * 4) = pack4(o); } }
        }
    PH_END
    PH_BEGIN(7) EpiMerge<0> e; e.gate = Z + 6144; e.T = TMP; e.Y = nullptr;
        run_gemm(lds, Z + 2048, ZLD, (const bf16_t*)(ws + WS_WBRM), MP, 1024, 1024, e, 0); small_gemm(lds, Z + 2048, ZLD, (const bf16_t*)(ws + WS_WBRM), 1024, 1024, e); PH_END
    PH_BEGIN(8) EpiMerge<1> e; e.gate = Z + 7168; e.T = TMP; e.Y = ABUF;
        run_gemm(lds, Z + 5120, ZLD, (const bf16_t*)(ws + WS_WBRG), MP, 1024, 1024, e, 0); small_gemm(lds, Z + 5120, ZLD, (const bf16_t*)(ws + WS_WBRG), 1024, 1024, e); PH_END
    PH_BEGIN(9) EpiResid e; e.res0 = XRES; e.res1 = XRES + (size_t)MP * DM; e.xout = XRES; e.aout = (bf16_t*)(ws + WS_ABUF2); e.gain = p.in[23]; e.ss = SS + (size_t)MT * 16; e.scale = 1.f;
        run_gemm(lds, ABUF, DM, (const bf16_t*)(ws + WS_WOUT), MP, 1024, 1024, e, 0); small_gemm(lds, ABUF, DM, (const bf16_t*)(ws + WS_WOUT), 1024, 1024, e); PH_END
    PH_BEGIN(10) EpiQ e; e.Q = (bf16_t*)(ws + WS_QBUF); e.ss = SS + (size_t)MT * 16;
        run_gemm(lds, (const bf16_t*)(ws + WS_ABUF2), DM, (const bf16_t*)(ws + WS_WQ), MP, 1024, 1024, e, 0); small_gemm(lds, (const bf16_t*)(ws + WS_ABUF2), DM, (const bf16_t*)(ws + WS_WQ), 1024, 1024, e); PH_END
    PH_BEGIN(11)
#pragma unroll 1
        for (int pass = 0; pass < 2; ++pass) {
            if (((blockIdx.x & 1) != 0) == (pass == 0)) { for (int it = blockIdx.x; it < 512; it += gridDim.x) attn_sample(p, lds, it); }
            else { for (int it = blockIdx.x; it < 512; it += gridDim.x) attn_prompt(p, lds, it); }
        }
    PH_END
    PH_BEGIN(12) EpiResid e; e.res0 = XRES; e.res1 = XRES + (size_t)MP * DM; e.xout = XRES; e.aout = ABUF; e.gain = p.in[29]; e.ss = SS + (size_t)MT * 32; e.scale = 1.f;
        run_gemm(lds, (const bf16_t*)(ws + WS_OBUF), DM, (const bf16_t*)(ws + WS_WO), MP, 1024, 1024, e, 0); small_gemm(lds, (const bf16_t*)(ws + WS_OBUF), DM, (const bf16_t*)(ws + WS_WO), 1024, 1024, e); PH_END
    PH_BEGIN(13) EpiGateUp e; e.H = Z; e.ss = SS + (size_t)MT * 32;
        run_gemm(lds, ABUF, DM, (const bf16_t*)(ws + WS_WGU2), MT, 5632, 1024, e, 0); PH_END
    PH_BEGIN(14) EpiResid e; e.res0 = XRES; e.res1 = XRES + (size_t)MP * DM; e.xout = TMP; e.aout = nullptr; e.gain = nullptr; e.ss = SS + (size_t)MT * 48; e.scale = 0.5f;
        run_gemm(lds, Z, DFF, (const bf16_t*)(ws + WS_WD2), MP, 1024, DFF, e, 0); small_gemm(lds, Z, DFF, (const bf16_t*)(ws + WS_WD2), 1024, DFF, e); PH_END
    PH_BEGIN(15)
        const int lane = threadIdx.x & 63, gw = blockIdx.x * 8 + (threadIdx.x >> 6), nw = gridDim.x * 8;
        for (int r = gw; r < MT; r += nw) { const float rs = rs_row(SS + (size_t)MT * 48, r); float* y = TMP + (size_t)r * DM;
#pragma unroll
            for (int i = 0; i < 4; ++i) { f32x4 v = *(const f32x4*)(y + i * 256 + lane * 4); const f32x4 gg = *(const f32x4*)(p.in[33] + i * 256 + lane * 4);
                __builtin_nontemporal_store(v * rs * gg, (f32x4*)(y + i * 256 + lane * 4)); } }
    PH_END
}

template <int KMASK> static bool setup_kernel() {
    if (hipFuncSetAttribute((const void*)fwd_kernel<KMASK>, hipFuncAttributeMaxDynamicSharedMemorySize, LDS_BYTES) != hipSuccess) { fprintf(stderr, "kernel_launch: hipFuncSetAttribute failed\n"); return false; }
    int per_cu = 0;
    if (hipOccupancyMaxActiveBlocksPerMultiprocessor(&per_cu, (const void*)fwd_kernel<KMASK>, NTHREADS, LDS_BYTES) != hipSuccess || per_cu < 1) fprintf(stderr, "kernel_launch: occupancy query says %d\n", per_cu);
    (void)hipGetLastError();
    return true;
}
template <int KMASK> static void launch_range(Params p, int lo, int hi, int grid, hipStream_t stream) {
    p.ph_lo = lo; p.ph_hi = hi;
    if (hipMemsetAsync((char*)p.ws + WS_BAR, 0, XCD_BAR_WORDS * 4, stream) != hipSuccess) { fprintf(stderr, "kernel_launch: memset of the barrier words failed\n"); return; }
    void* args[] = {&p};
    hipError_t e = hipLaunchCooperativeKernel((const void*)fwd_kernel<KMASK>, dim3(grid), dim3(NTHREADS), args, LDS_BYTES, stream);
    if (e != hipSuccess) fprintf(stderr, "kernel_launch: cooperative launch [%d,%d) failed: %s (grid %d)\n", lo, hi, hipGetErrorString(e), grid);
}
#ifndef N_LAUNCH
#define N_LAUNCH 1
#endif
extern "C" void kernel_launch(void* const* d_in, const int* in_sizes, int n_in, void* d_out, int out_size, void* d_ws, size_t ws_size, hipStream_t stream) {
    static int grid = 0;
    if (grid == 0) {
        if (n_in != 34 || (size_t)out_size != O_END || ws_size < WS_END) { fprintf(stderr, "kernel_launch: unexpected sizes n_in %d out %d ws %zu (need %zu)\n", n_in, out_size, ws_size, (size_t)WS_END); grid = -1; return; }
        int dev = 0, cus = 0;
        (void)hipGetDevice(&dev); (void)hipDeviceGetAttribute(&cus, hipDeviceAttributeMultiprocessorCount, dev);
        bool ok = true;
#if N_LAUNCH == 1
        ok = setup_kernel<0xffff>();
#else
        ok = setup_kernel<0x3fef>() && setup_kernel<0x0010>();
#endif
        if (!ok) { grid = -1; return; }
        grid = cus;
        if (grid < 64) { fprintf(stderr, "kernel_launch: needs >= 64 CUs\n"); grid = -1; return; }
    }
    if (grid < 0) return;
    Params p{};
    for (int i = 0; i < 34; ++i) p.in[i] = (const float*)d_in[i];
    p.out = (float*)d_out; p.ws = (unsigned char*)d_ws;
#if N_LAUNCH == 1
#ifndef PROBE_K
#define PROBE_K -1
#endif
#ifndef PROBE_BACK
#define PROBE_BACK 0
#endif
    if (PROBE_K >= 0) { launch_range<0xffff>(p, 0, PROBE_K + 1, grid, stream); launch_range<0xffff>(p, PROBE_K - PROBE_BACK, 16, grid, stream); }
    else launch_range<0xffff>(p, 0, 16, grid, stream);
#else
#ifndef DBG_HI
#define DBG_HI 14
#endif
    launch_range<0x3fef>(p, 0, DBG_HI < 4 ? DBG_HI : 4, grid, stream);
    if (DBG_HI > 4) launch_range<0x0010>(p, 4, 5, grid, stream);
    if (DBG_HI > 5) launch_range<0x3fef>(p, 5, DBG_HI, grid, stream);
#endif
}
```

```cpp
#include <hip/hip_runtime.h>
#include <hip/hip_cooperative_groups.h>
#include <cstdio>
namespace cg = cooperative_groups;
namespace pg8 {
#define PG8_LAS __attribute__((address_space(3)))
typedef unsigned short bf16_t;
typedef short bf16x8 __attribute__((ext_vector_type(8)));
typedef float f32x4 __attribute__((ext_vector_type(4)));
typedef unsigned u32x4 __attribute__((ext_vector_type(4)));
constexpr int BM = 256, BK = 64, HALF = 128, HTB = HALF * BK * 2  , STAGE_BYTES = 8 * HTB, NXCD = 8, WGM = 8;

__host__ __device__ __forceinline__ int lds_byte(int r, int c) { const int st = (r >> 4) * 2 + (c >> 5), rr = r & 15, cc = c & 31, ob = rr * 64 + cc * 2; return st * 1024 + (ob ^ (((ob >> 9) & 1) << 5)); }
__host__ __device__ __forceinline__ void stage_rc(int b, int& R, int& C) { const int st = b / 1024, sb = b % 1024, swz = sb ^ (((sb >> 9) & 1) << 5); R = (st >> 1) * 16 + swz / 64; C = (st & 1) * 32 + (swz % 64) / 2; }
__host__ __device__ __forceinline__ int perm32(int rho) { const int n = rho >> 4, i = rho & 15; return 8 * (i >> 2) + 4 * n + (i & 3); }

struct Unit { int pm, pn; };
struct Gemm { const bf16_t* A; const bf16_t* Bt; int M, N, K, lda, ldb; };
struct StaticOrder {
    int nM, nN, nwg, G, c;
    __host__ __device__ void init(int M, int N, int G_, int c_) { nM = M / BM; nN = N / BM; nwg = nM * nN; G = G_; c = c_; }
    __host__ __device__ bool next(int i, Unit& u) const {
        const long L = (long)i * G + c; if (L >= nwg) return false;
        int wgid = (int)L; { const int q = nwg / NXCD, r = nwg % NXCD, xcd = wgid % NXCD, off = wgid / NXCD; wgid = (xcd < r ? xcd * (q + 1) : r * (q + 1) + (xcd - r) * q) + off; }
        const int nig = WGM * nN, gid = wgid / nig, fm = gid * WGM, gsz = (nM - fm) < WGM ? (nM - fm) : WGM;
        u.pm = fm + ((wgid % nig) % gsz); u.pn = (wgid % nig) / gsz; return true;
    }
    __device__ __forceinline__ void a_ready(const Unit&) const {}
    __device__ __forceinline__ void done(const Unit&) const {}
};
__device__ __forceinline__ unsigned cvt_pk_bf16(float lo, float hi) { unsigned r; asm volatile("v_cvt_pk_bf16_f32 %0, %1, %2" : "=v"(r) : "v"(lo), "v"(hi)); return r; }
template <class Epi, class Sched>
__device__ __forceinline__ void gemm_phase(PG8_LAS unsigned char* lds, const Gemm g, const Sched& S, const Epi& E) {
    const int tid = threadIdx.x, wid = __builtin_amdgcn_readfirstlane(tid >> 6), lane = tid & 63, wr = wid >> 2, wc = wid & 3, fr = lane & 15, fq = lane >> 4;
    const int K = g.K, nt = K / BK;
    unsigned voffA[2], voffB[2];
#pragma unroll
    for (int i = 0; i < 2; ++i) { int R, C; stage_rc(tid * 16 + i * 8192, R, C); const int Rb = Epi::PERM ? ((R & ~31) + perm32(R & 31)) : R;
        voffA[i] = (unsigned)(R * g.lda + C) * 2u; voffB[i] = (unsigned)(Rb * g.ldb + C) * 2u; }
    const size_t kstep = (size_t)(BK * 2);
    const size_t hstepA = (size_t)HALF * g.lda * 2, hstepB = (size_t)HALF * g.ldb * 2;
    const size_t tstepA = 2 * hstepA, tstepB = 2 * hstepB;
    const unsigned ldsw = (unsigned)wid * 1024u;
    const int aoff = lds_byte(wr * 64 + fr, fq * 8), boff = lds_byte(wc * 32 + fr, fq * 8);
#define PG8_SA(b, h) (((b) * 2 + (h)) * HTB)
#define PG8_SB(b, h) ((4 + (b) * 2 + (h)) * HTB)
#define PG8_STAGE(bufoff, gbase, voff) do { _Pragma("unroll") for (int _i = 0; _i < 2; ++_i) \
        __builtin_amdgcn_global_load_lds((const unsigned*)((const char*)(gbase) + (voff)[_i]), (PG8_LAS unsigned*)(lds + (bufoff) + ldsw + _i * 8192), 16, 0, 0); } while (0)
#define PG8_LDA(dst, b, h) do { _Pragma("unroll") for (int m = 0; m < 4; ++m) _Pragma("unroll") for (int k = 0; k < 2; ++k) dst[m][k] = *(const PG8_LAS bf16x8*)(lds + PG8_SA(b, h) + aoff + m * 2048 + k * 1024); } while (0)
#define PG8_LDB(dst, b, h) do { _Pragma("unroll") for (int n = 0; n < 2; ++n) _Pragma("unroll") for (int k = 0; k < 2; ++k) dst[n][k] = *(const PG8_LAS bf16x8*)(lds + PG8_SB(b, h) + boff + n * 2048 + k * 1024); } while (0)
#define PG8_MMA(ai, bj, At, Bt) do { __builtin_amdgcn_s_setprio(1); _Pragma("unroll") for (int m = 0; m < 4; ++m) _Pragma("unroll") for (int n = 0; n < 2; ++n) _Pragma("unroll") for (int k = 0; k < 2; ++k) \
        acc[ai][bj][m][n] = __builtin_amdgcn_mfma_f32_16x16x32_bf16(Bt[n][k], At[m][k], acc[ai][bj][m][n], 0, 0, 0); __builtin_amdgcn_s_setprio(0); } while (0)
#define PG8_WAIT_V(n) asm volatile("s_waitcnt vmcnt(" #n ")" ::: "memory")
#define PG8_WAIT_L(n) asm volatile("s_waitcnt lgkmcnt(" #n ")" ::: "memory")
#define PG8_BAR __builtin_amdgcn_s_barrier()
#define PG8_SCHED __builtin_amdgcn_sched_barrier(0)
    Unit cur, nxt; int ui = 0;
    if (!S.next(0, cur)) return;
    f32x4 acc[2][2][4][2];
#pragma unroll
    for (int a = 0; a < 2; ++a)
#pragma unroll
        for (int b = 0; b < 2; ++b)
#pragma unroll
            for (int m = 0; m < 4; ++m)
#pragma unroll
                for (int n = 0; n < 2; ++n) acc[a][b][m][n] = (f32x4){0.f, 0.f, 0.f, 0.f};
    bf16x8 At[4][2], B0[2][2], B1[2][2];
    const char* cA = (const char*)g.A + (size_t)cur.pm * tstepA; const char* cB = (const char*)g.Bt + (size_t)cur.pn * tstepB;
    S.a_ready(cur);
    PG8_STAGE(PG8_SB(0, 0), cB, voffB); PG8_STAGE(PG8_SA(0, 0), cA, voffA); PG8_STAGE(PG8_SB(0, 1), cB + hstepB, voffB); PG8_STAGE(PG8_SA(0, 1), cA + hstepA, voffA);
    if (wr == 1) PG8_BAR;
    PG8_WAIT_V(4); PG8_BAR;
    PG8_STAGE(PG8_SB(1, 0), cB + kstep, voffB); PG8_STAGE(PG8_SA(1, 0), cA + kstep, voffA); PG8_STAGE(PG8_SB(1, 1), cB + hstepB + kstep, voffB);
    PG8_WAIT_V(6); PG8_BAR;
    for (;;) {
        const bool has_next = S.next(ui + 1, nxt);
        const char* nA = has_next ? (const char*)g.A + (size_t)nxt.pm * tstepA : cA; const char* nB = has_next ? (const char*)g.Bt + (size_t)nxt.pn * tstepB : cB;
        for (int t = 0; t < nt; t += 2) {
            const bool last = (t == nt - 2);
            const char* a1 = cA + (size_t)(t + 1) * kstep;
            const char* a2 = last ? nA : cA + (size_t)(t + 2) * kstep; const char* b2 = last ? nB : cB + (size_t)(t + 2) * kstep;
            const char* a3 = a2 + kstep; const char* b3 = b2 + kstep;
            if (last && has_next) S.a_ready(nxt);
            PG8_LDB(B0, 0, 0); PG8_SCHED; PG8_LDA(At, 0, 0); PG8_STAGE(PG8_SA(1, 1), a1 + hstepA, voffA);
            PG8_WAIT_L(8); PG8_BAR; PG8_WAIT_L(0); PG8_MMA(0, 0, At, B0); PG8_BAR; PG8_SCHED;
            PG8_LDB(B1, 0, 1); PG8_STAGE(PG8_SB(0, 0), b2, voffB);
            PG8_BAR; PG8_WAIT_L(0); PG8_MMA(0, 1, At, B1); PG8_BAR;
            PG8_LDA(At, 0, 1); PG8_STAGE(PG8_SA(0, 0), a2, voffA);
            PG8_BAR; PG8_WAIT_L(0); PG8_MMA(1, 0, At, B0); PG8_BAR; PG8_SCHED;
            PG8_STAGE(PG8_SB(0, 1), b2 + hstepB, voffB);
            PG8_WAIT_V(6); PG8_BAR; PG8_MMA(1, 1, At, B1); PG8_BAR;
            PG8_LDB(B0, 1, 0); PG8_SCHED; PG8_LDA(At, 1, 0); PG8_STAGE(PG8_SA(0, 1), a2 + hstepA, voffA);
            PG8_WAIT_L(8); PG8_BAR; PG8_WAIT_L(0); PG8_MMA(0, 0, At, B0); PG8_BAR; PG8_SCHED;
            PG8_LDB(B1, 1, 1); PG8_STAGE(PG8_SB(1, 0), b3, voffB);
            PG8_BAR; PG8_WAIT_L(0); PG8_MMA(0, 1, At, B1); PG8_BAR;
            PG8_LDA(At, 1, 1); PG8_STAGE(PG8_SA(1, 0), a3, voffA);
            PG8_BAR; PG8_WAIT_L(0); PG8_MMA(1, 0, At, B0); PG8_BAR; PG8_SCHED;
            PG8_STAGE(PG8_SB(1, 1), b3 + hstepB, voffB);
            PG8_WAIT_V(6); PG8_BAR; PG8_MMA(1, 1, At, B1); PG8_BAR;
        }
        if constexpr (!Epi::AFTER_DRAIN) { E(acc, cur, wr, wc, fr, fq); S.done(cur); }
        if (!has_next) break;
#pragma unroll
        for (int a = 0; a < 2; ++a)
#pragma unroll
            for (int b = 0; b < 2; ++b)
#pragma unroll
                for (int m = 0; m < 4; ++m)
#pragma unroll
                    for (int n = 0; n < 2; ++n) acc[a][b][m][n] = (f32x4){0.f, 0.f, 0.f, 0.f};
        cur = nxt; cA = nA; cB = nB; ++ui;
    }
    PG8_WAIT_V(0);
    if (wr == 0) PG8_BAR;
    PG8_BAR;
    if constexpr (Epi::AFTER_DRAIN) { E.fused(acc, cur, wr, wc, fr, fq, lds, wid, lane); S.done(cur); }
#undef PG8_SA
#undef PG8_SB
#undef PG8_STAGE
#undef PG8_LDA
#undef PG8_LDB
#undef PG8_MMA
#undef PG8_WAIT_V
#undef PG8_WAIT_L
#undef PG8_BAR
#undef PG8_SCHED
}
}
using pg8::bf16_t; using pg8::bf16x8; using pg8::f32x4; using pg8::u32x4;
typedef short s16x4 __attribute__((ext_vector_type(4)));
typedef unsigned u32x2 __attribute__((ext_vector_type(2)));
#define LAS __attribute__((address_space(3)))

constexpr int MP = 16384, MS = 512, MT = MP + MS, DM = 1024, DFF = 2816, ZLD = 8192, ZSLD = 32;
constexpr int NTHREADS = 512;
constexpr float EPSV = 1e-6f;
constexpr size_t SZ_WGU = 5632ull * 1024 * 2, SZ_WD = 1024ull * 2816 * 2, SZ_WIN = 8448ull * 1024 * 2, SZ_W1K = 1024ull * 1024 * 2;
constexpr size_t WS_WGU1 = 0;
constexpr size_t WS_WD1 = WS_WGU1 + SZ_WGU;
constexpr size_t WS_WIN = WS_WD1 + SZ_WD;
constexpr size_t WS_WBRM = WS_WIN + SZ_WIN;
constexpr size_t WS_WBRG = WS_WBRM + SZ_W1K;
constexpr size_t WS_WOUT = WS_WBRG + SZ_W1K;
constexpr size_t WS_WQ = WS_WOUT + SZ_W1K;
constexpr size_t WS_WO = WS_WQ + SZ_W1K;
constexpr size_t WS_WKV = WS_WO + SZ_W1K;
constexpr size_t WS_WGU2 = WS_WKV + 2 * SZ_W1K;
constexpr size_t WS_WD2 = WS_WGU2 + SZ_WGU;
constexpr size_t WS_ABUF = WS_WD2 + SZ_WD;
constexpr size_t WS_MEMA = WS_ABUF + (size_t)MT * DM * 2;
constexpr size_t WS_MEMKV = WS_MEMA + 2048ull * 1024 * 2;
constexpr size_t WS_XRES = WS_MEMKV + 2048ull * 2048 * 2;
constexpr size_t WS_ZS = WS_XRES + (size_t)MT * DM * 4;
constexpr size_t WS_SS = WS_ZS + (size_t)MT * ZSLD * 4;
constexpr size_t WS_SSQ = WS_SS + 4ull * MT * 16 * 4;
constexpr size_t WS_BEND = WS_SSQ + (size_t)MP * 32 * 4;
constexpr size_t WS_Z = WS_BEND + 1024ull * 128 * 4;
constexpr size_t WS_ABUF2 = WS_Z + (64ull << 20);
constexpr size_t WS_QBUF = WS_Z + (128ull << 20);
constexpr size_t WS_OBUF = WS_Z + (192ull << 20);
constexpr size_t WS_BAR = WS_Z + (size_t)MT * ZLD * 2;
constexpr size_t WS_END = WS_BAR + 16384;
constexpr size_t O_YP = 0, O_YS = 16777216, O_CP = 17301504, O_NP = 18350080, O_MPP = 18354176, O_SP = 18354208, O_MKP = 19402784, O_MVP = 21499936,
                 O_CS = 23597088, O_NS = 40374304, O_MSS = 40439840, O_SS = 40440352, O_END = 57217568;
constexpr int LDS_BYTES = 156 * 1024;

struct Params { const float* in[34]; float* out; unsigned char* ws; int ph_lo, ph_hi; };

typedef float f32x2_t __attribute__((ext_vector_type(2)));
typedef __bf16 bf16x2_t __attribute__((ext_vector_type(2)));
__device__ __forceinline__ unsigned cvt_pk(float lo, float hi) { f32x2_t v = {lo, hi}; bf16x2_t b = __builtin_convertvector(v, bf16x2_t); return __builtin_bit_cast(unsigned, b); }
__device__ __forceinline__ bf16_t f2bf(float x) { return (bf16_t)(cvt_pk(x, 0.f) & 0xffffu); }
__device__ __forceinline__ float bf2f(bf16_t x) { return __uint_as_float(((unsigned)x) << 16); }
__device__ __forceinline__ float bflo(unsigned w) { return __uint_as_float(w << 16); }
__device__ __forceinline__ float bfhi(unsigned w) { return __uint_as_float(w & 0xffff0000u); }
__device__ __forceinline__ float sigmoidf_(float x) { return __builtin_amdgcn_rcpf(1.f + __expf(-x)); }
__device__ __forceinline__ float logsigf_(float x) { return fminf(x, 0.f) - __logf(1.f + __expf(-fabsf(x))); }
__device__ __forceinline__ float rs_of(float ss) { return rsqrtf(ss * (1.f / 1024.f) + EPSV); }
__device__ __forceinline__ float rs_row(const float* ssp, int row) {
    const f32x4* q = (const f32x4*)(ssp + (size_t)row * 16); const f32x4 a = q[0], b = q[1], c = q[2], d = q[3];
    const f32x4 s = (a + b) + (c + d); return rs_of((s[0] + s[1]) + (s[2] + s[3])); }
__device__ __forceinline__ f32x4 mfma16(bf16x8 a, bf16x8 b, f32x4 c) { return __builtin_amdgcn_mfma_f32_16x16x32_bf16(a, b, c, 0, 0, 0); }
__device__ __forceinline__ bf16x8 pack8(f32x4 a, f32x4 b) {
    u32x4 w; w.x = cvt_pk(a[0], a[1]); w.y = cvt_pk(a[2], a[3]); w.z = cvt_pk(b[0], b[1]); w.w = cvt_pk(b[2], b[3]);
    return __builtin_bit_cast(bf16x8, w);
}
__device__ __forceinline__ u32x2 pack4(f32x4 a) { u32x2 w; w.x = cvt_pk(a[0], a[1]); w.y = cvt_pk(a[2], a[3]); return w; }
__device__ __forceinline__ bf16x8 tr_frag(unsigned a0, unsigned a1) {
    s16x4 r0, r1;
    asm volatile("ds_read_b64_tr_b16 %0, %2\n\tds_read_b64_tr_b16 %1, %3\n\ts_waitcnt lgkmcnt(0)" : "=&v"(r0), "=&v"(r1) : "v"(a0), "v"(a1) : "memory");
    return __builtin_shufflevector(r0, r1, 0, 1, 2, 3, 4, 5, 6, 7);
}
__device__ __forceinline__ void tr_frag2(unsigned a0, unsigned a1, unsigned b0, unsigned b1, bf16x8& fa, bf16x8& fb) {
    s16x4 r0, r1, r2, r3;
    asm volatile("ds_read_b64_tr_b16 %0, %4\n\tds_read_b64_tr_b16 %1, %5\n\tds_read_b64_tr_b16 %2, %6\n\tds_read_b64_tr_b16 %3, %7\n\ts_waitcnt lgkmcnt(0)"
                 : "=&v"(r0), "=&v"(r1), "=&v"(r2), "=&v"(r3) : "v"(a0), "v"(a1), "v"(b0), "v"(b1) : "memory");
    fa = __builtin_shufflevector(r0, r1, 0, 1, 2, 3, 4, 5, 6, 7); fb = __builtin_shufflevector(r2, r3, 0, 1, 2, 3, 4, 5, 6, 7);
}
__device__ __forceinline__ void tr_frag4(unsigned a0, unsigned a1, unsigned b0, unsigned b1, unsigned c0, unsigned c1, unsigned d0, unsigned d1, bf16x8& fa, bf16x8& fb, bf16x8& fc, bf16x8& fd) {
    s16x4 r0, r1, r2, r3, r4, r5, r6, r7;
    asm volatile("ds_read_b64_tr_b16 %0, %8\n\tds_read_b64_tr_b16 %1, %9\n\tds_read_b64_tr_b16 %2, %10\n\tds_read_b64_tr_b16 %3, %11\n\t"
                 "ds_read_b64_tr_b16 %4, %12\n\tds_read_b64_tr_b16 %5, %13\n\tds_read_b64_tr_b16 %6, %14\n\tds_read_b64_tr_b16 %7, %15\n\ts_waitcnt lgkmcnt(0)"
                 : "=&v"(r0), "=&v"(r1), "=&v"(r2), "=&v"(r3), "=&v"(r4), "=&v"(r5), "=&v"(r6), "=&v"(r7)
                 : "v"(a0), "v"(a1), "v"(b0), "v"(b1), "v"(c0), "v"(c1), "v"(d0), "v"(d1) : "memory");
    fa = __builtin_shufflevector(r0, r1, 0, 1, 2, 3, 4, 5, 6, 7); fb = __builtin_shufflevector(r2, r3, 0, 1, 2, 3, 4, 5, 6, 7);
    fc = __builtin_shufflevector(r4, r5, 0, 1, 2, 3, 4, 5, 6, 7); fd = __builtin_shufflevector(r6, r7, 0, 1, 2, 3, 4, 5, 6, 7);
}
__device__ __forceinline__ float xsum16_32(float v) { v += __shfl_xor(v, 16); v += __shfl_xor(v, 32); return v; }
__device__ __forceinline__ float xmax16_32(float v) { v = fmaxf(v, __shfl_xor(v, 16)); v = fmaxf(v, __shfl_xor(v, 32)); return v; }
__device__ __forceinline__ float wave_sum(float v) { for (int o = 32; o > 0; o >>= 1) v += __shfl_xor(v, o); return v; }
__device__ __forceinline__ float wave_max(float v) { for (int o = 32; o > 0; o >>= 1) v = fmaxf(v, __shfl_xor(v, o)); return v; }

#define XB_TMO      128
#define XB_XCNT(j)  (256  + 64 * (j))
#define XB_XSUB(j)  (1280 + 64 * (j))
#define XB_XGEN(j)  (2304 + 64 * (j))
#define XB_TOP      3328
#define XB_TOPGEN   3392
#define XCD_BAR_WORDS 3456
#define XB_SPIN_CAP (1u << 18)

__device__ __forceinline__ unsigned xb_ld(unsigned* p)              { return __hip_atomic_load(p, __ATOMIC_RELAXED, __HIP_MEMORY_SCOPE_AGENT); }
__device__ __forceinline__ unsigned xb_add(unsigned* p, unsigned v) { return __hip_atomic_fetch_add(p, v, __ATOMIC_RELAXED, __HIP_MEMORY_SCOPE_AGENT); }
__device__ __forceinline__ unsigned xb_xcc_id() { return (unsigned)__builtin_amdgcn_s_getreg((3 << 11) | 20) & 0xFu; }
#define XB_SPIN(cond, bar) do { unsigned _sp = 0; while (cond) { __builtin_amdgcn_s_sleep(1); \
    if ((++_sp & 255u) == 0u) { if (xb_ld(&(bar)[XB_TMO])) break; if (_sp > XB_SPIN_CAP) { atomicAdd(&(bar)[XB_TMO], 1u); break; } } } } while (0)

struct XcdBarrier {
    unsigned* bar; unsigned x;
    volatile LAS unsigned* st;
};

__device__ __forceinline__ XcdBarrier xcd_barrier_post(unsigned* bar, volatile LAS unsigned* st) {
    XcdBarrier b; b.bar = bar; b.x = xb_xcc_id(); b.st = st;
    if (threadIdx.x == 0) (void)xb_add(&bar[XB_XCNT(b.x)], 1u);
    return b;
}
__device__ __forceinline__ void xcd_barrier_complete(unsigned* bar, unsigned x, unsigned& nloc, unsigned& nx) {
    const unsigned G = gridDim.x * gridDim.y * gridDim.z;
    unsigned sum, cnt, mine, sp = 0u;
    for (;;) {
        sum = 0u; cnt = 0u; mine = 0u;
#pragma unroll
        for (unsigned j = 0; j < 16; ++j) { const unsigned c = xb_ld(&bar[XB_XCNT(j)]); sum += c; cnt += (c > 0u) ? 1u : 0u; mine = (j == x) ? c : mine; }
        if (sum == G) break;
        __builtin_amdgcn_s_sleep(1);
        if ((++sp & 255u) == 0u) { if (xb_ld(&bar[XB_TMO])) break; if (sp > XB_SPIN_CAP) { atomicAdd(&bar[XB_TMO], 1u); break; } }
    }
    nloc = mine > 0u ? mine : 1u; nx = cnt > 0u ? cnt : 1u;
}

__device__ __forceinline__ void xcd_barrier(const XcdBarrier& b) {
    asm volatile("s_waitcnt vmcnt(0)" ::: "memory");
    __syncthreads();
    if (threadIdx.x == 0) {
        unsigned* bar = b.bar;
        __builtin_amdgcn_s_waitcnt(0);
        unsigned nloc = b.st[0], nx = b.st[1];
        if (nloc == 0u) { xcd_barrier_complete(bar, b.x, nloc, nx); b.st[0] = nloc; b.st[1] = nx; }
        const unsigned old = xb_add(&bar[XB_XSUB(b.x)], 1u);
        const unsigned gen = old / nloc;
        if (old + 1u == (gen + 1u) * nloc) {
            __builtin_amdgcn_fence(__ATOMIC_RELEASE, "agent");
            asm volatile("s_waitcnt vmcnt(0)" ::: "memory");
            const unsigned og = xb_add(&bar[XB_TOP], 1u);
            const unsigned tg = og / nx;
            if (og + 1u == (tg + 1u) * nx) xb_add(&bar[XB_TOPGEN], 1u);
            else XB_SPIN(xb_ld(&bar[XB_TOPGEN]) == tg, bar);
            __builtin_amdgcn_fence(__ATOMIC_ACQUIRE, "agent");
            xb_add(&bar[XB_XGEN(b.x)], 1u);
            asm volatile("s_waitcnt vmcnt(0)" ::: "memory");
        } else {
            XB_SPIN(xb_ld(&bar[XB_XGEN(b.x)]) == gen, bar);
            __builtin_amdgcn_fence(__ATOMIC_ACQUIRE, "agent");
            asm volatile("s_waitcnt vmcnt(0)" ::: "memory");
        }
    }
    __syncthreads();
}


constexpr int PREP_EARLY_MASK = 0x060f, PREP_LATE_MASK = 0x39f0;
__device__ __forceinline__ int win_src_col(int r) {
    if (r < 3072) return r; if (r < 6144) return r + 8; if (r < 8192) return r + 24;
    if (r < 8200) return 3072 + (r - 8192); if (r < 8216) return 6152 + (r - 8200); return -1;
}
__device__ __forceinline__ void prep_transposes(const Params& p, unsigned char* lds, int dmask, int vb, int nvb) {
    float* tile = (float*)lds;
    const int tid = threadIdx.x;
    unsigned char* ws = p.ws;
    for (int d = 0; d < 14; ++d) {
        if (!((dmask >> d) & 1)) continue;
        const float* src; bf16_t* dst; int K, ldsrc, ntn, mode = 0, rowoff = 0; float scale = 1.f;
        switch (d) {
            case 0: src = p.in[10]; dst = (bf16_t*)(ws + WS_WGU1); K = 1024; ldsrc = 2816; ntn = 44; mode = 2; rowoff = 0; break;
            case 1: src = p.in[11]; dst = (bf16_t*)(ws + WS_WGU1); K = 1024; ldsrc = 2816; ntn = 44; mode = 2; rowoff = 128; break;
            case 2: src = p.in[12]; dst = (bf16_t*)(ws + WS_WD1); K = 2816; ldsrc = 1024; ntn = 16; break;
            case 3: src = p.in[14]; dst = (bf16_t*)(ws + WS_WIN); K = 1024; ldsrc = 8216; ntn = 132; mode = 1; break;
            case 4: src = p.in[20]; dst = (bf16_t*)(ws + WS_WBRM); K = 1024; ldsrc = 1024; ntn = 16; break;
            case 5: src = p.in[21]; dst = (bf16_t*)(ws + WS_WBRG); K = 1024; ldsrc = 1024; ntn = 16; break;
            case 6: src = p.in[22]; dst = (bf16_t*)(ws + WS_WOUT); K = 1024; ldsrc = 1024; ntn = 16; break;
            case 7: src = p.in[25]; dst = (bf16_t*)(ws + WS_WQ); K = 1024; ldsrc = 1024; ntn = 16; scale = 0.0625f; break;
            case 8: src = p.in[28]; dst = (bf16_t*)(ws + WS_WO); K = 1024; ldsrc = 1024; ntn = 16; break;
            case 9: src = p.in[26]; dst = (bf16_t*)(ws + WS_WKV); K = 1024; ldsrc = 1024; ntn = 16; break;
            case 10: src = p.in[27]; dst = (bf16_t*)(ws + WS_WKV); K = 1024; ldsrc = 1024; ntn = 16; rowoff = 1024; break;
            case 11: src = p.in[30]; dst = (bf16_t*)(ws + WS_WGU2); K = 1024; ldsrc = 2816; ntn = 44; mode = 2; rowoff = 0; break;
            case 12: src = p.in[31]; dst = (bf16_t*)(ws + WS_WGU2); K = 1024; ldsrc = 2816; ntn = 44; mode = 2; rowoff = 128; break;
            default: src = p.in[32]; dst = (bf16_t*)(ws + WS_WD2); K = 2816; ldsrc = 1024; ntn = 16; break;
        }
        const int nkt = K / 64, ntiles = nkt * ntn;
        for (int t = vb; t < ntiles; t += nvb) {
            const int kt = t % nkt, nt = t / nkt, k0 = kt * 64;
            {
                const int j = tid & 63;
                int srccol; float sc = scale;
                if (mode == 1) { srccol = win_src_col(nt * 64 + j); if ((srccol >= 512 && srccol < 1024) || (srccol >= 3080 && srccol < 3592)) sc = 0.08838834764831845f; }
                else srccol = nt * 64 + j;
#pragma unroll
                for (int ps = 0; ps < 8; ++ps) { const int i = (tid >> 6) + 8 * ps;
                    float v = 0.f; if (srccol >= 0) v = __builtin_nontemporal_load(src + (size_t)(k0 + i) * ldsrc + srccol) * sc;
                    tile[i * 65 + j] = v; }
            }
            __syncthreads();
            {
                const int j = tid >> 3, kc = tid & 7;
                int dstrow;
                if (mode == 1) dstrow = nt * 64 + j;
                else { const int sc_ = nt * 64 + j; dstrow = (mode == 2) ? ((sc_ >> 7) * 256 + (sc_ & 127) + rowoff) : (sc_ + rowoff); }
                float v[8];
#pragma unroll
                for (int e = 0; e < 8; ++e) v[e] = tile[(kc * 8 + e) * 65 + j];
                u32x4 w; w.x = cvt_pk(v[0], v[1]); w.y = cvt_pk(v[2], v[3]); w.z = cvt_pk(v[4], v[5]); w.w = cvt_pk(v[6], v[7]);
                *(u32x4*)(dst + (size_t)dstrow * K + k0 + kc * 8) = w;
            }
            __syncthreads();
        }
    }
}
__device__ __forceinline__ void prep_phase(const Params& p, unsigned char* lds) {
    const int tid = threadIdx.x;
    unsigned char* ws = p.ws;
    prep_transposes(p, lds, PREP_EARLY_MASK, (int)blockIdx.x, (int)gridDim.x);
    const int lane = tid & 63, gw = blockIdx.x * 8 + (tid >> 6), nw = gridDim.x * 8;
    for (int r = gw; r < MT + 2048; r += nw) {
        const float* x; const float* g; bf16_t* o;
        if (r < MP) { x = p.in[0] + (size_t)r * DM; g = p.in[9]; o = (bf16_t*)(ws + WS_ABUF) + (size_t)r * DM; }
        else if (r < MT) { x = p.in[1] + (size_t)(r - MP) * DM; g = p.in[9]; o = (bf16_t*)(ws + WS_ABUF) + (size_t)r * DM; }
        else { x = p.in[2] + (size_t)(r - MT) * DM; g = p.in[24]; o = (bf16_t*)(ws + WS_MEMA) + (size_t)(r - MT) * DM; }
        f32x4 v[4]; float ss = 0.f;
#pragma unroll
        for (int i = 0; i < 4; ++i) { v[i] = *(const f32x4*)(x + i * 256 + lane * 4); ss += v[i][0] * v[i][0] + v[i][1] * v[i][1] + v[i][2] * v[i][2] + v[i][3] * v[i][3]; }
        ss = wave_sum(ss); const float rs = rs_of(ss);
#pragma unroll
        for (int i = 0; i < 4; ++i) { const f32x4 gg = *(const f32x4*)(g + i * 256 + lane * 4);
            u32x2 w; w.x = cvt_pk(v[i][0] * rs * gg[0], v[i][1] * rs * gg[1]); w.y = cvt_pk(v[i][2] * rs * gg[2], v[i][3] * rs * gg[3]);
            *(u32x2*)(o + i * 256 + lane * 4) = w; }
    }
}

#define EPI_ROW(ai, m) (u.pm * 256 + (ai) * 128 + wr * 64 + (m) * 16 + fr)
#define EPI_COL(bj) (u.pn * 256 + (bj) * 128 + wc * 32 + fq * 8)
struct EpiGateUp {
    static constexpr bool PERM = true, AFTER_DRAIN = false;
    bf16_t* H; const float* ss;
    __device__ __forceinline__ void operator()(const f32x4 (&acc)[2][2][4][2], const pg8::Unit& u, int wr, int wc, int fr, int fq) const {
        float rsv[2][4];
#pragma unroll
        for (int ai = 0; ai < 2; ++ai)
#pragma unroll
            for (int m = 0; m < 4; ++m) rsv[ai][m] = ss ? rs_row(ss, EPI_ROW(ai, m)) : 1.f;
#pragma unroll
        for (int ai = 0; ai < 2; ++ai)
#pragma unroll
            for (int m = 0; m < 4; ++m) { const int row = EPI_ROW(ai, m); const float rs = rsv[ai][m];
                f32x4 hv[2];
#pragma unroll
                for (int n = 0; n < 2; ++n)
#pragma unroll
                    for (int j = 0; j < 4; ++j) { const float gt = acc[ai][0][m][n][j] * rs, up = acc[ai][1][m][n][j] * rs; hv[n][j] = gt * sigmoidf_(gt) * up; }
                *(u32x4*)(H + (size_t)row * DFF + u.pn * 128 + wc * 32 + fq * 8) = __builtin_bit_cast(u32x4, pack8(hv[0], hv[1])); }
    }
};
struct EpiMemKV {
    static constexpr bool PERM = true, AFTER_DRAIN = false;
    float* ok; float* ov; bf16_t* kv;
    __device__ __forceinline__ void operator()(const f32x4 (&acc)[2][2][4][2], const pg8::Unit& u, int wr, int wc, int fr, int fq) const {
#pragma unroll
        for (int ai = 0; ai < 2; ++ai)
#pragma unroll
            for (int m = 0; m < 4; ++m) { const int row = EPI_ROW(ai, m);
#pragma unroll
                for (int bj = 0; bj < 2; ++bj) { const int col = EPI_COL(bj);
                    float* o = (col < 1024) ? (ok + (size_t)row * 1024 + col) : (ov + (size_t)row * 1024 + (col - 1024));
                    __builtin_nontemporal_store(acc[ai][bj][m][0], (f32x4*)o); __builtin_nontemporal_store(acc[ai][bj][m][1], (f32x4*)(o + 4));
                    *(u32x4*)(kv + (size_t)row * 2048 + col) = __builtin_bit_cast(u32x4, pack8(acc[ai][bj][m][0], acc[ai][bj][m][1])); } }
    }
};
struct EpiResid {
    static constexpr bool PERM = true, AFTER_DRAIN = false;
    const float* res0; const float* res1; float* xout; bf16_t* aout; const float* gain; float* ss; float scale;
    __device__ __forceinline__ void operator()(const f32x4 (&acc)[2][2][4][2], const pg8::Unit& u, int wr, int wc, int fr, int fq) const {
        f32x4 gv[2][2];
        if (aout) {
#pragma unroll
            for (int bj = 0; bj < 2; ++bj) { gv[bj][0] = *(const f32x4*)(gain + EPI_COL(bj)); gv[bj][1] = *(const f32x4*)(gain + EPI_COL(bj) + 4); } }
#pragma unroll
        for (int ai = 0; ai < 2; ++ai) {
            f32x4 rv[4][2][2];
#pragma unroll
            for (int m = 0; m < 4; ++m) { const int row = EPI_ROW(ai, m);
                const float* rp = (row < MP) ? (res0 + (size_t)row * DM) : (res1 + (size_t)(row - MP) * DM);
#pragma unroll
                for (int bj = 0; bj < 2; ++bj) { rv[m][bj][0] = *(const f32x4*)(rp + EPI_COL(bj)); rv[m][bj][1] = *(const f32x4*)(rp + EPI_COL(bj) + 4); } }
#pragma unroll
            for (int m = 0; m < 4; ++m) { const int row = EPI_ROW(ai, m);
                float sq = 0.f;
#pragma unroll
                for (int bj = 0; bj < 2; ++bj) { const int col = EPI_COL(bj);
                    const f32x4 x0 = rv[m][bj][0] + acc[ai][bj][m][0] * scale, x1 = rv[m][bj][1] + acc[ai][bj][m][1] * scale;
                    *(f32x4*)(xout + (size_t)row * DM + col) = x0; *(f32x4*)(xout + (size_t)row * DM + col + 4) = x1;
#pragma unroll
                    for (int j = 0; j < 4; ++j) sq += x0[j] * x0[j] + x1[j] * x1[j];
                    if (aout) *(u32x4*)(aout + (size_t)row * DM + col) = __builtin_bit_cast(u32x4, pack8(x0 * gv[bj][0], x1 * gv[bj][1])); }
                sq = xsum16_32(sq);
                if (fq == 0) ss[(size_t)row * 16 + u.pn * 4 + wc] = sq; }
        }
    }
    __device__ __forceinline__ void small(f32x4 acc, int row, int col, int tc, int rt, int ct, int l16, int g, unsigned char* lds) const {
        const f32x4 x = *(const f32x4*)(res1 + (size_t)(row - MP) * DM + col) + acc * scale;
        *(f32x4*)(xout + (size_t)row * DM + col) = x;
        if (aout) { const f32x4 gv4 = *(const f32x4*)(gain + col); *(u32x2*)(aout + (size_t)row * DM + col) = pack4(x * gv4); }
        float sq = x[0] * x[0] + x[1] * x[1] + x[2] * x[2] + x[3] * x[3];
        sq = xsum16_32(sq);
        float* red = (float*)lds;
        if (g == 0) red[(rt * 4 + ct) * 16 + l16] = sq;
        __syncthreads();
        if (ct == 0 && g == 0) ss[(size_t)row * 16 + tc] = (red[(rt * 4) * 16 + l16] + red[(rt * 4 + 1) * 16 + l16]) + (red[(rt * 4 + 2) * 16 + l16] + red[(rt * 4 + 3) * 16 + l16]);
        __syncthreads();
    }
};
struct EpiZ {
    static constexpr bool PERM = true, AFTER_DRAIN = false;
    bf16_t* Z; float* ZS; const float* ss;
    __device__ __forceinline__ void operator()(const f32x4 (&acc)[2][2][4][2], const pg8::Unit& u, int wr, int wc, int fr, int fq) const {
#pragma unroll
        for (int ai = 0; ai < 2; ++ai) {
            float rsv[4];
#pragma unroll
            for (int m = 0; m < 4; ++m) rsv[m] = rs_row(ss, EPI_ROW(ai, m));
#pragma unroll
            for (int m = 0; m < 4; ++m) { const int row = EPI_ROW(ai, m); const float rs = rsv[m];
                if (u.pn < 32) {
#pragma unroll
                    for (int bj = 0; bj < 2; ++bj)
                        *(u32x4*)(Z + (size_t)row * ZLD + EPI_COL(bj)) = __builtin_bit_cast(u32x4, pack8(acc[ai][bj][m][0] * rs, acc[ai][bj][m][1] * rs));
                } else if (wc == 0) {
                    *(f32x4*)(ZS + (size_t)row * ZSLD + fq * 8) = acc[ai][0][m][0] * rs; *(f32x4*)(ZS + (size_t)row * ZSLD + fq * 8 + 4) = acc[ai][0][m][1] * rs;
                } } }
    }
};
template <int MODE> struct EpiMerge {
    static constexpr bool PERM = true, AFTER_DRAIN = false;
    const bf16_t* gate; float* T; bf16_t* Y;
    __device__ __forceinline__ void operator()(const f32x4 (&acc)[2][2][4][2], const pg8::Unit& u, int wr, int wc, int fr, int fq) const {
#pragma unroll
        for (int ai = 0; ai < 2; ++ai)
#pragma unroll
            for (int mh = 0; mh < 2; ++mh) {
                u32x4 gw[2][2]; u32x4 tvb[2][2]; bf16_t* Tb = (bf16_t*)T;
#pragma unroll
                for (int mm = 0; mm < 2; ++mm) { const int row = EPI_ROW(ai, mh * 2 + mm);
#pragma unroll
                    for (int bj = 0; bj < 2; ++bj) { gw[mm][bj] = *(const u32x4*)(gate + (size_t)row * ZLD + EPI_COL(bj));
                        if (MODE == 1) tvb[mm][bj] = *(const u32x4*)(Tb + (size_t)row * DM + EPI_COL(bj)); } }
#pragma unroll
                for (int mm = 0; mm < 2; ++mm) { const int m = mh * 2 + mm, row = EPI_ROW(ai, m);
#pragma unroll
                    for (int bj = 0; bj < 2; ++bj) { const int col = EPI_COL(bj); const u32x4 g4 = gw[mm][bj];
                        f32x4 s0, s1;
                        s0[0] = sigmoidf_(bflo(g4.x)); s0[1] = sigmoidf_(bfhi(g4.x)); s0[2] = sigmoidf_(bflo(g4.y)); s0[3] = sigmoidf_(bfhi(g4.y));
                        s1[0] = sigmoidf_(bflo(g4.z)); s1[1] = sigmoidf_(bfhi(g4.z)); s1[2] = sigmoidf_(bflo(g4.w)); s1[3] = sigmoidf_(bfhi(g4.w));
                        f32x4 v0 = acc[ai][bj][m][0] * s0, v1 = acc[ai][bj][m][1] * s1;
                        if (MODE == 0) *(u32x4*)(Tb + (size_t)row * DM + col) = __builtin_bit_cast(u32x4, pack8(v0, v1));
                        else { const u32x4 t4 = tvb[mm][bj];
                            v0 += (f32x4){bflo(t4.x), bfhi(t4.x), bflo(t4.y), bfhi(t4.y)}; v1 += (f32x4){bflo(t4.z), bfhi(t4.z), bflo(t4.w), bfhi(t4.w)};
                            *(u32x4*)(Y + (size_t)row * DM + col) = __builtin_bit_cast(u32x4, pack8(v0, v1)); } } }
            }
    }
    __device__ __forceinline__ void small(f32x4 acc, int row, int col, int tc, int rt, int ct, int l16, int g, unsigned char* lds) const {
        bf16_t* Tb = (bf16_t*)T;
        const u32x2 g2 = *(const u32x2*)(gate + (size_t)row * ZLD + col);
        f32x4 v = acc * (f32x4){sigmoidf_(bflo(g2.x)), sigmoidf_(bfhi(g2.x)), sigmoidf_(bflo(g2.y)), sigmoidf_(bfhi(g2.y))};
        if (MODE == 0) *(u32x2*)(Tb + (size_t)row * DM + col) = pack4(v);
        else { const u32x2 t2 = *(const u32x2*)(Tb + (size_t)row * DM + col);
            v += (f32x4){bflo(t2.x), bfhi(t2.x), bflo(t2.y), bfhi(t2.y)};
            *(u32x2*)(Y + (size_t)row * DM + col) = pack4(v); }
    }
};
struct EpiQ {
    static constexpr bool PERM = true, AFTER_DRAIN = false;
    bf16_t* Q; const float* ss;
    __device__ __forceinline__ void operator()(const f32x4 (&acc)[2][2][4][2], const pg8::Unit& u, int wr, int wc, int fr, int fq) const {
#pragma unroll
        for (int ai = 0; ai < 2; ++ai) {
            float rsv[4];
#pragma unroll
            for (int m = 0; m < 4; ++m) rsv[m] = rs_row(ss, EPI_ROW(ai, m));
#pragma unroll
            for (int m = 0; m < 4; ++m) { const int row = EPI_ROW(ai, m); const float rs = rsv[m];
#pragma unroll
                for (int bj = 0; bj < 2; ++bj)
                    *(u32x4*)(Q + (size_t)row * DM + EPI_COL(bj)) = __builtin_bit_cast(u32x4, pack8(acc[ai][bj][m][0] * rs, acc[ai][bj][m][1] * rs)); } }
    }
    __device__ __forceinline__ void small(f32x4 acc, int row, int col, int tc, int rt, int ct, int l16, int g, unsigned char* lds) const {
        *(u32x2*)(Q + (size_t)row * DM + col) = pack4(acc * rs_row(ss, row));
    }
};
template <class Epi>
__device__ __forceinline__ void small_gemm(unsigned char* lds, const bf16_t* A, int lda, const bf16_t* Bt, int N, int K, const Epi& E) {
    const int tid = threadIdx.x, w = tid >> 6, lane = tid & 63, g = lane >> 4, l16 = lane & 15;
    const int rt = w >> 2, ct = w & 3, nct = N / 64, ntiles = 16 * nct;
    for (int t = blockIdx.x; t < ntiles; t += gridDim.x) {
        const int tr = t / nct, tc = t - tr * nct;
        const int row = MP + tr * 32 + rt * 16 + l16, colb = tc * 64 + ct * 16;
        const bf16_t* ap = A + (size_t)row * lda + 8 * g;
        const bf16_t* bp = Bt + (size_t)(colb + l16) * K + 8 * g;
        f32x4 acc0 = (f32x4){0.f, 0.f, 0.f, 0.f}, acc1 = acc0;
#pragma unroll 4
        for (int k = 0; k < K; k += 64) {
            acc0 = mfma16(*(const bf16x8*)(bp + k), *(const bf16x8*)(ap + k), acc0);
            acc1 = mfma16(*(const bf16x8*)(bp + k + 32), *(const bf16x8*)(ap + k + 32), acc1);
        }
        E.small(acc0 + acc1, row, colb + 4 * g, tc, rt, ct, l16, g, lds);
    }
}
template <class Epi>
__device__ __forceinline__ void run_gemm(unsigned char* lds, const bf16_t* A, int lda, const bf16_t* Bt, int M, int N, int K, const Epi& E, int rot) {
    pg8::Gemm g; g.A = A; g.Bt = Bt; g.M = M; g.N = N; g.K = K; g.lda = lda; g.ldb = K;
    pg8::StaticOrder S; S.init(M, N, (int)gridDim.x, (int)((blockIdx.x + rot) % gridDim.x));
    pg8::gemm_phase<Epi, pg8::StaticOrder>((PG8_LAS unsigned char*)lds, g, S, E);
    __syncthreads();
}
constexpr int T_STRIDE = 272, V_STRIDE = 528;
constexpr int VQN = 2, VW = 256 / VQN, NVT = VW / 16, NOT = NVT / 2, V2_STRIDE = VW * 2 + 16;
constexpr int M_T0 = 0, M_T1 = 17408, M_TV = 34816, M_TC = M_TV + 64 * V2_STRIDE, M_SM = M_TC + VW * T_STRIDE;
template <int BR>
__device__ __forceinline__ void mixer_prompt(const Params& p, unsigned char* lds, int b, int h, int vq) {
    const int tid = threadIdx.x, w = tid >> 6, lane = tid & 63, g = lane >> 4, l16 = lane & 15, q4 = l16 >> 2, p4 = lane & 3;
    const int tt = w & 3, vh = w >> 2;
    bf16_t* Z = (bf16_t*)(p.ws + WS_Z);
    const float* ZS = (const float*)(p.ws + WS_ZS);
    float* SSQ = (float*)(p.ws + WS_SSQ);
    const float* BEND = (const float*)(p.ws + WS_BEND);
    const int qcol = (BR == 0 ? 0 : 3072) + h * 128, kcol = (BR == 0 ? 512 : 3584) + h * 128;
    const int vcol = (BR == 0 ? 1024 : 4096) + h * 256 + vq * VW, ocol = (BR == 0 ? 2048 : 5120) + h * 256 + vq * VW;
    unsigned char* T0 = lds + M_T0; unsigned char* T1 = lds + M_T1; unsigned char* TV = lds + M_TV; unsigned char* TC = lds + M_TC;
    float* sm = (float*)(lds + M_SM);
    float* gS = sm; float* Mt = sm + 64; float* at = sm + 128; float* emt = sm + 192; float* wsv = sm + 256; float* nvec = sm + 320; float* bend = sm + 448;
    float* misc = sm + 576; float* ssq = sm + 592; float* gaL = sm + 720; float* segtot = sm + 1744; float* waL = sm + 2256;
    const unsigned aT0_ = (unsigned)(size_t)T0, aT1_ = (unsigned)(size_t)T1, aTV_ = (unsigned)(size_t)TV;
    const float* gain = (BR == 0 ? p.in[18] : p.in[19]) + h * 256 + vq * VW;
    const int tloc = 16 * tt + l16;
    f32x4 gn[NOT];
#pragma unroll
    for (int vi = 0; vi < NOT; ++vi) gn[vi] = *(const f32x4*)(gain + (VW / 2) * vh + 16 * vi + 4 * g);
    f32x4 st[NVT];
#pragma unroll
    for (int c = 0; c < NVT; ++c) st[c] = (f32x4){0.f, 0.f, 0.f, 0.f};
    float m0 = 0.f;
    const float bi = (BR == 0) ? p.in[15][h] : 0.f, bfb = (BR == 0) ? p.in[15][4 + h] : 0.f;
    if (tid < 128) nvec[tid] = 0.f;
    u32x4 kreg[2], qreg[2], vreg[2]; bf16x8 qn[4]; float igr = 0.f, lfr = 0.f, gar[2] = {0.f, 0.f};
    const int ks_s0 = tid >> 4, ks_ch = tid & 15;
#define MIX_LOAD_CHUNK(R0) do { const size_t r_ = (size_t)(R0); \
        kreg[0] = *(const u32x4*)(Z + (r_ + ks_s0) * ZLD + kcol + ks_ch * 8); kreg[1] = *(const u32x4*)(Z + (r_ + ks_s0 + 32) * ZLD + kcol + ks_ch * 8); \
        vreg[0] = *(const u32x4*)(Z + (r_ + ks_s0) * ZLD + vcol + ks_ch * 8); vreg[1] = *(const u32x4*)(Z + (r_ + ks_s0 + 32) * ZLD + vcol + ks_ch * 8); \
        if (BR == 0) { _Pragma("unroll") for (int ks = 0; ks < 4; ++ks) qn[ks] = *(const bf16x8*)(Z + (r_ + tloc) * ZLD + qcol + 32 * ks + 8 * g); \
            if (w == 0) { igr = ZS[(r_ + lane) * ZSLD + h]; lfr = ZS[(r_ + lane) * ZSLD + 4 + h]; } } \
        else { qreg[0] = *(const u32x4*)(Z + (r_ + ks_s0) * ZLD + qcol + ks_ch * 8); qreg[1] = *(const u32x4*)(Z + (r_ + ks_s0 + 32) * ZLD + qcol + ks_ch * 8); \
            if (tid < 128) gar[0] = BEND[(r_ >> 6) * 512 + h * 128 + tid]; } } while (0)
    MIX_LOAD_CHUNK(b * 2048);
    __syncthreads();
    for (int c = 0; c < 32; ++c) {
        const int r0 = b * 2048 + c * 64;
        if (c > 0 && tid < 64) { float* sp_ = SSQ + ((size_t)(r0 - 64 + tid) * 8 + BR * 4 + h) * 4 + vq * 2; sp_[0] = ssq[tid] + ssq[64 + tid]; sp_[1] = 0.f; }
        unsigned aT0 = aT0_, aT1 = aT1_, aTV = aTV_;
        asm volatile("" : "+v"(aT0), "+v"(aT1), "+v"(aTV));
        if (BR == 0) {
            if (w == 0) {
                const float ig = igr + bi, lf = logsigf_(lfr + bfb);
                float F = lf;
#pragma unroll
                for (int o = 1; o < 64; o <<= 1) { const float y = __shfl_up(F, o); if (lane >= o) F += y; }
                const float gg = ig - F; float cm = gg;
#pragma unroll
                for (int o = 1; o < 64; o <<= 1) { const float y = __shfl_up(cm, o); if (lane >= o) cm = fmaxf(cm, y); }
                const float M = fmaxf(m0, cm), a = __expf(m0 - M);
                const float ML = __shfl(M, 63), aend = __shfl(a, 63), FL = __shfl(F, 63);
                gS[lane] = gg; Mt[lane] = M; at[lane] = a; emt[lane] = __expf(-(F + M)); wsv[lane] = __expf(gg - ML);
                if (lane == 0) misc[1] = aend;
                m0 = FL + ML;
            }
            __syncthreads();
#pragma unroll
            for (int i = 0; i < 2; ++i) { const int s = ks_s0 + 32 * i; const u32x4 kw = kreg[i];
                *(u32x4*)(T0 + s * T_STRIDE + ks_ch * 16) = kw;
                const float ww = wsv[s]; u32x4 o;
                o.x = cvt_pk(bflo(kw.x) * ww, bfhi(kw.x) * ww); o.y = cvt_pk(bflo(kw.y) * ww, bfhi(kw.y) * ww);
                o.z = cvt_pk(bflo(kw.z) * ww, bfhi(kw.z) * ww); o.w = cvt_pk(bflo(kw.w) * ww, bfhi(kw.w) * ww);
                *(u32x4*)(T1 + s * T_STRIDE + ks_ch * 16) = o; }
        } else {
            if (tid < 128) bend[tid] = gar[0];
#pragma unroll
            for (int i = 0; i < 2; ++i) { const int s = ks_s0 + 32 * i;
                *(u32x4*)(T0 + s * T_STRIDE + ks_ch * 16) = kreg[i]; *(u32x4*)(T1 + s * T_STRIDE + ks_ch * 16) = qreg[i]; }
        }
#pragma unroll
        for (int i = 0; i < 2; ++i) *(u32x4*)(TV + (ks_s0 + 32 * i) * V2_STRIDE + ks_ch * 16) = vreg[i];
#pragma unroll
        for (int c16 = 0; c16 < NVT; ++c16) *(u32x2*)(TC + (16 * c16 + l16) * T_STRIDE + (16 * w + 4 * g) * 2) = pack4(st[c16]);
        __syncthreads();
        bf16x8 qf[4];
#pragma unroll
        for (int ks = 0; ks < 4; ++ks) {
            if (BR == 0) qf[ks] = qn[ks];
            else qf[ks] = *(const bf16x8*)(T1 + tloc * T_STRIDE + (32 * ks + 8 * g) * 2);
        }
        bf16_t* op = Z + (size_t)(r0 + tloc) * ZLD + ocol + (VW / 2) * vh + 4 * g;
        u32x2 gwv[NOT];
#pragma unroll
        for (int vi = 0; vi < NOT; ++vi) gwv[vi] = *(const u32x2*)(op + 16 * vi);
        if (c < 31) MIX_LOAD_CHUNK(r0 + 64);
        f32x4 sacc[4];
#pragma unroll
        for (int si = 0; si < 4; ++si) { sacc[si] = (f32x4){0.f, 0.f, 0.f, 0.f};
#pragma unroll
            for (int ks = 0; ks < 4; ++ks) sacc[si] = mfma16(*(const bf16x8*)(T0 + (16 * si + l16) * T_STRIDE + (32 * ks + 8 * g) * 2), qf[ks], sacc[si]); }
        float den = 0.f;
        {
            const float Mtt = (BR == 0) ? Mt[tloc] : 0.f;
            f32x4 gS4[4];
#pragma unroll
            for (int si = 0; si < 4; ++si) gS4[si] = (BR == 0) ? *(const f32x4*)(gS + 16 * si + 4 * g) : (f32x4){0.f, 0.f, 0.f, 0.f};
#pragma unroll
            for (int si = 0; si < 4; ++si)
#pragma unroll
                for (int r = 0; r < 4; ++r) { const int s = 16 * si + 4 * g + r;
                    float wgt;
                    if (BR == 0) { const float e = __expf(fminf(gS4[si][r] - Mtt, 0.f)); wgt = (s <= tloc) ? e : 0.f; } else wgt = (s <= tloc) ? 1.f : 0.f;
                    sacc[si][r] *= wgt; den += sacc[si][r]; }
        }
        f32x4 oacc[NOT];
#pragma unroll
        for (int vi = 0; vi < NOT; ++vi) { oacc[vi] = (f32x4){0.f, 0.f, 0.f, 0.f};
#pragma unroll
            for (int ks = 0; ks < 4; ++ks) oacc[vi] = mfma16(*(const bf16x8*)(TC + ((VW / 2) * vh + 16 * vi + l16) * T_STRIDE + (32 * ks + 8 * g) * 2), qf[ks], oacc[vi]); }
        if (BR == 0) {
            den = xsum16_32(den);
            const float a_t = at[tloc];
            float nq = 0.f;
#pragma unroll
            for (int ks = 0; ks < 4; ++ks)
#pragma unroll
                for (int j = 0; j < 8; ++j) nq += nvec[32 * ks + 8 * g + j] * bf2f((bf16_t)qf[ks][j]);
            nq = xsum16_32(nq);
            den += a_t * nq;
#pragma unroll
            for (int vi = 0; vi < NOT; ++vi) oacc[vi] *= a_t;
        }
#pragma unroll
        for (int ks = 0; ks < 2; ++ks) {
            const bf16x8 pb = pack8(sacc[2 * ks], sacc[2 * ks + 1]);
#pragma unroll
            for (int vi = 0; vi < NOT; vi += 4) {
                const unsigned a0 = aTV + (32 * ks + 4 * g + q4) * V2_STRIDE + ((VW / 2) * vh + 16 * vi) * 2 + 8 * p4, a1 = a0 + 16 * V2_STRIDE;
                bf16x8 fa, fb, fc, fd; tr_frag4(a0, a1, a0 + 32, a1 + 32, a0 + 64, a1 + 64, a0 + 96, a1 + 96, fa, fb, fc, fd);
                oacc[vi] = mfma16(fa, pb, oacc[vi]); oacc[vi + 1] = mfma16(fb, pb, oacc[vi + 1]); oacc[vi + 2] = mfma16(fc, pb, oacc[vi + 2]); oacc[vi + 3] = mfma16(fd, pb, oacc[vi + 3]); }
        }
        if (BR == 0) { const float inv = 1.f / fmaxf(fabsf(den), emt[tloc]);
#pragma unroll
            for (int vi = 0; vi < NOT; ++vi) oacc[vi] *= inv; }
        float sq = 0.f;
#pragma unroll
        for (int vi = 0; vi < NOT; ++vi)
#pragma unroll
            for (int r = 0; r < 4; ++r) sq += oacc[vi][r] * oacc[vi][r];
        sq = xsum16_32(sq);
        if (g == 0) ssq[vh * 64 + tloc] = sq;
#pragma unroll
        for (int vi = 0; vi < NOT; ++vi) {
            const float gt[4] = {bflo(gwv[vi].x), bfhi(gwv[vi].x), bflo(gwv[vi].y), bfhi(gwv[vi].y)}; f32x4 o;
#pragma unroll
            for (int r = 0; r < 4; ++r) { const float sg = sigmoidf_(gt[r]); o[r] = oacc[vi][r] * gn[vi][r] * (BR == 0 ? sg : gt[r] * sg); }
            *(u32x2*)(op + 16 * vi) = pack4(o); }
        if (BR == 0) { const float aend = misc[1];
#pragma unroll
            for (int c16 = 0; c16 < NVT; ++c16) st[c16] *= aend; }
#pragma unroll
        for (int ks = 0; ks < 2; ++ks) {
            const unsigned ka0 = (BR == 0 ? aT1 : aT0) + (32 * ks + 8 * g + q4) * T_STRIDE + (16 * w) * 2 + 8 * p4;
            const bf16x8 kf = tr_frag(ka0, ka0 + 4 * T_STRIDE);
#pragma unroll
            for (int c16 = 0; c16 < NVT; c16 += 4) {
                const unsigned v0 = aTV + (32 * ks + 8 * g + q4) * V2_STRIDE + (16 * c16) * 2 + 8 * p4, v1 = v0 + 4 * V2_STRIDE;
                bf16x8 fa, fb, fc, fd; tr_frag4(v0, v1, v0 + 32, v1 + 32, v0 + 64, v1 + 64, v0 + 96, v1 + 96, fa, fb, fc, fd);
                st[c16] = mfma16(kf, fa, st[c16]); st[c16 + 1] = mfma16(kf, fb, st[c16 + 1]); st[c16 + 2] = mfma16(kf, fc, st[c16 + 2]); st[c16 + 3] = mfma16(kf, fd, st[c16 + 3]);
            }
        }
        if (BR == 1) {
            float eb[4];
#pragma unroll
            for (int r = 0; r < 4; ++r) eb[r] = __expf(bend[16 * w + 4 * g + r]);
#pragma unroll
            for (int c16 = 0; c16 < NVT; ++c16)
#pragma unroll
                for (int r = 0; r < 4; ++r) st[c16][r] *= eb[r];
        } else {
            const int d = tid & 127, seg = tid >> 7; float a2 = 0.f;
#pragma unroll
            for (int s = 0; s < 16; ++s) a2 += bf2f(*(const bf16_t*)(T1 + (seg * 16 + s) * T_STRIDE + d * 2));
            segtot[seg * 128 + d] = a2;
        }
        __syncthreads();
        if (BR == 0 && tid < 128) nvec[tid] = misc[1] * nvec[tid] + ((segtot[tid] + segtot[128 + tid]) + (segtot[256 + tid] + segtot[384 + tid]));
    }
#undef MIX_LOAD_CHUNK
    if (tid < 64) { float* sp_ = SSQ + ((size_t)(b * 2048 + 31 * 64 + tid) * 8 + BR * 4 + h) * 4 + vq * 2; sp_[0] = ssq[tid] + ssq[64 + tid]; sp_[1] = 0.f; }
    const int bh = b * 4 + h;
    if (BR == 0) {
        float* Co = p.out + O_CP + (size_t)bh * 32768;
#pragma unroll
        for (int c16 = 0; c16 < NVT; ++c16) __builtin_nontemporal_store(st[c16], (f32x4*)(Co + (size_t)(VW * vq + 16 * c16 + l16) * 128 + 16 * w + 4 * g));
        if (vq == 0) { if (tid < 128) p.out[O_NP + bh * 128 + tid] = nvec[tid];
            if (tid == 0) p.out[O_MPP + bh] = m0; }
    } else {
        float* So = p.out + O_SP + (size_t)bh * 32768;
#pragma unroll
        for (int c16 = 0; c16 < NVT; ++c16)
#pragma unroll
            for (int r = 0; r < 4; ++r) So[(size_t)(16 * w + 4 * g + r) * 256 + VW * vq + 16 * c16 + l16] = st[c16][r];
    }
    __syncthreads();
}

__device__ __forceinline__ void gla_prep(const Params& p, unsigned char* lds, int item) {
    const int tid = threadIdx.x, d = tid & 127, seg = tid >> 7;
    const int h = item & 3, c = (item >> 2) & 31, b = item >> 7;
    bf16_t* Z = (bf16_t*)(p.ws + WS_Z);
    const float* ZS = (const float*)(p.ws + WS_ZS);
    float* BEND = (float*)(p.ws + WS_BEND);
    float* gaL = (float*)lds; float* waL = gaL + 1024; float* segtot = waL + 2048;
    const int r0 = b * 2048 + c * 64, qcol = 3072 + h * 128, kcol = 3584 + h * 128;
    gaL[tid] = ZS[(size_t)(r0 + (tid >> 4)) * ZSLD + 8 + (tid & 15)]; gaL[tid + 512] = ZS[(size_t)(r0 + 32 + (tid >> 4)) * ZSLD + 8 + (tid & 15)];
#pragma unroll
    for (int j = 0; j < 4; ++j) { const int id = tid + 512 * j; waL[id] = p.in[16][(id >> 7) * 512 + h * 128 + (id & 127)]; }
    const float ba = p.in[17][h * 128 + d];
    __syncthreads();
    float wa[16];
#pragma unroll
    for (int j = 0; j < 16; ++j) wa[j] = waL[j * 128 + d];
    float la[16]; float run = 0.f;
#pragma unroll
    for (int i = 0; i < 16; ++i) { const int t = seg * 16 + i; float x = ba;
#pragma unroll
        for (int j = 0; j < 16; ++j) x += gaL[t * 16 + j] * wa[j];
        run += logsigf_(x) * 0.0625f; la[i] = run; }
    segtot[seg * 128 + d] = run;
    __syncthreads();
    float pre = 0.f, tot = 0.f;
#pragma unroll
    for (int s2 = 0; s2 < 4; ++s2) { const float v = segtot[s2 * 128 + d]; tot += v; if (s2 < seg) pre += v; }
    if (seg == 0) BEND[(size_t)(b * 32 + c) * 512 + h * 128 + d] = tot;
    bf16_t qv[16], kv[16];
#pragma unroll
    for (int i = 0; i < 16; ++i) { const int t = seg * 16 + i; qv[i] = Z[(size_t)(r0 + t) * ZLD + qcol + d]; kv[i] = Z[(size_t)(r0 + t) * ZLD + kcol + d]; }
#pragma unroll
    for (int i = 0; i < 16; ++i) { const int t = seg * 16 + i; const float bb = la[i] + pre;
        Z[(size_t)(r0 + t) * ZLD + qcol + d] = f2bf(bf2f(qv[i]) * __expf(bb)); Z[(size_t)(r0 + t) * ZLD + kcol + d] = f2bf(bf2f(kv[i]) * __expf(-bb)); }
    __syncthreads();
}

template <int BR>
__device__ __forceinline__ void mixer_sample(const Params& p, unsigned char* lds, int b, int h) {
    const int tid = threadIdx.x, w = tid >> 6, lane = tid & 63;
    bf16_t* Z = (bf16_t*)(p.ws + WS_Z);
    const float* ZS = (const float*)(p.ws + WS_ZS);
    const int qcol = (BR == 0 ? 0 : 3072) + h * 128, kcol = (BR == 0 ? 512 : 3584) + h * 128, vcol = (BR == 0 ? 1024 : 4096) + h * 256, ocol = (BR == 0 ? 2048 : 5120) + h * 256;
    float* sm = (float*)lds;
    float* qa = sm; float* ka = sm + 512; float* kd = sm + 1024; float* dec = sm + 1536; float* vv = sm + 1664; float* qk = sm + 2688; float* sc = sm + 2704;
    float* part = sm + 2752; float* red = sm + 4800;
    const int r0 = MP + 4 * b, bh = b * 4 + h;
    const float* gain = (BR == 0 ? p.in[18] : p.in[19]) + h * 256;
    float a_t[4] = {1.f, 1.f, 1.f, 1.f}, mt[4] = {0.f, 0.f, 0.f, 0.f}, aend = 1.f;
    {
        const int t = tid >> 7, d = tid & 127;
        const float qraw = bf2f(Z[(size_t)(r0 + t) * ZLD + qcol + d]), kraw = bf2f(Z[(size_t)(r0 + t) * ZLD + kcol + d]);
#pragma unroll
        for (int i = 0; i < 2; ++i) { const int id = tid + 512 * i; vv[id] = bf2f(Z[(size_t)(r0 + (id >> 8)) * ZLD + vcol + (id & 255)]); }
        if (BR == 0) {
            const float m0 = p.in[5][bh], bi = p.in[15][h], bfb = p.in[15][4 + h];
            float F = 0.f, cm = -3.0e38f, gg[4], Mv[4];
#pragma unroll
            for (int s = 0; s < 4; ++s) { const float ig = ZS[(size_t)(r0 + s) * ZSLD + h] + bi, lf = logsigf_(ZS[(size_t)(r0 + s) * ZSLD + 4 + h] + bfb);
                F += lf; gg[s] = ig - F; cm = fmaxf(cm, gg[s]); Mv[s] = fmaxf(m0, cm); a_t[s] = __expf(m0 - Mv[s]); mt[s] = F + Mv[s]; }
            aend = a_t[3];
            float wsel = 0.f;
#pragma unroll
            for (int s = 0; s < 4; ++s) { const float ws_ = __expf(gg[s] - Mv[3]); if (s == t) wsel = ws_; }
            qa[tid] = qraw; ka[tid] = kraw; kd[tid] = wsel * kraw;
            if (tid < 128) dec[tid] = aend;
            if (tid == 0) {
#pragma unroll
                for (int s = 0; s < 4; ++s) { sc[16 + s] = gg[s]; sc[20 + s] = Mv[s]; } }
        } else {
            float la[4];
#pragma unroll
            for (int s = 0; s < 4; ++s) { float x = p.in[17][h * 128 + d];
#pragma unroll
                for (int j = 0; j < 16; ++j) x += ZS[(size_t)(r0 + s) * ZSLD + 8 + j] * p.in[16][j * 512 + h * 128 + d];
                la[s] = logsigf_(x) * 0.0625f; }
            float bt = 0.f, bendv = 0.f;
#pragma unroll
            for (int s = 0; s < 4; ++s) { bendv += la[s]; if (s <= t) bt += la[s]; }
            qa[tid] = qraw * __expf(bt); ka[tid] = kraw * __expf(-bt); kd[tid] = kraw * __expf(bendv - bt);
            if (t == 0) dec[d] = __expf(bendv);
        }
    }
    __syncthreads();
    {
        const int pr = tid >> 5, l = tid & 31, t = pr >> 2, s = pr & 3;
        const f32x4 a = *(const f32x4*)(qa + t * 128 + l * 4), k4 = *(const f32x4*)(ka + s * 128 + l * 4);
        float v = a[0] * k4[0] + a[1] * k4[1] + a[2] * k4[2] + a[3] * k4[3];
#pragma unroll
        for (int o = 16; o > 0; o >>= 1) v += __shfl_xor(v, o);
        if (l == 0) { float wgt; if (BR == 0) wgt = (s <= t) ? __expf(sc[16 + s] - sc[20 + t]) : 0.f; else wgt = (s <= t) ? 1.f : 0.f; qk[pr] = v * wgt; }
        if (BR == 0 && tid < 128) {
            const int t2 = tid >> 5;
            const f32x4 n4 = *(const f32x4*)(p.in[4] + (size_t)bh * 128 + l * 4), q4v = *(const f32x4*)(qa + t2 * 128 + l * 4);
            float v2 = n4[0] * q4v[0] + n4[1] * q4v[1] + n4[2] * q4v[2] + n4[3] * q4v[3];
#pragma unroll
            for (int o = 16; o > 0; o >>= 1) v2 += __shfl_xor(v2, o);
            if (l == 0) sc[12 + t2] = v2;
        }
    }
    __syncthreads();
    float hv[4]; int vown; bool owner;
    if (BR == 0) {
        const int l32 = lane & 31, half = lane >> 5;
        const float* C0 = p.in[3] + (size_t)bh * 32768 + 4 * l32;
        float* C1 = p.out + O_CS + (size_t)bh * 32768 + 4 * l32;
        f32x4 qa4[4], kd4[4]; const f32x4 dec4 = *(const f32x4*)(dec + 4 * l32);
#pragma unroll
        for (int t = 0; t < 4; ++t) { qa4[t] = *(const f32x4*)(qa + t * 128 + 4 * l32); kd4[t] = *(const f32x4*)(kd + t * 128 + 4 * l32); }
#pragma unroll
        for (int ib = 0; ib < 16; ib += 8) {
            f32x4 cv[8];
#pragma unroll
            for (int e = 0; e < 8; ++e) cv[e] = __builtin_nontemporal_load((const f32x4*)(C0 + (size_t)(w * 32 + 2 * (ib + e) + half) * 128));
#pragma unroll
            for (int e = 0; e < 8; ++e) { const int v = w * 32 + 2 * (ib + e) + half; const f32x4 c = cv[e];
                float wv[4], pt[4];
#pragma unroll
                for (int s = 0; s < 4; ++s) wv[s] = vv[s * 256 + v];
                f32x4 o = dec4 * c;
#pragma unroll
                for (int s = 0; s < 4; ++s) o += kd4[s] * wv[s];
                __builtin_nontemporal_store(o, (f32x4*)(C1 + (size_t)v * 128));
#pragma unroll
                for (int t = 0; t < 4; ++t) { float x = c[0] * qa4[t][0] + c[1] * qa4[t][1] + c[2] * qa4[t][2] + c[3] * qa4[t][3];
#pragma unroll
                    for (int of = 16; of > 0; of >>= 1) x += __shfl_xor(x, of);
                    pt[t] = x; }
                if (l32 == 0) {
#pragma unroll
                    for (int t = 0; t < 4; ++t) part[t * 256 + v] = pt[t]; }
            }
        }
        if (tid < 128) { float acc = aend * p.in[4][(size_t)bh * 128 + tid];
#pragma unroll
            for (int s = 0; s < 4; ++s) acc += kd[s * 128 + tid];
            p.out[O_NS + (size_t)bh * 128 + tid] = acc; }
        if (tid == 0) p.out[O_MSS + bh] = mt[3];
        __syncthreads();
        vown = tid & 255; owner = (tid < 256);
        {
            float wv2[4];
#pragma unroll
            for (int s = 0; s < 4; ++s) wv2[s] = vv[s * 256 + vown];
#pragma unroll
            for (int t = 0; t < 4; ++t) { float num = a_t[t] * part[t * 256 + vown], den = a_t[t] * sc[12 + t];
#pragma unroll
                for (int s = 0; s < 4; ++s) { num += qk[t * 4 + s] * wv2[s]; den += qk[t * 4 + s]; }
                hv[t] = num / fmaxf(fabsf(den), __expf(-mt[t])); }
        }
    } else {
        const int v4 = lane * 4;
        const float* S0 = p.in[6] + ((size_t)bh * 128 + 16 * w) * 256 + v4;
        float* S1 = p.out + O_SS + ((size_t)bh * 128 + 16 * w) * 256 + v4;
        float* part8 = sm + 4864;
        f32x4 wv4[4], pt4[4];
#pragma unroll
        for (int s = 0; s < 4; ++s) { wv4[s] = *(const f32x4*)(vv + s * 256 + v4); pt4[s] = (f32x4){0.f, 0.f, 0.f, 0.f}; }
#pragma unroll
        for (int jb = 0; jb < 16; jb += 8) {
            f32x4 s0v[8];
#pragma unroll
            for (int e = 0; e < 8; ++e) s0v[e] = __builtin_nontemporal_load((const f32x4*)(S0 + (size_t)(jb + e) * 256));
#pragma unroll
            for (int e = 0; e < 8; ++e) { const int j = jb + e, d = 16 * w + j; const f32x4 s0 = s0v[e];
                f32x4 acc = s0 * dec[d];
#pragma unroll
                for (int t = 0; t < 4; ++t) pt4[t] += s0 * qa[t * 128 + d];
#pragma unroll
                for (int s2 = 0; s2 < 4; ++s2) acc += wv4[s2] * kd[s2 * 128 + d];
                __builtin_nontemporal_store(acc, (f32x4*)(S1 + (size_t)j * 256)); } }
#pragma unroll
        for (int t = 0; t < 4; ++t) *(f32x4*)(part8 + (w * 4 + t) * 256 + v4) = pt4[t];
        __syncthreads();
        vown = tid & 255; owner = (tid < 256);
#pragma unroll
        for (int t = 0; t < 4; ++t) { float num = 0.f;
#pragma unroll
            for (int w2 = 0; w2 < 8; ++w2) num += part8[(w2 * 4 + t) * 256 + vown];
#pragma unroll
            for (int s2 = 0; s2 < 4; ++s2) num += qk[t * 4 + s2] * vv[s2 * 256 + vown];
            hv[t] = num; }
    }
#pragma unroll
    for (int t = 0; t < 4; ++t) { float q2 = owner ? hv[t] * hv[t] : 0.f; q2 = wave_sum(q2); if (lane == 0) red[w * 4 + t] = q2; }
    __syncthreads();
    if (owner) {
#pragma unroll
        for (int t = 0; t < 4; ++t) { float tot = 0.f;
#pragma unroll
            for (int w2 = 0; w2 < 8; ++w2) tot += red[w2 * 4 + t];
            const float rs = rsqrtf(tot * (1.f / 256.f) + EPSV);
            bf16_t* op = Z + (size_t)(r0 + t) * ZLD + ocol + vown;
            const float gt = bf2f(*op), sg = sigmoidf_(gt);
            *op = f2bf(hv[t] * rs * gain[vown] * (BR == 0 ? sg : gt * sg)); }
    }
    __syncthreads();
}

__device__ __forceinline__ void attn_prompt(const Params& p, unsigned char* lds, int item) {
    const int tid = threadIdx.x, w = tid >> 6, lane = tid & 63, g = lane >> 4, l16 = lane & 15, q4 = l16 >> 2, p4 = lane & 3;
    const int qt = item & 15, h = (item >> 4) & 3, b = item >> 6;
    const bf16_t* KV = (const bf16_t*)(p.ws + WS_MEMKV) + (size_t)b * 256 * 2048 + h * 256;
    const bf16_t* Q = (const bf16_t*)(p.ws + WS_QBUF);
    bf16_t* O = (bf16_t*)(p.ws + WS_OBUF);
    const size_t rq = (size_t)b * 2048 + qt * 128 + 16 * w + l16;
    const unsigned aL = (unsigned)(size_t)lds;
#pragma unroll 4
    for (int i = 0; i < 16; ++i) { const int id = tid + 512 * i, key = id >> 5, ch = id & 31;
        *(u32x4*)(lds + key * V_STRIDE + ch * 16) = *(const u32x4*)(KV + (size_t)key * 2048 + ch * 8); }
    __syncthreads();
    f32x4 s[16];
#pragma unroll
    for (int ki = 0; ki < 16; ++ki) s[ki] = (f32x4){0.f, 0.f, 0.f, 0.f};
#pragma unroll
    for (int ks = 0; ks < 8; ++ks) { const bf16x8 qfk = *(const bf16x8*)(Q + rq * DM + h * 256 + 32 * ks + 8 * g);
#pragma unroll
        for (int ki = 0; ki < 16; ++ki) s[ki] = mfma16(*(const bf16x8*)(lds + (16 * ki + l16) * V_STRIDE + (32 * ks + 8 * g) * 2), qfk, s[ki]); }
    float mx = -3.0e38f;
#pragma unroll
    for (int ki = 0; ki < 16; ++ki)
#pragma unroll
        for (int r = 0; r < 4; ++r) mx = fmaxf(mx, s[ki][r]);
    mx = xmax16_32(mx);
    float sum = 0.f;
#pragma unroll
    for (int ki = 0; ki < 16; ++ki)
#pragma unroll
        for (int r = 0; r < 4; ++r) { const float e = __expf(s[ki][r] - mx); s[ki][r] = e; sum += e; }
    sum = xsum16_32(sum);
    bf16x8 pf[8];
#pragma unroll
    for (int ks = 0; ks < 8; ++ks) pf[ks] = pack8(s[2 * ks], s[2 * ks + 1]);
    __syncthreads();
#pragma unroll 4
    for (int i = 0; i < 16; ++i) { const int id = tid + 512 * i, key = id >> 5, ch = id & 31;
        *(u32x4*)(lds + key * V_STRIDE + ch * 16) = *(const u32x4*)(KV + (size_t)key * 2048 + 1024 + ch * 8); }
    __syncthreads();
    const float inv = 1.f / sum;
#pragma unroll
    for (int hh = 0; hh < 2; ++hh) {
        f32x4 o[8];
#pragma unroll
        for (int hi = 0; hi < 8; ++hi) o[hi] = (f32x4){0.f, 0.f, 0.f, 0.f};
#pragma unroll
        for (int ks = 0; ks < 8; ++ks) {
            unsigned aLk = aL + (32 * ks + 4 * g + q4) * V_STRIDE + 8 * p4 + hh * 256;
            asm volatile("" : "+v"(aLk));
#pragma unroll
            for (int hi = 0; hi < 8; hi += 4) {
                const unsigned a0 = aLk + (16 * hi) * 2, a1 = a0 + 16 * V_STRIDE;
                bf16x8 fa, fb, fc, fd; tr_frag4(a0, a1, a0 + 32, a1 + 32, a0 + 64, a1 + 64, a0 + 96, a1 + 96, fa, fb, fc, fd);
                o[hi] = mfma16(fa, pf[ks], o[hi]); o[hi + 1] = mfma16(fb, pf[ks], o[hi + 1]); o[hi + 2] = mfma16(fc, pf[ks], o[hi + 2]); o[hi + 3] = mfma16(fd, pf[ks], o[hi + 3]);
            }
        }
#pragma unroll
        for (int hi = 0; hi < 8; ++hi) *(u32x2*)(O + rq * DM + h * 256 + hh * 128 + 16 * hi + 4 * g) = pack4(o[hi] * inv);
    }
    __syncthreads();
}
__device__ __forceinline__ void attn_sample(const Params& p, unsigned char* lds, int item) {
    const int tid = threadIdx.x, w = tid >> 6, lane = tid & 63;
    const int h = item & 3, b = item >> 2;
    const float* Kc = p.in[7] + ((size_t)b * 1024 + h) * 256;
    const float* Vc = p.in[8] + ((size_t)b * 1024 + h) * 256;
    const bf16_t* Q = (const bf16_t*)(p.ws + WS_QBUF);
    bf16_t* O = (bf16_t*)(p.ws + WS_OBUF);
    float* sc = (float*)lds; float* po = sc + 1024;
    const size_t r0 = MP + 4 * b;
    f32x4 q[4];
#pragma unroll
    for (int t = 0; t < 4; ++t) { const u32x2 qw = *(const u32x2*)(Q + (r0 + t) * DM + h * 256 + lane * 4); q[t] = (f32x4){bflo(qw.x), bfhi(qw.x), bflo(qw.y), bfhi(qw.y)}; }
    {
        const bool b5 = (lane & 32) != 0, b4 = (lane & 16) != 0, b3 = (lane & 8) != 0, b2 = (lane & 4) != 0;
#pragma unroll 2
        for (int kg = 0; kg < 8; ++kg) { const int key0 = w * 32 + kg * 4;
            f32x4 kv[4];
#pragma unroll
            for (int k = 0; k < 4; ++k) kv[k] = __builtin_nontemporal_load((const f32x4*)(Kc + (size_t)(key0 + k) * 1024 + lane * 4));
            float v[16];
#pragma unroll
            for (int k = 0; k < 4; ++k)
#pragma unroll
                for (int t = 0; t < 4; ++t) v[k * 4 + t] = kv[k][0] * q[t][0] + kv[k][1] * q[t][1] + kv[k][2] * q[t][2] + kv[k][3] * q[t][3];
            float a8[8], a4[4], a2[2];
#pragma unroll
            for (int i = 0; i < 8; ++i) { const float keep = b5 ? v[i + 8] : v[i], send = b5 ? v[i] : v[i + 8]; a8[i] = keep + __shfl_xor(send, 32); }
#pragma unroll
            for (int i = 0; i < 4; ++i) { const float keep = b4 ? a8[i + 4] : a8[i], send = b4 ? a8[i] : a8[i + 4]; a4[i] = keep + __shfl_xor(send, 16); }
#pragma unroll
            for (int i = 0; i < 2; ++i) { const float keep = b3 ? a4[i + 2] : a4[i], send = b3 ? a4[i] : a4[i + 2]; a2[i] = keep + __shfl_xor(send, 8); }
            float d = (b2 ? a2[1] : a2[0]) + __shfl_xor(b2 ? a2[0] : a2[1], 4);
            d += __shfl_xor(d, 2); d += __shfl_xor(d, 1);
            if ((lane & 3) == 0) { const int j = (lane >> 2) & 15; sc[(j & 3) * 256 + key0 + (j >> 2)] = d; }
        }
    }
    __syncthreads();
    if (w < 4) { float v[4], mx = -3.0e38f;
#pragma unroll
        for (int i = 0; i < 4; ++i) { v[i] = sc[w * 256 + lane + 64 * i]; mx = fmaxf(mx, v[i]); }
        mx = wave_max(mx); float sum = 0.f;
#pragma unroll
        for (int i = 0; i < 4; ++i) { v[i] = __expf(v[i] - mx); sum += v[i]; }
        sum = wave_sum(sum); const float inv = 1.f / sum;
#pragma unroll
        for (int i = 0; i < 4; ++i) sc[w * 256 + lane + 64 * i] = v[i] * inv; }
    __syncthreads();
    {
        const int hd4 = lane * 4; float* po8 = sc + 1024;
        f32x4 acc4[4];
#pragma unroll
        for (int t = 0; t < 4; ++t) acc4[t] = (f32x4){0.f, 0.f, 0.f, 0.f};
#pragma unroll 8
        for (int kk = 0; kk < 32; ++kk) { const int key = w * 32 + kk; const f32x4 v4 = __builtin_nontemporal_load((const f32x4*)(Vc + (size_t)key * 1024 + hd4));
#pragma unroll
            for (int t = 0; t < 4; ++t) acc4[t] += v4 * sc[t * 256 + key]; }
#pragma unroll
        for (int t = 0; t < 4; ++t) *(f32x4*)(po8 + (w * 4 + t) * 256 + hd4) = acc4[t];
        __syncthreads();
        if (tid < 256) {
#pragma unroll
            for (int t = 0; t < 4; ++t) { float o = 0.f;
#pragma unroll
                for (int w2 = 0; w2 < 8; ++w2) o += po8[(w2 * 4 + t) * 256 + tid];
                O[(r0 + t) * DM + h * 256 + tid] = f2bf(o); } }
    }
    __syncthreads();
}

#ifndef ONLY_PH
#define ONLY_PH -1
#endif
#ifndef MIXEN
#define MIXEN 15
#endif
#ifndef PH_MASK
#define PH_MASK 0xffff
#endif
#define PH_ENABLED(x) ((ONLY_PH < 0 || ONLY_PH == (x)) && ((PH_MASK >> (x)) & 1) && ((KMASK >> (x)) & 1))
__device__ __forceinline__ void grid_barrier(unsigned char* wsb, unsigned char* lds) {
    XcdBarrier b; b.bar = (unsigned*)(wsb + WS_BAR); b.x = xb_xcc_id(); b.st = (volatile LAS unsigned*)(lds + LDS_BYTES - 16);
    xcd_barrier(b);
}
template <int KMASK> __global__ void __launch_bounds__(512, 2) fwd_kernel(Params p) {
    extern __shared__ __attribute__((aligned(16))) unsigned char lds[];
    cg::grid_group grid = cg::this_grid();
    volatile LAS unsigned* xb_st = (volatile LAS unsigned*)(lds + LDS_BYTES - 16);
    if (threadIdx.x == 0) { xb_st[0] = 0u; xb_st[1] = 0u; }
    __syncthreads();
    (void)xcd_barrier_post((unsigned*)(p.ws + WS_BAR), xb_st);
#ifndef DUP_MASK
#define DUP_MASK 0
#endif
#define PH_BEGIN(k) if (PH_ENABLED(k) && p.ph_lo <= (k) && (k) < p.ph_hi) for (int rep_ = 0; rep_ < (((DUP_MASK >> (k)) & 1) ? 2 : 1); ++rep_) { if ((k) > p.ph_lo || rep_) { if (p.ph_hi > 1000) grid.sync(); else grid_barrier(p.ws, lds); } \
        unsigned char* ws; float* outp; { unsigned long long w_ = (unsigned long long)p.ws, o_ = (unsigned long long)p.out; \
        unsigned a0_ = __builtin_amdgcn_readfirstlane((unsigned)w_), a1_ = __builtin_amdgcn_readfirstlane((unsigned)(w_ >> 32)), a2_ = __builtin_amdgcn_readfirstlane((unsigned)o_), a3_ = __builtin_amdgcn_readfirstlane((unsigned)(o_ >> 32)); \
        asm volatile("" : "+s"(a0_), "+s"(a1_), "+s"(a2_), "+s"(a3_)); ws = (unsigned char*)(((unsigned long long)a1_ << 32) | a0_); outp = (float*)(((unsigned long long)a3_ << 32) | a2_); } \
        bf16_t* ABUF = (bf16_t*)(ws + WS_ABUF); bf16_t* Z = (bf16_t*)(ws + WS_Z); float* XRES = (float*)(ws + WS_XRES); float* SS = (float*)(ws + WS_SS); float* TMP = outp + O_YP; \
        (void)ABUF; (void)Z; (void)XRES; (void)SS; (void)TMP;
#define PH_END }
    PH_BEGIN(0) prep_phase(p, lds); PH_END
    PH_BEGIN(1)
        EpiGateUp e1; e1.H = Z; e1.ss = nullptr;
        run_gemm(lds, ABUF, DM, (const bf16_t*)(ws + WS_WGU1), MT, 5632, 1024, e1, 0);
        EpiMemKV e2; e2.ok = outp + O_MKP; e2.ov = outp + O_MVP; e2.kv = (bf16_t*)(ws + WS_MEMKV);
        run_gemm(lds, (const bf16_t*)(ws + WS_MEMA), DM, (const bf16_t*)(ws + WS_WKV), 2048, 2048, 1024, e2, 64);
    PH_END
    PH_BEGIN(2) EpiResid e; e.res0 = p.in[0]; e.res1 = p.in[1]; e.xout = XRES; e.aout = ABUF; e.gain = p.in[13]; e.ss = SS; e.scale = 0.5f;
        run_gemm(lds, Z, DFF, (const bf16_t*)(ws + WS_WD1), MP, 1024, DFF, e, 0); small_gemm(lds, Z, DFF, (const bf16_t*)(ws + WS_WD1), 1024, DFF, e); PH_END
    PH_BEGIN(3) EpiZ e; e.Z = Z; e.ZS = (float*)(ws + WS_ZS); e.ss = SS;
        run_gemm(lds, ABUF, DM, (const bf16_t*)(ws + WS_WIN), MT, 8448, 1024, e, 0); PH_END
    PH_BEGIN(4)
        for (int it = blockIdx.x; it < 1024; it += gridDim.x) gla_prep(p, lds, it);
    PH_END
    PH_BEGIN(5)
        const int bx = (int)blockIdx.x, G = (int)gridDim.x;
        const int NCH = (G >= 256) ? 128 : 0;
        if (bx < NCH || NCH == 0) {
            for (int it0 = bx; it0 < 128; it0 += (NCH ? NCH : G)) { const int it = NCH ? ((((it0 & 7) * 8 + (it0 >> 4)) << 1) | ((it0 >> 3) & 1)) : it0;
                if (it < 64) { if (MIXEN & 1) mixer_prompt<0>(p, lds, it >> 3, (it >> 1) & 3, it & 1); } }
            for (int it0 = bx; it0 < 128; it0 += (NCH ? NCH : G)) { const int it = NCH ? ((((it0 & 7) * 8 + (it0 >> 4)) << 1) | ((it0 >> 3) & 1)) : it0;
                if (it >= 64) { if (MIXEN & 2) mixer_prompt<1>(p, lds, (it - 64) >> 3, (it >> 1) & 3, it & 1); } }
        }
        if (bx >= NCH) {
            for (int it = bx - NCH; it < 512; it += G - NCH) { if (MIXEN & 4) mixer_sample<0>(p, lds, it >> 2, it & 3); }
            for (int it = bx - NCH; it < 512; it += G - NCH) { if (MIXEN & 8) mixer_sample<1>(p, lds, it >> 2, it & 3); }
            prep_transposes(p, lds, PREP_LATE_MASK, bx - NCH, G - NCH);
        }
    PH_END
    PH_BEGIN(6)
        const float* SSQ = (const float*)(ws + WS_SSQ);
        const int lane = threadIdx.x & 63, gw = blockIdx.x * 8 + (threadIdx.x >> 6), nw = gridDim.x * 8;
        for (int i0 = gw; i0 < MP * 8; i0 += 4 * nw) {
            f32x4 sp[4]; u32x2 wv[4];
#pragma unroll
            for (int e = 0; e < 4; ++e) { const int i = i0 + e * nw; if (i < MP * 8) { sp[e] = *(const f32x4*)(SSQ + (size_t)i * 4);
                    wv[e] = *(const u32x2*)(Z + (size_t)(i >> 3) * ZLD + (((i & 7) >> 2) ? 5120 : 2048) + (i & 3) * 256 + lane * 4); } }
#pragma unroll
            for (int e = 0; e < 4; ++e) { const int i = i0 + e * nw; if (i < MP * 8) {
                    const float rs = rsqrtf(((sp[e][0] + sp[e][1]) + (sp[e][2] + sp[e][3])) * (1.f / 256.f) + EPSV);
                    f32x4 o = {bflo(wv[e].x) * rs, bfhi(wv[e].x) * rs, bflo(wv[e].y) * rs, bfhi(wv[e].y) * rs};
                    *(u32x2*)(Z + (size_t)(i >> 3) * ZLD + (((i & 7) >> 2) ? 5120 : 2048) + (i & 3) * 256 + lane * 4) = pack4(o); } }
        }
    PH_END
    PH_BEGIN(7) EpiMerge<0> e; e.gate = Z + 6144; e.T = TMP; e.Y = nullptr;
        run_gemm(lds, Z + 2048, ZLD, (const bf16_t*)(ws + WS_WBRM), MP, 1024, 1024, e, 0); small_gemm(lds, Z + 2048, ZLD, (const bf16_t*)(ws + WS_WBRM), 1024, 1024, e); PH_END
    PH_BEGIN(8) EpiMerge<1> e; e.gate = Z + 7168; e.T = TMP; e.Y = ABUF;
        run_gemm(lds, Z + 5120, ZLD, (const bf16_t*)(ws + WS_WBRG), MP, 1024, 1024, e, 0); small_gemm(lds, Z + 5120, ZLD, (const bf16_t*)(ws + WS_WBRG), 1024, 1024, e); PH_END
    PH_BEGIN(9) EpiResid e; e.res0 = XRES; e.res1 = XRES + (size_t)MP * DM; e.xout = XRES; e.aout = (bf16_t*)(ws + WS_ABUF2); e.gain = p.in[23]; e.ss = SS + (size_t)MT * 16; e.scale = 1.f;
        run_gemm(lds, ABUF, DM, (const bf16_t*)(ws + WS_WOUT), MP, 1024, 1024, e, 0); small_gemm(lds, ABUF, DM, (const bf16_t*)(ws + WS_WOUT), 1024, 1024, e); PH_END
    PH_BEGIN(10) EpiQ e; e.Q = (bf16_t*)(ws + WS_QBUF); e.ss = SS + (size_t)MT * 16;
        run_gemm(lds, (const bf16_t*)(ws + WS_ABUF2), DM, (const bf16_t*)(ws + WS_WQ), MP, 1024, 1024, e, 0); small_gemm(lds, (const bf16_t*)(ws + WS_ABUF2), DM, (const bf16_t*)(ws + WS_WQ), 1024, 1024, e); PH_END
    PH_BEGIN(11)
#pragma unroll 1
        for (int pass = 0; pass < 2; ++pass) {
            if (((blockIdx.x & 1) != 0) == (pass == 0)) { for (int it = blockIdx.x; it < 512; it += gridDim.x) attn_sample(p, lds, it); }
            else { for (int it = blockIdx.x; it < 512; it += gridDim.x) attn_prompt(p, lds, it); }
        }
    PH_END
    PH_BEGIN(12) EpiResid e; e.res0 = XRES; e.res1 = XRES + (size_t)MP * DM; e.xout = XRES; e.aout = ABUF; e.gain = p.in[29]; e.ss = SS + (size_t)MT * 32; e.scale = 1.f;
        run_gemm(lds, (const bf16_t*)(ws + WS_OBUF), DM, (const bf16_t*)(ws + WS_WO), MP, 1024, 1024, e, 0); small_gemm(lds, (const bf16_t*)(ws + WS_OBUF), DM, (const bf16_t*)(ws + WS_WO), 1024, 1024, e); PH_END
    PH_BEGIN(13) EpiGateUp e; e.H = Z; e.ss = SS + (size_t)MT * 32;
        run_gemm(lds, ABUF, DM, (const bf16_t*)(ws + WS_WGU2), MT, 5632, 1024, e, 0); PH_END
    PH_BEGIN(14) EpiResid e; e.res0 = XRES; e.res1 = XRES + (size_t)MP * DM; e.xout = TMP; e.aout = nullptr; e.gain = nullptr; e.ss = SS + (size_t)MT * 48; e.scale = 0.5f;
        run_gemm(lds, Z, DFF, (const bf16_t*)(ws + WS_WD2), MP, 1024, DFF, e, 0); small_gemm(lds, Z, DFF, (const bf16_t*)(ws + WS_WD2), 1024, DFF, e); PH_END
    PH_BEGIN(15)
        const int lane = threadIdx.x & 63, gw = blockIdx.x * 8 + (threadIdx.x >> 6), nw = gridDim.x * 8;
        for (int r = gw; r < MT; r += nw) { const float rs = rs_row(SS + (size_t)MT * 48, r); float* y = TMP + (size_t)r * DM;
#pragma unroll
            for (int i = 0; i < 4; ++i) { f32x4 v = *(const f32x4*)(y + i * 256 + lane * 4); const f32x4 gg = *(const f32x4*)(p.in[33] + i * 256 + lane * 4);
                __builtin_nontemporal_store(v * rs * gg, (f32x4*)(y + i * 256 + lane * 4)); } }
    PH_END
}

template <int KMASK> static bool setup_kernel() {
    if (hipFuncSetAttribute((const void*)fwd_kernel<KMASK>, hipFuncAttributeMaxDynamicSharedMemorySize, LDS_BYTES) != hipSuccess) { fprintf(stderr, "kernel_launch: hipFuncSetAttribute failed\n"); return false; }
    int per_cu = 0;
    if (hipOccupancyMaxActiveBlocksPerMultiprocessor(&per_cu, (const void*)fwd_kernel<KMASK>, NTHREADS, LDS_BYTES) != hipSuccess || per_cu < 1) fprintf(stderr, "kernel_launch: occupancy query says %d\n", per_cu);
    (void)hipGetLastError();
    return true;
}
template <int KMASK> static void launch_range(Params p, int lo, int hi, int grid, hipStream_t stream) {
    p.ph_lo = lo; p.ph_hi = hi;
    if (hipMemsetAsync((char*)p.ws + WS_BAR, 0, XCD_BAR_WORDS * 4, stream) != hipSuccess) { fprintf(stderr, "kernel_launch: memset of the barrier words failed\n"); return; }
    void* args[] = {&p};
    hipError_t e = hipLaunchCooperativeKernel((const void*)fwd_kernel<KMASK>, dim3(grid), dim3(NTHREADS), args, LDS_BYTES, stream);
    if (e != hipSuccess) fprintf(stderr, "kernel_launch: cooperative launch [%d,%d) failed: %s (grid %d)\n", lo, hi, hipGetErrorString(e), grid);
}
#ifndef N_LAUNCH
#define N_LAUNCH 1
#endif
extern "C" void kernel_launch(void* const* d_in, const int* in_sizes, int n_in, void* d_out, int out_size, void* d_ws, size_t ws_size, hipStream_t stream) {
    static int grid = 0;
    if (grid == 0) {
        if (n_in != 34 || (size_t)out_size != O_END || ws_size < WS_END) { fprintf(stderr, "kernel_launch: unexpected sizes n_in %d out %d ws %zu (need %zu)\n", n_in, out_size, ws_size, (size_t)WS_END); grid = -1; return; }
        int dev = 0, cus = 0;
        (void)hipGetDevice(&dev); (void)hipDeviceGetAttribute(&cus, hipDeviceAttributeMultiprocessorCount, dev);
        bool ok = true;
#if N_LAUNCH == 1
        ok = setup_kernel<0xffff>();
#else
        ok = setup_kernel<0x3fef>() && setup_kernel<0x0010>();
#endif
        if (!ok) { grid = -1; return; }
        grid = cus;
        if (grid < 64) { fprintf(stderr, "kernel_launch: needs >= 64 CUs\n"); grid = -1; return; }
    }
    if (grid < 0) return;
    Params p{};
    for (int i = 0; i < 34; ++i) p.in[i] = (const float*)d_in[i];
    p.out = (float*)d_out; p.ws = (unsigned char*)d_ws;
#if N_LAUNCH == 1
#ifndef PROBE_K
#define PROBE_K -1
#endif
#ifndef PROBE_BACK
#define PROBE_BACK 0
#endif
    if (PROBE_K >= 0) { launch_range<0xffff>(p, 0, PROBE_K + 1, grid, stream); launch_range<0xffff>(p, PROBE_K - PROBE_BACK, 16, grid, stream); }
    else launch_range<0xffff>(p, 0, 16, grid, stream);
#else
#ifndef DBG_HI
#define DBG_HI 14
#endif
    launch_range<0x3fef>(p, 0, DBG_HI < 4 ? DBG_HI : 4, grid, stream);
    if (DBG_HI > 4) launch_range<0x0010>(p, 4, 5, grid, stream);
    if (DBG_HI > 5) launch_range<0x3fef>(p, 5, DBG_HI, grid, stream);
#endif
}
```

```cpp
#include <hip/hip_runtime.h>
#include <hip/hip_cooperative_groups.h>
#include <cstdio>
namespace cg = cooperative_groups;
namespace pg8 {
#define PG8_LAS __attribute__((address_space(3)))
typedef unsigned short bf16_t;
typedef short bf16x8 __attribute__((ext_vector_type(8)));
typedef float f32x4 __attribute__((ext_vector_type(4)));
typedef unsigned u32x4 __attribute__((ext_vector_type(4)));
constexpr int BM = 256, BK = 64, HALF = 128, HTB = HALF * BK * 2  , STAGE_BYTES = 8 * HTB, NXCD = 8, WGM = 8;

__host__ __device__ __forceinline__ int lds_byte(int r, int c) { const int st = (r >> 4) * 2 + (c >> 5), rr = r & 15, cc = c & 31, ob = rr * 64 + cc * 2; return st * 1024 + (ob ^ (((ob >> 9) & 1) << 5)); }
__host__ __device__ __forceinline__ void stage_rc(int b, int& R, int& C) { const int st = b / 1024, sb = b % 1024, swz = sb ^ (((sb >> 9) & 1) << 5); R = (st >> 1) * 16 + swz / 64; C = (st & 1) * 32 + (swz % 64) / 2; }
__host__ __device__ __forceinline__ int perm32(int rho) { const int n = rho >> 4, i = rho & 15; return 8 * (i >> 2) + 4 * n + (i & 3); }

struct Unit { int pm, pn; };
struct Gemm { const bf16_t* A; const bf16_t* Bt; int M, N, K, lda, ldb; };
struct StaticOrder {
    int nM, nN, nwg, G, c;
    __host__ __device__ void init(int M, int N, int G_, int c_) { nM = M / BM; nN = N / BM; nwg = nM * nN; G = G_; c = c_; }
    __host__ __device__ bool next(int i, Unit& u) const {
        const long L = (long)i * G + c; if (L >= nwg) return false;
        int wgid = (int)L; { const int q = nwg / NXCD, r = nwg % NXCD, xcd = wgid % NXCD, off = wgid / NXCD; wgid = (xcd < r ? xcd * (q + 1) : r * (q + 1) + (xcd - r) * q) + off; }
        const int nig = WGM * nN, gid = wgid / nig, fm = gid * WGM, gsz = (nM - fm) < WGM ? (nM - fm) : WGM;
        u.pm = fm + ((wgid % nig) % gsz); u.pn = (wgid % nig) / gsz; return true;
    }
    __device__ __forceinline__ void a_ready(const Unit&) const {}
    __device__ __forceinline__ void done(const Unit&) const {}
};
__device__ __forceinline__ unsigned cvt_pk_bf16(float lo, float hi) { unsigned r; asm volatile("v_cvt_pk_bf16_f32 %0, %1, %2" : "=v"(r) : "v"(lo), "v"(hi)); return r; }
template <class Epi, class Sched>
__device__ __forceinline__ void gemm_phase(PG8_LAS unsigned char* lds, const Gemm g, const Sched& S, const Epi& E) {
    const int tid = threadIdx.x, wid = __builtin_amdgcn_readfirstlane(tid >> 6), lane = tid & 63, wr = wid >> 2, wc = wid & 3, fr = lane & 15, fq = lane >> 4;
    const int K = g.K, nt = K / BK;
    unsigned voffA[2], voffB[2];
#pragma unroll
    for (int i = 0; i < 2; ++i) { int R, C; stage_rc(tid * 16 + i * 8192, R, C); const int Rb = Epi::PERM ? ((R & ~31) + perm32(R & 31)) : R;
        voffA[i] = (unsigned)(R * g.lda + C) * 2u; voffB[i] = (unsigned)(Rb * g.ldb + C) * 2u; }
    const size_t kstep = (size_t)(BK * 2);
    const size_t hstepA = (size_t)HALF * g.lda * 2, hstepB = (size_t)HALF * g.ldb * 2;
    const size_t tstepA = 2 * hstepA, tstepB = 2 * hstepB;
    const unsigned ldsw = (unsigned)wid * 1024u;
    const int aoff = lds_byte(wr * 64 + fr, fq * 8), boff = lds_byte(wc * 32 + fr, fq * 8);
#define PG8_SA(b, h) (((b) * 2 + (h)) * HTB)
#define PG8_SB(b, h) ((4 + (b) * 2 + (h)) * HTB)
#define PG8_STAGE(bufoff, gbase, voff) do { _Pragma("unroll") for (int _i = 0; _i < 2; ++_i) \
        __builtin_amdgcn_global_load_lds((const unsigned*)((const char*)(gbase) + (voff)[_i]), (PG8_LAS unsigned*)(lds + (bufoff) + ldsw + _i * 8192), 16, 0, 0); } while (0)
#define PG8_LDA(dst, b, h) do { _Pragma("unroll") for (int m = 0; m < 4; ++m) _Pragma("unroll") for (int k = 0; k < 2; ++k) dst[m][k] = *(const PG8_LAS bf16x8*)(lds + PG8_SA(b, h) + aoff + m * 2048 + k * 1024); } while (0)
#define PG8_LDB(dst, b, h) do { _Pragma("unroll") for (int n = 0; n < 2; ++n) _Pragma("unroll") for (int k = 0; k < 2; ++k) dst[n][k] = *(const PG8_LAS bf16x8*)(lds + PG8_SB(b, h) + boff + n * 2048 + k * 1024); } while (0)
#define PG8_MMA(ai, bj, At, Bt) do { __builtin_amdgcn_s_setprio(1); _Pragma("unroll") for (int m = 0; m < 4; ++m) _Pragma("unroll") for (int n = 0; n < 2; ++n) _Pragma("unroll") for (int k = 0; k < 2; ++k) \
        acc[ai][bj][m][n] = __builtin_amdgcn_mfma_f32_16x16x32_bf16(Bt[n][k], At[m][k], acc[ai][bj][m][n], 0, 0, 0); __builtin_amdgcn_s_setprio(0); } while (0)
#define PG8_WAIT_V(n) asm volatile("s_waitcnt vmcnt(" #n ")" ::: "memory")
#define PG8_WAIT_L(n) asm volatile("s_waitcnt lgkmcnt(" #n ")" ::: "memory")
#define PG8_BAR __builtin_amdgcn_s_barrier()
#define PG8_SCHED __builtin_amdgcn_sched_barrier(0)
    Unit cur, nxt; int ui = 0;
    if (!S.next(0, cur)) return;
    f32x4 acc[2][2][4][2];
#pragma unroll
    for (int a = 0; a < 2; ++a)
#pragma unroll
        for (int b = 0; b < 2; ++b)
#pragma unroll
            for (int m = 0; m < 4; ++m)
#pragma unroll
                for (int n = 0; n < 2; ++n) acc[a][b][m][n] = (f32x4){0.f, 0.f, 0.f, 0.f};
    bf16x8 At[4][2], B0[2][2], B1[2][2];
    const char* cA = (const char*)g.A + (size_t)cur.pm * tstepA; const char* cB = (const char*)g.Bt + (size_t)cur.pn * tstepB;
    S.a_ready(cur);
    PG8_STAGE(PG8_SB(0, 0), cB, voffB); PG8_STAGE(PG8_SA(0, 0), cA, voffA); PG8_STAGE(PG8_SB(0, 1), cB + hstepB, voffB); PG8_STAGE(PG8_SA(0, 1), cA + hstepA, voffA);
    if (wr == 1) PG8_BAR;
    PG8_WAIT_V(4); PG8_BAR;
    PG8_STAGE(PG8_SB(1, 0), cB + kstep, voffB); PG8_STAGE(PG8_SA(1, 0), cA + kstep, voffA); PG8_STAGE(PG8_SB(1, 1), cB + hstepB + kstep, voffB);
    PG8_WAIT_V(6); PG8_BAR;
    for (;;) {
        const bool has_next = S.next(ui + 1, nxt);
        const char* nA = has_next ? (const char*)g.A + (size_t)nxt.pm * tstepA : cA; const char* nB = has_next ? (const char*)g.Bt + (size_t)nxt.pn * tstepB : cB;
        for (int t = 0; t < nt; t += 2) {
            const bool last = (t == nt - 2);
            const char* a1 = cA + (size_t)(t + 1) * kstep;
            const char* a2 = last ? nA : cA + (size_t)(t + 2) * kstep; const char* b2 = last ? nB : cB + (size_t)(t + 2) * kstep;
            const char* a3 = a2 + kstep; const char* b3 = b2 + kstep;
            if (last && has_next) S.a_ready(nxt);
            PG8_LDB(B0, 0, 0); PG8_SCHED; PG8_LDA(At, 0, 0); PG8_STAGE(PG8_SA(1, 1), a1 + hstepA, voffA);
            PG8_WAIT_L(8); PG8_BAR; PG8_WAIT_L(0); PG8_MMA(0, 0, At, B0); PG8_BAR; PG8_SCHED;
            PG8_LDB(B1, 0, 1); PG8_STAGE(PG8_SB(0, 0), b2, voffB);
            PG8_BAR; PG8_WAIT_L(0); PG8_MMA(0, 1, At, B1); PG8_BAR;
            PG8_LDA(At, 0, 1); PG8_STAGE(PG8_SA(0, 0), a2, voffA);
            PG8_BAR; PG8_WAIT_L(0); PG8_MMA(1, 0, At, B0); PG8_BAR; PG8_SCHED;
            PG8_STAGE(PG8_SB(0, 1), b2 + hstepB, voffB);
            PG8_WAIT_V(6); PG8_BAR; PG8_MMA(1, 1, At, B1); PG8_BAR;
            PG8_LDB(B0, 1, 0); PG8_SCHED; PG8_LDA(At, 1, 0); PG8_STAGE(PG8_SA(0, 1), a2 + hstepA, voffA);
            PG8_WAIT_L(8); PG8_BAR; PG8_WAIT_L(0); PG8_MMA(0, 0, At, B0); PG8_BAR; PG8_SCHED;
            PG8_LDB(B1, 1, 1); PG8_STAGE(PG8_SB(1, 0), b3, voffB);
            PG8_BAR; PG8_WAIT_L(0); PG8_MMA(0, 1, At, B1); PG8_BAR;
            PG8_LDA(At, 1, 1); PG8_STAGE(PG8_SA(1, 0), a3, voffA);
            PG8_BAR; PG8_WAIT_L(0); PG8_MMA(1, 0, At, B0); PG8_BAR; PG8_SCHED;
            PG8_STAGE(PG8_SB(1, 1), b3 + hstepB, voffB);
            PG8_WAIT_V(6); PG8_BAR; PG8_MMA(1, 1, At, B1); PG8_BAR;
        }
        if constexpr (!Epi::AFTER_DRAIN) { E(acc, cur, wr, wc, fr, fq); S.done(cur); }
        if (!has_next) break;
#pragma unroll
        for (int a = 0; a < 2; ++a)
#pragma unroll
            for (int b = 0; b < 2; ++b)
#pragma unroll
                for (int m = 0; m < 4; ++m)
#pragma unroll
                    for (int n = 0; n < 2; ++n) acc[a][b][m][n] = (f32x4){0.f, 0.f, 0.f, 0.f};
        cur = nxt; cA = nA; cB = nB; ++ui;
    }
    PG8_WAIT_V(0);
    if (wr == 0) PG8_BAR;
    PG8_BAR;
    if constexpr (Epi::AFTER_DRAIN) { E.fused(acc, cur, wr, wc, fr, fq, lds, wid, lane); S.done(cur); }
#undef PG8_SA
#undef PG8_SB
#undef PG8_STAGE
#undef PG8_LDA
#undef PG8_LDB
#undef PG8_MMA
#undef PG8_WAIT_V
#undef PG8_WAIT_L
#undef PG8_BAR
#undef PG8_SCHED
}
}
using pg8::bf16_t; using pg8::bf16x8; using pg8::f32x4; using pg8::u32x4;
typedef short s16x4 __attribute__((ext_vector_type(4)));
typedef unsigned u32x2 __attribute__((ext_vector_type(2)));
#define LAS __attribute__((address_space(3)))

constexpr int MP = 16384, MS = 512, MT = MP + MS, DM = 1024, DFF = 2816, ZLD = 8192, ZSLD = 32;
constexpr int NTHREADS = 512;
constexpr float EPSV = 1e-6f;
constexpr size_t SZ_WGU = 5632ull * 1024 * 2, SZ_WD = 1024ull * 2816 * 2, SZ_WIN = 8448ull * 1024 * 2, SZ_W1K = 1024ull * 1024 * 2;
constexpr size_t WS_WGU1 = 0;
constexpr size_t WS_WD1 = WS_WGU1 + SZ_WGU;
constexpr size_t WS_WIN = WS_WD1 + SZ_WD;
constexpr size_t WS_WBRM = WS_WIN + SZ_WIN;
constexpr size_t WS_WBRG = WS_WBRM + SZ_W1K;
constexpr size_t WS_WOUT = WS_WBRG + SZ_W1K;
constexpr size_t WS_WQ = WS_WOUT + SZ_W1K;
constexpr size_t WS_WO = WS_WQ + SZ_W1K;
constexpr size_t WS_WKV = WS_WO + SZ_W1K;
constexpr size_t WS_WGU2 = WS_WKV + 2 * SZ_W1K;
constexpr size_t WS_WD2 = WS_WGU2 + SZ_WGU;
constexpr size_t WS_ABUF = WS_WD2 + SZ_WD;
constexpr size_t WS_MEMA = WS_ABUF + (size_t)MT * DM * 2;
constexpr size_t WS_MEMKV = WS_MEMA + 2048ull * 1024 * 2;
constexpr size_t WS_XRES = WS_MEMKV + 2048ull * 2048 * 2;
constexpr size_t WS_ZS = WS_XRES + (size_t)MT * DM * 4;
constexpr size_t WS_SS = WS_ZS + (size_t)MT * ZSLD * 4;
constexpr size_t WS_SSQ = WS_SS + 4ull * MT * 16 * 4;
constexpr size_t WS_BEND = WS_SSQ + (size_t)MP * 32 * 4;
constexpr size_t WS_Z = WS_BEND + 1024ull * 128 * 4;
constexpr size_t WS_ABUF2 = WS_Z + (64ull << 20);
constexpr size_t WS_QBUF = WS_Z + (128ull << 20);
constexpr size_t WS_OBUF = WS_Z + (192ull << 20);
constexpr size_t WS_BAR = WS_Z + (size_t)MT * ZLD * 2;
constexpr size_t WS_END = WS_BAR + 16384;
constexpr size_t O_YP = 0, O_YS = 16777216, O_CP = 17301504, O_NP = 18350080, O_MPP = 18354176, O_SP = 18354208, O_MKP = 19402784, O_MVP = 21499936,
                 O_CS = 23597088, O_NS = 40374304, O_MSS = 40439840, O_SS = 40440352, O_END = 57217568;
constexpr int LDS_BYTES = 156 * 1024;

struct Params { const float* in[34]; float* out; unsigned char* ws; int ph_lo, ph_hi; };

typedef float f32x2_t __attribute__((ext_vector_type(2)));
typedef __bf16 bf16x2_t __attribute__((ext_vector_type(2)));
__device__ __forceinline__ unsigned cvt_pk(float lo, float hi) { f32x2_t v = {lo, hi}; bf16x2_t b = __builtin_convertvector(v, bf16x2_t); return __builtin_bit_cast(unsigned, b); }
__device__ __forceinline__ bf16_t f2bf(float x) { return (bf16_t)(cvt_pk(x, 0.f) & 0xffffu); }
__device__ __forceinline__ float bf2f(bf16_t x) { return __uint_as_float(((unsigned)x) << 16); }
__device__ __forceinline__ float bflo(unsigned w) { return __uint_as_float(w << 16); }
__device__ __forceinline__ float bfhi(unsigned w) { return __uint_as_float(w & 0xffff0000u); }
__device__ __forceinline__ float sigmoidf_(float x) { return __builtin_amdgcn_rcpf(1.f + __expf(-x)); }
__device__ __forceinline__ float logsigf_(float x) { return fminf(x, 0.f) - __logf(1.f + __expf(-fabsf(x))); }
__device__ __forceinline__ float rs_of(float ss) { return rsqrtf(ss * (1.f / 1024.f) + EPSV); }
__device__ __forceinline__ float rs_row(const float* ssp, int row) {
    const f32x4* q = (const f32x4*)(ssp + (size_t)row * 16); const f32x4 a = q[0], b = q[1], c = q[2], d = q[3];
    const f32x4 s = (a + b) + (c + d); return rs_of((s[0] + s[1]) + (s[2] + s[3])); }
__device__ __forceinline__ f32x4 mfma16(bf16x8 a, bf16x8 b, f32x4 c) { return __builtin_amdgcn_mfma_f32_16x16x32_bf16(a, b, c, 0, 0, 0); }
__device__ __forceinline__ bf16x8 pack8(f32x4 a, f32x4 b) {
    u32x4 w; w.x = cvt_pk(a[0], a[1]); w.y = cvt_pk(a[2], a[3]); w.z = cvt_pk(b[0], b[1]); w.w = cvt_pk(b[2], b[3]);
    return __builtin_bit_cast(bf16x8, w);
}
__device__ __forceinline__ u32x2 pack4(f32x4 a) { u32x2 w; w.x = cvt_pk(a[0], a[1]); w.y = cvt_pk(a[2], a[3]); return w; }
__device__ __forceinline__ bf16x8 tr_frag(unsigned a0, unsigned a1) {
    s16x4 r0, r1;
    asm volatile("ds_read_b64_tr_b16 %0, %2\n\tds_read_b64_tr_b16 %1, %3\n\ts_waitcnt lgkmcnt(0)" : "=&v"(r0), "=&v"(r1) : "v"(a0), "v"(a1) : "memory");
    return __builtin_shufflevector(r0, r1, 0, 1, 2, 3, 4, 5, 6, 7);
}
__device__ __forceinline__ void tr_frag2(unsigned a0, unsigned a1, unsigned b0, unsigned b1, bf16x8& fa, bf16x8& fb) {
    s16x4 r0, r1, r2, r3;
    asm volatile("ds_read_b64_tr_b16 %0, %4\n\tds_read_b64_tr_b16 %1, %5\n\tds_read_b64_tr_b16 %2, %6\n\tds_read_b64_tr_b16 %3, %7\n\ts_waitcnt lgkmcnt(0)"
                 : "=&v"(r0), "=&v"(r1), "=&v"(r2), "=&v"(r3) : "v"(a0), "v"(a1), "v"(b0), "v"(b1) : "memory");
    fa = __builtin_shufflevector(r0, r1, 0, 1, 2, 3, 4, 5, 6, 7); fb = __builtin_shufflevector(r2, r3, 0, 1, 2, 3, 4, 5, 6, 7);
}
__device__ __forceinline__ void tr_frag4(unsigned a0, unsigned a1, unsigned b0, unsigned b1, unsigned c0, unsigned c1, unsigned d0, unsigned d1, bf16x8& fa, bf16x8& fb, bf16x8& fc, bf16x8& fd) {
    s16x4 r0, r1, r2, r3, r4, r5, r6, r7;
    asm volatile("ds_read_b64_tr_b16 %0, %8\n\tds_read_b64_tr_b16 %1, %9\n\tds_read_b64_tr_b16 %2, %10\n\tds_read_b64_tr_b16 %3, %11\n\t"
                 "ds_read_b64_tr_b16 %4, %12\n\tds_read_b64_tr_b16 %5, %13\n\tds_read_b64_tr_b16 %6, %14\n\tds_read_b64_tr_b16 %7, %15\n\ts_waitcnt lgkmcnt(0)"
                 : "=&v"(r0), "=&v"(r1), "=&v"(r2), "=&v"(r3), "=&v"(r4), "=&v"(r5), "=&v"(r6), "=&v"(r7)
                 : "v"(a0), "v"(a1), "v"(b0), "v"(b1), "v"(c0), "v"(c1), "v"(d0), "v"(d1) : "memory");
    fa = __builtin_shufflevector(r0, r1, 0, 1, 2, 3, 4, 5, 6, 7); fb = __builtin_shufflevector(r2, r3, 0, 1, 2, 3, 4, 5, 6, 7);
    fc = __builtin_shufflevector(r4, r5, 0, 1, 2, 3, 4, 5, 6, 7); fd = __builtin_shufflevector(r6, r7, 0, 1, 2, 3, 4, 5, 6, 7);
}
__device__ __forceinline__ float xsum16_32(float v) { v += __shfl_xor(v, 16); v += __shfl_xor(v, 32); return v; }
__device__ __forceinline__ float xmax16_32(float v) { v = fmaxf(v, __shfl_xor(v, 16)); v = fmaxf(v, __shfl_xor(v, 32)); return v; }
__device__ __forceinline__ float wave_sum(float v) { for (int o = 32; o > 0; o >>= 1) v += __shfl_xor(v, o); return v; }
__device__ __forceinline__ float wave_max(float v) { for (int o = 32; o > 0; o >>= 1) v = fmaxf(v, __shfl_xor(v, o)); return v; }

#define XB_TMO      128
#define XB_XCNT(j)  (256  + 64 * (j))
#define XB_XSUB(j)  (1280 + 64 * (j))
#define XB_XGEN(j)  (2304 + 64 * (j))
#define XB_TOP      3328
#define XB_TOPGEN   3392
#define XCD_BAR_WORDS 3456
#define XB_SPIN_CAP (1u << 18)

__device__ __forceinline__ unsigned xb_ld(unsigned* p)              { return __hip_atomic_load(p, __ATOMIC_RELAXED, __HIP_MEMORY_SCOPE_AGENT); }
__device__ __forceinline__ unsigned xb_add(unsigned* p, unsigned v) { return __hip_atomic_fetch_add(p, v, __ATOMIC_RELAXED, __HIP_MEMORY_SCOPE_AGENT); }
__device__ __forceinline__ unsigned xb_xcc_id() { return (unsigned)__builtin_amdgcn_s_getreg((3 << 11) | 20) & 0xFu; }
#define XB_SPIN(cond, bar) do { unsigned _sp = 0; while (cond) { __builtin_amdgcn_s_sleep(1); \
    if ((++_sp & 255u) == 0u) { if (xb_ld(&(bar)[XB_TMO])) break; if (_sp > XB_SPIN_CAP) { atomicAdd(&(bar)[XB_TMO], 1u); break; } } } } while (0)

struct XcdBarrier {
    unsigned* bar; unsigned x;
    volatile LAS unsigned* st;
};

__device__ __forceinline__ XcdBarrier xcd_barrier_post(unsigned* bar, volatile LAS unsigned* st) {
    XcdBarrier b; b.bar = bar; b.x = xb_xcc_id(); b.st = st;
    if (threadIdx.x == 0) (void)xb_add(&bar[XB_XCNT(b.x)], 1u);
    return b;
}
__device__ __forceinline__ void xcd_barrier_complete(unsigned* bar, unsigned x, unsigned& nloc, unsigned& nx) {
    const unsigned G = gridDim.x * gridDim.y * gridDim.z;
    unsigned sum, cnt, mine, sp = 0u;
    for (;;) {
        sum = 0u; cnt = 0u; mine = 0u;
#pragma unroll
        for (unsigned j = 0; j < 16; ++j) { const unsigned c = xb_ld(&bar[XB_XCNT(j)]); sum += c; cnt += (c > 0u) ? 1u : 0u; mine = (j == x) ? c : mine; }
        if (sum == G) break;
        __builtin_amdgcn_s_sleep(1);
        if ((++sp & 255u) == 0u) { if (xb_ld(&bar[XB_TMO])) break; if (sp > XB_SPIN_CAP) { atomicAdd(&bar[XB_TMO], 1u); break; } }
    }
    nloc = mine > 0u ? mine : 1u; nx = cnt > 0u ? cnt : 1u;
}

__device__ __forceinline__ void xcd_barrier(const XcdBarrier& b) {
    asm volatile("s_waitcnt vmcnt(0)" ::: "memory");
    __syncthreads();
    if (threadIdx.x == 0) {
        unsigned* bar = b.bar;
        __builtin_amdgcn_s_waitcnt(0);
        unsigned nloc = b.st[0], nx = b.st[1];
        if (nloc == 0u) { xcd_barrier_complete(bar, b.x, nloc, nx); b.st[0] = nloc; b.st[1] = nx; }
        const unsigned old = xb_add(&bar[XB_XSUB(b.x)], 1u);
        const unsigned gen = old / nloc;
        if (old + 1u == (gen + 1u) * nloc) {
            __builtin_amdgcn_fence(__ATOMIC_RELEASE, "agent");
            asm volatile("s_waitcnt vmcnt(0)" ::: "memory");
            const unsigned og = xb_add(&bar[XB_TOP], 1u);
            const unsigned tg = og / nx;
            if (og + 1u == (tg + 1u) * nx) xb_add(&bar[XB_TOPGEN], 1u);
            else XB_SPIN(xb_ld(&bar[XB_TOPGEN]) == tg, bar);
            __builtin_amdgcn_fence(__ATOMIC_ACQUIRE, "agent");
            xb_add(&bar[XB_XGEN(b.x)], 1u);
            asm volatile("s_waitcnt vmcnt(0)" ::: "memory");
        } else {
            XB_SPIN(xb_ld(&bar[XB_XGEN(b.x)]) == gen, bar);
            __builtin_amdgcn_fence(__ATOMIC_ACQUIRE, "agent");
            asm volatile("s_waitcnt vmcnt(0)" ::: "memory");
        }
    }
    __syncthreads();
}


constexpr int PREP_EARLY_MASK = 0x060f, PREP_LATE_MASK = 0x39f0;
__device__ __forceinline__ int win_src_col(int r) {
    if (r < 3072) return r; if (r < 6144) return r + 8; if (r < 8192) return r + 24;
    if (r < 8200) return 3072 + (r - 8192); if (r < 8216) return 6152 + (r - 8200); return -1;
}
__device__ __forceinline__ void prep_transposes(const Params& p, unsigned char* lds, int dmask, int vb, int nvb) {
    float* tile = (float*)lds;
    const int tid = threadIdx.x;
    unsigned char* ws = p.ws;
    for (int d = 0; d < 14; ++d) {
        if (!((dmask >> d) & 1)) continue;
        const float* src; bf16_t* dst; int K, ldsrc, ntn, mode = 0, rowoff = 0; float scale = 1.f;
        switch (d) {
            case 0: src = p.in[10]; dst = (bf16_t*)(ws + WS_WGU1); K = 1024; ldsrc = 2816; ntn = 44; mode = 2; rowoff = 0; break;
            case 1: src = p.in[11]; dst = (bf16_t*)(ws + WS_WGU1); K = 1024; ldsrc = 2816; ntn = 44; mode = 2; rowoff = 128; break;
            case 2: src = p.in[12]; dst = (bf16_t*)(ws + WS_WD1); K = 2816; ldsrc = 1024; ntn = 16; break;
            case 3: src = p.in[14]; dst = (bf16_t*)(ws + WS_WIN); K = 1024; ldsrc = 8216; ntn = 132; mode = 1; break;
            case 4: src = p.in[20]; dst = (bf16_t*)(ws + WS_WBRM); K = 1024; ldsrc = 1024; ntn = 16; break;
            case 5: src = p.in[21]; dst = (bf16_t*)(ws + WS_WBRG); K = 1024; ldsrc = 1024; ntn = 16; break;
            case 6: src = p.in[22]; dst = (bf16_t*)(ws + WS_WOUT); K = 1024; ldsrc = 1024; ntn = 16; break;
            case 7: src = p.in[25]; dst = (bf16_t*)(ws + WS_WQ); K = 1024; ldsrc = 1024; ntn = 16; scale = 0.0625f; break;
            case 8: src = p.in[28]; dst = (bf16_t*)(ws + WS_WO); K = 1024; ldsrc = 1024; ntn = 16; break;
            case 9: src = p.in[26]; dst = (bf16_t*)(ws + WS_WKV); K = 1024; ldsrc = 1024; ntn = 16; break;
            case 10: src = p.in[27]; dst = (bf16_t*)(ws + WS_WKV); K = 1024; ldsrc = 1024; ntn = 16; rowoff = 1024; break;
            case 11: src = p.in[30]; dst = (bf16_t*)(ws + WS_WGU2); K = 1024; ldsrc = 2816; ntn = 44; mode = 2; rowoff = 0; break;
            case 12: src = p.in[31]; dst = (bf16_t*)(ws + WS_WGU2); K = 1024; ldsrc = 2816; ntn = 44; mode = 2; rowoff = 128; break;
            default: src = p.in[32]; dst = (bf16_t*)(ws + WS_WD2); K = 2816; ldsrc = 1024; ntn = 16; break;
        }
        const int nkt = K / 64, ntiles = nkt * ntn;
        for (int t = vb; t < ntiles; t += nvb) {
            const int kt = t % nkt, nt = t / nkt, k0 = kt * 64;
            {
                const int j = tid & 63;
                int srccol; float sc = scale;
                if (mode == 1) { srccol = win_src_col(nt * 64 + j); if ((srccol >= 512 && srccol < 1024) || (srccol >= 3080 && srccol < 3592)) sc = 0.08838834764831845f; }
                else srccol = nt * 64 + j;
#pragma unroll
                for (int ps = 0; ps < 8; ++ps) { const int i = (tid >> 6) + 8 * ps;
                    float v = 0.f; if (srccol >= 0) v = __builtin_nontemporal_load(src + (size_t)(k0 + i) * ldsrc + srccol) * sc;
                    tile[i * 65 + j] = v; }
            }
            __syncthreads();
            {
                const int j = tid >> 3, kc = tid & 7;
                int dstrow;
                if (mode == 1) dstrow = nt * 64 + j;
                else { const int sc_ = nt * 64 + j; dstrow = (mode == 2) ? ((sc_ >> 7) * 256 + (sc_ & 127) + rowoff) : (sc_ + rowoff); }
                float v[8];
#pragma unroll
                for (int e = 0; e < 8; ++e) v[e] = tile[(kc * 8 + e) * 65 + j];
                u32x4 w; w.x = cvt_pk(v[0], v[1]); w.y = cvt_pk(v[2], v[3]); w.z = cvt_pk(v[4], v[5]); w.w = cvt_pk(v[6], v[7]);
                *(u32x4*)(dst + (size_t)dstrow * K + k0 + kc * 8) = w;
            }
            __syncthreads();
        }
    }
}
__device__ __forceinline__ void prep_phase(const Params& p, unsigned char* lds) {
    const int tid = threadIdx.x;
    unsigned char* ws = p.ws;
    prep_transposes(p, lds, PREP_EARLY_MASK, (int)blockIdx.x, (int)gridDim.x);
    const int lane = tid & 63, gw = blockIdx.x * 8 + (tid >> 6), nw = gridDim.x * 8;
    for (int r = gw; r < MT + 2048; r += nw) {
        const float* x; const float* g; bf16_t* o;
        if (r < MP) { x = p.in[0] + (size_t)r * DM; g = p.in[9]; o = (bf16_t*)(ws + WS_ABUF) + (size_t)r * DM; }
        else if (r < MT) { x = p.in[1] + (size_t)(r - MP) * DM; g = p.in[9]; o = (bf16_t*)(ws + WS_ABUF) + (size_t)r * DM; }
        else { x = p.in[2] + (size_t)(r - MT) * DM; g = p.in[24]; o = (bf16_t*)(ws + WS_MEMA) + (size_t)(r - MT) * DM; }
        f32x4 v[4]; float ss = 0.f;
#pragma unroll
        for (int i = 0; i < 4; ++i) { v[i] = *(const f32x4*)(x + i * 256 + lane * 4); ss += v[i][0] * v[i][0] + v[i][1] * v[i][1] + v[i][2] * v[i][2] + v[i][3] * v[i][3]; }
        ss = wave_sum(ss); const float rs = rs_of(ss);
#pragma unroll
        for (int i = 0; i < 4; ++i) { const f32x4 gg = *(const f32x4*)(g + i * 256 + lane * 4);
            u32x2 w; w.x = cvt_pk(v[i][0] * rs * gg[0], v[i][1] * rs * gg[1]); w.y = cvt_pk(v[i][2] * rs * gg[2], v[i][3] * rs * gg[3]);
            *(u32x2*)(o + i * 256 + lane * 4) = w; }
    }
}

#define EPI_ROW(ai, m) (u.pm * 256 + (ai) * 128 + wr * 64 + (m) * 16 + fr)
#define EPI_COL(bj) (u.pn * 256 + (bj) * 128 + wc * 32 + fq * 8)
struct EpiGateUp {
    static constexpr bool PERM = true, AFTER_DRAIN = false;
    bf16_t* H; const float* ss;
    __device__ __forceinline__ void operator()(const f32x4 (&acc)[2][2][4][2], const pg8::Unit& u, int wr, int wc, int fr, int fq) const {
        float rsv[2][4];
#pragma unroll
        for (int ai = 0; ai < 2; ++ai)
#pragma unroll
            for (int m = 0; m < 4; ++m) rsv[ai][m] = ss ? rs_row(ss, EPI_ROW(ai, m)) : 1.f;
#pragma unroll
        for (int ai = 0; ai < 2; ++ai)
#pragma unroll
            for (int m = 0; m < 4; ++m) { const int row = EPI_ROW(ai, m); const float rs = rsv[ai][m];
                f32x4 hv[2];
#pragma unroll
                for (int n = 0; n < 2; ++n)
#pragma unroll
                    for (int j = 0; j < 4; ++j) { const float gt = acc[ai][0][m][n][j] * rs, up = acc[ai][1][m][n][j] * rs; hv[n][j] = gt * sigmoidf_(gt) * up; }
                *(u32x4*)(H + (size_t)row * DFF + u.pn * 128 + wc * 32 + fq * 8) = __builtin_bit_cast(u32x4, pack8(hv[0], hv[1])); }
    }
};
struct EpiMemKV {
    static constexpr bool PERM = true, AFTER_DRAIN = false;
    float* ok; float* ov; bf16_t* kv;
    __device__ __forceinline__ void operator()(const f32x4 (&acc)[2][2][4][2], const pg8::Unit& u, int wr, int wc, int fr, int fq) const {
#pragma unroll
        for (int ai = 0; ai < 2; ++ai)
#pragma unroll
            for (int m = 0; m < 4; ++m) { const int row = EPI_ROW(ai, m);
#pragma unroll
                for (int bj = 0; bj < 2; ++bj) { const int col = EPI_COL(bj);
                    float* o = (col < 1024) ? (ok + (size_t)row * 1024 + col) : (ov + (size_t)row * 1024 + (col - 1024));
                    __builtin_nontemporal_store(acc[ai][bj][m][0], (f32x4*)o); __builtin_nontemporal_store(acc[ai][bj][m][1], (f32x4*)(o + 4));
                    *(u32x4*)(kv + (size_t)row * 2048 + col) = __builtin_bit_cast(u32x4, pack8(acc[ai][bj][m][0], acc[ai][bj][m][1])); } }
    }
};
struct EpiResid {
    static constexpr bool PERM = true, AFTER_DRAIN = false;
    const float* res0; const float* res1; float* xout; bf16_t* aout; const float* gain; float* ss; float scale;
    __device__ __forceinline__ void operator()(const f32x4 (&acc)[2][2][4][2], const pg8::Unit& u, int wr, int wc, int fr, int fq) const {
        f32x4 gv[2][2];
        if (aout) {
#pragma unroll
            for (int bj = 0; bj < 2; ++bj) { gv[bj][0] = *(const f32x4*)(gain + EPI_COL(bj)); gv[bj][1] = *(const f32x4*)(gain + EPI_COL(bj) + 4); } }
#pragma unroll
        for (int ai = 0; ai < 2; ++ai) {
            f32x4 rv[4][2][2];
#pragma unroll
            for (int m = 0; m < 4; ++m) { const int row = EPI_ROW(ai, m);
                const float* rp = (row < MP) ? (res0 + (size_t)row * DM) : (res1 + (size_t)(row - MP) * DM);
#pragma unroll
                for (int bj = 0; bj < 2; ++bj) { rv[m][bj][0] = *(const f32x4*)(rp + EPI_COL(bj)); rv[m][bj][1] = *(const f32x4*)(rp + EPI_COL(bj) + 4); } }
#pragma unroll
            for (int m = 0; m < 4; ++m) { const int row = EPI_ROW(ai, m);
                float sq = 0.f;
#pragma unroll
                for (int bj = 0; bj < 2; ++bj) { const int col = EPI_COL(bj);
                    const f32x4 x0 = rv[m][bj][0] + acc[ai][bj][m][0] * scale, x1 = rv[m][bj][1] + acc[ai][bj][m][1] * scale;
                    *(f32x4*)(xout + (size_t)row * DM + col) = x0; *(f32x4*)(xout + (size_t)row * DM + col + 4) = x1;
#pragma unroll
                    for (int j = 0; j < 4; ++j) sq += x0[j] * x0[j] + x1[j] * x1[j];
                    if (aout) *(u32x4*)(aout + (size_t)row * DM + col) = __builtin_bit_cast(u32x4, pack8(x0 * gv[bj][0], x1 * gv[bj][1])); }
                sq = xsum16_32(sq);
                if (fq == 0) ss[(size_t)row * 16 + u.pn * 4 + wc] = sq; }
        }
    }
    __device__ __forceinline__ void small(f32x4 acc, int row, int col, int tc, int rt, int ct, int l16, int g, unsigned char* lds) const {
        const f32x4 x = *(const f32x4*)(res1 + (size_t)(row - MP) * DM + col) + acc * scale;
        *(f32x4*)(xout + (size_t)row * DM + col) = x;
        if (aout) { const f32x4 gv4 = *(const f32x4*)(gain + col); *(u32x2*)(aout + (size_t)row * DM + col) = pack4(x * gv4); }
        float sq = x[0] * x[0] + x[1] * x[1] + x[2] * x[2] + x[3] * x[3];
        sq = xsum16_32(sq);
        float* red = (float*)lds;
        if (g == 0) red[(rt * 4 + ct) * 16 + l16] = sq;
        __syncthreads();
        if (ct == 0 && g == 0) ss[(size_t)row * 16 + tc] = (red[(rt * 4) * 16 + l16] + red[(rt * 4 + 1) * 16 + l16]) + (red[(rt * 4 + 2) * 16 + l16] + red[(rt * 4 + 3) * 16 + l16]);
        __syncthreads();
    }
};
struct EpiZ {
    static constexpr bool PERM = true, AFTER_DRAIN = false;
    bf16_t* Z; float* ZS; const float* ss;
    __device__ __forceinline__ void operator()(const f32x4 (&acc)[2][2][4][2], const pg8::Unit& u, int wr, int wc, int fr, int fq) const {
#pragma unroll
        for (int ai = 0; ai < 2; ++ai) {
            float rsv[4];
#pragma unroll
            for (int m = 0; m < 4; ++m) rsv[m] = rs_row(ss, EPI_ROW(ai, m));
#pragma unroll
            for (int m = 0; m < 4; ++m) { const int row = EPI_ROW(ai, m); const float rs = rsv[m];
                if (u.pn < 32) {
#pragma unroll
                    for (int bj = 0; bj < 2; ++bj)
                        *(u32x4*)(Z + (size_t)row * ZLD + EPI_COL(bj)) = __builtin_bit_cast(u32x4, pack8(acc[ai][bj][m][0] * rs, acc[ai][bj][m][1] * rs));
                } else if (wc == 0) {
                    *(f32x4*)(ZS + (size_t)row * ZSLD + fq * 8) = acc[ai][0][m][0] * rs; *(f32x4*)(ZS + (size_t)row * ZSLD + fq * 8 + 4) = acc[ai][0][m][1] * rs;
                } } }
    }
};
template <int MODE> struct EpiMerge {
    static constexpr bool PERM = true, AFTER_DRAIN = false;
    const bf16_t* gate; float* T; bf16_t* Y;
    __device__ __forceinline__ void operator()(const f32x4 (&acc)[2][2][4][2], const pg8::Unit& u, int wr, int wc, int fr, int fq) const {
#pragma unroll
        for (int ai = 0; ai < 2; ++ai)
#pragma unroll
            for (int mh = 0; mh < 2; ++mh) {
                u32x4 gw[2][2]; u32x4 tvb[2][2]; bf16_t* Tb = (bf16_t*)T;
#pragma unroll
                for (int mm = 0; mm < 2; ++mm) { const int row = EPI_ROW(ai, mh * 2 + mm);
#pragma unroll
                    for (int bj = 0; bj < 2; ++bj) { gw[mm][bj] = *(const u32x4*)(gate + (size_t)row * ZLD + EPI_COL(bj));
                        if (MODE == 1) tvb[mm][bj] = *(const u32x4*)(Tb + (size_t)row * DM + EPI_COL(bj)); } }
#pragma unroll
                for (int mm = 0; mm < 2; ++mm) { const int m = mh * 2 + mm, row = EPI_ROW(ai, m);
#pragma unroll
                    for (int bj = 0; bj < 2; ++bj) { const int col = EPI_COL(bj); const u32x4 g4 = gw[mm][bj];
                        f32x4 s0, s1;
                        s0[0] = sigmoidf_(bflo(g4.x)); s0[1] = sigmoidf_(bfhi(g4.x)); s0[2] = sigmoidf_(bflo(g4.y)); s0[3] = sigmoidf_(bfhi(g4.y));
                        s1[0] = sigmoidf_(bflo(g4.z)); s1[1] = sigmoidf_(bfhi(g4.z)); s1[2] = sigmoidf_(bflo(g4.w)); s1[3] = sigmoidf_(bfhi(g4.w));
                        f32x4 v0 = acc[ai][bj][m][0] * s0, v1 = acc[ai][bj][m][1] * s1;
                        if (MODE == 0) *(u32x4*)(Tb + (size_t)row * DM + col) = __builtin_bit_cast(u32x4, pack8(v0, v1));
                        else { const u32x4 t4 = tvb[mm][bj];
                            v0 += (f32x4){bflo(t4.x), bfhi(t4.x), bflo(t4.y), bfhi(t4.y)}; v1 += (f32x4){bflo(t4.z), bfhi(t4.z), bflo(t4.w), bfhi(t4.w)};
                            *(u32x4*)(Y + (size_t)row * DM + col) = __builtin_bit_cast(u32x4, pack8(v0, v1)); } } }
            }
    }
    __device__ __forceinline__ void small(f32x4 acc, int row, int col, int tc, int rt, int ct, int l16, int g, unsigned char* lds) const {
        bf16_t* Tb = (bf16_t*)T;
        const u32x2 g2 = *(const u32x2*)(gate + (size_t)row * ZLD + col);
        f32x4 v = acc * (f32x4){sigmoidf_(bflo(g2.x)), sigmoidf_(bfhi(g2.x)), sigmoidf_(bflo(g2.y)), sigmoidf_(bfhi(g2.y))};
        if (MODE == 0) *(u32x2*)(Tb + (size_t)row * DM + col) = pack4(v);
        else { const u32x2 t2 = *(const u32x2*)(Tb + (size_t)row * DM + col);
            v += (f32x4){bflo(t2.x), bfhi(t2.x), bflo(t2.y), bfhi(t2.y)};
            *(u32x2*)(Y + (size_t)row * DM + col) = pack4(v); }
    }
};
struct EpiQ {
    static constexpr bool PERM = true, AFTER_DRAIN = false;
    bf16_t* Q; const float* ss;
    __device__ __forceinline__ void operator()(const f32x4 (&acc)[2][2][4][2], const pg8::Unit& u, int wr, int wc, int fr, int fq) const {
#pragma unroll
        for (int ai = 0; ai < 2; ++ai) {
            float rsv[4];
#pragma unroll
            for (int m = 0; m < 4; ++m) rsv[m] = rs_row(ss, EPI_ROW(ai, m));
#pragma unroll
            for (int m = 0; m < 4; ++m) { const int row = EPI_ROW(ai, m); const float rs = rsv[m];
#pragma unroll
                for (int bj = 0; bj < 2; ++bj)
                    *(u32x4*)(Q + (size_t)row * DM + EPI_COL(bj)) = __builtin_bit_cast(u32x4, pack8(acc[ai][bj][m][0] * rs, acc[ai][bj][m][1] * rs)); } }
    }
    __device__ __forceinline__ void small(f32x4 acc, int row, int col, int tc, int rt, int ct, int l16, int g, unsigned char* lds) const {
        *(u32x2*)(Q + (size_t)row * DM + col) = pack4(acc * rs_row(ss, row));
    }
};
template <class Epi>
__device__ __forceinline__ void small_gemm(unsigned char* lds, const bf16_t* A, int lda, const bf16_t* Bt, int N, int K, const Epi& E) {
    const int tid = threadIdx.x, w = tid >> 6, lane = tid & 63, g = lane >> 4, l16 = lane & 15;
    const int rt = w >> 2, ct = w & 3, nct = N / 64, ntiles = 16 * nct;
    for (int t = blockIdx.x; t < ntiles; t += gridDim.x) {
        const int tr = t / nct, tc = t - tr * nct;
        const int row = MP + tr * 32 + rt * 16 + l16, colb = tc * 64 + ct * 16;
        const bf16_t* ap = A + (size_t)row * lda + 8 * g;
        const bf16_t* bp = Bt + (size_t)(colb + l16) * K + 8 * g;
        f32x4 acc0 = (f32x4){0.f, 0.f, 0.f, 0.f}, acc1 = acc0;
#pragma unroll 4
        for (int k = 0; k < K; k += 64) {
            acc0 = mfma16(*(const bf16x8*)(bp + k), *(const bf16x8*)(ap + k), acc0);
            acc1 = mfma16(*(const bf16x8*)(bp + k + 32), *(const bf16x8*)(ap + k + 32), acc1);
        }
        E.small(acc0 + acc1, row, colb + 4 * g, tc, rt, ct, l16, g, lds);
    }
}
template <class Epi>
__device__ __forceinline__ void run_gemm(unsigned char* lds, const bf16_t* A, int lda, const bf16_t* Bt, int M, int N, int K, const Epi& E, int rot) {
    pg8::Gemm g; g.A = A; g.Bt = Bt; g.M = M; g.N = N; g.K = K; g.lda = lda; g.ldb = K;
    pg8::StaticOrder S; S.init(M, N, (int)gridDim.x, (int)((blockIdx.x + rot) % gridDim.x));
    pg8::gemm_phase<Epi, pg8::StaticOrder>((PG8_LAS unsigned char*)lds, g, S, E);
    __syncthreads();
}
constexpr int T_STRIDE = 272, V_STRIDE = 528;
constexpr int VQN = 2, VW = 256 / VQN, NVT = VW / 16, NOT = NVT / 2, V2_STRIDE = VW * 2 + 16;
constexpr int M_T0 = 0, M_T1 = 17408, M_TV = 34816, M_TC = M_TV + 64 * V2_STRIDE, M_SM = M_TC + VW * T_STRIDE;
template <int BR>
__device__ __forceinline__ void mixer_prompt(const Params& p, unsigned char* lds, int b, int h, int vq) {
    const int tid = threadIdx.x, w = tid >> 6, lane = tid & 63, g = lane >> 4, l16 = lane & 15, q4 = l16 >> 2, p4 = lane & 3;
    const int tt = w & 3, vh = w >> 2;
    bf16_t* Z = (bf16_t*)(p.ws + WS_Z);
    const float* ZS = (const float*)(p.ws + WS_ZS);
    float* SSQ = (float*)(p.ws + WS_SSQ);
    const float* BEND = (const float*)(p.ws + WS_BEND);
    const int qcol = (BR == 0 ? 0 : 3072) + h * 128, kcol = (BR == 0 ? 512 : 3584) + h * 128;
    const int vcol = (BR == 0 ? 1024 : 4096) + h * 256 + vq * VW, ocol = (BR == 0 ? 2048 : 5120) + h * 256 + vq * VW;
    unsigned char* T0 = lds + M_T0; unsigned char* T1 = lds + M_T1; unsigned char* TV = lds + M_TV; unsigned char* TC = lds + M_TC;
    float* sm = (float*)(lds + M_SM);
    float* gS = sm; float* Mt = sm + 64; float* at = sm + 128; float* emt = sm + 192; float* wsv = sm + 256; float* nvec = sm + 320; float* bend = sm + 448;
    float* misc = sm + 576; float* ssq = sm + 592; float* gaL = sm + 720; float* segtot = sm + 1744; float* waL = sm + 2256;
    const unsigned aT0_ = (unsigned)(size_t)T0, aT1_ = (unsigned)(size_t)T1, aTV_ = (unsigned)(size_t)TV;
    const float* gain = (BR == 0 ? p.in[18] : p.in[19]) + h * 256 + vq * VW;
    const int tloc = 16 * tt + l16;
    f32x4 gn[NOT];
#pragma unroll
    for (int vi = 0; vi < NOT; ++vi) gn[vi] = *(const f32x4*)(gain + (VW / 2) * vh + 16 * vi + 4 * g);
    f32x4 st[NVT];
#pragma unroll
    for (int c = 0; c < NVT; ++c) st[c] = (f32x4){0.f, 0.f, 0.f, 0.f};
    float m0 = 0.f;
    const float bi = (BR == 0) ? p.in[15][h] : 0.f, bfb = (BR == 0) ? p.in[15][4 + h] : 0.f;
    if (tid < 128) nvec[tid] = 0.f;
    u32x4 kreg[2], qreg[2], vreg[2]; bf16x8 qn[4]; float igr = 0.f, lfr = 0.f, gar[2] = {0.f, 0.f};
    const int ks_s0 = tid >> 4, ks_ch = tid & 15;
#define MIX_LOAD_CHUNK(R0) do { const size_t r_ = (size_t)(R0); \
        kreg[0] = *(const u32x4*)(Z + (r_ + ks_s0) * ZLD + kcol + ks_ch * 8); kreg[1] = *(const u32x4*)(Z + (r_ + ks_s0 + 32) * ZLD + kcol + ks_ch * 8); \
        vreg[0] = *(const u32x4*)(Z + (r_ + ks_s0) * ZLD + vcol + ks_ch * 8); vreg[1] = *(const u32x4*)(Z + (r_ + ks_s0 + 32) * ZLD + vcol + ks_ch * 8); \
        if (BR == 0) { _Pragma("unroll") for (int ks = 0; ks < 4; ++ks) qn[ks] = *(const bf16x8*)(Z + (r_ + tloc) * ZLD + qcol + 32 * ks + 8 * g); \
            if (w == 0) { igr = ZS[(r_ + lane) * ZSLD + h]; lfr = ZS[(r_ + lane) * ZSLD + 4 + h]; } } \
        else { qreg[0] = *(const u32x4*)(Z + (r_ + ks_s0) * ZLD + qcol + ks_ch * 8); qreg[1] = *(const u32x4*)(Z + (r_ + ks_s0 + 32) * ZLD + qcol + ks_ch * 8); \
            if (tid < 128) gar[0] = BEND[(r_ >> 6) * 512 + h * 128 + tid]; } } while (0)
    MIX_LOAD_CHUNK(b * 2048);
    __syncthreads();
    for (int c = 0; c < 32; ++c) {
        const int r0 = b * 2048 + c * 64;
        if (c > 0 && tid < 64) { float* sp_ = SSQ + ((size_t)(r0 - 64 + tid) * 8 + BR * 4 + h) * 4 + vq * 2; sp_[0] = ssq[tid] + ssq[64 + tid]; sp_[1] = 0.f; }
        unsigned aT0 = aT0_, aT1 = aT1_, aTV = aTV_;
        asm volatile("" : "+v"(aT0), "+v"(aT1), "+v"(aTV));
        if (BR == 0) {
            if (w == 0) {
                const float ig = igr + bi, lf = logsigf_(lfr + bfb);
                float F = lf;
#pragma unroll
                for (int o = 1; o < 64; o <<= 1) { const float y = __shfl_up(F, o); if (lane >= o) F += y; }
                const float gg = ig - F; float cm = gg;
#pragma unroll
                for (int o = 1; o < 64; o <<= 1) { const float y = __shfl_up(cm, o); if (lane >= o) cm = fmaxf(cm, y); }
                const float M = fmaxf(m0, cm), a = __expf(m0 - M);
                const float ML = __shfl(M, 63), aend = __shfl(a, 63), FL = __shfl(F, 63);
                gS[lane] = gg; Mt[lane] = M; at[lane] = a; emt[lane] = __expf(-(F + M)); wsv[lane] = __expf(gg - ML);
                if (lane == 0) misc[1] = aend;
                m0 = FL + ML;
            }
            __syncthreads();
#pragma unroll
            for (int i = 0; i < 2; ++i) { const int s = ks_s0 + 32 * i; const u32x4 kw = kreg[i];
                *(u32x4*)(T0 + s * T_STRIDE + ks_ch * 16) = kw;
                const float ww = wsv[s]; u32x4 o;
                o.x = cvt_pk(bflo(kw.x) * ww, bfhi(kw.x) * ww); o.y = cvt_pk(bflo(kw.y) * ww, bfhi(kw.y) * ww);
                o.z = cvt_pk(bflo(kw.z) * ww, bfhi(kw.z) * ww); o.w = cvt_pk(bflo(kw.w) * ww, bfhi(kw.w) * ww);
                *(u32x4*)(T1 + s * T_STRIDE + ks_ch * 16) = o; }
        } else {
            if (tid < 128) bend[tid] = gar[0];
#pragma unroll
            for (int i = 0; i < 2; ++i) { const int s = ks_s0 + 32 * i;
                *(u32x4*)(T0 + s * T_STRIDE + ks_ch * 16) = kreg[i]; *(u32x4*)(T1 + s * T_STRIDE + ks_ch * 16) = qreg[i]; }
        }
#pragma unroll
        for (int i = 0; i < 2; ++i) *(u32x4*)(TV + (ks_s0 + 32 * i) * V2_STRIDE + ks_ch * 16) = vreg[i];
#pragma unroll
        for (int c16 = 0; c16 < NVT; ++c16) *(u32x2*)(TC + (16 * c16 + l16) * T_STRIDE + (16 * w + 4 * g) * 2) = pack4(st[c16]);
        __syncthreads();
        bf16x8 qf[4];
#pragma unroll
        for (int ks = 0; ks < 4; ++ks) {
            if (BR == 0) qf[ks] = qn[ks];
            else qf[ks] = *(const bf16x8*)(T1 + tloc * T_STRIDE + (32 * ks + 8 * g) * 2);
        }
        bf16_t* op = Z + (size_t)(r0 + tloc) * ZLD + ocol + (VW / 2) * vh + 4 * g;
        u32x2 gwv[NOT];
#pragma unroll
        for (int vi = 0; vi < NOT; ++vi) gwv[vi] = *(const u32x2*)(op + 16 * vi);
        if (c < 31) MIX_LOAD_CHUNK(r0 + 64);
        f32x4 sacc[4];
#pragma unroll
        for (int si = 0; si < 4; ++si) { sacc[si] = (f32x4){0.f, 0.f, 0.f, 0.f};
#pragma unroll
            for (int ks = 0; ks < 4; ++ks) sacc[si] = mfma16(*(const bf16x8*)(T0 + (16 * si + l16) * T_STRIDE + (32 * ks + 8 * g) * 2), qf[ks], sacc[si]); }
        float den = 0.f;
        {
            const float Mtt = (BR == 0) ? Mt[tloc] : 0.f;
            f32x4 gS4[4];
#pragma unroll
            for (int si = 0; si < 4; ++si) gS4[si] = (BR == 0) ? *(const f32x4*)(gS + 16 * si + 4 * g) : (f32x4){0.f, 0.f, 0.f, 0.f};
#pragma unroll
            for (int si = 0; si < 4; ++si)
#pragma unroll
                for (int r = 0; r < 4; ++r) { const int s = 16 * si + 4 * g + r;
                    float wgt;
                    if (BR == 0) { const float e = __expf(fminf(gS4[si][r] - Mtt, 0.f)); wgt = (s <= tloc) ? e : 0.f; } else wgt = (s <= tloc) ? 1.f : 0.f;
                    sacc[si][r] *= wgt; den += sacc[si][r]; }
        }
        f32x4 oacc[NOT];
#pragma unroll
        for (int vi = 0; vi < NOT; ++vi) { oacc[vi] = (f32x4){0.f, 0.f, 0.f, 0.f};
#pragma unroll
            for (int ks = 0; ks < 4; ++ks) oacc[vi] = mfma16(*(const bf16x8*)(TC + ((VW / 2) * vh + 16 * vi + l16) * T_STRIDE + (32 * ks + 8 * g) * 2), qf[ks], oacc[vi]); }
        if (BR == 0) {
            den = xsum16_32(den);
            const float a_t = at[tloc];
            float nq = 0.f;
#pragma unroll
            for (int ks = 0; ks < 4; ++ks)
#pragma unroll
                for (int j = 0; j < 8; ++j) nq += nvec[32 * ks + 8 * g + j] * bf2f((bf16_t)qf[ks][j]);
            nq = xsum16_32(nq);
            den += a_t * nq;
#pragma unroll
            for (int vi = 0; vi < NOT; ++vi) oacc[vi] *= a_t;
        }
#pragma unroll
        for (int ks = 0; ks < 2; ++ks) {
            const bf16x8 pb = pack8(sacc[2 * ks], sacc[2 * ks + 1]);
#pragma unroll
            for (int vi = 0; vi < NOT; vi += 4) {
                const unsigned a0 = aTV + (32 * ks + 4 * g + q4) * V2_STRIDE + ((VW / 2) * vh + 16 * vi) * 2 + 8 * p4, a1 = a0 + 16 * V2_STRIDE;
                bf16x8 fa, fb, fc, fd; tr_frag4(a0, a1, a0 + 32, a1 + 32, a0 + 64, a1 + 64, a0 + 96, a1 + 96, fa, fb, fc, fd);
                oacc[vi] = mfma16(fa, pb, oacc[vi]); oacc[vi + 1] = mfma16(fb, pb, oacc[vi + 1]); oacc[vi + 2] = mfma16(fc, pb, oacc[vi + 2]); oacc[vi + 3] = mfma16(fd, pb, oacc[vi + 3]); }
        }
        if (BR == 0) { const float inv = 1.f / fmaxf(fabsf(den), emt[tloc]);
#pragma unroll
            for (int vi = 0; vi < NOT; ++vi) oacc[vi] *= inv; }
        float sq = 0.f;
#pragma unroll
        for (int vi = 0; vi < NOT; ++vi)
#pragma unroll
            for (int r = 0; r < 4; ++r) sq += oacc[vi][r] * oacc[vi][r];
        sq = xsum16_32(sq);
        if (g == 0) ssq[vh * 64 + tloc] = sq;
#pragma unroll
        for (int vi = 0; vi < NOT; ++vi) {
            const float gt[4] = {bflo(gwv[vi].x), bfhi(gwv[vi].x), bflo(gwv[vi].y), bfhi(gwv[vi].y)}; f32x4 o;
#pragma unroll
            for (int r = 0; r < 4; ++r) { const float sg = sigmoidf_(gt[r]); o[r] = oacc[vi][r] * gn[vi][r] * (BR == 0 ? sg : gt[r] * sg); }
            *(u32x2*)(op + 16 * vi) = pack4(o); }
        if (BR == 0) { const float aend = misc[1];
#pragma unroll
            for (int c16 = 0; c16 < NVT; ++c16) st[c16] *= aend; }
#pragma unroll
        for (int ks = 0; ks < 2; ++ks) {
            const unsigned ka0 = (BR == 0 ? aT1 : aT0) + (32 * ks + 8 * g + q4) * T_STRIDE + (16 * w) * 2 + 8 * p4;
            const bf16x8 kf = tr_frag(ka0, ka0 + 4 * T_STRIDE);
#pragma unroll
            for (int c16 = 0; c16 < NVT; c16 += 4) {
                const unsigned v0 = aTV + (32 * ks + 8 * g + q4) * V2_STRIDE + (16 * c16) * 2 + 8 * p4, v1 = v0 + 4 * V2_STRIDE;
                bf16x8 fa, fb, fc, fd; tr_frag4(v0, v1, v0 + 32, v1 + 32, v0 + 64, v1 + 64, v0 + 96, v1 + 96, fa, fb, fc, fd);
                st[c16] = mfma16(kf, fa, st[c16]); st[c16 + 1] = mfma16(kf, fb, st[c16 + 1]); st[c16 + 2] = mfma16(kf, fc, st[c16 + 2]); st[c16 + 3] = mfma16(kf, fd, st[c16 + 3]);
            }
        }
        if (BR == 1) {
            float eb[4];
#pragma unroll
            for (int r = 0; r < 4; ++r) eb[r] = __expf(bend[16 * w + 4 * g + r]);
#pragma unroll
            for (int c16 = 0; c16 < NVT; ++c16)
#pragma unroll
                for (int r = 0; r < 4; ++r) st[c16][r] *= eb[r];
        } else {
            const int d = tid & 127, seg = tid >> 7; float a2 = 0.f;
#pragma unroll
            for (int s = 0; s < 16; ++s) a2 += bf2f(*(const bf16_t*)(T1 + (seg * 16 + s) * T_STRIDE + d * 2));
            segtot[seg * 128 + d] = a2;
        }
        __syncthreads();
        if (BR == 0 && tid < 128) nvec[tid] = misc[1] * nvec[tid] + ((segtot[tid] + segtot[128 + tid]) + (segtot[256 + tid] + segtot[384 + tid]));
    }
#undef MIX_LOAD_CHUNK
    if (tid < 64) { float* sp_ = SSQ + ((size_t)(b * 2048 + 31 * 64 + tid) * 8 + BR * 4 + h) * 4 + vq * 2; sp_[0] = ssq[tid] + ssq[64 + tid]; sp_[1] = 0.f; }
    const int bh = b * 4 + h;
    if (BR == 0) {
        float* Co = p.out + O_CP + (size_t)bh * 32768;
#pragma unroll
        for (int c16 = 0; c16 < NVT; ++c16) __builtin_nontemporal_store(st[c16], (f32x4*)(Co + (size_t)(VW * vq + 16 * c16 + l16) * 128 + 16 * w + 4 * g));
        if (vq == 0) { if (tid < 128) p.out[O_NP + bh * 128 + tid] = nvec[tid];
            if (tid == 0) p.out[O_MPP + bh] = m0; }
    } else {
        float* So = p.out + O_SP + (size_t)bh * 32768;
#pragma unroll
        for (int c16 = 0; c16 < NVT; ++c16)
#pragma unroll
            for (int r = 0; r < 4; ++r) So[(size_t)(16 * w + 4 * g + r) * 256 + VW * vq + 16 * c16 + l16] = st[c16][r];
    }
    __syncthreads();
}

__device__ __forceinline__ void gla_prep(const Params& p, unsigned char* lds, int item) {
    const int tid = threadIdx.x, d = tid & 127, seg = tid >> 7;
    const int h = item & 3, c = (item >> 2) & 31, b = item >> 7;
    bf16_t* Z = (bf16_t*)(p.ws + WS_Z);
    const float* ZS = (const float*)(p.ws + WS_ZS);
    float* BEND = (float*)(p.ws + WS_BEND);
    float* gaL = (float*)lds; float* waL = gaL + 1024; float* segtot = waL + 2048;
    const int r0 = b * 2048 + c * 64, qcol = 3072 + h * 128, kcol = 3584 + h * 128;
    gaL[tid] = ZS[(size_t)(r0 + (tid >> 4)) * ZSLD + 8 + (tid & 15)]; gaL[tid + 512] = ZS[(size_t)(r0 + 32 + (tid >> 4)) * ZSLD + 8 + (tid & 15)];
#pragma unroll
    for (int j = 0; j < 4; ++j) { const int id = tid + 512 * j; waL[id] = p.in[16][(id >> 7) * 512 + h * 128 + (id & 127)]; }
    const float ba = p.in[17][h * 128 + d];
    __syncthreads();
    float wa[16];
#pragma unroll
    for (int j = 0; j < 16; ++j) wa[j] = waL[j * 128 + d];
    float la[16]; float run = 0.f;
#pragma unroll
    for (int i = 0; i < 16; ++i) { const int t = seg * 16 + i; float x = ba;
#pragma unroll
        for (int j = 0; j < 16; ++j) x += gaL[t * 16 + j] * wa[j];
        run += logsigf_(x) * 0.0625f; la[i] = run; }
    segtot[seg * 128 + d] = run;
    __syncthreads();
    float pre = 0.f, tot = 0.f;
#pragma unroll
    for (int s2 = 0; s2 < 4; ++s2) { const float v = segtot[s2 * 128 + d]; tot += v; if (s2 < seg) pre += v; }
    if (seg == 0) BEND[(size_t)(b * 32 + c) * 512 + h * 128 + d] = tot;
    bf16_t qv[16], kv[16];
#pragma unroll
    for (int i = 0; i < 16; ++i) { const int t = seg * 16 + i; qv[i] = Z[(size_t)(r0 + t) * ZLD + qcol + d]; kv[i] = Z[(size_t)(r0 + t) * ZLD + kcol + d]; }
#pragma unroll
    for (int i = 0; i < 16; ++i) { const int t = seg * 16 + i; const float bb = la[i] + pre;
        Z[(size_t)(r0 + t) * ZLD + qcol + d] = f2bf(bf2f(qv[i]) * __expf(bb)); Z[(size_t)(r0 + t) * ZLD + kcol + d] = f2bf(bf2f(kv[i]) * __expf(-bb)); }
    __syncthreads();
}

template <int BR>
__device__ __forceinline__ void mixer_sample(const Params& p, unsigned char* lds, int b, int h) {
    const int tid = threadIdx.x, w = tid >> 6, lane = tid & 63;
    bf16_t* Z = (bf16_t*)(p.ws + WS_Z);
    const float* ZS = (const float*)(p.ws + WS_ZS);
    const int qcol = (BR == 0 ? 0 : 3072) + h * 128, kcol = (BR == 0 ? 512 : 3584) + h * 128, vcol = (BR == 0 ? 1024 : 4096) + h * 256, ocol = (BR == 0 ? 2048 : 5120) + h * 256;
    float* sm = (float*)lds;
    float* qa = sm; float* ka = sm + 512; float* kd = sm + 1024; float* dec = sm + 1536; float* vv = sm + 1664; float* qk = sm + 2688; float* sc = sm + 2704;
    float* part = sm + 2752; float* red = sm + 4800;
    const int r0 = MP + 4 * b, bh = b * 4 + h;
    const float* gain = (BR == 0 ? p.in[18] : p.in[19]) + h * 256;
    float a_t[4] = {1.f, 1.f, 1.f, 1.f}, mt[4] = {0.f, 0.f, 0.f, 0.f}, aend = 1.f;
    {
        const int t = tid >> 7, d = tid & 127;
        const float qraw = bf2f(Z[(size_t)(r0 + t) * ZLD + qcol + d]), kraw = bf2f(Z[(size_t)(r0 + t) * ZLD + kcol + d]);
#pragma unroll
        for (int i = 0; i < 2; ++i) { const int id = tid + 512 * i; vv[id] = bf2f(Z[(size_t)(r0 + (id >> 8)) * ZLD + vcol + (id & 255)]); }
        if (BR == 0) {
            const float m0 = p.in[5][bh], bi = p.in[15][h], bfb = p.in[15][4 + h];
            float F = 0.f, cm = -3.0e38f, gg[4], Mv[4];
#pragma unroll
            for (int s = 0; s < 4; ++s) { const float ig = ZS[(size_t)(r0 + s) * ZSLD + h] + bi, lf = logsigf_(ZS[(size_t)(r0 + s) * ZSLD + 4 + h] + bfb);
                F += lf; gg[s] = ig - F; cm = fmaxf(cm, gg[s]); Mv[s] = fmaxf(m0, cm); a_t[s] = __expf(m0 - Mv[s]); mt[s] = F + Mv[s]; }
            aend = a_t[3];
            float wsel = 0.f;
#pragma unroll
            for (int s = 0; s < 4; ++s) { const float ws_ = __expf(gg[s] - Mv[3]); if (s == t) wsel = ws_; }
            qa[tid] = qraw; ka[tid] = kraw; kd[tid] = wsel * kraw;
            if (tid < 128) dec[tid] = aend;
            if (tid == 0) {
#pragma unroll
                for (int s = 0; s < 4; ++s) { sc[16 + s] = gg[s]; sc[20 + s] = Mv[s]; } }
        } else {
            float la[4];
#pragma unroll
            for (int s = 0; s < 4; ++s) { float x = p.in[17][h * 128 + d];
#pragma unroll
                for (int j = 0; j < 16; ++j) x += ZS[(size_t)(r0 + s) * ZSLD + 8 + j] * p.in[16][j * 512 + h * 128 + d];
                la[s] = logsigf_(x) * 0.0625f; }
            float bt = 0.f, bendv = 0.f;
#pragma unroll
            for (int s = 0; s < 4; ++s) { bendv += la[s]; if (s <= t) bt += la[s]; }
            qa[tid] = qraw * __expf(bt); ka[tid] = kraw * __expf(-bt); kd[tid] = kraw * __expf(bendv - bt);
            if (t == 0) dec[d] = __expf(bendv);
        }
    }
    __syncthreads();
    {
        const int pr = tid >> 5, l = tid & 31, t = pr >> 2, s = pr & 3;
        const f32x4 a = *(const f32x4*)(qa + t * 128 + l * 4), k4 = *(const f32x4*)(ka + s * 128 + l * 4);
        float v = a[0] * k4[0] + a[1] * k4[1] + a[2] * k4[2] + a[3] * k4[3];
#pragma unroll
        for (int o = 16; o > 0; o >>= 1) v += __shfl_xor(v, o);
        if (l == 0) { float wgt; if (BR == 0) wgt = (s <= t) ? __expf(sc[16 + s] - sc[20 + t]) : 0.f; else wgt = (s <= t) ? 1.f : 0.f; qk[pr] = v * wgt; }
        if (BR == 0 && tid < 128) {
            const int t2 = tid >> 5;
            const f32x4 n4 = *(const f32x4*)(p.in[4] + (size_t)bh * 128 + l * 4), q4v = *(const f32x4*)(qa + t2 * 128 + l * 4);
            float v2 = n4[0] * q4v[0] + n4[1] * q4v[1] + n4[2] * q4v[2] + n4[3] * q4v[3];
#pragma unroll
            for (int o = 16; o > 0; o >>= 1) v2 += __shfl_xor(v2, o);
            if (l == 0) sc[12 + t2] = v2;
        }
    }
    __syncthreads();
    float hv[4]; int vown; bool owner;
    if (BR == 0) {
        const int l32 = lane & 31, half = lane >> 5;
        const float* C0 = p.in[3] + (size_t)bh * 32768 + 4 * l32;
        float* C1 = p.out + O_CS + (size_t)bh * 32768 + 4 * l32;
        f32x4 qa4[4], kd4[4]; const f32x4 dec4 = *(const f32x4*)(dec + 4 * l32);
#pragma unroll
        for (int t = 0; t < 4; ++t) { qa4[t] = *(const f32x4*)(qa + t * 128 + 4 * l32); kd4[t] = *(const f32x4*)(kd + t * 128 + 4 * l32); }
#pragma unroll
        for (int ib = 0; ib < 16; ib += 8) {
            f32x4 cv[8];
#pragma unroll
            for (int e = 0; e < 8; ++e) cv[e] = __builtin_nontemporal_load((const f32x4*)(C0 + (size_t)(w * 32 + 2 * (ib + e) + half) * 128));
#pragma unroll
            for (int e = 0; e < 8; ++e) { const int v = w * 32 + 2 * (ib + e) + half; const f32x4 c = cv[e];
                float wv[4], pt[4];
#pragma unroll
                for (int s = 0; s < 4; ++s) wv[s] = vv[s * 256 + v];
                f32x4 o = dec4 * c;
#pragma unroll
                for (int s = 0; s < 4; ++s) o += kd4[s] * wv[s];
                __builtin_nontemporal_store(o, (f32x4*)(C1 + (size_t)v * 128));
#pragma unroll
                for (int t = 0; t < 4; ++t) { float x = c[0] * qa4[t][0] + c[1] * qa4[t][1] + c[2] * qa4[t][2] + c[3] * qa4[t][3];
#pragma unroll
                    for (int of = 16; of > 0; of >>= 1) x += __shfl_xor(x, of);
                    pt[t] = x; }
                if (l32 == 0) {
#pragma unroll
                    for (int t = 0; t < 4; ++t) part[t * 256 + v] = pt[t]; }
            }
        }
        if (tid < 128) { float acc = aend * p.in[4][(size_t)bh * 128 + tid];
#pragma unroll
            for (int s = 0; s < 4; ++s) acc += kd[s * 128 + tid];
            p.out[O_NS + (size_t)bh * 128 + tid] = acc; }
        if (tid == 0) p.out[O_MSS + bh] = mt[3];
        __syncthreads();
        vown = tid & 255; owner = (tid < 256);
        {
            float wv2[4];
#pragma unroll
            for (int s = 0; s < 4; ++s) wv2[s] = vv[s * 256 + vown];
#pragma unroll
            for (int t = 0; t < 4; ++t) { float num = a_t[t] * part[t * 256 + vown], den = a_t[t] * sc[12 + t];
#pragma unroll
                for (int s = 0; s < 4; ++s) { num += qk[t * 4 + s] * wv2[s]; den += qk[t * 4 + s]; }
                hv[t] = num / fmaxf(fabsf(den), __expf(-mt[t])); }
        }
    } else {
        const int v4 = lane * 4;
        const float* S0 = p.in[6] + ((size_t)bh * 128 + 16 * w) * 256 + v4;
        float* S1 = p.out + O_SS + ((size_t)bh * 128 + 16 * w) * 256 + v4;
        float* part8 = sm + 4864;
        f32x4 wv4[4], pt4[4];
#pragma unroll
        for (int s = 0; s < 4; ++s) { wv4[s] = *(const f32x4*)(vv + s * 256 + v4); pt4[s] = (f32x4){0.f, 0.f, 0.f, 0.f}; }
#pragma unroll
        for (int jb = 0; jb < 16; jb += 8) {
            f32x4 s0v[8];
#pragma unroll
            for (int e = 0; e < 8; ++e) s0v[e] = __builtin_nontemporal_load((const f32x4*)(S0 + (size_t)(jb + e) * 256));
#pragma unroll
            for (int e = 0; e < 8; ++e) { const int j = jb + e, d = 16 * w + j; const f32x4 s0 = s0v[e];
                f32x4 acc = s0 * dec[d];
#pragma unroll
                for (int t = 0; t < 4; ++t) pt4[t] += s0 * qa[t * 128 + d];
#pragma unroll
                for (int s2 = 0; s2 < 4; ++s2) acc += wv4[s2] * kd[s2 * 128 + d];
                __builtin_nontemporal_store(acc, (f32x4*)(S1 + (size_t)j * 256)); } }
#pragma unroll
        for (int t = 0; t < 4; ++t) *(f32x4*)(part8 + (w * 4 + t) * 256 + v4) = pt4[t];
        __syncthreads();
        vown = tid & 255; owner = (tid < 256);
#pragma unroll
        for (int t = 0; t < 4; ++t) { float num = 0.f;
#pragma unroll
            for (int w2 = 0; w2 < 8; ++w2) num += part8[(w2 * 4 + t) * 256 + vown];
#pragma unroll
            for (int s2 = 0; s2 < 4; ++s2) num += qk[t * 4 + s2] * vv[s2 * 256 + vown];
            hv[t] = num; }
    }
#pragma unroll
    for (int t = 0; t < 4; ++t) { float q2 = owner ? hv[t] * hv[t] : 0.f; q2 = wave_sum(q2); if (lane == 0) red[w * 4 + t] = q2; }
    __syncthreads();
    if (owner) {
#pragma unroll
        for (int t = 0; t < 4; ++t) { float tot = 0.f;
#pragma unroll
            for (int w2 = 0; w2 < 8; ++w2) tot += red[w2 * 4 + t];
            const float rs = rsqrtf(tot * (1.f / 256.f) + EPSV);
            bf16_t* op = Z + (size_t)(r0 + t) * ZLD + ocol + vown;
            const float gt = bf2f(*op), sg = sigmoidf_(gt);
            *op = f2bf(hv[t] * rs * gain[vown] * (BR == 0 ? sg : gt * sg)); }
    }
    __syncthreads();
}

__device__ __forceinline__ void attn_prompt(const Params& p, unsigned char* lds, int item) {
    const int tid = threadIdx.x, w = tid >> 6, lane = tid & 63, g = lane >> 4, l16 = lane & 15, q4 = l16 >> 2, p4 = lane & 3;
    const int qt = item & 15, h = (item >> 4) & 3, b = item >> 6;
    const bf16_t* KV = (const bf16_t*)(p.ws + WS_MEMKV) + (size_t)b * 256 * 2048 + h * 256;
    const bf16_t* Q = (const bf16_t*)(p.ws + WS_QBUF);
    bf16_t* O = (bf16_t*)(p.ws + WS_OBUF);
    const size_t rq = (size_t)b * 2048 + qt * 128 + 16 * w + l16;
    const unsigned aL = (unsigned)(size_t)lds;
#pragma unroll 4
    for (int i = 0; i < 16; ++i) { const int id = tid + 512 * i, key = id >> 5, ch = id & 31;
        *(u32x4*)(lds + key * V_STRIDE + ch * 16) = *(const u32x4*)(KV + (size_t)key * 2048 + ch * 8); }
    __syncthreads();
    f32x4 s[16];
#pragma unroll
    for (int ki = 0; ki < 16; ++ki) s[ki] = (f32x4){0.f, 0.f, 0.f, 0.f};
#pragma unroll
    for (int ks = 0; ks < 8; ++ks) { const bf16x8 qfk = *(const bf16x8*)(Q + rq * DM + h * 256 + 32 * ks + 8 * g);
#pragma unroll
        for (int ki = 0; ki < 16; ++ki) s[ki] = mfma16(*(const bf16x8*)(lds + (16 * ki + l16) * V_STRIDE + (32 * ks + 8 * g) * 2), qfk, s[ki]); }
    float mx = -3.0e38f;
#pragma unroll
    for (int ki = 0; ki < 16; ++ki)
#pragma unroll
        for (int r = 0; r < 4; ++r) mx = fmaxf(mx, s[ki][r]);
    mx = xmax16_32(mx);
    float sum = 0.f;
#pragma unroll
    for (int ki = 0; ki < 16; ++ki)
#pragma unroll
        for (int r = 0; r < 4; ++r) { const float e = __expf(s[ki][r] - mx); s[ki][r] = e; sum += e; }
    sum = xsum16_32(sum);
    bf16x8 pf[8];
#pragma unroll
    for (int ks = 0; ks < 8; ++ks) pf[ks] = pack8(s[2 * ks], s[2 * ks + 1]);
    __syncthreads();
#pragma unroll 4
    for (int i = 0; i < 16; ++i) { const int id = tid + 512 * i, key = id >> 5, ch = id & 31;
        *(u32x4*)(lds + key * V_STRIDE + ch * 16) = *(const u32x4*)(KV + (size_t)key * 2048 + 1024 + ch * 8); }
    __syncthreads();
    const float inv = 1.f / sum;
#pragma unroll
    for (int hh = 0; hh < 2; ++hh) {
        f32x4 o[8];
#pragma unroll
        for (int hi = 0; hi < 8; ++hi) o[hi] = (f32x4){0.f, 0.f, 0.f, 0.f};
#pragma unroll
        for (int ks = 0; ks < 8; ++ks) {
            unsigned aLk = aL + (32 * ks + 4 * g + q4) * V_STRIDE + 8 * p4 + hh * 256;
            asm volatile("" : "+v"(aLk));
#pragma unroll
            for (int hi = 0; hi < 8; hi += 4) {
                const unsigned a0 = aLk + (16 * hi) * 2, a1 = a0 + 16 * V_STRIDE;
                bf16x8 fa, fb, fc, fd; tr_frag4(a0, a1, a0 + 32, a1 + 32, a0 + 64, a1 + 64, a0 + 96, a1 + 96, fa, fb, fc, fd);
                o[hi] = mfma16(fa, pf[ks], o[hi]); o[hi + 1] = mfma16(fb, pf[ks], o[hi + 1]); o[hi + 2] = mfma16(fc, pf[ks], o[hi + 2]); o[hi + 3] = mfma16(fd, pf[ks], o[hi + 3]);
            }
        }
#pragma unroll
        for (int hi = 0; hi < 8; ++hi) *(u32x2*)(O + rq * DM + h * 256 + hh * 128 + 16 * hi + 4 * g) = pack4(o[hi] * inv);
    }
    __syncthreads();
}
__device__ __forceinline__ void attn_sample(const Params& p, unsigned char* lds, int item) {
    const int tid = threadIdx.x, w = tid >> 6, lane = tid & 63;
    const int h = item & 3, b = item >> 2;
    const float* Kc = p.in[7] + ((size_t)b * 1024 + h) * 256;
    const float* Vc = p.in[8] + ((size_t)b * 1024 + h) * 256;
    const bf16_t* Q = (const bf16_t*)(p.ws + WS_QBUF);
    bf16_t* O = (bf16_t*)(p.ws + WS_OBUF);
    float* sc = (float*)lds; float* po = sc + 1024;
    const size_t r0 = MP + 4 * b;
    f32x4 q[4];
#pragma unroll
    for (int t = 0; t < 4; ++t) { const u32x2 qw = *(const u32x2*)(Q + (r0 + t) * DM + h * 256 + lane * 4); q[t] = (f32x4){bflo(qw.x), bfhi(qw.x), bflo(qw.y), bfhi(qw.y)}; }
    {
        const bool b5 = (lane & 32) != 0, b4 = (lane & 16) != 0, b3 = (lane & 8) != 0, b2 = (lane & 4) != 0;
#pragma unroll 2
        for (int kg = 0; kg < 8; ++kg) { const int key0 = w * 32 + kg * 4;
            f32x4 kv[4];
#pragma unroll
            for (int k = 0; k < 4; ++k) kv[k] = __builtin_nontemporal_load((const f32x4*)(Kc + (size_t)(key0 + k) * 1024 + lane * 4));
            float v[16];
#pragma unroll
            for (int k = 0; k < 4; ++k)
#pragma unroll
                for (int t = 0; t < 4; ++t) v[k * 4 + t] = kv[k][0] * q[t][0] + kv[k][1] * q[t][1] + kv[k][2] * q[t][2] + kv[k][3] * q[t][3];
            float a8[8], a4[4], a2[2];
#pragma unroll
            for (int i = 0; i < 8; ++i) { const float keep = b5 ? v[i + 8] : v[i], send = b5 ? v[i] : v[i + 8]; a8[i] = keep + __shfl_xor(send, 32); }
#pragma unroll
            for (int i = 0; i < 4; ++i) { const float keep = b4 ? a8[i + 4] : a8[i], send = b4 ? a8[i] : a8[i + 4]; a4[i] = keep + __shfl_xor(send, 16); }
#pragma unroll
            for (int i = 0; i < 2; ++i) { const float keep = b3 ? a4[i + 2] : a4[i], send = b3 ? a4[i] : a4[i + 2]; a2[i] = keep + __shfl_xor(send, 8); }
            float d = (b2 ? a2[1] : a2[0]) + __shfl_xor(b2 ? a2[0] : a2[1], 4);
            d += __shfl_xor(d, 2); d += __shfl_xor(d, 1);
            if ((lane & 3) == 0) { const int j = (lane >> 2) & 15; sc[(j & 3) * 256 + key0 + (j >> 2)] = d; }
        }
    }
    __syncthreads();
    if (w < 4) { float v[4], mx = -3.0e38f;
#pragma unroll
        for (int i = 0; i < 4; ++i) { v[i] = sc[w * 256 + lane + 64 * i]; mx = fmaxf(mx, v[i]); }
        mx = wave_max(mx); float sum = 0.f;
#pragma unroll
        for (int i = 0; i < 4; ++i) { v[i] = __expf(v[i] - mx); sum += v[i]; }
        sum = wave_sum(sum); const float inv = 1.f / sum;
#pragma unroll
        for (int i = 0; i < 4; ++i) sc[w * 256 + lane + 64 * i] = v[i] * inv; }
    __syncthreads();
    {
        const int hd4 = lane * 4; float* po8 = sc + 1024;
        f32x4 acc4[4];
#pragma unroll
        for (int t = 0; t < 4; ++t) acc4[t] = (f32x4){0.f, 0.f, 0.f, 0.f};
#pragma unroll 8
        for (int kk = 0; kk < 32; ++kk) { const int key = w * 32 + kk; const f32x4 v4 = __builtin_nontemporal_load((const f32x4*)(Vc + (size_t)key * 1024 + hd4));
#pragma unroll
            for (int t = 0; t < 4; ++t) acc4[t] += v4 * sc[t * 256 + key]; }
#pragma unroll
        for (int t = 0; t < 4; ++t) *(f32x4*)(po8 + (w * 4 + t) * 256 + hd4) = acc4[t];
        __syncthreads();
        if (tid < 256) {
#pragma unroll
            for (int t = 0; t < 4; ++t) { float o = 0.f;
#pragma unroll
                for (int w2 = 0; w2 < 8; ++w2) o += po8[(w2 * 4 + t) * 256 + tid];
                O[(r0 + t) * DM + h * 256 + tid] = f2bf(o); } }
    }
    __syncthreads();
}

#ifndef ONLY_PH
#define ONLY_PH -1
#endif
#ifndef MIXEN
#define MIXEN 15
#endif
#ifndef PH_MASK
#define PH_MASK 0xffff
#endif
#define PH_ENABLED(x) ((ONLY_PH < 0 || ONLY_PH == (x)) && ((PH_MASK >> (x)) & 1) && ((KMASK >> (x)) & 1))
__device__ __forceinline__ void grid_barrier(unsigned char* wsb, unsigned char* lds) {
    XcdBarrier b; b.bar = (unsigned*)(wsb + WS_BAR); b.x = xb_xcc_id(); b.st = (volatile LAS unsigned*)(lds + LDS_BYTES - 16);
    xcd_barrier(b);
}
template <int KMASK> __global__ void __launch_bounds__(512, 2) fwd_kernel(Params p) {
    extern __shared__ __attribute__((aligned(16))) unsigned char lds[];
    cg::grid_group grid = cg::this_grid();
    volatile LAS unsigned* xb_st = (volatile LAS unsigned*)(lds + LDS_BYTES - 16);
    if (threadIdx.x == 0) { xb_st[0] = 0u; xb_st[1] = 0u; }
    __syncthreads();
    (void)xcd_barrier_post((unsigned*)(p.ws + WS_BAR), xb_st);
#ifndef DUP_MASK
#define DUP_MASK 0
#endif
#define PH_BEGIN(k) if (PH_ENABLED(k) && p.ph_lo <= (k) && (k) < p.ph_hi) for (int rep_ = 0; rep_ < (((DUP_MASK >> (k)) & 1) ? 2 : 1); ++rep_) { if ((k) > p.ph_lo || rep_) { if (p.ph_hi > 1000) grid.sync(); else grid_barrier(p.ws, lds); } \
        unsigned char* ws; float* outp; { unsigned long long w_ = (unsigned long long)p.ws, o_ = (unsigned long long)p.out; \
        unsigned a0_ = __builtin_amdgcn_readfirstlane((unsigned)w_), a1_ = __builtin_amdgcn_readfirstlane((unsigned)(w_ >> 32)), a2_ = __builtin_amdgcn_readfirstlane((unsigned)o_), a3_ = __builtin_amdgcn_readfirstlane((unsigned)(o_ >> 32)); \
        asm volatile("" : "+s"(a0_), "+s"(a1_), "+s"(a2_), "+s"(a3_)); ws = (unsigned char*)(((unsigned long long)a1_ << 32) | a0_); outp = (float*)(((unsigned long long)a3_ << 32) | a2_); } \
        bf16_t* ABUF = (bf16_t*)(ws + WS_ABUF); bf16_t* Z = (bf16_t*)(ws + WS_Z); float* XRES = (float*)(ws + WS_XRES); float* SS = (float*)(ws + WS_SS); float* TMP = outp + O_YP; \
        (void)ABUF; (void)Z; (void)XRES; (void)SS; (void)TMP;
#define PH_END }
    PH_BEGIN(0) prep_phase(p, lds); PH_END
    PH_BEGIN(1)
        EpiGateUp e1; e1.H = Z; e1.ss = nullptr;
        run_gemm(lds, ABUF, DM, (const bf16_t*)(ws + WS_WGU1), MT, 5632, 1024, e1, 0);
        EpiMemKV e2; e2.ok = outp + O_MKP; e2.ov = outp + O_MVP; e2.kv = (bf16_t*)(ws + WS_MEMKV);
        run_gemm(lds, (const bf16_t*)(ws + WS_MEMA), DM, (const bf16_t*)(ws + WS_WKV), 2048, 2048, 1024, e2, 64);
    PH_END
    PH_BEGIN(2) EpiResid e; e.res0 = p.in[0]; e.res1 = p.in[1]; e.xout = XRES; e.aout = ABUF; e.gain = p.in[13]; e.ss = SS; e.scale = 0.5f;
        run_gemm(lds, Z, DFF, (const bf16_t*)(ws + WS_WD1), MP, 1024, DFF, e, 0); small_gemm(lds, Z, DFF, (const bf16_t*)(ws + WS_WD1), 1024, DFF, e); PH_END
    PH_BEGIN(3) EpiZ e; e.Z = Z; e.ZS = (float*)(ws + WS_ZS); e.ss = SS;
        run_gemm(lds, ABUF, DM, (const bf16_t*)(ws + WS_WIN), MT, 8448, 1024, e, 0); PH_END
    PH_BEGIN(4)
        for (int it = blockIdx.x; it < 1024; it += gridDim.x) gla_prep(p, lds, it);
    PH_END
    PH_BEGIN(5)
        const int bx = (int)blockIdx.x, G = (int)gridDim.x;
        const int NCH = (G >= 256) ? 128 : 0;
        if (bx < NCH || NCH == 0) {
            for (int it0 = bx; it0 < 128; it0 += (NCH ? NCH : G)) { const int it = NCH ? ((((it0 & 7) * 8 + (it0 >> 4)) << 1) | ((it0 >> 3) & 1)) : it0;
                if (it < 64) { if (MIXEN & 1) mixer_prompt<0>(p, lds, it >> 3, (it >> 1) & 3, it & 1); } }
            for (int it0 = bx; it0 < 128; it0 += (NCH ? NCH : G)) { const int it = NCH ? ((((it0 & 7) * 8 + (it0 >> 4)) << 1) | ((it0 >> 3) & 1)) : it0;
                if (it >= 64) { if (MIXEN & 2) mixer_prompt<1>(p, lds, (it - 64) >> 3, (it >> 1) & 3, it & 1); } }
        }
        if (bx >= NCH) {
            for (int it = bx - NCH; it < 512; it += G - NCH) { if (MIXEN & 4) mixer_sample<0>(p, lds, it >> 2, it & 3); }
            for (int it = bx - NCH; it < 512; it += G - NCH) { if (MIXEN & 8) mixer_sample<1>(p, lds, it >> 2, it & 3); }
            prep_transposes(p, lds, PREP_LATE_MASK, bx - NCH, G - NCH);
        }
    PH_END
    PH_BEGIN(6)
        const float* SSQ = (const float*)(ws + WS_SSQ);
        const int lane = threadIdx.x & 63, gw = blockIdx.x * 8 + (threadIdx.x >> 6), nw = gridDim.x * 8;
        for (int i0 = gw; i0 < MP * 8; i0 += 4 * nw) {
            f32x4 sp[4]; u32x2 wv[4];
#pragma unroll
            for (int e = 0; e < 4; ++e) { const int i = i0 + e * nw; if (i < MP * 8) { sp[e] = *(const f32x4*)(SSQ + (size_t)i * 4);
                    wv[e] = *(const u32x2*)(Z + (size_t)(i >> 3) * ZLD + (((i & 7) >> 2) ? 5120 : 2048) + (i & 3) * 256 + lane * 4); } }
#pragma unroll
            for (int e = 0; e < 4; ++e) { const int i = i0 + e * nw; if (i < MP * 8) {
                    const float rs = rsqrtf(((sp[e][0] + sp[e][1]) + (sp[e][2] + sp[e][3])) * (1.f / 256.f) + EPSV);
                    f32x4 o = {bflo(wv[e].x) * rs, bfhi(wv[e].x) * rs, bflo(wv[e].y) * rs, bfhi(wv[e].y) * rs};
                    *(u32x2*)(Z + (size_t)(i >> 3) * ZLD + (((i & 7) >> 2) ? 5120 : 2048) + (i & 3) * 256 + lane * 4) = pack4(o); } }
        }
    PH_END
    PH_BEGIN(7)
        { EpiMerge<0> e; e.gate = Z + 6144; e.T = TMP; e.Y = nullptr;
          run_gemm(lds, Z + 2048, ZLD, (const bf16_t*)(ws + WS_WBRM), MP, 1024, 1024, e, 0); small_gemm(lds, Z + 2048, ZLD, (const bf16_t*)(ws + WS_WBRM), 1024, 1024, e); }
        { EpiMerge<1> e; e.gate = Z + 7168; e.T = TMP; e.Y = ABUF;
          run_gemm(lds, Z + 5120, ZLD, (const bf16_t*)(ws + WS_WBRG), MP, 1024, 1024, e, 0); small_gemm(lds, Z + 5120, ZLD, (const bf16_t*)(ws + WS_WBRG), 1024, 1024, e); }
    PH_END
    PH_BEGIN(9) EpiResid e; e.res0 = XRES; e.res1 = XRES + (size_t)MP * DM; e.xout = XRES; e.aout = (bf16_t*)(ws + WS_ABUF2); e.gain = p.in[23]; e.ss = SS + (size_t)MT * 16; e.scale = 1.f;
        run_gemm(lds, ABUF, DM, (const bf16_t*)(ws + WS_WOUT), MP, 1024, 1024, e, 0); small_gemm(lds, ABUF, DM, (const bf16_t*)(ws + WS_WOUT), 1024, 1024, e); PH_END
    PH_BEGIN(10) EpiQ e; e.Q = (bf16_t*)(ws + WS_QBUF); e.ss = SS + (size_t)MT * 16;
        run_gemm(lds, (const bf16_t*)(ws + WS_ABUF2), DM, (const bf16_t*)(ws + WS_WQ), MP, 1024, 1024, e, 0); small_gemm(lds, (const bf16_t*)(ws + WS_ABUF2), DM, (const bf16_t*)(ws + WS_WQ), 1024, 1024, e); PH_END
    PH_BEGIN(11)
#pragma unroll 1
        for (int pass = 0; pass < 2; ++pass) {
            if (((blockIdx.x & 1) != 0) == (pass == 0)) { for (int it = blockIdx.x; it < 512; it += gridDim.x) attn_sample(p, lds, it); }
            else { for (int it = blockIdx.x; it < 512; it += gridDim.x) attn_prompt(p, lds, it); }
        }
    PH_END
    PH_BEGIN(12) EpiResid e; e.res0 = XRES; e.res1 = XRES + (size_t)MP * DM; e.xout = XRES; e.aout = ABUF; e.gain = p.in[29]; e.ss = SS + (size_t)MT * 32; e.scale = 1.f;
        run_gemm(lds, (const bf16_t*)(ws + WS_OBUF), DM, (const bf16_t*)(ws + WS_WO), MP, 1024, 1024, e, 0); small_gemm(lds, (const bf16_t*)(ws + WS_OBUF), DM, (const bf16_t*)(ws + WS_WO), 1024, 1024, e); PH_END
    PH_BEGIN(13) EpiGateUp e; e.H = Z; e.ss = SS + (size_t)MT * 32;
        run_gemm(lds, ABUF, DM, (const bf16_t*)(ws + WS_WGU2), MT, 5632, 1024, e, 0); PH_END
    PH_BEGIN(14) EpiResid e; e.res0 = XRES; e.res1 = XRES + (size_t)MP * DM; e.xout = TMP; e.aout = nullptr; e.gain = nullptr; e.ss = SS + (size_t)MT * 48; e.scale = 0.5f;
        run_gemm(lds, Z, DFF, (const bf16_t*)(ws + WS_WD2), MP, 1024, DFF, e, 0); small_gemm(lds, Z, DFF, (const bf16_t*)(ws + WS_WD2), 1024, DFF, e); PH_END
    PH_BEGIN(15)
        const int lane = threadIdx.x & 63, gw = blockIdx.x * 8 + (threadIdx.x >> 6), nw = gridDim.x * 8;
        for (int r = gw; r < MT; r += nw) { const float rs = rs_row(SS + (size_t)MT * 48, r); float* y = TMP + (size_t)r * DM;
#pragma unroll
            for (int i = 0; i < 4; ++i) { f32x4 v = *(const f32x4*)(y + i * 256 + lane * 4); const f32x4 gg = *(const f32x4*)(p.in[33] + i * 256 + lane * 4);
                __builtin_nontemporal_store(v * rs * gg, (f32x4*)(y + i * 256 + lane * 4)); } }
    PH_END
}

template <int KMASK> static bool setup_kernel() {
    if (hipFuncSetAttribute((const void*)fwd_kernel<KMASK>, hipFuncAttributeMaxDynamicSharedMemorySize, LDS_BYTES) != hipSuccess) { fprintf(stderr, "kernel_launch: hipFuncSetAttribute failed\n"); return false; }
    int per_cu = 0;
    if (hipOccupancyMaxActiveBlocksPerMultiprocessor(&per_cu, (const void*)fwd_kernel<KMASK>, NTHREADS, LDS_BYTES) != hipSuccess || per_cu < 1) fprintf(stderr, "kernel_launch: occupancy query says %d\n", per_cu);
    (void)hipGetLastError();
    return true;
}
template <int KMASK> static void launch_range(Params p, int lo, int hi, int grid, hipStream_t stream) {
    p.ph_lo = lo; p.ph_hi = hi;
    if (hipMemsetAsync((char*)p.ws + WS_BAR, 0, XCD_BAR_WORDS * 4, stream) != hipSuccess) { fprintf(stderr, "kernel_launch: memset of the barrier words failed\n"); return; }
    void* args[] = {&p};
    hipError_t e = hipLaunchCooperativeKernel((const void*)fwd_kernel<KMASK>, dim3(grid), dim3(NTHREADS), args, LDS_BYTES, stream);
    if (e != hipSuccess) fprintf(stderr, "kernel_launch: cooperative launch [%d,%d) failed: %s (grid %d)\n", lo, hi, hipGetErrorString(e), grid);
}
#ifndef N_LAUNCH
#define N_LAUNCH 1
#endif
extern "C" void kernel_launch(void* const* d_in, const int* in_sizes, int n_in, void* d_out, int out_size, void* d_ws, size_t ws_size, hipStream_t stream) {
    static int grid = 0;
    if (grid == 0) {
        if (n_in != 34 || (size_t)out_size != O_END || ws_size < WS_END) { fprintf(stderr, "kernel_launch: unexpected sizes n_in %d out %d ws %zu (need %zu)\n", n_in, out_size, ws_size, (size_t)WS_END); grid = -1; return; }
        int dev = 0, cus = 0;
        (void)hipGetDevice(&dev); (void)hipDeviceGetAttribute(&cus, hipDeviceAttributeMultiprocessorCount, dev);
        bool ok = true;
#if N_LAUNCH == 1
        ok = setup_kernel<0xffff>();
#else
        ok = setup_kernel<0x3fef>() && setup_kernel<0x0010>();
#endif
        if (!ok) { grid = -1; return; }
        grid = cus;
        if (grid < 64) { fprintf(stderr, "kernel_launch: needs >= 64 CUs\n"); grid = -1; return; }
    }
    if (grid < 0) return;
    Params p{};
    for (int i = 0; i < 34; ++i) p.in[i] = (const float*)d_in[i];
    p.out = (float*)d_out; p.ws = (unsigned char*)d_ws;
#if N_LAUNCH == 1
#ifndef PROBE_K
#define PROBE_K -1
#endif
#ifndef PROBE_BACK
#define PROBE_BACK 0
#endif
    if (PROBE_K >= 0) { launch_range<0xffff>(p, 0, PROBE_K + 1, grid, stream); launch_range<0xffff>(p, PROBE_K - PROBE_BACK, 16, grid, stream); }
    else launch_range<0xffff>(p, 0, 16, grid, stream);
#else
#ifndef DBG_HI
#define DBG_HI 14
#endif
    launch_range<0x3fef>(p, 0, DBG_HI < 4 ? DBG_HI : 4, grid, stream);
    if (DBG_HI > 4) launch_range<0x0010>(p, 4, 5, grid, stream);
    if (DBG_HI > 5) launch_range<0x3fef>(p, 5, DBG_HI, grid, stream);
#endif
}
```

```cpp
#include <hip/hip_runtime.h>
#include <hip/hip_cooperative_groups.h>
#include <cstdio>
namespace cg = cooperative_groups;
namespace pg8 {
#define PG8_LAS __attribute__((address_space(3)))
typedef unsigned short bf16_t;
typedef short bf16x8 __attribute__((ext_vector_type(8)));
typedef float f32x4 __attribute__((ext_vector_type(4)));
typedef unsigned u32x4 __attribute__((ext_vector_type(4)));
constexpr int BM = 256, BK = 64, HALF = 128, HTB = HALF * BK * 2  , STAGE_BYTES = 8 * HTB, NXCD = 8, WGM = 8;

__host__ __device__ __forceinline__ int lds_byte(int r, int c) { const int st = (r >> 4) * 2 + (c >> 5), rr = r & 15, cc = c & 31, ob = rr * 64 + cc * 2; return st * 1024 + (ob ^ (((ob >> 9) & 1) << 5)); }
__host__ __device__ __forceinline__ void stage_rc(int b, int& R, int& C) { const int st = b / 1024, sb = b % 1024, swz = sb ^ (((sb >> 9) & 1) << 5); R = (st >> 1) * 16 + swz / 64; C = (st & 1) * 32 + (swz % 64) / 2; }
__host__ __device__ __forceinline__ int perm32(int rho) { const int n = rho >> 4, i = rho & 15; return 8 * (i >> 2) + 4 * n + (i & 3); }

struct Unit { int pm, pn; };
struct Gemm { const bf16_t* A; const bf16_t* Bt; int M, N, K, lda, ldb; };
struct StaticOrder {
    int nM, nN, nwg, G, c;
    __host__ __device__ void init(int M, int N, int G_, int c_) { nM = M / BM; nN = N / BM; nwg = nM * nN; G = G_; c = c_; }
    __host__ __device__ bool next(int i, Unit& u) const {
        const long L = (long)i * G + c; if (L >= nwg) return false;
        int wgid = (int)L; { const int q = nwg / NXCD, r = nwg % NXCD, xcd = wgid % NXCD, off = wgid / NXCD; wgid = (xcd < r ? xcd * (q + 1) : r * (q + 1) + (xcd - r) * q) + off; }
        const int nig = WGM * nN, gid = wgid / nig, fm = gid * WGM, gsz = (nM - fm) < WGM ? (nM - fm) : WGM;
        u.pm = fm + ((wgid % nig) % gsz); u.pn = (wgid % nig) / gsz; return true;
    }
    __device__ __forceinline__ void a_ready(const Unit&) const {}
    __device__ __forceinline__ void done(const Unit&) const {}
};
__device__ __forceinline__ unsigned cvt_pk_bf16(float lo, float hi) { unsigned r; asm volatile("v_cvt_pk_bf16_f32 %0, %1, %2" : "=v"(r) : "v"(lo), "v"(hi)); return r; }
template <class Epi, class Sched>
__device__ __forceinline__ void gemm_phase(PG8_LAS unsigned char* lds, const Gemm g, const Sched& S, const Epi& E) {
    const int tid = threadIdx.x, wid = __builtin_amdgcn_readfirstlane(tid >> 6), lane = tid & 63, wr = wid >> 2, wc = wid & 3, fr = lane & 15, fq = lane >> 4;
    const int K = g.K, nt = K / BK;
    unsigned voffA[2], voffB[2];
#pragma unroll
    for (int i = 0; i < 2; ++i) { int R, C; stage_rc(tid * 16 + i * 8192, R, C); const int Rb = Epi::PERM ? ((R & ~31) + perm32(R & 31)) : R;
        voffA[i] = (unsigned)(R * g.lda + C) * 2u; voffB[i] = (unsigned)(Rb * g.ldb + C) * 2u; }
    const size_t kstep = (size_t)(BK * 2);
    const size_t hstepA = (size_t)HALF * g.lda * 2, hstepB = (size_t)HALF * g.ldb * 2;
    const size_t tstepA = 2 * hstepA, tstepB = 2 * hstepB;
    const unsigned ldsw = (unsigned)wid * 1024u;
    const int aoff = lds_byte(wr * 64 + fr, fq * 8), boff = lds_byte(wc * 32 + fr, fq * 8);
#define PG8_SA(b, h) (((b) * 2 + (h)) * HTB)
#define PG8_SB(b, h) ((4 + (b) * 2 + (h)) * HTB)
#define PG8_STAGE(bufoff, gbase, voff) do { _Pragma("unroll") for (int _i = 0; _i < 2; ++_i) \
        __builtin_amdgcn_global_load_lds((const unsigned*)((const char*)(gbase) + (voff)[_i]), (PG8_LAS unsigned*)(lds + (bufoff) + ldsw + _i * 8192), 16, 0, 0); } while (0)
#define PG8_LDA(dst, b, h) do { _Pragma("unroll") for (int m = 0; m < 4; ++m) _Pragma("unroll") for (int k = 0; k < 2; ++k) dst[m][k] = *(const PG8_LAS bf16x8*)(lds + PG8_SA(b, h) + aoff + m * 2048 + k * 1024); } while (0)
#define PG8_LDB(dst, b, h) do { _Pragma("unroll") for (int n = 0; n < 2; ++n) _Pragma("unroll") for (int k = 0; k < 2; ++k) dst[n][k] = *(const PG8_LAS bf16x8*)(lds + PG8_SB(b, h) + boff + n * 2048 + k * 1024); } while (0)
#define PG8_MMA(ai, bj, At, Bt) do { __builtin_amdgcn_s_setprio(1); _Pragma("unroll") for (int m = 0; m < 4; ++m) _Pragma("unroll") for (int n = 0; n < 2; ++n) _Pragma("unroll") for (int k = 0; k < 2; ++k) \
        acc[ai][bj][m][n] = __builtin_amdgcn_mfma_f32_16x16x32_bf16(Bt[n][k], At[m][k], acc[ai][bj][m][n], 0, 0, 0); __builtin_amdgcn_s_setprio(0); } while (0)
#define PG8_WAIT_V(n) asm volatile("s_waitcnt vmcnt(" #n ")" ::: "memory")
#define PG8_WAIT_L(n) asm volatile("s_waitcnt lgkmcnt(" #n ")" ::: "memory")
#define PG8_BAR __builtin_amdgcn_s_barrier()
#define PG8_SCHED __builtin_amdgcn_sched_barrier(0)
    Unit cur, nxt; int ui = 0;
    if (!S.next(0, cur)) return;
    f32x4 acc[2][2][4][2];
#pragma unroll
    for (int a = 0; a < 2; ++a)
#pragma unroll
        for (int b = 0; b < 2; ++b)
#pragma unroll
            for (int m = 0; m < 4; ++m)
#pragma unroll
                for (int n = 0; n < 2; ++n) acc[a][b][m][n] = (f32x4){0.f, 0.f, 0.f, 0.f};
    bf16x8 At[4][2], B0[2][2], B1[2][2];
    const char* cA = (const char*)g.A + (size_t)cur.pm * tstepA; const char* cB = (const char*)g.Bt + (size_t)cur.pn * tstepB;
    S.a_ready(cur);
    PG8_STAGE(PG8_SB(0, 0), cB, voffB); PG8_STAGE(PG8_SA(0, 0), cA, voffA); PG8_STAGE(PG8_SB(0, 1), cB + hstepB, voffB); PG8_STAGE(PG8_SA(0, 1), cA + hstepA, voffA);
    if (wr == 1) PG8_BAR;
    PG8_WAIT_V(4); PG8_BAR;
    PG8_STAGE(PG8_SB(1, 0), cB + kstep, voffB); PG8_STAGE(PG8_SA(1, 0), cA + kstep, voffA); PG8_STAGE(PG8_SB(1, 1), cB + hstepB + kstep, voffB);
    PG8_WAIT_V(6); PG8_BAR;
    for (;;) {
        const bool has_next = S.next(ui + 1, nxt);
        const char* nA = has_next ? (const char*)g.A + (size_t)nxt.pm * tstepA : cA; const char* nB = has_next ? (const char*)g.Bt + (size_t)nxt.pn * tstepB : cB;
        for (int t = 0; t < nt; t += 2) {
            const bool last = (t == nt - 2);
            const char* a1 = cA + (size_t)(t + 1) * kstep;
            const char* a2 = last ? nA : cA + (size_t)(t + 2) * kstep; const char* b2 = last ? nB : cB + (size_t)(t + 2) * kstep;
            const char* a3 = a2 + kstep; const char* b3 = b2 + kstep;
            if (last && has_next) S.a_ready(nxt);
            PG8_LDB(B0, 0, 0); PG8_SCHED; PG8_LDA(At, 0, 0); PG8_STAGE(PG8_SA(1, 1), a1 + hstepA, voffA);
            PG8_WAIT_L(8); PG8_BAR; PG8_WAIT_L(0); PG8_MMA(0, 0, At, B0); PG8_BAR; PG8_SCHED;
            PG8_LDB(B1, 0, 1); PG8_STAGE(PG8_SB(0, 0), b2, voffB);
            PG8_BAR; PG8_WAIT_L(0); PG8_MMA(0, 1, At, B1); PG8_BAR;
            PG8_LDA(At, 0, 1); PG8_STAGE(PG8_SA(0, 0), a2, voffA);
            PG8_BAR; PG8_WAIT_L(0); PG8_MMA(1, 0, At, B0); PG8_BAR; PG8_SCHED;
            PG8_STAGE(PG8_SB(0, 1), b2 + hstepB, voffB);
            PG8_WAIT_V(6); PG8_BAR; PG8_MMA(1, 1, At, B1); PG8_BAR;
            PG8_LDB(B0, 1, 0); PG8_SCHED; PG8_LDA(At, 1, 0); PG8_STAGE(PG8_SA(0, 1), a2 + hstepA, voffA);
            PG8_WAIT_L(8); PG8_BAR; PG8_WAIT_L(0); PG8_MMA(0, 0, At, B0); PG8_BAR; PG8_SCHED;
            PG8_LDB(B1, 1, 1); PG8_STAGE(PG8_SB(1, 0), b3, voffB);
            PG8_BAR; PG8_WAIT_L(0); PG8_MMA(0, 1, At, B1); PG8_BAR;
            PG8_LDA(At, 1, 1); PG8_STAGE(PG8_SA(1, 0), a3, voffA);
            PG8_BAR; PG8_WAIT_L(0); PG8_MMA(1, 0, At, B0); PG8_BAR; PG8_SCHED;
            PG8_STAGE(PG8_SB(1, 1), b3 + hstepB, voffB);
            PG8_WAIT_V(6); PG8_BAR; PG8_MMA(1, 1, At, B1); PG8_BAR;
        }
        if constexpr (!Epi::AFTER_DRAIN) { E(acc, cur, wr, wc, fr, fq); S.done(cur); }
        if (!has_next) break;
#pragma unroll
        for (int a = 0; a < 2; ++a)
#pragma unroll
            for (int b = 0; b < 2; ++b)
#pragma unroll
                for (int m = 0; m < 4; ++m)
#pragma unroll
                    for (int n = 0; n < 2; ++n) acc[a][b][m][n] = (f32x4){0.f, 0.f, 0.f, 0.f};
        cur = nxt; cA = nA; cB = nB; ++ui;
    }
    PG8_WAIT_V(0);
    if (wr == 0) PG8_BAR;
    PG8_BAR;
    if constexpr (Epi::AFTER_DRAIN) { E.fused(acc, cur, wr, wc, fr, fq, lds, wid, lane); S.done(cur); }
#undef PG8_SA
#undef PG8_SB
#undef PG8_STAGE
#undef PG8_LDA
#undef PG8_LDB
#undef PG8_MMA
#undef PG8_WAIT_V
#undef PG8_WAIT_L
#undef PG8_BAR
#undef PG8_SCHED
}
}
using pg8::bf16_t; using pg8::bf16x8; using pg8::f32x4; using pg8::u32x4;
typedef short s16x4 __attribute__((ext_vector_type(4)));
typedef unsigned u32x2 __attribute__((ext_vector_type(2)));
#define LAS __attribute__((address_space(3)))

constexpr int MP = 16384, MS = 512, MT = MP + MS, DM = 1024, DFF = 2816, ZLD = 8192, ZSLD = 32;
constexpr int NTHREADS = 512;
constexpr float EPSV = 1e-6f;
constexpr size_t SZ_WGU = 5632ull * 1024 * 2, SZ_WD = 1024ull * 2816 * 2, SZ_WIN = 8448ull * 1024 * 2, SZ_W1K = 1024ull * 1024 * 2;
constexpr size_t WS_WGU1 = 0;
constexpr size_t WS_WD1 = WS_WGU1 + SZ_WGU;
constexpr size_t WS_WIN = WS_WD1 + SZ_WD;
constexpr size_t WS_WBRM = WS_WIN + SZ_WIN;
constexpr size_t WS_WBRG = WS_WBRM + SZ_W1K;
constexpr size_t WS_WOUT = WS_WBRG + SZ_W1K;
constexpr size_t WS_WQ = WS_WOUT + SZ_W1K;
constexpr size_t WS_WO = WS_WQ + SZ_W1K;
constexpr size_t WS_WKV = WS_WO + SZ_W1K;
constexpr size_t WS_WGU2 = WS_WKV + 2 * SZ_W1K;
constexpr size_t WS_WD2 = WS_WGU2 + SZ_WGU;
constexpr size_t WS_ABUF = WS_WD2 + SZ_WD;
constexpr size_t WS_MEMA = WS_ABUF + (size_t)MT * DM * 2;
constexpr size_t WS_MEMKV = WS_MEMA + 2048ull * 1024 * 2;
constexpr size_t WS_XRES = WS_MEMKV + 2048ull * 2048 * 2;
constexpr size_t WS_ZS = WS_XRES + (size_t)MT * DM * 4;
constexpr size_t WS_SS = WS_ZS + (size_t)MT * ZSLD * 4;
constexpr size_t WS_SSQ = WS_SS + 4ull * MT * 16 * 4;
constexpr size_t WS_BEND = WS_SSQ + (size_t)MP * 32 * 4;
constexpr size_t WS_Z = WS_BEND + 1024ull * 128 * 4;
constexpr size_t WS_ABUF2 = WS_Z + (64ull << 20);
constexpr size_t WS_QBUF = WS_Z + (128ull << 20);
constexpr size_t WS_OBUF = WS_Z + (192ull << 20);
constexpr size_t WS_BAR = WS_Z + (size_t)MT * ZLD * 2;
constexpr size_t WS_END = WS_BAR + 16384;
constexpr size_t O_YP = 0, O_YS = 16777216, O_CP = 17301504, O_NP = 18350080, O_MPP = 18354176, O_SP = 18354208, O_MKP = 19402784, O_MVP = 21499936,
                 O_CS = 23597088, O_NS = 40374304, O_MSS = 40439840, O_SS = 40440352, O_END = 57217568;
constexpr int LDS_BYTES = 156 * 1024;

struct Params { const float* in[34]; float* out; unsigned char* ws; int ph_lo, ph_hi; };

typedef float f32x2_t __attribute__((ext_vector_type(2)));
typedef __bf16 bf16x2_t __attribute__((ext_vector_type(2)));
__device__ __forceinline__ unsigned cvt_pk(float lo, float hi) { f32x2_t v = {lo, hi}; bf16x2_t b = __builtin_convertvector(v, bf16x2_t); return __builtin_bit_cast(unsigned, b); }
__device__ __forceinline__ bf16_t f2bf(float x) { return (bf16_t)(cvt_pk(x, 0.f) & 0xffffu); }
__device__ __forceinline__ float bf2f(bf16_t x) { return __uint_as_float(((unsigned)x) << 16); }
__device__ __forceinline__ float bflo(unsigned w) { return __uint_as_float(w << 16); }
__device__ __forceinline__ float bfhi(unsigned w) { return __uint_as_float(w & 0xffff0000u); }
__device__ __forceinline__ float sigmoidf_(float x) { return __builtin_amdgcn_rcpf(1.f + __expf(-x)); }
__device__ __forceinline__ float logsigf_(float x) { return fminf(x, 0.f) - __logf(1.f + __expf(-fabsf(x))); }
__device__ __forceinline__ float rs_of(float ss) { return rsqrtf(ss * (1.f / 1024.f) + EPSV); }
__device__ __forceinline__ float rs_row(const float* ssp, int row) {
    const f32x4* q = (const f32x4*)(ssp + (size_t)row * 16); const f32x4 a = q[0], b = q[1], c = q[2], d = q[3];
    const f32x4 s = (a + b) + (c + d); return rs_of((s[0] + s[1]) + (s[2] + s[3])); }
__device__ __forceinline__ f32x4 mfma16(bf16x8 a, bf16x8 b, f32x4 c) { return __builtin_amdgcn_mfma_f32_16x16x32_bf16(a, b, c, 0, 0, 0); }
__device__ __forceinline__ bf16x8 pack8(f32x4 a, f32x4 b) {
    u32x4 w; w.x = cvt_pk(a[0], a[1]); w.y = cvt_pk(a[2], a[3]); w.z = cvt_pk(b[0], b[1]); w.w = cvt_pk(b[2], b[3]);
    return __builtin_bit_cast(bf16x8, w);
}
__device__ __forceinline__ u32x2 pack4(f32x4 a) { u32x2 w; w.x = cvt_pk(a[0], a[1]); w.y = cvt_pk(a[2], a[3]); return w; }
__device__ __forceinline__ bf16x8 tr_frag(unsigned a0, unsigned a1) {
    s16x4 r0, r1;
    asm volatile("ds_read_b64_tr_b16 %0, %2\n\tds_read_b64_tr_b16 %1, %3\n\ts_waitcnt lgkmcnt(0)" : "=&v"(r0), "=&v"(r1) : "v"(a0), "v"(a1) : "memory");
    return __builtin_shufflevector(r0, r1, 0, 1, 2, 3, 4, 5, 6, 7);
}
__device__ __forceinline__ void tr_frag2(unsigned a0, unsigned a1, unsigned b0, unsigned b1, bf16x8& fa, bf16x8& fb) {
    s16x4 r0, r1, r2, r3;
    asm volatile("ds_read_b64_tr_b16 %0, %4\n\tds_read_b64_tr_b16 %1, %5\n\tds_read_b64_tr_b16 %2, %6\n\tds_read_b64_tr_b16 %3, %7\n\ts_waitcnt lgkmcnt(0)"
                 : "=&v"(r0), "=&v"(r1), "=&v"(r2), "=&v"(r3) : "v"(a0), "v"(a1), "v"(b0), "v"(b1) : "memory");
    fa = __builtin_shufflevector(r0, r1, 0, 1, 2, 3, 4, 5, 6, 7); fb = __builtin_shufflevector(r2, r3, 0, 1, 2, 3, 4, 5, 6, 7);
}
__device__ __forceinline__ void tr_frag4(unsigned a0, unsigned a1, unsigned b0, unsigned b1, unsigned c0, unsigned c1, unsigned d0, unsigned d1, bf16x8& fa, bf16x8& fb, bf16x8& fc, bf16x8& fd) {
    s16x4 r0, r1, r2, r3, r4, r5, r6, r7;
    asm volatile("ds_read_b64_tr_b16 %0, %8\n\tds_read_b64_tr_b16 %1, %9\n\tds_read_b64_tr_b16 %2, %10\n\tds_read_b64_tr_b16 %3, %11\n\t"
                 "ds_read_b64_tr_b16 %4, %12\n\tds_read_b64_tr_b16 %5, %13\n\tds_read_b64_tr_b16 %6, %14\n\tds_read_b64_tr_b16 %7, %15\n\ts_waitcnt lgkmcnt(0)"
                 : "=&v"(r0), "=&v"(r1), "=&v"(r2), "=&v"(r3), "=&v"(r4), "=&v"(r5), "=&v"(r6), "=&v"(r7)
                 : "v"(a0), "v"(a1), "v"(b0), "v"(b1), "v"(c0), "v"(c1), "v"(d0), "v"(d1) : "memory");
    fa = __builtin_shufflevector(r0, r1, 0, 1, 2, 3, 4, 5, 6, 7); fb = __builtin_shufflevector(r2, r3, 0, 1, 2, 3, 4, 5, 6, 7);
    fc = __builtin_shufflevector(r4, r5, 0, 1, 2, 3, 4, 5, 6, 7); fd = __builtin_shufflevector(r6, r7, 0, 1, 2, 3, 4, 5, 6, 7);
}
__device__ __forceinline__ float xsum16_32(float v) { v += __shfl_xor(v, 16); v += __shfl_xor(v, 32); return v; }
__device__ __forceinline__ float xmax16_32(float v) { v = fmaxf(v, __shfl_xor(v, 16)); v = fmaxf(v, __shfl_xor(v, 32)); return v; }
__device__ __forceinline__ float wave_sum(float v) { for (int o = 32; o > 0; o >>= 1) v += __shfl_xor(v, o); return v; }
__device__ __forceinline__ float wave_max(float v) { for (int o = 32; o > 0; o >>= 1) v = fmaxf(v, __shfl_xor(v, o)); return v; }

#define XB_TMO      128
#define XB_XCNT(j)  (256  + 64 * (j))
#define XB_XSUB(j)  (1280 + 64 * (j))
#define XB_XGEN(j)  (2304 + 64 * (j))
#define XB_TOP      3328
#define XB_TOPGEN   3392
#define XCD_BAR_WORDS 3456
#define XB_SPIN_CAP (1u << 18)

__device__ __forceinline__ unsigned xb_ld(unsigned* p)              { return __hip_atomic_load(p, __ATOMIC_RELAXED, __HIP_MEMORY_SCOPE_AGENT); }
__device__ __forceinline__ unsigned xb_add(unsigned* p, unsigned v) { return __hip_atomic_fetch_add(p, v, __ATOMIC_RELAXED, __HIP_MEMORY_SCOPE_AGENT); }
__device__ __forceinline__ unsigned xb_xcc_id() { return (unsigned)__builtin_amdgcn_s_getreg((3 << 11) | 20) & 0xFu; }
#define XB_SPIN(cond, bar) do { unsigned _sp = 0; while (cond) { __builtin_amdgcn_s_sleep(1); \
    if ((++_sp & 255u) == 0u) { if (xb_ld(&(bar)[XB_TMO])) break; if (_sp > XB_SPIN_CAP) { atomicAdd(&(bar)[XB_TMO], 1u); break; } } } } while (0)

struct XcdBarrier {
    unsigned* bar; unsigned x;
    volatile LAS unsigned* st;
};

__device__ __forceinline__ XcdBarrier xcd_barrier_post(unsigned* bar, volatile LAS unsigned* st) {
    XcdBarrier b; b.bar = bar; b.x = xb_xcc_id(); b.st = st;
    if (threadIdx.x == 0) (void)xb_add(&bar[XB_XCNT(b.x)], 1u);
    return b;
}
__device__ __forceinline__ void xcd_barrier_complete(unsigned* bar, unsigned x, unsigned& nloc, unsigned& nx) {
    const unsigned G = gridDim.x * gridDim.y * gridDim.z;
    unsigned sum, cnt, mine, sp = 0u;
    for (;;) {
        sum = 0u; cnt = 0u; mine = 0u;
#pragma unroll
        for (unsigned j = 0; j < 16; ++j) { const unsigned c = xb_ld(&bar[XB_XCNT(j)]); sum += c; cnt += (c > 0u) ? 1u : 0u; mine = (j == x) ? c : mine; }
        if (sum == G) break;
        __builtin_amdgcn_s_sleep(1);
        if ((++sp & 255u) == 0u) { if (xb_ld(&bar[XB_TMO])) break; if (sp > XB_SPIN_CAP) { atomicAdd(&bar[XB_TMO], 1u); break; } }
    }
    nloc = mine > 0u ? mine : 1u; nx = cnt > 0u ? cnt : 1u;
}

__device__ __forceinline__ void xcd_barrier(const XcdBarrier& b) {
    asm volatile("s_waitcnt vmcnt(0)" ::: "memory");
    __syncthreads();
    if (threadIdx.x == 0) {
        unsigned* bar = b.bar;
        __builtin_amdgcn_s_waitcnt(0);
        unsigned nloc = b.st[0], nx = b.st[1];
        if (nloc == 0u) { xcd_barrier_complete(bar, b.x, nloc, nx); b.st[0] = nloc; b.st[1] = nx; }
        const unsigned old = xb_add(&bar[XB_XSUB(b.x)], 1u);
        const unsigned gen = old / nloc;
        if (old + 1u == (gen + 1u) * nloc) {
            __builtin_amdgcn_fence(__ATOMIC_RELEASE, "agent");
            asm volatile("s_waitcnt vmcnt(0)" ::: "memory");
            const unsigned og = xb_add(&bar[XB_TOP], 1u);
            const unsigned tg = og / nx;
            if (og + 1u == (tg + 1u) * nx) xb_add(&bar[XB_TOPGEN], 1u);
            else XB_SPIN(xb_ld(&bar[XB_TOPGEN]) == tg, bar);
            __builtin_amdgcn_fence(__ATOMIC_ACQUIRE, "agent");
            xb_add(&bar[XB_XGEN(b.x)], 1u);
            asm volatile("s_waitcnt vmcnt(0)" ::: "memory");
        } else {
            XB_SPIN(xb_ld(&bar[XB_XGEN(b.x)]) == gen, bar);
            __builtin_amdgcn_fence(__ATOMIC_ACQUIRE, "agent");
            asm volatile("s_waitcnt vmcnt(0)" ::: "memory");
        }
    }
    __syncthreads();
}


constexpr int PREP_EARLY_MASK = 0x060f, PREP_LATE_MASK = 0x39f0;
__device__ __forceinline__ int win_src_col(int r) {
    if (r < 3072) return r; if (r < 6144) return r + 8; if (r < 8192) return r + 24;
    if (r < 8200) return 3072 + (r - 8192); if (r < 8216) return 6152 + (r - 8200); return -1;
}
__device__ __forceinline__ void prep_transposes(const Params& p, unsigned char* lds, int dmask, int vb, int nvb) {
    float* tile = (float*)lds;
    const int tid = threadIdx.x;
    unsigned char* ws = p.ws;
    for (int d = 0; d < 14; ++d) {
        if (!((dmask >> d) & 1)) continue;
        const float* src; bf16_t* dst; int K, ldsrc, ntn, mode = 0, rowoff = 0; float scale = 1.f;
        switch (d) {
            case 0: src = p.in[10]; dst = (bf16_t*)(ws + WS_WGU1); K = 1024; ldsrc = 2816; ntn = 44; mode = 2; rowoff = 0; break;
            case 1: src = p.in[11]; dst = (bf16_t*)(ws + WS_WGU1); K = 1024; ldsrc = 2816; ntn = 44; mode = 2; rowoff = 128; break;
            case 2: src = p.in[12]; dst = (bf16_t*)(ws + WS_WD1); K = 2816; ldsrc = 1024; ntn = 16; break;
            case 3: src = p.in[14]; dst = (bf16_t*)(ws + WS_WIN); K = 1024; ldsrc = 8216; ntn = 132; mode = 1; break;
            case 4: src = p.in[20]; dst = (bf16_t*)(ws + WS_WBRM); K = 1024; ldsrc = 1024; ntn = 16; break;
            case 5: src = p.in[21]; dst = (bf16_t*)(ws + WS_WBRG); K = 1024; ldsrc = 1024; ntn = 16; break;
            case 6: src = p.in[22]; dst = (bf16_t*)(ws + WS_WOUT); K = 1024; ldsrc = 1024; ntn = 16; break;
            case 7: src = p.in[25]; dst = (bf16_t*)(ws + WS_WQ); K = 1024; ldsrc = 1024; ntn = 16; scale = 0.0625f; break;
            case 8: src = p.in[28]; dst = (bf16_t*)(ws + WS_WO); K = 1024; ldsrc = 1024; ntn = 16; break;
            case 9: src = p.in[26]; dst = (bf16_t*)(ws + WS_WKV); K = 1024; ldsrc = 1024; ntn = 16; break;
            case 10: src = p.in[27]; dst = (bf16_t*)(ws + WS_WKV); K = 1024; ldsrc = 1024; ntn = 16; rowoff = 1024; break;
            case 11: src = p.in[30]; dst = (bf16_t*)(ws + WS_WGU2); K = 1024; ldsrc = 2816; ntn = 44; mode = 2; rowoff = 0; break;
            case 12: src = p.in[31]; dst = (bf16_t*)(ws + WS_WGU2); K = 1024; ldsrc = 2816; ntn = 44; mode = 2; rowoff = 128; break;
            default: src = p.in[32]; dst = (bf16_t*)(ws + WS_WD2); K = 2816; ldsrc = 1024; ntn = 16; break;
        }
        const int nkt = K / 64, ntiles = nkt * ntn;
        for (int t = vb; t < ntiles; t += nvb) {
            const int kt = t % nkt, nt = t / nkt, k0 = kt * 64;
            {
                const int j = tid & 63;
                int srccol; float sc = scale;
                if (mode == 1) { srccol = win_src_col(nt * 64 + j); if ((srccol >= 512 && srccol < 1024) || (srccol >= 3080 && srccol < 3592)) sc = 0.08838834764831845f; }
                else srccol = nt * 64 + j;
#pragma unroll
                for (int ps = 0; ps < 8; ++ps) { const int i = (tid >> 6) + 8 * ps;
                    float v = 0.f; if (srccol >= 0) v = __builtin_nontemporal_load(src + (size_t)(k0 + i) * ldsrc + srccol) * sc;
                    tile[i * 65 + j] = v; }
            }
            __syncthreads();
            {
                const int j = tid >> 3, kc = tid & 7;
                int dstrow;
                if (mode == 1) dstrow = nt * 64 + j;
                else { const int sc_ = nt * 64 + j; dstrow = (mode == 2) ? ((sc_ >> 7) * 256 + (sc_ & 127) + rowoff) : (sc_ + rowoff); }
                float v[8];
#pragma unroll
                for (int e = 0; e < 8; ++e) v[e] = tile[(kc * 8 + e) * 65 + j];
                u32x4 w; w.x = cvt_pk(v[0], v[1]); w.y = cvt_pk(v[2], v[3]); w.z = cvt_pk(v[4], v[5]); w.w = cvt_pk(v[6], v[7]);
                *(u32x4*)(dst + (size_t)dstrow * K + k0 + kc * 8) = w;
            }
            __syncthreads();
        }
    }
}
__device__ __forceinline__ void prep_phase(const Params& p, unsigned char* lds) {
    const int tid = threadIdx.x;
    unsigned char* ws = p.ws;
    prep_transposes(p, lds, PREP_EARLY_MASK, (int)blockIdx.x, (int)gridDim.x);
    const int lane = tid & 63, gw = blockIdx.x * 8 + (tid >> 6), nw = gridDim.x * 8;
    for (int r = gw; r < MT + 2048; r += nw) {
        const float* x; const float* g; bf16_t* o;
        if (r < MP) { x = p.in[0] + (size_t)r * DM; g = p.in[9]; o = (bf16_t*)(ws + WS_ABUF) + (size_t)r * DM; }
        else if (r < MT) { x = p.in[1] + (size_t)(r - MP) * DM; g = p.in[9]; o = (bf16_t*)(ws + WS_ABUF) + (size_t)r * DM; }
        else { x = p.in[2] + (size_t)(r - MT) * DM; g = p.in[24]; o = (bf16_t*)(ws + WS_MEMA) + (size_t)(r - MT) * DM; }
        f32x4 v[4]; float ss = 0.f;
#pragma unroll
        for (int i = 0; i < 4; ++i) { v[i] = *(const f32x4*)(x + i * 256 + lane * 4); ss += v[i][0] * v[i][0] + v[i][1] * v[i][1] + v[i][2] * v[i][2] + v[i][3] * v[i][3]; }
        ss = wave_sum(ss); const float rs = rs_of(ss);
#pragma unroll
        for (int i = 0; i < 4; ++i) { const f32x4 gg = *(const f32x4*)(g + i * 256 + lane * 4);
            u32x2 w; w.x = cvt_pk(v[i][0] * rs * gg[0], v[i][1] * rs * gg[1]); w.y = cvt_pk(v[i][2] * rs * gg[2], v[i][3] * rs * gg[3]);
            *(u32x2*)(o + i * 256 + lane * 4) = w; }
    }
}

#define EPI_ROW(ai, m) (u.pm * 256 + (ai) * 128 + wr * 64 + (m) * 16 + fr)
#define EPI_COL(bj) (u.pn * 256 + (bj) * 128 + wc * 32 + fq * 8)
struct EpiGateUp {
    static constexpr bool PERM = true, AFTER_DRAIN = false;
    bf16_t* H; const float* ss;
    __device__ __forceinline__ void operator()(const f32x4 (&acc)[2][2][4][2], const pg8::Unit& u, int wr, int wc, int fr, int fq) const {
        float rsv[2][4];
#pragma unroll
        for (int ai = 0; ai < 2; ++ai)
#pragma unroll
            for (int m = 0; m < 4; ++m) rsv[ai][m] = ss ? rs_row(ss, EPI_ROW(ai, m)) : 1.f;
#pragma unroll
        for (int ai = 0; ai < 2; ++ai)
#pragma unroll
            for (int m = 0; m < 4; ++m) { const int row = EPI_ROW(ai, m); const float rs = rsv[ai][m];
                f32x4 hv[2];
#pragma unroll
                for (int n = 0; n < 2; ++n)
#pragma unroll
                    for (int j = 0; j < 4; ++j) { const float gt = acc[ai][0][m][n][j] * rs, up = acc[ai][1][m][n][j] * rs; hv[n][j] = gt * sigmoidf_(gt) * up; }
                *(u32x4*)(H + (size_t)row * DFF + u.pn * 128 + wc * 32 + fq * 8) = __builtin_bit_cast(u32x4, pack8(hv[0], hv[1])); }
    }
};
struct EpiMemKV {
    static constexpr bool PERM = true, AFTER_DRAIN = false;
    float* ok; float* ov; bf16_t* kv;
    __device__ __forceinline__ void operator()(const f32x4 (&acc)[2][2][4][2], const pg8::Unit& u, int wr, int wc, int fr, int fq) const {
#pragma unroll
        for (int ai = 0; ai < 2; ++ai)
#pragma unroll
            for (int m = 0; m < 4; ++m) { const int row = EPI_ROW(ai, m);
#pragma unroll
                for (int bj = 0; bj < 2; ++bj) { const int col = EPI_COL(bj);
                    float* o = (col < 1024) ? (ok + (size_t)row * 1024 + col) : (ov + (size_t)row * 1024 + (col - 1024));
                    __builtin_nontemporal_store(acc[ai][bj][m][0], (f32x4*)o); __builtin_nontemporal_store(acc[ai][bj][m][1], (f32x4*)(o + 4));
                    *(u32x4*)(kv + (size_t)row * 2048 + col) = __builtin_bit_cast(u32x4, pack8(acc[ai][bj][m][0], acc[ai][bj][m][1])); } }
    }
};
struct EpiResid {
    static constexpr bool PERM = true, AFTER_DRAIN = false;
    const float* res0; const float* res1; float* xout; bf16_t* aout; const float* gain; float* ss; float scale;
    __device__ __forceinline__ void operator()(const f32x4 (&acc)[2][2][4][2], const pg8::Unit& u, int wr, int wc, int fr, int fq) const {
        f32x4 gv[2][2];
        if (aout) {
#pragma unroll
            for (int bj = 0; bj < 2; ++bj) { gv[bj][0] = *(const f32x4*)(gain + EPI_COL(bj)); gv[bj][1] = *(const f32x4*)(gain + EPI_COL(bj) + 4); } }
#pragma unroll
        for (int ai = 0; ai < 2; ++ai) {
            f32x4 rv[4][2][2];
#pragma unroll
            for (int m = 0; m < 4; ++m) { const int row = EPI_ROW(ai, m);
                const float* rp = (row < MP) ? (res0 + (size_t)row * DM) : (res1 + (size_t)(row - MP) * DM);
#pragma unroll
                for (int bj = 0; bj < 2; ++bj) { rv[m][bj][0] = *(const f32x4*)(rp + EPI_COL(bj)); rv[m][bj][1] = *(const f32x4*)(rp + EPI_COL(bj) + 4); } }
#pragma unroll
            for (int m = 0; m < 4; ++m) { const int row = EPI_ROW(ai, m);
                float sq = 0.f;
#pragma unroll
                for (int bj = 0; bj < 2; ++bj) { const int col = EPI_COL(bj);
                    const f32x4 x0 = rv[m][bj][0] + acc[ai][bj][m][0] * scale, x1 = rv[m][bj][1] + acc[ai][bj][m][1] * scale;
                    *(f32x4*)(xout + (size_t)row * DM + col) = x0; *(f32x4*)(xout + (size_t)row * DM + col + 4) = x1;
#pragma unroll
                    for (int j = 0; j < 4; ++j) sq += x0[j] * x0[j] + x1[j] * x1[j];
                    if (aout) *(u32x4*)(aout + (size_t)row * DM + col) = __builtin_bit_cast(u32x4, pack8(x0 * gv[bj][0], x1 * gv[bj][1])); }
                sq = xsum16_32(sq);
                if (fq == 0) ss[(size_t)row * 16 + u.pn * 4 + wc] = sq; }
        }
    }
    __device__ __forceinline__ void small(f32x4 acc, int row, int col, int tc, int rt, int ct, int l16, int g, unsigned char* lds) const {
        const f32x4 x = *(const f32x4*)(res1 + (size_t)(row - MP) * DM + col) + acc * scale;
        *(f32x4*)(xout + (size_t)row * DM + col) = x;
        if (aout) { const f32x4 gv4 = *(const f32x4*)(gain + col); *(u32x2*)(aout + (size_t)row * DM + col) = pack4(x * gv4); }
        float sq = x[0] * x[0] + x[1] * x[1] + x[2] * x[2] + x[3] * x[3];
        sq = xsum16_32(sq);
        float* red = (float*)lds;
        if (g == 0) red[(rt * 4 + ct) * 16 + l16] = sq;
        __syncthreads();
        if (ct == 0 && g == 0) ss[(size_t)row * 16 + tc] = (red[(rt * 4) * 16 + l16] + red[(rt * 4 + 1) * 16 + l16]) + (red[(rt * 4 + 2) * 16 + l16] + red[(rt * 4 + 3) * 16 + l16]);
        __syncthreads();
    }
};
struct EpiZ {
    static constexpr bool PERM = true, AFTER_DRAIN = false;
    bf16_t* Z; float* ZS; const float* ss;
    __device__ __forceinline__ void operator()(const f32x4 (&acc)[2][2][4][2], const pg8::Unit& u, int wr, int wc, int fr, int fq) const {
#pragma unroll
        for (int ai = 0; ai < 2; ++ai) {
            float rsv[4];
#pragma unroll
            for (int m = 0; m < 4; ++m) rsv[m] = rs_row(ss, EPI_ROW(ai, m));
#pragma unroll
            for (int m = 0; m < 4; ++m) { const int row = EPI_ROW(ai, m); const float rs = rsv[m];
                if (u.pn < 32) {
#pragma unroll
                    for (int bj = 0; bj < 2; ++bj)
                        *(u32x4*)(Z + (size_t)row * ZLD + EPI_COL(bj)) = __builtin_bit_cast(u32x4, pack8(acc[ai][bj][m][0] * rs, acc[ai][bj][m][1] * rs));
                } else if (wc == 0) {
                    *(f32x4*)(ZS + (size_t)row * ZSLD + fq * 8) = acc[ai][0][m][0] * rs; *(f32x4*)(ZS + (size_t)row * ZSLD + fq * 8 + 4) = acc[ai][0][m][1] * rs;
                } } }
    }
};
template <int MODE> struct EpiMerge {
    static constexpr bool PERM = true, AFTER_DRAIN = false;
    const bf16_t* gate; float* T; bf16_t* Y;
    __device__ __forceinline__ void operator()(const f32x4 (&acc)[2][2][4][2], const pg8::Unit& u, int wr, int wc, int fr, int fq) const {
#pragma unroll
        for (int ai = 0; ai < 2; ++ai)
#pragma unroll
            for (int mh = 0; mh < 2; ++mh) {
                u32x4 gw[2][2]; u32x4 tvb[2][2]; bf16_t* Tb = (bf16_t*)T;
#pragma unroll
                for (int mm = 0; mm < 2; ++mm) { const int row = EPI_ROW(ai, mh * 2 + mm);
#pragma unroll
                    for (int bj = 0; bj < 2; ++bj) { gw[mm][bj] = *(const u32x4*)(gate + (size_t)row * ZLD + EPI_COL(bj));
                        if (MODE == 1) tvb[mm][bj] = *(const u32x4*)(Tb + (size_t)row * DM + EPI_COL(bj)); } }
#pragma unroll
                for (int mm = 0; mm < 2; ++mm) { const int m = mh * 2 + mm, row = EPI_ROW(ai, m);
#pragma unroll
                    for (int bj = 0; bj < 2; ++bj) { const int col = EPI_COL(bj); const u32x4 g4 = gw[mm][bj];
                        f32x4 s0, s1;
                        s0[0] = sigmoidf_(bflo(g4.x)); s0[1] = sigmoidf_(bfhi(g4.x)); s0[2] = sigmoidf_(bflo(g4.y)); s0[3] = sigmoidf_(bfhi(g4.y));
                        s1[0] = sigmoidf_(bflo(g4.z)); s1[1] = sigmoidf_(bfhi(g4.z)); s1[2] = sigmoidf_(bflo(g4.w)); s1[3] = sigmoidf_(bfhi(g4.w));
                        f32x4 v0 = acc[ai][bj][m][0] * s0, v1 = acc[ai][bj][m][1] * s1;
                        if (MODE == 0) *(u32x4*)(Tb + (size_t)row * DM + col) = __builtin_bit_cast(u32x4, pack8(v0, v1));
                        else { const u32x4 t4 = tvb[mm][bj];
                            v0 += (f32x4){bflo(t4.x), bfhi(t4.x), bflo(t4.y), bfhi(t4.y)}; v1 += (f32x4){bflo(t4.z), bfhi(t4.z), bflo(t4.w), bfhi(t4.w)};
                            *(u32x4*)(Y + (size_t)row * DM + col) = __builtin_bit_cast(u32x4, pack8(v0, v1)); } } }
            }
    }
    __device__ __forceinline__ void small(f32x4 acc, int row, int col, int tc, int rt, int ct, int l16, int g, unsigned char* lds) const {
        bf16_t* Tb = (bf16_t*)T;
        const u32x2 g2 = *(const u32x2*)(gate + (size_t)row * ZLD + col);
        f32x4 v = acc * (f32x4){sigmoidf_(bflo(g2.x)), sigmoidf_(bfhi(g2.x)), sigmoidf_(bflo(g2.y)), sigmoidf_(bfhi(g2.y))};
        if (MODE == 0) *(u32x2*)(Tb + (size_t)row * DM + col) = pack4(v);
        else { const u32x2 t2 = *(const u32x2*)(Tb + (size_t)row * DM + col);
            v += (f32x4){bflo(t2.x), bfhi(t2.x), bflo(t2.y), bfhi(t2.y)};
            *(u32x2*)(Y + (size_t)row * DM + col) = pack4(v); }
    }
};
struct EpiQ {
    static constexpr bool PERM = true, AFTER_DRAIN = false;
    bf16_t* Q; const float* ss;
    __device__ __forceinline__ void operator()(const f32x4 (&acc)[2][2][4][2], const pg8::Unit& u, int wr, int wc, int fr, int fq) const {
#pragma unroll
        for (int ai = 0; ai < 2; ++ai) {
            float rsv[4];
#pragma unroll
            for (int m = 0; m < 4; ++m) rsv[m] = rs_row(ss, EPI_ROW(ai, m));
#pragma unroll
            for (int m = 0; m < 4; ++m) { const int row = EPI_ROW(ai, m); const float rs = rsv[m];
#pragma unroll
                for (int bj = 0; bj < 2; ++bj)
                    *(u32x4*)(Q + (size_t)row * DM + EPI_COL(bj)) = __builtin_bit_cast(u32x4, pack8(acc[ai][bj][m][0] * rs, acc[ai][bj][m][1] * rs)); } }
    }
    __device__ __forceinline__ void small(f32x4 acc, int row, int col, int tc, int rt, int ct, int l16, int g, unsigned char* lds) const {
        *(u32x2*)(Q + (size_t)row * DM + col) = pack4(acc * rs_row(ss, row));
    }
};
template <class Epi>
__device__ __forceinline__ void small_gemm(unsigned char* lds, const bf16_t* A, int lda, const bf16_t* Bt, int N, int K, const Epi& E) {
    const int tid = threadIdx.x, w = tid >> 6, lane = tid & 63, g = lane >> 4, l16 = lane & 15;
    const int rt = w >> 2, ct = w & 3, nct = N / 64, ntiles = 16 * nct;
    for (int t = blockIdx.x; t < ntiles; t += gridDim.x) {
        const int tr = t / nct, tc = t - tr * nct;
        const int row = MP + tr * 32 + rt * 16 + l16, colb = tc * 64 + ct * 16;
        const bf16_t* ap = A + (size_t)row * lda + 8 * g;
        const bf16_t* bp = Bt + (size_t)(colb + l16) * K + 8 * g;
        f32x4 acc0 = (f32x4){0.f, 0.f, 0.f, 0.f}, acc1 = acc0;
#pragma unroll 4
        for (int k = 0; k < K; k += 64) {
            acc0 = mfma16(*(const bf16x8*)(bp + k), *(const bf16x8*)(ap + k), acc0);
            acc1 = mfma16(*(const bf16x8*)(bp + k + 32), *(const bf16x8*)(ap + k + 32), acc1);
        }
        E.small(acc0 + acc1, row, colb + 4 * g, tc, rt, ct, l16, g, lds);
    }
}
template <class Epi>
__device__ __forceinline__ void run_gemm(unsigned char* lds, const bf16_t* A, int lda, const bf16_t* Bt, int M, int N, int K, const Epi& E, int rot) {
    pg8::Gemm g; g.A = A; g.Bt = Bt; g.M = M; g.N = N; g.K = K; g.lda = lda; g.ldb = K;
    pg8::StaticOrder S; S.init(M, N, (int)gridDim.x, (int)((blockIdx.x + rot) % gridDim.x));
    pg8::gemm_phase<Epi, pg8::StaticOrder>((PG8_LAS unsigned char*)lds, g, S, E);
    __syncthreads();
}
constexpr int T_STRIDE = 272, V_STRIDE = 528;
constexpr int VQN = 2, VW = 256 / VQN, NVT = VW / 16, NOT = NVT / 2, V2_STRIDE = VW * 2 + 16;
constexpr int M_T0 = 0, M_T1 = 17408, M_TV = 34816, M_TC = M_TV + 64 * V2_STRIDE, M_SM = M_TC + VW * T_STRIDE;
template <int BR>
__device__ __forceinline__ void mixer_prompt(const Params& p, unsigned char* lds, int b, int h, int vq) {
    const int tid = threadIdx.x, w = tid >> 6, lane = tid & 63, g = lane >> 4, l16 = lane & 15, q4 = l16 >> 2, p4 = lane & 3;
    const int tt = w & 3, vh = w >> 2;
    bf16_t* Z = (bf16_t*)(p.ws + WS_Z);
    const float* ZS = (const float*)(p.ws + WS_ZS);
    float* SSQ = (float*)(p.ws + WS_SSQ);
    const float* BEND = (const float*)(p.ws + WS_BEND);
    const int qcol = (BR == 0 ? 0 : 3072) + h * 128, kcol = (BR == 0 ? 512 : 3584) + h * 128;
    const int vcol = (BR == 0 ? 1024 : 4096) + h * 256 + vq * VW, ocol = (BR == 0 ? 2048 : 5120) + h * 256 + vq * VW;
    unsigned char* T0 = lds + M_T0; unsigned char* T1 = lds + M_T1; unsigned char* TV = lds + M_TV; unsigned char* TC = lds + M_TC;
    float* sm = (float*)(lds + M_SM);
    float* gS = sm; float* Mt = sm + 64; float* at = sm + 128; float* emt = sm + 192; float* wsv = sm + 256; float* nvec = sm + 320; float* bend = sm + 448;
    float* misc = sm + 576; float* ssq = sm + 592; float* gaL = sm + 720; float* segtot = sm + 1744; float* waL = sm + 2256;
    const unsigned aT0_ = (unsigned)(size_t)T0, aT1_ = (unsigned)(size_t)T1, aTV_ = (unsigned)(size_t)TV;
    const float* gain = (BR == 0 ? p.in[18] : p.in[19]) + h * 256 + vq * VW;
    const int tloc = 16 * tt + l16;
    f32x4 gn[NOT];
#pragma unroll
    for (int vi = 0; vi < NOT; ++vi) gn[vi] = *(const f32x4*)(gain + (VW / 2) * vh + 16 * vi + 4 * g);
    f32x4 st[NVT];
#pragma unroll
    for (int c = 0; c < NVT; ++c) st[c] = (f32x4){0.f, 0.f, 0.f, 0.f};
    float m0 = 0.f;
    const float bi = (BR == 0) ? p.in[15][h] : 0.f, bfb = (BR == 0) ? p.in[15][4 + h] : 0.f;
    if (tid < 128) nvec[tid] = 0.f;
    u32x4 kreg[2], qreg[2], vreg[2]; bf16x8 qn[4]; float igr = 0.f, lfr = 0.f, gar[2] = {0.f, 0.f};
    const int ks_s0 = tid >> 4, ks_ch = tid & 15;
#define MIX_LOAD_CHUNK(R0) do { const size_t r_ = (size_t)(R0); \
        kreg[0] = *(const u32x4*)(Z + (r_ + ks_s0) * ZLD + kcol + ks_ch * 8); kreg[1] = *(const u32x4*)(Z + (r_ + ks_s0 + 32) * ZLD + kcol + ks_ch * 8); \
        vreg[0] = *(const u32x4*)(Z + (r_ + ks_s0) * ZLD + vcol + ks_ch * 8); vreg[1] = *(const u32x4*)(Z + (r_ + ks_s0 + 32) * ZLD + vcol + ks_ch * 8); \
        if (BR == 0) { _Pragma("unroll") for (int ks = 0; ks < 4; ++ks) qn[ks] = *(const bf16x8*)(Z + (r_ + tloc) * ZLD + qcol + 32 * ks + 8 * g); \
            if (w == 0) { igr = ZS[(r_ + lane) * ZSLD + h]; lfr = ZS[(r_ + lane) * ZSLD + 4 + h]; } } \
        else { qreg[0] = *(const u32x4*)(Z + (r_ + ks_s0) * ZLD + qcol + ks_ch * 8); qreg[1] = *(const u32x4*)(Z + (r_ + ks_s0 + 32) * ZLD + qcol + ks_ch * 8); \
            if (tid < 128) gar[0] = BEND[(r_ >> 6) * 512 + h * 128 + tid]; } } while (0)
    MIX_LOAD_CHUNK(b * 2048);
    __syncthreads();
    for (int c = 0; c < 32; ++c) {
        const int r0 = b * 2048 + c * 64;
        if (c > 0 && tid < 64) { float* sp_ = SSQ + ((size_t)(r0 - 64 + tid) * 8 + BR * 4 + h) * 4 + vq * 2; sp_[0] = ssq[tid] + ssq[64 + tid]; sp_[1] = 0.f; }
        unsigned aT0 = aT0_, aT1 = aT1_, aTV = aTV_;
        asm volatile("" : "+v"(aT0), "+v"(aT1), "+v"(aTV));
        if (BR == 0) {
            if (w == 0) {
                const float ig = igr + bi, lf = logsigf_(lfr + bfb);
                float F = lf;
#pragma unroll
                for (int o = 1; o < 64; o <<= 1) { const float y = __shfl_up(F, o); if (lane >= o) F += y; }
                const float gg = ig - F; float cm = gg;
#pragma unroll
                for (int o = 1; o < 64; o <<= 1) { const float y = __shfl_up(cm, o); if (lane >= o) cm = fmaxf(cm, y); }
                const float M = fmaxf(m0, cm), a = __expf(m0 - M);
                const float ML = __shfl(M, 63), aend = __shfl(a, 63), FL = __shfl(F, 63);
                gS[lane] = gg; Mt[lane] = M; at[lane] = a; emt[lane] = __expf(-(F + M)); wsv[lane] = __expf(gg - ML);
                if (lane == 0) misc[1] = aend;
                m0 = FL + ML;
            }
            __syncthreads();
#pragma unroll
            for (int i = 0; i < 2; ++i) { const int s = ks_s0 + 32 * i; const u32x4 kw = kreg[i];
                *(u32x4*)(T0 + s * T_STRIDE + ks_ch * 16) = kw;
                const float ww = wsv[s]; u32x4 o;
                o.x = cvt_pk(bflo(kw.x) * ww, bfhi(kw.x) * ww); o.y = cvt_pk(bflo(kw.y) * ww, bfhi(kw.y) * ww);
                o.z = cvt_pk(bflo(kw.z) * ww, bfhi(kw.z) * ww); o.w = cvt_pk(bflo(kw.w) * ww, bfhi(kw.w) * ww);
                *(u32x4*)(T1 + s * T_STRIDE + ks_ch * 16) = o; }
        } else {
            if (tid < 128) bend[tid] = gar[0];
#pragma unroll
            for (int i = 0; i < 2; ++i) { const int s = ks_s0 + 32 * i;
                *(u32x4*)(T0 + s * T_STRIDE + ks_ch * 16) = kreg[i]; *(u32x4*)(T1 + s * T_STRIDE + ks_ch * 16) = qreg[i]; }
        }
#pragma unroll
        for (int i = 0; i < 2; ++i) *(u32x4*)(TV + (ks_s0 + 32 * i) * V2_STRIDE + ks_ch * 16) = vreg[i];
#pragma unroll
        for (int c16 = 0; c16 < NVT; ++c16) *(u32x2*)(TC + (16 * c16 + l16) * T_STRIDE + (16 * w + 4 * g) * 2) = pack4(st[c16]);
        __syncthreads();
        bf16x8 qf[4];
#pragma unroll
        for (int ks = 0; ks < 4; ++ks) {
            if (BR == 0) qf[ks] = qn[ks];
            else qf[ks] = *(const bf16x8*)(T1 + tloc * T_STRIDE + (32 * ks + 8 * g) * 2);
        }
        bf16_t* op = Z + (size_t)(r0 + tloc) * ZLD + ocol + (VW / 2) * vh + 4 * g;
        u32x2 gwv[NOT];
#pragma unroll
        for (int vi = 0; vi < NOT; ++vi) gwv[vi] = *(const u32x2*)(op + 16 * vi);
        if (c < 31) MIX_LOAD_CHUNK(r0 + 64);
        f32x4 sacc[4];
#pragma unroll
        for (int si = 0; si < 4; ++si) { sacc[si] = (f32x4){0.f, 0.f, 0.f, 0.f};
#pragma unroll
            for (int ks = 0; ks < 4; ++ks) sacc[si] = mfma16(*(const bf16x8*)(T0 + (16 * si + l16) * T_STRIDE + (32 * ks + 8 * g) * 2), qf[ks], sacc[si]); }
        float den = 0.f;
        {
            const float Mtt = (BR == 0) ? Mt[tloc] : 0.f;
            f32x4 gS4[4];
#pragma unroll
            for (int si = 0; si < 4; ++si) gS4[si] = (BR == 0) ? *(const f32x4*)(gS + 16 * si + 4 * g) : (f32x4){0.f, 0.f, 0.f, 0.f};
#pragma unroll
            for (int si = 0; si < 4; ++si)
#pragma unroll
                for (int r = 0; r < 4; ++r) { const int s = 16 * si + 4 * g + r;
                    float wgt;
                    if (BR == 0) { const float e = __expf(fminf(gS4[si][r] - Mtt, 0.f)); wgt = (s <= tloc) ? e : 0.f; } else wgt = (s <= tloc) ? 1.f : 0.f;
                    sacc[si][r] *= wgt; den += sacc[si][r]; }
        }
        f32x4 oacc[NOT];
#pragma unroll
        for (int vi = 0; vi < NOT; ++vi) { oacc[vi] = (f32x4){0.f, 0.f, 0.f, 0.f};
#pragma unroll
            for (int ks = 0; ks < 4; ++ks) oacc[vi] = mfma16(*(const bf16x8*)(TC + ((VW / 2) * vh + 16 * vi + l16) * T_STRIDE + (32 * ks + 8 * g) * 2), qf[ks], oacc[vi]); }
        if (BR == 0) {
            den = xsum16_32(den);
            const float a_t = at[tloc];
            float nq = 0.f;
#pragma unroll
            for (int ks = 0; ks < 4; ++ks)
#pragma unroll
                for (int j = 0; j < 8; ++j) nq += nvec[32 * ks + 8 * g + j] * bf2f((bf16_t)qf[ks][j]);
            nq = xsum16_32(nq);
            den += a_t * nq;
#pragma unroll
            for (int vi = 0; vi < NOT; ++vi) oacc[vi] *= a_t;
        }
#pragma unroll
        for (int ks = 0; ks < 2; ++ks) {
            const bf16x8 pb = pack8(sacc[2 * ks], sacc[2 * ks + 1]);
#pragma unroll
            for (int vi = 0; vi < NOT; vi += 4) {
                const unsigned a0 = aTV + (32 * ks + 4 * g + q4) * V2_STRIDE + ((VW / 2) * vh + 16 * vi) * 2 + 8 * p4, a1 = a0 + 16 * V2_STRIDE;
                bf16x8 fa, fb, fc, fd; tr_frag4(a0, a1, a0 + 32, a1 + 32, a0 + 64, a1 + 64, a0 + 96, a1 + 96, fa, fb, fc, fd);
                oacc[vi] = mfma16(fa, pb, oacc[vi]); oacc[vi + 1] = mfma16(fb, pb, oacc[vi + 1]); oacc[vi + 2] = mfma16(fc, pb, oacc[vi + 2]); oacc[vi + 3] = mfma16(fd, pb, oacc[vi + 3]); }
        }
        if (BR == 0) { const float inv = 1.f / fmaxf(fabsf(den), emt[tloc]);
#pragma unroll
            for (int vi = 0; vi < NOT; ++vi) oacc[vi] *= inv; }
        float sq = 0.f;
#pragma unroll
        for (int vi = 0; vi < NOT; ++vi)
#pragma unroll
            for (int r = 0; r < 4; ++r) sq += oacc[vi][r] * oacc[vi][r];
        sq = xsum16_32(sq);
        if (g == 0) ssq[vh * 64 + tloc] = sq;
#pragma unroll
        for (int vi = 0; vi < NOT; ++vi) {
            const float gt[4] = {bflo(gwv[vi].x), bfhi(gwv[vi].x), bflo(gwv[vi].y), bfhi(gwv[vi].y)}; f32x4 o;
#pragma unroll
            for (int r = 0; r < 4; ++r) { const float sg = sigmoidf_(gt[r]); o[r] = oacc[vi][r] * gn[vi][r] * (BR == 0 ? sg : gt[r] * sg); }
            *(u32x2*)(op + 16 * vi) = pack4(o); }
        if (BR == 0) { const float aend = misc[1];
#pragma unroll
            for (int c16 = 0; c16 < NVT; ++c16) st[c16] *= aend; }
#pragma unroll
        for (int ks = 0; ks < 2; ++ks) {
            const unsigned ka0 = (BR == 0 ? aT1 : aT0) + (32 * ks + 8 * g + q4) * T_STRIDE + (16 * w) * 2 + 8 * p4;
            const bf16x8 kf = tr_frag(ka0, ka0 + 4 * T_STRIDE);
#pragma unroll
            for (int c16 = 0; c16 < NVT; c16 += 4) {
                const unsigned v0 = aTV + (32 * ks + 8 * g + q4) * V2_STRIDE + (16 * c16) * 2 + 8 * p4, v1 = v0 + 4 * V2_STRIDE;
                bf16x8 fa, fb, fc, fd; tr_frag4(v0, v1, v0 + 32, v1 + 32, v0 + 64, v1 + 64, v0 + 96, v1 + 96, fa, fb, fc, fd);
                st[c16] = mfma16(kf, fa, st[c16]); st[c16 + 1] = mfma16(kf, fb, st[c16 + 1]); st[c16 + 2] = mfma16(kf, fc, st[c16 + 2]); st[c16 + 3] = mfma16(kf, fd, st[c16 + 3]);
            }
        }
        if (BR == 1) {
            float eb[4];
#pragma unroll
            for (int r = 0; r < 4; ++r) eb[r] = __expf(bend[16 * w + 4 * g + r]);
#pragma unroll
            for (int c16 = 0; c16 < NVT; ++c16)
#pragma unroll
                for (int r = 0; r < 4; ++r) st[c16][r] *= eb[r];
        } else {
            const int d = tid & 127, seg = tid >> 7; float a2 = 0.f;
#pragma unroll
            for (int s = 0; s < 16; ++s) a2 += bf2f(*(const bf16_t*)(T1 + (seg * 16 + s) * T_STRIDE + d * 2));
            segtot[seg * 128 + d] = a2;
        }
        __syncthreads();
        if (BR == 0 && tid < 128) nvec[tid] = misc[1] * nvec[tid] + ((segtot[tid] + segtot[128 + tid]) + (segtot[256 + tid] + segtot[384 + tid]));
    }
#undef MIX_LOAD_CHUNK
    if (tid < 64) { float* sp_ = SSQ + ((size_t)(b * 2048 + 31 * 64 + tid) * 8 + BR * 4 + h) * 4 + vq * 2; sp_[0] = ssq[tid] + ssq[64 + tid]; sp_[1] = 0.f; }
    const int bh = b * 4 + h;
    if (BR == 0) {
        float* Co = p.out + O_CP + (size_t)bh * 32768;
#pragma unroll
        for (int c16 = 0; c16 < NVT; ++c16) __builtin_nontemporal_store(st[c16], (f32x4*)(Co + (size_t)(VW * vq + 16 * c16 + l16) * 128 + 16 * w + 4 * g));
        if (vq == 0) { if (tid < 128) p.out[O_NP + bh * 128 + tid] = nvec[tid];
            if (tid == 0) p.out[O_MPP + bh] = m0; }
    } else {
        float* So = p.out + O_SP + (size_t)bh * 32768;
#pragma unroll
        for (int c16 = 0; c16 < NVT; ++c16)
#pragma unroll
            for (int r = 0; r < 4; ++r) So[(size_t)(16 * w + 4 * g + r) * 256 + VW * vq + 16 * c16 + l16] = st[c16][r];
    }
    __syncthreads();
}

__device__ __forceinline__ void gla_prep(const Params& p, unsigned char* lds, int item) {
    const int tid = threadIdx.x, d = tid & 127, seg = tid >> 7;
    const int h = item & 3, c = (item >> 2) & 31, b = item >> 7;
    bf16_t* Z = (bf16_t*)(p.ws + WS_Z);
    const float* ZS = (const float*)(p.ws + WS_ZS);
    float* BEND = (float*)(p.ws + WS_BEND);
    float* gaL = (float*)lds; float* waL = gaL + 1024; float* segtot = waL + 2048;
    const int r0 = b * 2048 + c * 64, qcol = 3072 + h * 128, kcol = 3584 + h * 128;
    gaL[tid] = ZS[(size_t)(r0 + (tid >> 4)) * ZSLD + 8 + (tid & 15)]; gaL[tid + 512] = ZS[(size_t)(r0 + 32 + (tid >> 4)) * ZSLD + 8 + (tid & 15)];
#pragma unroll
    for (int j = 0; j < 4; ++j) { const int id = tid + 512 * j; waL[id] = p.in[16][(id >> 7) * 512 + h * 128 + (id & 127)]; }
    const float ba = p.in[17][h * 128 + d];
    __syncthreads();
    float wa[16];
#pragma unroll
    for (int j = 0; j < 16; ++j) wa[j] = waL[j * 128 + d];
    float la[16]; float run = 0.f;
#pragma unroll
    for (int i = 0; i < 16; ++i) { const int t = seg * 16 + i; float x = ba;
#pragma unroll
        for (int j = 0; j < 16; ++j) x += gaL[t * 16 + j] * wa[j];
        run += logsigf_(x) * 0.0625f; la[i] = run; }
    segtot[seg * 128 + d] = run;
    __syncthreads();
    float pre = 0.f, tot = 0.f;
#pragma unroll
    for (int s2 = 0; s2 < 4; ++s2) { const float v = segtot[s2 * 128 + d]; tot += v; if (s2 < seg) pre += v; }
    if (seg == 0) BEND[(size_t)(b * 32 + c) * 512 + h * 128 + d] = tot;
    bf16_t qv[16], kv[16];
#pragma unroll
    for (int i = 0; i < 16; ++i) { const int t = seg * 16 + i; qv[i] = Z[(size_t)(r0 + t) * ZLD + qcol + d]; kv[i] = Z[(size_t)(r0 + t) * ZLD + kcol + d]; }
#pragma unroll
    for (int i = 0; i < 16; ++i) { const int t = seg * 16 + i; const float bb = la[i] + pre;
        Z[(size_t)(r0 + t) * ZLD + qcol + d] = f2bf(bf2f(qv[i]) * __expf(bb)); Z[(size_t)(r0 + t) * ZLD + kcol + d] = f2bf(bf2f(kv[i]) * __expf(-bb)); }
    __syncthreads();
}

template <int BR>
__device__ __forceinline__ void mixer_sample(const Params& p, unsigned char* lds, int b, int h) {
    const int tid = threadIdx.x, w = tid >> 6, lane = tid & 63;
    bf16_t* Z = (bf16_t*)(p.ws + WS_Z);
    const float* ZS = (const float*)(p.ws + WS_ZS);
    const int qcol = (BR == 0 ? 0 : 3072) + h * 128, kcol = (BR == 0 ? 512 : 3584) + h * 128, vcol = (BR == 0 ? 1024 : 4096) + h * 256, ocol = (BR == 0 ? 2048 : 5120) + h * 256;
    float* sm = (float*)lds;
    float* qa = sm; float* ka = sm + 512; float* kd = sm + 1024; float* dec = sm + 1536; float* vv = sm + 1664; float* qk = sm + 2688; float* sc = sm + 2704;
    float* part = sm + 2752; float* red = sm + 4800;
    const int r0 = MP + 4 * b, bh = b * 4 + h;
    const float* gain = (BR == 0 ? p.in[18] : p.in[19]) + h * 256;
    float a_t[4] = {1.f, 1.f, 1.f, 1.f}, mt[4] = {0.f, 0.f, 0.f, 0.f}, aend = 1.f;
    {
        const int t = tid >> 7, d = tid & 127;
        const float qraw = bf2f(Z[(size_t)(r0 + t) * ZLD + qcol + d]), kraw = bf2f(Z[(size_t)(r0 + t) * ZLD + kcol + d]);
#pragma unroll
        for (int i = 0; i < 2; ++i) { const int id = tid + 512 * i; vv[id] = bf2f(Z[(size_t)(r0 + (id >> 8)) * ZLD + vcol + (id & 255)]); }
        if (BR == 0) {
            const float m0 = p.in[5][bh], bi = p.in[15][h], bfb = p.in[15][4 + h];
            float F = 0.f, cm = -3.0e38f, gg[4], Mv[4];
#pragma unroll
            for (int s = 0; s < 4; ++s) { const float ig = ZS[(size_t)(r0 + s) * ZSLD + h] + bi, lf = logsigf_(ZS[(size_t)(r0 + s) * ZSLD + 4 + h] + bfb);
                F += lf; gg[s] = ig - F; cm = fmaxf(cm, gg[s]); Mv[s] = fmaxf(m0, cm); a_t[s] = __expf(m0 - Mv[s]); mt[s] = F + Mv[s]; }
            aend = a_t[3];
            float wsel = 0.f;
#pragma unroll
            for (int s = 0; s < 4; ++s) { const float ws_ = __expf(gg[s] - Mv[3]); if (s == t) wsel = ws_; }
            qa[tid] = qraw; ka[tid] = kraw; kd[tid] = wsel * kraw;
            if (tid < 128) dec[tid] = aend;
            if (tid == 0) {
#pragma unroll
                for (int s = 0; s < 4; ++s) { sc[16 + s] = gg[s]; sc[20 + s] = Mv[s]; } }
        } else {
            float la[4];
#pragma unroll
            for (int s = 0; s < 4; ++s) { float x = p.in[17][h * 128 + d];
#pragma unroll
                for (int j = 0; j < 16; ++j) x += ZS[(size_t)(r0 + s) * ZSLD + 8 + j] * p.in[16][j * 512 + h * 128 + d];
                la[s] = logsigf_(x) * 0.0625f; }
            float bt = 0.f, bendv = 0.f;
#pragma unroll
            for (int s = 0; s < 4; ++s) { bendv += la[s]; if (s <= t) bt += la[s]; }
            qa[tid] = qraw * __expf(bt); ka[tid] = kraw * __expf(-bt); kd[tid] = kraw * __expf(bendv - bt);
            if (t == 0) dec[d] = __expf(bendv);
        }
    }
    __syncthreads();
    {
        const int pr = tid >> 5, l = tid & 31, t = pr >> 2, s = pr & 3;
        const f32x4 a = *(const f32x4*)(qa + t * 128 + l * 4), k4 = *(const f32x4*)(ka + s * 128 + l * 4);
        float v = a[0] * k4[0] + a[1] * k4[1] + a[2] * k4[2] + a[3] * k4[3];
#pragma unroll
        for (int o = 16; o > 0; o >>= 1) v += __shfl_xor(v, o);
        if (l == 0) { float wgt; if (BR == 0) wgt = (s <= t) ? __expf(sc[16 + s] - sc[20 + t]) : 0.f; else wgt = (s <= t) ? 1.f : 0.f; qk[pr] = v * wgt; }
        if (BR == 0 && tid < 128) {
            const int t2 = tid >> 5;
            const f32x4 n4 = *(const f32x4*)(p.in[4] + (size_t)bh * 128 + l * 4), q4v = *(const f32x4*)(qa + t2 * 128 + l * 4);
            float v2 = n4[0] * q4v[0] + n4[1] * q4v[1] + n4[2] * q4v[2] + n4[3] * q4v[3];
#pragma unroll
            for (int o = 16; o > 0; o >>= 1) v2 += __shfl_xor(v2, o);
            if (l == 0) sc[12 + t2] = v2;
        }
    }
    __syncthreads();
    float hv[4]; int vown; bool owner;
    if (BR == 0) {
        const int l32 = lane & 31, half = lane >> 5;
        const float* C0 = p.in[3] + (size_t)bh * 32768 + 4 * l32;
        float* C1 = p.out + O_CS + (size_t)bh * 32768 + 4 * l32;
        f32x4 qa4[4], kd4[4]; const f32x4 dec4 = *(const f32x4*)(dec + 4 * l32);
#pragma unroll
        for (int t = 0; t < 4; ++t) { qa4[t] = *(const f32x4*)(qa + t * 128 + 4 * l32); kd4[t] = *(const f32x4*)(kd + t * 128 + 4 * l32); }
#pragma unroll
        for (int ib = 0; ib < 16; ib += 8) {
            f32x4 cv[8];
#pragma unroll
            for (int e = 0; e < 8; ++e) cv[e] = __builtin_nontemporal_load((const f32x4*)(C0 + (size_t)(w * 32 + 2 * (ib + e) + half) * 128));
#pragma unroll
            for (int e = 0; e < 8; ++e) { const int v = w * 32 + 2 * (ib + e) + half; const f32x4 c = cv[e];
                float wv[4], pt[4];
#pragma unroll
                for (int s = 0; s < 4; ++s) wv[s] = vv[s * 256 + v];
                f32x4 o = dec4 * c;
#pragma unroll
                for (int s = 0; s < 4; ++s) o += kd4[s] * wv[s];
                __builtin_nontemporal_store(o, (f32x4*)(C1 + (size_t)v * 128));
#pragma unroll
                for (int t = 0; t < 4; ++t) { float x = c[0] * qa4[t][0] + c[1] * qa4[t][1] + c[2] * qa4[t][2] + c[3] * qa4[t][3];
#pragma unroll
                    for (int of = 16; of > 0; of >>= 1) x += __shfl_xor(x, of);
                    pt[t] = x; }
                if (l32 == 0) {
#pragma unroll
                    for (int t = 0; t < 4; ++t) part[t * 256 + v] = pt[t]; }
            }
        }
        if (tid < 128) { float acc = aend * p.in[4][(size_t)bh * 128 + tid];
#pragma unroll
            for (int s = 0; s < 4; ++s) acc += kd[s * 128 + tid];
            p.out[O_NS + (size_t)bh * 128 + tid] = acc; }
        if (tid == 0) p.out[O_MSS + bh] = mt[3];
        __syncthreads();
        vown = tid & 255; owner = (tid < 256);
        {
            float wv2[4];
#pragma unroll
            for (int s = 0; s < 4; ++s) wv2[s] = vv[s * 256 + vown];
#pragma unroll
            for (int t = 0; t < 4; ++t) { float num = a_t[t] * part[t * 256 + vown], den = a_t[t] * sc[12 + t];
#pragma unroll
                for (int s = 0; s < 4; ++s) { num += qk[t * 4 + s] * wv2[s]; den += qk[t * 4 + s]; }
                hv[t] = num / fmaxf(fabsf(den), __expf(-mt[t])); }
        }
    } else {
        const int v4 = lane * 4;
        const float* S0 = p.in[6] + ((size_t)bh * 128 + 16 * w) * 256 + v4;
        float* S1 = p.out + O_SS + ((size_t)bh * 128 + 16 * w) * 256 + v4;
        float* part8 = sm + 4864;
        f32x4 wv4[4], pt4[4];
#pragma unroll
        for (int s = 0; s < 4; ++s) { wv4[s] = *(const f32x4*)(vv + s * 256 + v4); pt4[s] = (f32x4){0.f, 0.f, 0.f, 0.f}; }
#pragma unroll
        for (int jb = 0; jb < 16; jb += 8) {
            f32x4 s0v[8];
#pragma unroll
            for (int e = 0; e < 8; ++e) s0v[e] = __builtin_nontemporal_load((const f32x4*)(S0 + (size_t)(jb + e) * 256));
#pragma unroll
            for (int e = 0; e < 8; ++e) { const int j = jb + e, d = 16 * w + j; const f32x4 s0 = s0v[e];
                f32x4 acc = s0 * dec[d];
#pragma unroll
                for (int t = 0; t < 4; ++t) pt4[t] += s0 * qa[t * 128 + d];
#pragma unroll
                for (int s2 = 0; s2 < 4; ++s2) acc += wv4[s2] * kd[s2 * 128 + d];
                __builtin_nontemporal_store(acc, (f32x4*)(S1 + (size_t)j * 256)); } }
#pragma unroll
        for (int t = 0; t < 4; ++t) *(f32x4*)(part8 + (w * 4 + t) * 256 + v4) = pt4[t];
        __syncthreads();
        vown = tid & 255; owner = (tid < 256);
#pragma unroll
        for (int t = 0; t < 4; ++t) { float num = 0.f;
#pragma unroll
            for (int w2 = 0; w2 < 8; ++w2) num += part8[(w2 * 4 + t) * 256 + vown];
#pragma unroll
            for (int s2 = 0; s2 < 4; ++s2) num += qk[t * 4 + s2] * vv[s2 * 256 + vown];
            hv[t] = num; }
    }
#pragma unroll
    for (int t = 0; t < 4; ++t) { float q2 = owner ? hv[t] * hv[t] : 0.f; q2 = wave_sum(q2); if (lane == 0) red[w * 4 + t] = q2; }
    __syncthreads();
    if (owner) {
#pragma unroll
        for (int t = 0; t < 4; ++t) { float tot = 0.f;
#pragma unroll
            for (int w2 = 0; w2 < 8; ++w2) tot += red[w2 * 4 + t];
            const float rs = rsqrtf(tot * (1.f / 256.f) + EPSV);
            bf16_t* op = Z + (size_t)(r0 + t) * ZLD + ocol + vown;
            const float gt = bf2f(*op), sg = sigmoidf_(gt);
            *op = f2bf(hv[t] * rs * gain[vown] * (BR == 0 ? sg : gt * sg)); }
    }
    __syncthreads();
}

__device__ __forceinline__ void attn_prompt(const Params& p, unsigned char* lds, int item) {
    const int tid = threadIdx.x, w = tid >> 6, lane = tid & 63, g = lane >> 4, l16 = lane & 15, q4 = l16 >> 2, p4 = lane & 3;
    const int qt = item & 15, h = (item >> 4) & 3, b = item >> 6;
    const bf16_t* KV = (const bf16_t*)(p.ws + WS_MEMKV) + (size_t)b * 256 * 2048 + h * 256;
    const bf16_t* Q = (const bf16_t*)(p.ws + WS_QBUF);
    bf16_t* O = (bf16_t*)(p.ws + WS_OBUF);
    const size_t rq = (size_t)b * 2048 + qt * 128 + 16 * w + l16;
    const unsigned aL = (unsigned)(size_t)lds;
#pragma unroll 8
    for (int i = 0; i < 16; ++i) { const int id = tid + 512 * i, key = id >> 5, ch = id & 31;
        *(u32x4*)(lds + key * V_STRIDE + ch * 16) = *(const u32x4*)(KV + (size_t)key * 2048 + ch * 8); }
    __syncthreads();
    f32x4 s[16];
#pragma unroll
    for (int ki = 0; ki < 16; ++ki) s[ki] = (f32x4){0.f, 0.f, 0.f, 0.f};
#pragma unroll
    for (int ks = 0; ks < 8; ++ks) { const bf16x8 qfk = *(const bf16x8*)(Q + rq * DM + h * 256 + 32 * ks + 8 * g);
#pragma unroll
        for (int ki = 0; ki < 16; ++ki) s[ki] = mfma16(*(const bf16x8*)(lds + (16 * ki + l16) * V_STRIDE + (32 * ks + 8 * g) * 2), qfk, s[ki]); }
    float mx = -3.0e38f;
#pragma unroll
    for (int ki = 0; ki < 16; ++ki)
#pragma unroll
        for (int r = 0; r < 4; ++r) mx = fmaxf(mx, s[ki][r]);
    mx = xmax16_32(mx);
    float sum = 0.f;
#pragma unroll
    for (int ki = 0; ki < 16; ++ki)
#pragma unroll
        for (int r = 0; r < 4; ++r) { const float e = __expf(s[ki][r] - mx); s[ki][r] = e; sum += e; }
    sum = xsum16_32(sum);
    bf16x8 pf[8];
#pragma unroll
    for (int ks = 0; ks < 8; ++ks) pf[ks] = pack8(s[2 * ks], s[2 * ks + 1]);
    __syncthreads();
#pragma unroll 8
    for (int i = 0; i < 16; ++i) { const int id = tid + 512 * i, key = id >> 5, ch = id & 31;
        *(u32x4*)(lds + key * V_STRIDE + ch * 16) = *(const u32x4*)(KV + (size_t)key * 2048 + 1024 + ch * 8); }
    __syncthreads();
    const float inv = 1.f / sum;
#pragma unroll
    for (int hh = 0; hh < 2; ++hh) {
        f32x4 o[8];
#pragma unroll
        for (int hi = 0; hi < 8; ++hi) o[hi] = (f32x4){0.f, 0.f, 0.f, 0.f};
#pragma unroll
        for (int ks = 0; ks < 8; ++ks) {
            unsigned aLk = aL + (32 * ks + 4 * g + q4) * V_STRIDE + 8 * p4 + hh * 256;
            asm volatile("" : "+v"(aLk));
#pragma unroll
            for (int hi = 0; hi < 8; hi += 4) {
                const unsigned a0 = aLk + (16 * hi) * 2, a1 = a0 + 16 * V_STRIDE;
                bf16x8 fa, fb, fc, fd; tr_frag4(a0, a1, a0 + 32, a1 + 32, a0 + 64, a1 + 64, a0 + 96, a1 + 96, fa, fb, fc, fd);
                o[hi] = mfma16(fa, pf[ks], o[hi]); o[hi + 1] = mfma16(fb, pf[ks], o[hi + 1]); o[hi + 2] = mfma16(fc, pf[ks], o[hi + 2]); o[hi + 3] = mfma16(fd, pf[ks], o[hi + 3]);
            }
        }
#pragma unroll
        for (int hi = 0; hi < 8; ++hi) *(u32x2*)(O + rq * DM + h * 256 + hh * 128 + 16 * hi + 4 * g) = pack4(o[hi] * inv);
    }
    __syncthreads();
}
__device__ __forceinline__ void attn_sample(const Params& p, unsigned char* lds, int item) {
    const int tid = threadIdx.x, w = tid >> 6, lane = tid & 63;
    const int h = item & 3, b = item >> 2;
    const float* Kc = p.in[7] + ((size_t)b * 1024 + h) * 256;
    const float* Vc = p.in[8] + ((size_t)b * 1024 + h) * 256;
    const bf16_t* Q = (const bf16_t*)(p.ws + WS_QBUF);
    bf16_t* O = (bf16_t*)(p.ws + WS_OBUF);
    float* sc = (float*)lds; float* po = sc + 1024;
    const size_t r0 = MP + 4 * b;
    f32x4 q[4];
#pragma unroll
    for (int t = 0; t < 4; ++t) { const u32x2 qw = *(const u32x2*)(Q + (r0 + t) * DM + h * 256 + lane * 4); q[t] = (f32x4){bflo(qw.x), bfhi(qw.x), bflo(qw.y), bfhi(qw.y)}; }
    {
        const bool b5 = (lane & 32) != 0, b4 = (lane & 16) != 0, b3 = (lane & 8) != 0, b2 = (lane & 4) != 0;
#pragma unroll 2
        for (int kg = 0; kg < 8; ++kg) { const int key0 = w * 32 + kg * 4;
            f32x4 kv[4];
#pragma unroll
            for (int k = 0; k < 4; ++k) kv[k] = __builtin_nontemporal_load((const f32x4*)(Kc + (size_t)(key0 + k) * 1024 + lane * 4));
            float v[16];
#pragma unroll
            for (int k = 0; k < 4; ++k)
#pragma unroll
                for (int t = 0; t < 4; ++t) v[k * 4 + t] = kv[k][0] * q[t][0] + kv[k][1] * q[t][1] + kv[k][2] * q[t][2] + kv[k][3] * q[t][3];
            float a8[8], a4[4], a2[2];
#pragma unroll
            for (int i = 0; i < 8; ++i) { const float keep = b5 ? v[i + 8] : v[i], send = b5 ? v[i] : v[i + 8]; a8[i] = keep + __shfl_xor(send, 32); }
#pragma unroll
            for (int i = 0; i < 4; ++i) { const float keep = b4 ? a8[i + 4] : a8[i], send = b4 ? a8[i] : a8[i + 4]; a4[i] = keep + __shfl_xor(send, 16); }
#pragma unroll
            for (int i = 0; i < 2; ++i) { const float keep = b3 ? a4[i + 2] : a4[i], send = b3 ? a4[i] : a4[i + 2]; a2[i] = keep + __shfl_xor(send, 8); }
            float d = (b2 ? a2[1] : a2[0]) + __shfl_xor(b2 ? a2[0] : a2[1], 4);
            d += __shfl_xor(d, 2); d += __shfl_xor(d, 1);
            if ((lane & 3) == 0) { const int j = (lane >> 2) & 15; sc[(j & 3) * 256 + key0 + (j >> 2)] = d; }
        }
    }
    __syncthreads();
    if (w < 4) { float v[4], mx = -3.0e38f;
#pragma unroll
        for (int i = 0; i < 4; ++i) { v[i] = sc[w * 256 + lane + 64 * i]; mx = fmaxf(mx, v[i]); }
        mx = wave_max(mx); float sum = 0.f;
#pragma unroll
        for (int i = 0; i < 4; ++i) { v[i] = __expf(v[i] - mx); sum += v[i]; }
        sum = wave_sum(sum); const float inv = 1.f / sum;
#pragma unroll
        for (int i = 0; i < 4; ++i) sc[w * 256 + lane + 64 * i] = v[i] * inv; }
    __syncthreads();
    {
        const int hd4 = lane * 4; float* po8 = sc + 1024;
        f32x4 acc4[4];
#pragma unroll
        for (int t = 0; t < 4; ++t) acc4[t] = (f32x4){0.f, 0.f, 0.f, 0.f};
#pragma unroll 8
        for (int kk = 0; kk < 32; ++kk) { const int key = w * 32 + kk; const f32x4 v4 = __builtin_nontemporal_load((const f32x4*)(Vc + (size_t)key * 1024 + hd4));
#pragma unroll
            for (int t = 0; t < 4; ++t) acc4[t] += v4 * sc[t * 256 + key]; }
#pragma unroll
        for (int t = 0; t < 4; ++t) *(f32x4*)(po8 + (w * 4 + t) * 256 + hd4) = acc4[t];
        __syncthreads();
        if (tid < 256) {
#pragma unroll
            for (int t = 0; t < 4; ++t) { float o = 0.f;
#pragma unroll
                for (int w2 = 0; w2 < 8; ++w2) o += po8[(w2 * 4 + t) * 256 + tid];
                O[(r0 + t) * DM + h * 256 + tid] = f2bf(o); } }
    }
    __syncthreads();
}

#ifndef ONLY_PH
#define ONLY_PH -1
#endif
#ifndef MIXEN
#define MIXEN 15
#endif
#ifndef PH_MASK
#define PH_MASK 0xffff
#endif
#define PH_ENABLED(x) ((ONLY_PH < 0 || ONLY_PH == (x)) && ((PH_MASK >> (x)) & 1) && ((KMASK >> (x)) & 1))
__device__ __forceinline__ void grid_barrier(unsigned char* wsb, unsigned char* lds) {
    XcdBarrier b; b.bar = (unsigned*)(wsb + WS_BAR); b.x = xb_xcc_id(); b.st = (volatile LAS unsigned*)(lds + LDS_BYTES - 16);
    xcd_barrier(b);
}
template <int KMASK> __global__ void __launch_bounds__(512, 2) fwd_kernel(Params p) {
    extern __shared__ __attribute__((aligned(16))) unsigned char lds[];
    cg::grid_group grid = cg::this_grid();
    volatile LAS unsigned* xb_st = (volatile LAS unsigned*)(lds + LDS_BYTES - 16);
    if (threadIdx.x == 0) { xb_st[0] = 0u; xb_st[1] = 0u; }
    __syncthreads();
    (void)xcd_barrier_post((unsigned*)(p.ws + WS_BAR), xb_st);
#ifndef DUP_MASK
#define DUP_MASK 0
#endif
#define PH_BEGIN(k) if (PH_ENABLED(k) && p.ph_lo <= (k) && (k) < p.ph_hi) for (int rep_ = 0; rep_ < (((DUP_MASK >> (k)) & 1) ? 2 : 1); ++rep_) { if ((k) > p.ph_lo || rep_) { if (p.ph_hi > 1000) grid.sync(); else grid_barrier(p.ws, lds); } \
        unsigned char* ws; float* outp; { unsigned long long w_ = (unsigned long long)p.ws, o_ = (unsigned long long)p.out; \
        unsigned a0_ = __builtin_amdgcn_readfirstlane((unsigned)w_), a1_ = __builtin_amdgcn_readfirstlane((unsigned)(w_ >> 32)), a2_ = __builtin_amdgcn_readfirstlane((unsigned)o_), a3_ = __builtin_amdgcn_readfirstlane((unsigned)(o_ >> 32)); \
        asm volatile("" : "+s"(a0_), "+s"(a1_), "+s"(a2_), "+s"(a3_)); ws = (unsigned char*)(((unsigned long long)a1_ << 32) | a0_); outp = (float*)(((unsigned long long)a3_ << 32) | a2_); } \
        bf16_t* ABUF = (bf16_t*)(ws + WS_ABUF); bf16_t* Z = (bf16_t*)(ws + WS_Z); float* XRES = (float*)(ws + WS_XRES); float* SS = (float*)(ws + WS_SS); float* TMP = outp + O_YP; \
        (void)ABUF; (void)Z; (void)XRES; (void)SS; (void)TMP;
#define PH_END }
    PH_BEGIN(0) prep_phase(p, lds); PH_END
    PH_BEGIN(1)
        EpiGateUp e1; e1.H = Z; e1.ss = nullptr;
        run_gemm(lds, ABUF, DM, (const bf16_t*)(ws + WS_WGU1), MT, 5632, 1024, e1, 0);
        EpiMemKV e2; e2.ok = outp + O_MKP; e2.ov = outp + O_MVP; e2.kv = (bf16_t*)(ws + WS_MEMKV);
        run_gemm(lds, (const bf16_t*)(ws + WS_MEMA), DM, (const bf16_t*)(ws + WS_WKV), 2048, 2048, 1024, e2, 64);
    PH_END
    PH_BEGIN(2) EpiResid e; e.res0 = p.in[0]; e.res1 = p.in[1]; e.xout = XRES; e.aout = ABUF; e.gain = p.in[13]; e.ss = SS; e.scale = 0.5f;
        run_gemm(lds, Z, DFF, (const bf16_t*)(ws + WS_WD1), MP, 1024, DFF, e, 0); small_gemm(lds, Z, DFF, (const bf16_t*)(ws + WS_WD1), 1024, DFF, e); PH_END
    PH_BEGIN(3) EpiZ e; e.Z = Z; e.ZS = (float*)(ws + WS_ZS); e.ss = SS;
        run_gemm(lds, ABUF, DM, (const bf16_t*)(ws + WS_WIN), MT, 8448, 1024, e, 0); PH_END
    PH_BEGIN(4)
        for (int it = blockIdx.x; it < 1024; it += gridDim.x) gla_prep(p, lds, it);
    PH_END
    PH_BEGIN(5)
        const int bx = (int)blockIdx.x, G = (int)gridDim.x;
        const int NCH = (G >= 256) ? 128 : 0;
        if (bx < NCH || NCH == 0) {
            for (int it0 = bx; it0 < 128; it0 += (NCH ? NCH : G)) { const int it = NCH ? ((((it0 & 7) * 8 + (it0 >> 4)) << 1) | ((it0 >> 3) & 1)) : it0;
                if (it < 64) { if (MIXEN & 1) mixer_prompt<0>(p, lds, it >> 3, (it >> 1) & 3, it & 1); } }
            for (int it0 = bx; it0 < 128; it0 += (NCH ? NCH : G)) { const int it = NCH ? ((((it0 & 7) * 8 + (it0 >> 4)) << 1) | ((it0 >> 3) & 1)) : it0;
                if (it >= 64) { if (MIXEN & 2) mixer_prompt<1>(p, lds, (it - 64) >> 3, (it >> 1) & 3, it & 1); } }
        }
        if (bx >= NCH) {
            for (int it = bx - NCH; it < 512; it += G - NCH) { if (MIXEN & 4) mixer_sample<0>(p, lds, it >> 2, it & 3); }
            for (int it = bx - NCH; it < 512; it += G - NCH) { if (MIXEN & 8) mixer_sample<1>(p, lds, it >> 2, it & 3); }
            prep_transposes(p, lds, PREP_LATE_MASK, bx - NCH, G - NCH);
        }
    PH_END
    PH_BEGIN(6)
        const float* SSQ = (const float*)(ws + WS_SSQ);
        const int lane = threadIdx.x & 63, gw = blockIdx.x * 8 + (threadIdx.x >> 6), nw = gridDim.x * 8;
        for (int i0 = gw; i0 < MP * 8; i0 += 4 * nw) {
            f32x4 sp[4]; u32x2 wv[4];
#pragma unroll
            for (int e = 0; e < 4; ++e) { const int i = i0 + e * nw; if (i < MP * 8) { sp[e] = *(const f32x4*)(SSQ + (size_t)i * 4);
                    wv[e] = *(const u32x2*)(Z + (size_t)(i >> 3) * ZLD + (((i & 7) >> 2) ? 5120 : 2048) + (i & 3) * 256 + lane * 4); } }
#pragma unroll
            for (int e = 0; e < 4; ++e) { const int i = i0 + e * nw; if (i < MP * 8) {
                    const float rs = rsqrtf(((sp[e][0] + sp[e][1]) + (sp[e][2] + sp[e][3])) * (1.f / 256.f) + EPSV);
                    f32x4 o = {bflo(wv[e].x) * rs, bfhi(wv[e].x) * rs, bflo(wv[e].y) * rs, bfhi(wv[e].y) * rs};
                    *(u32x2*)(Z + (size_t)(i >> 3) * ZLD + (((i & 7) >> 2) ? 5120 : 2048) + (i & 3) * 256 + lane * 4) = pack4(o); } }
        }
    PH_END
    PH_BEGIN(7)
        { EpiMerge<0> e; e.gate = Z + 6144; e.T = TMP; e.Y = nullptr;
          run_gemm(lds, Z + 2048, ZLD, (const bf16_t*)(ws + WS_WBRM), MP, 1024, 1024, e, 0); small_gemm(lds, Z + 2048, ZLD, (const bf16_t*)(ws + WS_WBRM), 1024, 1024, e); }
        { EpiMerge<1> e; e.gate = Z + 7168; e.T = TMP; e.Y = ABUF;
          run_gemm(lds, Z + 5120, ZLD, (const bf16_t*)(ws + WS_WBRG), MP, 1024, 1024, e, 0); small_gemm(lds, Z + 5120, ZLD, (const bf16_t*)(ws + WS_WBRG), 1024, 1024, e); }
    PH_END
    PH_BEGIN(9) EpiResid e; e.res0 = XRES; e.res1 = XRES + (size_t)MP * DM; e.xout = XRES; e.aout = (bf16_t*)(ws + WS_ABUF2); e.gain = p.in[23]; e.ss = SS + (size_t)MT * 16; e.scale = 1.f;
        run_gemm(lds, ABUF, DM, (const bf16_t*)(ws + WS_WOUT), MP, 1024, 1024, e, 0); small_gemm(lds, ABUF, DM, (const bf16_t*)(ws + WS_WOUT), 1024, 1024, e); PH_END
    PH_BEGIN(10) EpiQ e; e.Q = (bf16_t*)(ws + WS_QBUF); e.ss = SS + (size_t)MT * 16;
        run_gemm(lds, (const bf16_t*)(ws + WS_ABUF2), DM, (const bf16_t*)(ws + WS_WQ), MP, 1024, 1024, e, 0); small_gemm(lds, (const bf16_t*)(ws + WS_ABUF2), DM, (const bf16_t*)(ws + WS_WQ), 1024, 1024, e); PH_END
    PH_BEGIN(11)
#pragma unroll 1
        for (int pass = 0; pass < 2; ++pass) {
            if (((blockIdx.x & 1) != 0) == (pass == 0)) { for (int it = blockIdx.x; it < 512; it += gridDim.x) attn_sample(p, lds, it); }
            else { for (int it = blockIdx.x; it < 512; it += gridDim.x) attn_prompt(p, lds, it); }
        }
    PH_END
    PH_BEGIN(12) EpiResid e; e.res0 = XRES; e.res1 = XRES + (size_t)MP * DM; e.xout = XRES; e.aout = ABUF; e.gain = p.in[29]; e.ss = SS + (size_t)MT * 32; e.scale = 1.f;
        run_gemm(lds, (const bf16_t*)(ws + WS_OBUF), DM, (const bf16_t*)(ws + WS_WO), MP, 1024, 1024, e, 0); small_gemm(lds, (const bf16_t*)(ws + WS_OBUF), DM, (const bf16_t*)(ws + WS_WO), 1024, 1024, e); PH_END
    PH_BEGIN(13) EpiGateUp e; e.H = Z; e.ss = SS + (size_t)MT * 32;
        run_gemm(lds, ABUF, DM, (const bf16_t*)(ws + WS_WGU2), MT, 5632, 1024, e, 0); PH_END
    PH_BEGIN(14) EpiResid e; e.res0 = XRES; e.res1 = XRES + (size_t)MP * DM; e.xout = TMP; e.aout = nullptr; e.gain = nullptr; e.ss = SS + (size_t)MT * 48; e.scale = 0.5f;
        run_gemm(lds, Z, DFF, (const bf16_t*)(ws + WS_WD2), MP, 1024, DFF, e, 0); small_gemm(lds, Z, DFF, (const bf16_t*)(ws + WS_WD2), 1024, DFF, e); PH_END
    PH_BEGIN(15)
        const int lane = threadIdx.x & 63, gw = blockIdx.x * 8 + (threadIdx.x >> 6), nw = gridDim.x * 8;
        for (int r = gw; r < MT; r += nw) { const float rs = rs_row(SS + (size_t)MT * 48, r); float* y = TMP + (size_t)r * DM;
#pragma unroll
            for (int i = 0; i < 4; ++i) { f32x4 v = *(const f32x4*)(y + i * 256 + lane * 4); const f32x4 gg = *(const f32x4*)(p.in[33] + i * 256 + lane * 4);
                __builtin_nontemporal_store(v * rs * gg, (f32x4*)(y + i * 256 + lane * 4)); } }
    PH_END
}

template <int KMASK> static bool setup_kernel() {
    if (hipFuncSetAttribute((const void*)fwd_kernel<KMASK>, hipFuncAttributeMaxDynamicSharedMemorySize, LDS_BYTES) != hipSuccess) { fprintf(stderr, "kernel_launch: hipFuncSetAttribute failed\n"); return false; }
    int per_cu = 0;
    if (hipOccupancyMaxActiveBlocksPerMultiprocessor(&per_cu, (const void*)fwd_kernel<KMASK>, NTHREADS, LDS_BYTES) != hipSuccess || per_cu < 1) fprintf(stderr, "kernel_launch: occupancy query says %d\n", per_cu);
    (void)hipGetLastError();
    return true;
}
template <int KMASK> static void launch_range(Params p, int lo, int hi, int grid, hipStream_t stream) {
    p.ph_lo = lo; p.ph_hi = hi;
    if (hipMemsetAsync((char*)p.ws + WS_BAR, 0, XCD_BAR_WORDS * 4, stream) != hipSuccess) { fprintf(stderr, "kernel_launch: memset of the barrier words failed\n"); return; }
    void* args[] = {&p};
    hipError_t e = hipLaunchCooperativeKernel((const void*)fwd_kernel<KMASK>, dim3(grid), dim3(NTHREADS), args, LDS_BYTES, stream);
    if (e != hipSuccess) fprintf(stderr, "kernel_launch: cooperative launch [%d,%d) failed: %s (grid %d)\n", lo, hi, hipGetErrorString(e), grid);
}
#ifndef N_LAUNCH
#define N_LAUNCH 1
#endif
extern "C" void kernel_launch(void* const* d_in, const int* in_sizes, int n_in, void* d_out, int out_size, void* d_ws, size_t ws_size, hipStream_t stream) {
    static int grid = 0;
    if (grid == 0) {
        if (n_in != 34 || (size_t)out_size != O_END || ws_size < WS_END) { fprintf(stderr, "kernel_launch: unexpected sizes n_in %d out %d ws %zu (need %zu)\n", n_in, out_size, ws_size, (size_t)WS_END); grid = -1; return; }
        int dev = 0, cus = 0;
        (void)hipGetDevice(&dev); (void)hipDeviceGetAttribute(&cus, hipDeviceAttributeMultiprocessorCount, dev);
        bool ok = true;
#if N_LAUNCH == 1
        ok = setup_kernel<0xffff>();
#else
        ok = setup_kernel<0x3fef>() && setup_kernel<0x0010>();
#endif
        if (!ok) { grid = -1; return; }
        grid = cus;
        if (grid < 64) { fprintf(stderr, "kernel_launch: needs >= 64 CUs\n"); grid = -1; return; }
    }
    if (grid < 0) return;
    Params p{};
    for (int i = 0; i < 34; ++i) p.in[i] = (const float*)d_in[i];
    p.out = (float*)d_out; p.ws = (unsigned char*)d_ws;
#if N_LAUNCH == 1
#ifndef PROBE_K
#define PROBE_K -1
#endif
#ifndef PROBE_BACK
#define PROBE_BACK 0
#endif
    if (PROBE_K >= 0) { launch_range<0xffff>(p, 0, PROBE_K + 1, grid, stream); launch_range<0xffff>(p, PROBE_K - PROBE_BACK, 16, grid, stream); }
    else launch_range<0xffff>(p, 0, 16, grid, stream);
#else
#ifndef DBG_HI
#define DBG_HI 14
#endif
    launch_range<0x3fef>(p, 0, DBG_HI < 4 ? DBG_HI : 4, grid, stream);
    if (DBG_HI > 4) launch_range<0x0010>(p, 4, 5, grid, stream);
    if (DBG_HI > 5) launch_range<0x3fef>(p, 5, DBG_HI, grid, stream);
#endif
}
```

```cpp
#include <hip/hip_runtime.h>
#include <hip/hip_cooperative_groups.h>
#include <cstdio>
namespace cg = cooperative_groups;
namespace pg8 {
#define PG8_LAS __attribute__((address_space(3)))
typedef unsigned short bf16_t;
typedef short bf16x8 __attribute__((ext_vector_type(8)));
typedef float f32x4 __attribute__((ext_vector_type(4)));
typedef unsigned u32x4 __attribute__((ext_vector_type(4)));
constexpr int BM = 256, BK = 64, HALF = 128, HTB = HALF * BK * 2  , STAGE_BYTES = 8 * HTB, NXCD = 8, WGM = 8;

__host__ __device__ __forceinline__ int lds_byte(int r, int c) { const int st = (r >> 4) * 2 + (c >> 5), rr = r & 15, cc = c & 31, ob = rr * 64 + cc * 2; return st * 1024 + (ob ^ (((ob >> 9) & 1) << 5)); }
__host__ __device__ __forceinline__ void stage_rc(int b, int& R, int& C) { const int st = b / 1024, sb = b % 1024, swz = sb ^ (((sb >> 9) & 1) << 5); R = (st >> 1) * 16 + swz / 64; C = (st & 1) * 32 + (swz % 64) / 2; }
__host__ __device__ __forceinline__ int perm32(int rho) { const int n = rho >> 4, i = rho & 15; return 8 * (i >> 2) + 4 * n + (i & 3); }

struct Unit { int pm, pn; };
struct Gemm { const bf16_t* A; const bf16_t* Bt; int M, N, K, lda, ldb; };
struct StaticOrder {
    int nM, nN, nwg, G, c;
    __host__ __device__ void init(int M, int N, int G_, int c_) { nM = M / BM; nN = N / BM; nwg = nM * nN; G = G_; c = c_; }
    __host__ __device__ bool next(int i, Unit& u) const {
        const long L = (long)i * G + c; if (L >= nwg) return false;
        int wgid = (int)L; { const int q = nwg / NXCD, r = nwg % NXCD, xcd = wgid % NXCD, off = wgid / NXCD; wgid = (xcd < r ? xcd * (q + 1) : r * (q + 1) + (xcd - r) * q) + off; }
        const int nig = WGM * nN, gid = wgid / nig, fm = gid * WGM, gsz = (nM - fm) < WGM ? (nM - fm) : WGM;
        u.pm = fm + ((wgid % nig) % gsz); u.pn = (wgid % nig) / gsz; return true;
    }
    __device__ __forceinline__ void a_ready(const Unit&) const {}
    __device__ __forceinline__ void done(const Unit&) const {}
};
__device__ __forceinline__ unsigned cvt_pk_bf16(float lo, float hi) { unsigned r; asm volatile("v_cvt_pk_bf16_f32 %0, %1, %2" : "=v"(r) : "v"(lo), "v"(hi)); return r; }
template <class Epi, class Sched>
__device__ __forceinline__ void gemm_phase(PG8_LAS unsigned char* lds, const Gemm g, const Sched& S, const Epi& E) {
    const int tid = threadIdx.x, wid = __builtin_amdgcn_readfirstlane(tid >> 6), lane = tid & 63, wr = wid >> 2, wc = wid & 3, fr = lane & 15, fq = lane >> 4;
    const int K = g.K, nt = K / BK;
    unsigned voffA[2], voffB[2];
#pragma unroll
    for (int i = 0; i < 2; ++i) { int R, C; stage_rc(tid * 16 + i * 8192, R, C); const int Rb = Epi::PERM ? ((R & ~31) + perm32(R & 31)) : R;
        voffA[i] = (unsigned)(R * g.lda + C) * 2u; voffB[i] = (unsigned)(Rb * g.ldb + C) * 2u; }
    const size_t kstep = (size_t)(BK * 2);
    const size_t hstepA = (size_t)HALF * g.lda * 2, hstepB = (size_t)HALF * g.ldb * 2;
    const size_t tstepA = 2 * hstepA, tstepB = 2 * hstepB;
    const unsigned ldsw = (unsigned)wid * 1024u;
    const int aoff = lds_byte(wr * 64 + fr, fq * 8), boff = lds_byte(wc * 32 + fr, fq * 8);
#define PG8_SA(b, h) (((b) * 2 + (h)) * HTB)
#define PG8_SB(b, h) ((4 + (b) * 2 + (h)) * HTB)
#define PG8_STAGE(bufoff, gbase, voff) do { _Pragma("unroll") for (int _i = 0; _i < 2; ++_i) \
        __builtin_amdgcn_global_load_lds((const unsigned*)((const char*)(gbase) + (voff)[_i]), (PG8_LAS unsigned*)(lds + (bufoff) + ldsw + _i * 8192), 16, 0, 0); } while (0)
#define PG8_LDA(dst, b, h) do { _Pragma("unroll") for (int m = 0; m < 4; ++m) _Pragma("unroll") for (int k = 0; k < 2; ++k) dst[m][k] = *(const PG8_LAS bf16x8*)(lds + PG8_SA(b, h) + aoff + m * 2048 + k * 1024); } while (0)
#define PG8_LDB(dst, b, h) do { _Pragma("unroll") for (int n = 0; n < 2; ++n) _Pragma("unroll") for (int k = 0; k < 2; ++k) dst[n][k] = *(const PG8_LAS bf16x8*)(lds + PG8_SB(b, h) + boff + n * 2048 + k * 1024); } while (0)
#define PG8_MMA(ai, bj, At, Bt) do { __builtin_amdgcn_s_setprio(1); _Pragma("unroll") for (int m = 0; m < 4; ++m) _Pragma("unroll") for (int n = 0; n < 2; ++n) _Pragma("unroll") for (int k = 0; k < 2; ++k) \
        acc[ai][bj][m][n] = __builtin_amdgcn_mfma_f32_16x16x32_bf16(Bt[n][k], At[m][k], acc[ai][bj][m][n], 0, 0, 0); __builtin_amdgcn_s_setprio(0); } while (0)
#define PG8_WAIT_V(n) asm volatile("s_waitcnt vmcnt(" #n ")" ::: "memory")
#define PG8_WAIT_L(n) asm volatile("s_waitcnt lgkmcnt(" #n ")" ::: "memory")
#define PG8_BAR __builtin_amdgcn_s_barrier()
#define PG8_SCHED __builtin_amdgcn_sched_barrier(0)
    Unit cur, nxt; int ui = 0;
    if (!S.next(0, cur)) return;
    f32x4 acc[2][2][4][2];
#pragma unroll
    for (int a = 0; a < 2; ++a)
#pragma unroll
        for (int b = 0; b < 2; ++b)
#pragma unroll
            for (int m = 0; m < 4; ++m)
#pragma unroll
                for (int n = 0; n < 2; ++n) acc[a][b][m][n] = (f32x4){0.f, 0.f, 0.f, 0.f};
    bf16x8 At[4][2], B0[2][2], B1[2][2];
    const char* cA = (const char*)g.A + (size_t)cur.pm * tstepA; const char* cB = (const char*)g.Bt + (size_t)cur.pn * tstepB;
    S.a_ready(cur);
    PG8_STAGE(PG8_SB(0, 0), cB, voffB); PG8_STAGE(PG8_SA(0, 0), cA, voffA); PG8_STAGE(PG8_SB(0, 1), cB + hstepB, voffB); PG8_STAGE(PG8_SA(0, 1), cA + hstepA, voffA);
    if (wr == 1) PG8_BAR;
    PG8_WAIT_V(4); PG8_BAR;
    PG8_STAGE(PG8_SB(1, 0), cB + kstep, voffB); PG8_STAGE(PG8_SA(1, 0), cA + kstep, voffA); PG8_STAGE(PG8_SB(1, 1), cB + hstepB + kstep, voffB);
    PG8_WAIT_V(6); PG8_BAR;
    for (;;) {
        const bool has_next = S.next(ui + 1, nxt);
        const char* nA = has_next ? (const char*)g.A + (size_t)nxt.pm * tstepA : cA; const char* nB = has_next ? (const char*)g.Bt + (size_t)nxt.pn * tstepB : cB;
        for (int t = 0; t < nt; t += 2) {
            const bool last = (t == nt - 2);
            const char* a1 = cA + (size_t)(t + 1) * kstep;
            const char* a2 = last ? nA : cA + (size_t)(t + 2) * kstep; const char* b2 = last ? nB : cB + (size_t)(t + 2) * kstep;
            const char* a3 = a2 + kstep; const char* b3 = b2 + kstep;
            if (last && has_next) S.a_ready(nxt);
            PG8_LDB(B0, 0, 0); PG8_SCHED; PG8_LDA(At, 0, 0); PG8_STAGE(PG8_SA(1, 1), a1 + hstepA, voffA);
            PG8_WAIT_L(8); PG8_BAR; PG8_WAIT_L(0); PG8_MMA(0, 0, At, B0); PG8_BAR; PG8_SCHED;
            PG8_LDB(B1, 0, 1); PG8_STAGE(PG8_SB(0, 0), b2, voffB);
            PG8_BAR; PG8_WAIT_L(0); PG8_MMA(0, 1, At, B1); PG8_BAR;
            PG8_LDA(At, 0, 1); PG8_STAGE(PG8_SA(0, 0), a2, voffA);
            PG8_BAR; PG8_WAIT_L(0); PG8_MMA(1, 0, At, B0); PG8_BAR; PG8_SCHED;
            PG8_STAGE(PG8_SB(0, 1), b2 + hstepB, voffB);
            PG8_WAIT_V(6); PG8_BAR; PG8_MMA(1, 1, At, B1); PG8_BAR;
            PG8_LDB(B0, 1, 0); PG8_SCHED; PG8_LDA(At, 1, 0); PG8_STAGE(PG8_SA(0, 1), a2 + hstepA, voffA);
            PG8_WAIT_L(8); PG8_BAR; PG8_WAIT_L(0); PG8_MMA(0, 0, At, B0); PG8_BAR; PG8_SCHED;
            PG8_LDB(B1, 1, 1); PG8_STAGE(PG8_SB(1, 0), b3, voffB);
            PG8_BAR; PG8_WAIT_L(0); PG8_MMA(0, 1, At, B1); PG8_BAR;
            PG8_LDA(At, 1, 1); PG8_STAGE(PG8_SA(1, 0), a3, voffA);
            PG8_BAR; PG8_WAIT_L(0); PG8_MMA(1, 0, At, B0); PG8_BAR; PG8_SCHED;
            PG8_STAGE(PG8_SB(1, 1), b3 + hstepB, voffB);
            PG8_WAIT_V(6); PG8_BAR; PG8_MMA(1, 1, At, B1); PG8_BAR;
        }
        if constexpr (!Epi::AFTER_DRAIN) { E(acc, cur, wr, wc, fr, fq); S.done(cur); }
        if (!has_next) break;
#pragma unroll
        for (int a = 0; a < 2; ++a)
#pragma unroll
            for (int b = 0; b < 2; ++b)
#pragma unroll
                for (int m = 0; m < 4; ++m)
#pragma unroll
                    for (int n = 0; n < 2; ++n) acc[a][b][m][n] = (f32x4){0.f, 0.f, 0.f, 0.f};
        cur = nxt; cA = nA; cB = nB; ++ui;
    }
    PG8_WAIT_V(0);
    if (wr == 0) PG8_BAR;
    PG8_BAR;
    if constexpr (Epi::AFTER_DRAIN) { E.fused(acc, cur, wr, wc, fr, fq, lds, wid, lane); S.done(cur); }
#undef PG8_SA
#undef PG8_SB
#undef PG8_STAGE
#undef PG8_LDA
#undef PG8_LDB
#undef PG8_MMA
#undef PG8_WAIT_V
#undef PG8_WAIT_L
#undef PG8_BAR
#undef PG8_SCHED
}
}
using pg8::bf16_t; using pg8::bf16x8; using pg8::f32x4; using pg8::u32x4;
typedef short s16x4 __attribute__((ext_vector_type(4)));
typedef unsigned u32x2 __attribute__((ext_vector_type(2)));
#define LAS __attribute__((address_space(3)))

constexpr int MP = 16384, MS = 512, MT = MP + MS, DM = 1024, DFF = 2816, ZLD = 8192, ZSLD = 32;
constexpr int NTHREADS = 512;
constexpr float EPSV = 1e-6f;
constexpr size_t SZ_WGU = 5632ull * 1024 * 2, SZ_WD = 1024ull * 2816 * 2, SZ_WIN = 8448ull * 1024 * 2, SZ_W1K = 1024ull * 1024 * 2;
constexpr size_t WS_WGU1 = 0;
constexpr size_t WS_WD1 = WS_WGU1 + SZ_WGU;
constexpr size_t WS_WIN = WS_WD1 + SZ_WD;
constexpr size_t WS_WBRM = WS_WIN + SZ_WIN;
constexpr size_t WS_WBRG = WS_WBRM + SZ_W1K;
constexpr size_t WS_WOUT = WS_WBRG + SZ_W1K;
constexpr size_t WS_WQ = WS_WOUT + SZ_W1K;
constexpr size_t WS_WO = WS_WQ + SZ_W1K;
constexpr size_t WS_WKV = WS_WO + SZ_W1K;
constexpr size_t WS_WGU2 = WS_WKV + 2 * SZ_W1K;
constexpr size_t WS_WD2 = WS_WGU2 + SZ_WGU;
constexpr size_t WS_ABUF = WS_WD2 + SZ_WD;
constexpr size_t WS_MEMA = WS_ABUF + (size_t)MT * DM * 2;
constexpr size_t WS_MEMKV = WS_MEMA + 2048ull * 1024 * 2;
constexpr size_t WS_XRES = WS_MEMKV + 2048ull * 2048 * 2;
constexpr size_t WS_ZS = WS_XRES + (size_t)MT * DM * 4;
constexpr size_t WS_SS = WS_ZS + (size_t)MT * ZSLD * 4;
constexpr size_t WS_SSQ = WS_SS + 4ull * MT * 16 * 4;
constexpr size_t WS_BEND = WS_SSQ + (size_t)MP * 32 * 4;
constexpr size_t WS_Z = WS_BEND + 1024ull * 128 * 4;
constexpr size_t WS_ABUF2 = WS_Z + (64ull << 20);
constexpr size_t WS_QBUF = WS_Z + (128ull << 20);
constexpr size_t WS_OBUF = WS_Z + (192ull << 20);
constexpr size_t WS_BAR = WS_Z + (size_t)MT * ZLD * 2;
constexpr size_t WS_END = WS_BAR + 16384;
constexpr size_t O_YP = 0, O_YS = 16777216, O_CP = 17301504, O_NP = 18350080, O_MPP = 18354176, O_SP = 18354208, O_MKP = 19402784, O_MVP = 21499936,
                 O_CS = 23597088, O_NS = 40374304, O_MSS = 40439840, O_SS = 40440352, O_END = 57217568;
constexpr int LDS_BYTES = 156 * 1024;

struct Params { const float* in[34]; float* out; unsigned char* ws; int ph_lo, ph_hi; };

typedef float f32x2_t __attribute__((ext_vector_type(2)));
typedef __bf16 bf16x2_t __attribute__((ext_vector_type(2)));
__device__ __forceinline__ unsigned cvt_pk(float lo, float hi) { f32x2_t v = {lo, hi}; bf16x2_t b = __builtin_convertvector(v, bf16x2_t); return __builtin_bit_cast(unsigned, b); }
__device__ __forceinline__ bf16_t f2bf(float x) { return (bf16_t)(cvt_pk(x, 0.f) & 0xffffu); }
__device__ __forceinline__ float bf2f(bf16_t x) { return __uint_as_float(((unsigned)x) << 16); }
__device__ __forceinline__ float bflo(unsigned w) { return __uint_as_float(w << 16); }
__device__ __forceinline__ float bfhi(unsigned w) { return __uint_as_float(w & 0xffff0000u); }
__device__ __forceinline__ float sigmoidf_(float x) { return __builtin_amdgcn_rcpf(1.f + __expf(-x)); }
__device__ __forceinline__ float logsigf_(float x) { return fminf(x, 0.f) - __logf(1.f + __expf(-fabsf(x))); }
__device__ __forceinline__ float rs_of(float ss) { return rsqrtf(ss * (1.f / 1024.f) + EPSV); }
__device__ __forceinline__ float rs_row(const float* ssp, int row) {
    const f32x4* q = (const f32x4*)(ssp + (size_t)row * 16); const f32x4 a = q[0], b = q[1], c = q[2], d = q[3];
    const f32x4 s = (a + b) + (c + d); return rs_of((s[0] + s[1]) + (s[2] + s[3])); }
__device__ __forceinline__ f32x4 mfma16(bf16x8 a, bf16x8 b, f32x4 c) { return __builtin_amdgcn_mfma_f32_16x16x32_bf16(a, b, c, 0, 0, 0); }
__device__ __forceinline__ bf16x8 pack8(f32x4 a, f32x4 b) {
    u32x4 w; w.x = cvt_pk(a[0], a[1]); w.y = cvt_pk(a[2], a[3]); w.z = cvt_pk(b[0], b[1]); w.w = cvt_pk(b[2], b[3]);
    return __builtin_bit_cast(bf16x8, w);
}
__device__ __forceinline__ u32x2 pack4(f32x4 a) { u32x2 w; w.x = cvt_pk(a[0], a[1]); w.y = cvt_pk(a[2], a[3]); return w; }
__device__ __forceinline__ bf16x8 tr_frag(unsigned a0, unsigned a1) {
    s16x4 r0, r1;
    asm volatile("ds_read_b64_tr_b16 %0, %2\n\tds_read_b64_tr_b16 %1, %3\n\ts_waitcnt lgkmcnt(0)" : "=&v"(r0), "=&v"(r1) : "v"(a0), "v"(a1) : "memory");
    return __builtin_shufflevector(r0, r1, 0, 1, 2, 3, 4, 5, 6, 7);
}
__device__ __forceinline__ void tr_frag2(unsigned a0, unsigned a1, unsigned b0, unsigned b1, bf16x8& fa, bf16x8& fb) {
    s16x4 r0, r1, r2, r3;
    asm volatile("ds_read_b64_tr_b16 %0, %4\n\tds_read_b64_tr_b16 %1, %5\n\tds_read_b64_tr_b16 %2, %6\n\tds_read_b64_tr_b16 %3, %7\n\ts_waitcnt lgkmcnt(0)"
                 : "=&v"(r0), "=&v"(r1), "=&v"(r2), "=&v"(r3) : "v"(a0), "v"(a1), "v"(b0), "v"(b1) : "memory");
    fa = __builtin_shufflevector(r0, r1, 0, 1, 2, 3, 4, 5, 6, 7); fb = __builtin_shufflevector(r2, r3, 0, 1, 2, 3, 4, 5, 6, 7);
}
__device__ __forceinline__ void tr_frag4(unsigned a0, unsigned a1, unsigned b0, unsigned b1, unsigned c0, unsigned c1, unsigned d0, unsigned d1, bf16x8& fa, bf16x8& fb, bf16x8& fc, bf16x8& fd) {
    s16x4 r0, r1, r2, r3, r4, r5, r6, r7;
    asm volatile("ds_read_b64_tr_b16 %0, %8\n\tds_read_b64_tr_b16 %1, %9\n\tds_read_b64_tr_b16 %2, %10\n\tds_read_b64_tr_b16 %3, %11\n\t"
                 "ds_read_b64_tr_b16 %4, %12\n\tds_read_b64_tr_b16 %5, %13\n\tds_read_b64_tr_b16 %6, %14\n\tds_read_b64_tr_b16 %7, %15\n\ts_waitcnt lgkmcnt(0)"
                 : "=&v"(r0), "=&v"(r1), "=&v"(r2), "=&v"(r3), "=&v"(r4), "=&v"(r5), "=&v"(r6), "=&v"(r7)
                 : "v"(a0), "v"(a1), "v"(b0), "v"(b1), "v"(c0), "v"(c1), "v"(d0), "v"(d1) : "memory");
    fa = __builtin_shufflevector(r0, r1, 0, 1, 2, 3, 4, 5, 6, 7); fb = __builtin_shufflevector(r2, r3, 0, 1, 2, 3, 4, 5, 6, 7);
    fc = __builtin_shufflevector(r4, r5, 0, 1, 2, 3, 4, 5, 6, 7); fd = __builtin_shufflevector(r6, r7, 0, 1, 2, 3, 4, 5, 6, 7);
}
__device__ __forceinline__ float xsum16_32(float v) { v += __shfl_xor(v, 16); v += __shfl_xor(v, 32); return v; }
__device__ __forceinline__ float xmax16_32(float v) { v = fmaxf(v, __shfl_xor(v, 16)); v = fmaxf(v, __shfl_xor(v, 32)); return v; }
__device__ __forceinline__ float wave_sum(float v) { for (int o = 32; o > 0; o >>= 1) v += __shfl_xor(v, o); return v; }
__device__ __forceinline__ float wave_max(float v) { for (int o = 32; o > 0; o >>= 1) v = fmaxf(v, __shfl_xor(v, o)); return v; }

#define XB_TMO      128
#define XB_XCNT(j)  (256  + 64 * (j))
#define XB_XSUB(j)  (1280 + 64 * (j))
#define XB_XGEN(j)  (2304 + 64 * (j))
#define XB_TOP      3328
#define XB_TOPGEN   3392
#define XCD_BAR_WORDS 3456
#define XB_SPIN_CAP (1u << 18)

__device__ __forceinline__ unsigned xb_ld(unsigned* p)              { return __hip_atomic_load(p, __ATOMIC_RELAXED, __HIP_MEMORY_SCOPE_AGENT); }
__device__ __forceinline__ unsigned xb_add(unsigned* p, unsigned v) { return __hip_atomic_fetch_add(p, v, __ATOMIC_RELAXED, __HIP_MEMORY_SCOPE_AGENT); }
__device__ __forceinline__ unsigned xb_xcc_id() { return (unsigned)__builtin_amdgcn_s_getreg((3 << 11) | 20) & 0xFu; }
#define XB_SPIN(cond, bar) do { unsigned _sp = 0; while (cond) { __builtin_amdgcn_s_sleep(1); \
    if ((++_sp & 255u) == 0u) { if (xb_ld(&(bar)[XB_TMO])) break; if (_sp > XB_SPIN_CAP) { atomicAdd(&(bar)[XB_TMO], 1u); break; } } } } while (0)

struct XcdBarrier {
    unsigned* bar; unsigned x;
    volatile LAS unsigned* st;
};

__device__ __forceinline__ XcdBarrier xcd_barrier_post(unsigned* bar, volatile LAS unsigned* st) {
    XcdBarrier b; b.bar = bar; b.x = xb_xcc_id(); b.st = st;
    if (threadIdx.x == 0) (void)xb_add(&bar[XB_XCNT(b.x)], 1u);
    return b;
}
__device__ __forceinline__ void xcd_barrier_complete(unsigned* bar, unsigned x, unsigned& nloc, unsigned& nx) {
    const unsigned G = gridDim.x * gridDim.y * gridDim.z;
    unsigned sum, cnt, mine, sp = 0u;
    for (;;) {
        sum = 0u; cnt = 0u; mine = 0u;
#pragma unroll
        for (unsigned j = 0; j < 16; ++j) { const unsigned c = xb_ld(&bar[XB_XCNT(j)]); sum += c; cnt += (c > 0u) ? 1u : 0u; mine = (j == x) ? c : mine; }
        if (sum == G) break;
        __builtin_amdgcn_s_sleep(1);
        if ((++sp & 255u) == 0u) { if (xb_ld(&bar[XB_TMO])) break; if (sp > XB_SPIN_CAP) { atomicAdd(&bar[XB_TMO], 1u); break; } }
    }
    nloc = mine > 0u ? mine : 1u; nx = cnt > 0u ? cnt : 1u;
}

__device__ __forceinline__ void xcd_barrier(const XcdBarrier& b) {
    asm volatile("s_waitcnt vmcnt(0)" ::: "memory");
    __syncthreads();
    if (threadIdx.x == 0) {
        unsigned* bar = b.bar;
        __builtin_amdgcn_s_waitcnt(0);
        unsigned nloc = b.st[0], nx = b.st[1];
        if (nloc == 0u) { xcd_barrier_complete(bar, b.x, nloc, nx); b.st[0] = nloc; b.st[1] = nx; }
        const unsigned old = xb_add(&bar[XB_XSUB(b.x)], 1u);
        const unsigned gen = old / nloc;
        if (old + 1u == (gen + 1u) * nloc) {
            __builtin_amdgcn_fence(__ATOMIC_RELEASE, "agent");
            asm volatile("s_waitcnt vmcnt(0)" ::: "memory");
            const unsigned og = xb_add(&bar[XB_TOP], 1u);
            const unsigned tg = og / nx;
            if (og + 1u == (tg + 1u) * nx) xb_add(&bar[XB_TOPGEN], 1u);
            else XB_SPIN(xb_ld(&bar[XB_TOPGEN]) == tg, bar);
            __builtin_amdgcn_fence(__ATOMIC_ACQUIRE, "agent");
            xb_add(&bar[XB_XGEN(b.x)], 1u);
            asm volatile("s_waitcnt vmcnt(0)" ::: "memory");
        } else {
            XB_SPIN(xb_ld(&bar[XB_XGEN(b.x)]) == gen, bar);
            __builtin_amdgcn_fence(__ATOMIC_ACQUIRE, "agent");
            asm volatile("s_waitcnt vmcnt(0)" ::: "memory");
        }
    }
    __syncthreads();
}


constexpr int PREP_EARLY_MASK = 0x060f, PREP_LATE_MASK = 0x39f0;
__device__ __forceinline__ int win_src_col(int r) {
    if (r < 3072) return r; if (r < 6144) return r + 8; if (r < 8192) return r + 24;
    if (r < 8200) return 3072 + (r - 8192); if (r < 8216) return 6152 + (r - 8200); return -1;
}
__device__ __forceinline__ void prep_transposes(const Params& p, unsigned char* lds, int dmask, int vb, int nvb) {
    float* tile = (float*)lds;
    const int tid = threadIdx.x;
    unsigned char* ws = p.ws;
    for (int d = 0; d < 14; ++d) {
        if (!((dmask >> d) & 1)) continue;
        const float* src; bf16_t* dst; int K, ldsrc, ntn, mode = 0, rowoff = 0; float scale = 1.f;
        switch (d) {
            case 0: src = p.in[10]; dst = (bf16_t*)(ws + WS_WGU1); K = 1024; ldsrc = 2816; ntn = 44; mode = 2; rowoff = 0; break;
            case 1: src = p.in[11]; dst = (bf16_t*)(ws + WS_WGU1); K = 1024; ldsrc = 2816; ntn = 44; mode = 2; rowoff = 128; break;
            case 2: src = p.in[12]; dst = (bf16_t*)(ws + WS_WD1); K = 2816; ldsrc = 1024; ntn = 16; break;
            case 3: src = p.in[14]; dst = (bf16_t*)(ws + WS_WIN); K = 1024; ldsrc = 8216; ntn = 132; mode = 1; break;
            case 4: src = p.in[20]; dst = (bf16_t*)(ws + WS_WBRM); K = 1024; ldsrc = 1024; ntn = 16; break;
            case 5: src = p.in[21]; dst = (bf16_t*)(ws + WS_WBRG); K = 1024; ldsrc = 1024; ntn = 16; break;
            case 6: src = p.in[22]; dst = (bf16_t*)(ws + WS_WOUT); K = 1024; ldsrc = 1024; ntn = 16; break;
            case 7: src = p.in[25]; dst = (bf16_t*)(ws + WS_WQ); K = 1024; ldsrc = 1024; ntn = 16; scale = 0.0625f; break;
            case 8: src = p.in[28]; dst = (bf16_t*)(ws + WS_WO); K = 1024; ldsrc = 1024; ntn = 16; break;
            case 9: src = p.in[26]; dst = (bf16_t*)(ws + WS_WKV); K = 1024; ldsrc = 1024; ntn = 16; break;
            case 10: src = p.in[27]; dst = (bf16_t*)(ws + WS_WKV); K = 1024; ldsrc = 1024; ntn = 16; rowoff = 1024; break;
            case 11: src = p.in[30]; dst = (bf16_t*)(ws + WS_WGU2); K = 1024; ldsrc = 2816; ntn = 44; mode = 2; rowoff = 0; break;
            case 12: src = p.in[31]; dst = (bf16_t*)(ws + WS_WGU2); K = 1024; ldsrc = 2816; ntn = 44; mode = 2; rowoff = 128; break;
            default: src = p.in[32]; dst = (bf16_t*)(ws + WS_WD2); K = 2816; ldsrc = 1024; ntn = 16; break;
        }
        const int nkt = K / 64, ntiles = nkt * ntn;
        for (int t = vb; t < ntiles; t += nvb) {
            const int kt = t % nkt, nt = t / nkt, k0 = kt * 64;
            {
                const int j = tid & 63;
                int srccol; float sc = scale;
                if (mode == 1) { srccol = win_src_col(nt * 64 + j); if ((srccol >= 512 && srccol < 1024) || (srccol >= 3080 && srccol < 3592)) sc = 0.08838834764831845f; }
                else srccol = nt * 64 + j;
#pragma unroll
                for (int ps = 0; ps < 8; ++ps) { const int i = (tid >> 6) + 8 * ps;
                    float v = 0.f; if (srccol >= 0) v = __builtin_nontemporal_load(src + (size_t)(k0 + i) * ldsrc + srccol) * sc;
                    tile[i * 65 + j] = v; }
            }
            __syncthreads();
            {
                const int j = tid >> 3, kc = tid & 7;
                int dstrow;
                if (mode == 1) dstrow = nt * 64 + j;
                else { const int sc_ = nt * 64 + j; dstrow = (mode == 2) ? ((sc_ >> 7) * 256 + (sc_ & 127) + rowoff) : (sc_ + rowoff); }
                float v[8];
#pragma unroll
                for (int e = 0; e < 8; ++e) v[e] = tile[(kc * 8 + e) * 65 + j];
                u32x4 w; w.x = cvt_pk(v[0], v[1]); w.y = cvt_pk(v[2], v[3]); w.z = cvt_pk(v[4], v[5]); w.w = cvt_pk(v[6], v[7]);
                *(u32x4*)(dst + (size_t)dstrow * K + k0 + kc * 8) = w;
            }
            __syncthreads();
        }
    }
}
__device__ __forceinline__ void prep_phase(const Params& p, unsigned char* lds) {
    const int tid = threadIdx.x;
    unsigned char* ws = p.ws;
    prep_transposes(p, lds, PREP_EARLY_MASK, (int)blockIdx.x, (int)gridDim.x);
    const int lane = tid & 63, gw = blockIdx.x * 8 + (tid >> 6), nw = gridDim.x * 8;
    for (int r = gw; r < MT + 2048; r += nw) {
        const float* x; const float* g; bf16_t* o;
        if (r < MP) { x = p.in[0] + (size_t)r * DM; g = p.in[9]; o = (bf16_t*)(ws + WS_ABUF) + (size_t)r * DM; }
        else if (r < MT) { x = p.in[1] + (size_t)(r - MP) * DM; g = p.in[9]; o = (bf16_t*)(ws + WS_ABUF) + (size_t)r * DM; }
        else { x = p.in[2] + (size_t)(r - MT) * DM; g = p.in[24]; o = (bf16_t*)(ws + WS_MEMA) + (size_t)(r - MT) * DM; }
        f32x4 v[4]; float ss = 0.f;
#pragma unroll
        for (int i = 0; i < 4; ++i) { v[i] = *(const f32x4*)(x + i * 256 + lane * 4); ss += v[i][0] * v[i][0] + v[i][1] * v[i][1] + v[i][2] * v[i][2] + v[i][3] * v[i][3]; }
        ss = wave_sum(ss); const float rs = rs_of(ss);
#pragma unroll
        for (int i = 0; i < 4; ++i) { const f32x4 gg = *(const f32x4*)(g + i * 256 + lane * 4);
            u32x2 w; w.x = cvt_pk(v[i][0] * rs * gg[0], v[i][1] * rs * gg[1]); w.y = cvt_pk(v[i][2] * rs * gg[2], v[i][3] * rs * gg[3]);
            *(u32x2*)(o + i * 256 + lane * 4) = w; }
    }
}

#define EPI_ROW(ai, m) (u.pm * 256 + (ai) * 128 + wr * 64 + (m) * 16 + fr)
#define EPI_COL(bj) (u.pn * 256 + (bj) * 128 + wc * 32 + fq * 8)
struct EpiGateUp {
    static constexpr bool PERM = true, AFTER_DRAIN = false;
    bf16_t* H; const float* ss;
    __device__ __forceinline__ void operator()(const f32x4 (&acc)[2][2][4][2], const pg8::Unit& u, int wr, int wc, int fr, int fq) const {
        float rsv[2][4];
#pragma unroll
        for (int ai = 0; ai < 2; ++ai)
#pragma unroll
            for (int m = 0; m < 4; ++m) rsv[ai][m] = ss ? rs_row(ss, EPI_ROW(ai, m)) : 1.f;
#pragma unroll
        for (int ai = 0; ai < 2; ++ai)
#pragma unroll
            for (int m = 0; m < 4; ++m) { const int row = EPI_ROW(ai, m); const float rs = rsv[ai][m];
                f32x4 hv[2];
#pragma unroll
                for (int n = 0; n < 2; ++n)
#pragma unroll
                    for (int j = 0; j < 4; ++j) { const float gt = acc[ai][0][m][n][j] * rs, up = acc[ai][1][m][n][j] * rs; hv[n][j] = gt * sigmoidf_(gt) * up; }
                *(u32x4*)(H + (size_t)row * DFF + u.pn * 128 + wc * 32 + fq * 8) = __builtin_bit_cast(u32x4, pack8(hv[0], hv[1])); }
    }
};
struct EpiMemKV {
    static constexpr bool PERM = true, AFTER_DRAIN = false;
    float* ok; float* ov; bf16_t* kv;
    __device__ __forceinline__ void operator()(const f32x4 (&acc)[2][2][4][2], const pg8::Unit& u, int wr, int wc, int fr, int fq) const {
#pragma unroll
        for (int ai = 0; ai < 2; ++ai)
#pragma unroll
            for (int m = 0; m < 4; ++m) { const int row = EPI_ROW(ai, m);
#pragma unroll
                for (int bj = 0; bj < 2; ++bj) { const int col = EPI_COL(bj);
                    float* o = (col < 1024) ? (ok + (size_t)row * 1024 + col) : (ov + (size_t)row * 1024 + (col - 1024));
                    __builtin_nontemporal_store(acc[ai][bj][m][0], (f32x4*)o); __builtin_nontemporal_store(acc[ai][bj][m][1], (f32x4*)(o + 4));
                    *(u32x4*)(kv + (size_t)row * 2048 + col) = __builtin_bit_cast(u32x4, pack8(acc[ai][bj][m][0], acc[ai][bj][m][1])); } }
    }
};
struct EpiResid {
    static constexpr bool PERM = true, AFTER_DRAIN = false;
    const float* res0; const float* res1; float* xout; bf16_t* aout; const float* gain; float* ss; float scale;
    __device__ __forceinline__ void operator()(const f32x4 (&acc)[2][2][4][2], const pg8::Unit& u, int wr, int wc, int fr, int fq) const {
        f32x4 gv[2][2];
        if (aout) {
#pragma unroll
            for (int bj = 0; bj < 2; ++bj) { gv[bj][0] = *(const f32x4*)(gain + EPI_COL(bj)); gv[bj][1] = *(const f32x4*)(gain + EPI_COL(bj) + 4); } }
#pragma unroll
        for (int ai = 0; ai < 2; ++ai) {
            f32x4 rv[4][2][2];
#pragma unroll
            for (int m = 0; m < 4; ++m) { const int row = EPI_ROW(ai, m);
                const float* rp = (row < MP) ? (res0 + (size_t)row * DM) : (res1 + (size_t)(row - MP) * DM);
#pragma unroll
                for (int bj = 0; bj < 2; ++bj) { rv[m][bj][0] = *(const f32x4*)(rp + EPI_COL(bj)); rv[m][bj][1] = *(const f32x4*)(rp + EPI_COL(bj) + 4); } }
#pragma unroll
            for (int m = 0; m < 4; ++m) { const int row = EPI_ROW(ai, m);
                float sq = 0.f;
#pragma unroll
                for (int bj = 0; bj < 2; ++bj) { const int col = EPI_COL(bj);
                    const f32x4 x0 = rv[m][bj][0] + acc[ai][bj][m][0] * scale, x1 = rv[m][bj][1] + acc[ai][bj][m][1] * scale;
                    *(f32x4*)(xout + (size_t)row * DM + col) = x0; *(f32x4*)(xout + (size_t)row * DM + col + 4) = x1;
#pragma unroll
                    for (int j = 0; j < 4; ++j) sq += x0[j] * x0[j] + x1[j] * x1[j];
                    if (aout) *(u32x4*)(aout + (size_t)row * DM + col) = __builtin_bit_cast(u32x4, pack8(x0 * gv[bj][0], x1 * gv[bj][1])); }
                sq = xsum16_32(sq);
                if (fq == 0) ss[(size_t)row * 16 + u.pn * 4 + wc] = sq; }
        }
    }
    __device__ __forceinline__ void small(f32x4 acc, int row, int col, int tc, int rt, int ct, int l16, int g, unsigned char* lds) const {
        const f32x4 x = *(const f32x4*)(res1 + (size_t)(row - MP) * DM + col) + acc * scale;
        *(f32x4*)(xout + (size_t)row * DM + col) = x;
        if (aout) { const f32x4 gv4 = *(const f32x4*)(gain + col); *(u32x2*)(aout + (size_t)row * DM + col) = pack4(x * gv4); }
        float sq = x[0] * x[0] + x[1] * x[1] + x[2] * x[2] + x[3] * x[3];
        sq = xsum16_32(sq);
        float* red = (float*)lds;
        if (g == 0) red[(rt * 4 + ct) * 16 + l16] = sq;
        __syncthreads();
        if (ct == 0 && g == 0) ss[(size_t)row * 16 + tc] = (red[(rt * 4) * 16 + l16] + red[(rt * 4 + 1) * 16 + l16]) + (red[(rt * 4 + 2) * 16 + l16] + red[(rt * 4 + 3) * 16 + l16]);
        __syncthreads();
    }
};
struct EpiZ {
    static constexpr bool PERM = true, AFTER_DRAIN = false;
    bf16_t* Z; float* ZS; const float* ss;
    __device__ __forceinline__ void operator()(const f32x4 (&acc)[2][2][4][2], const pg8::Unit& u, int wr, int wc, int fr, int fq) const {
#pragma unroll
        for (int ai = 0; ai < 2; ++ai) {
            float rsv[4];
#pragma unroll
            for (int m = 0; m < 4; ++m) rsv[m] = rs_row(ss, EPI_ROW(ai, m));
#pragma unroll
            for (int m = 0; m < 4; ++m) { const int row = EPI_ROW(ai, m); const float rs = rsv[m];
                if (u.pn < 32) {
#pragma unroll
                    for (int bj = 0; bj < 2; ++bj)
                        *(u32x4*)(Z + (size_t)row * ZLD + EPI_COL(bj)) = __builtin_bit_cast(u32x4, pack8(acc[ai][bj][m][0] * rs, acc[ai][bj][m][1] * rs));
                } else if (wc == 0) {
                    *(f32x4*)(ZS + (size_t)row * ZSLD + fq * 8) = acc[ai][0][m][0] * rs; *(f32x4*)(ZS + (size_t)row * ZSLD + fq * 8 + 4) = acc[ai][0][m][1] * rs;
                } } }
    }
};
template <int MODE> struct EpiMerge {
    static constexpr bool PERM = true, AFTER_DRAIN = false;
    const bf16_t* gate; float* T; bf16_t* Y;
    __device__ __forceinline__ void operator()(const f32x4 (&acc)[2][2][4][2], const pg8::Unit& u, int wr, int wc, int fr, int fq) const {
#pragma unroll
        for (int ai = 0; ai < 2; ++ai)
#pragma unroll
            for (int mh = 0; mh < 2; ++mh) {
                u32x4 gw[2][2]; u32x4 tvb[2][2]; bf16_t* Tb = (bf16_t*)T;
#pragma unroll
                for (int mm = 0; mm < 2; ++mm) { const int row = EPI_ROW(ai, mh * 2 + mm);
#pragma unroll
                    for (int bj = 0; bj < 2; ++bj) { gw[mm][bj] = *(const u32x4*)(gate + (size_t)row * ZLD + EPI_COL(bj));
                        if (MODE == 1) tvb[mm][bj] = *(const u32x4*)(Tb + (size_t)row * DM + EPI_COL(bj)); } }
#pragma unroll
                for (int mm = 0; mm < 2; ++mm) { const int m = mh * 2 + mm, row = EPI_ROW(ai, m);
#pragma unroll
                    for (int bj = 0; bj < 2; ++bj) { const int col = EPI_COL(bj); const u32x4 g4 = gw[mm][bj];
                        f32x4 s0, s1;
                        s0[0] = sigmoidf_(bflo(g4.x)); s0[1] = sigmoidf_(bfhi(g4.x)); s0[2] = sigmoidf_(bflo(g4.y)); s0[3] = sigmoidf_(bfhi(g4.y));
                        s1[0] = sigmoidf_(bflo(g4.z)); s1[1] = sigmoidf_(bfhi(g4.z)); s1[2] = sigmoidf_(bflo(g4.w)); s1[3] = sigmoidf_(bfhi(g4.w));
                        f32x4 v0 = acc[ai][bj][m][0] * s0, v1 = acc[ai][bj][m][1] * s1;
                        if (MODE == 0) *(u32x4*)(Tb + (size_t)row * DM + col) = __builtin_bit_cast(u32x4, pack8(v0, v1));
                        else { const u32x4 t4 = tvb[mm][bj];
                            v0 += (f32x4){bflo(t4.x), bfhi(t4.x), bflo(t4.y), bfhi(t4.y)}; v1 += (f32x4){bflo(t4.z), bfhi(t4.z), bflo(t4.w), bfhi(t4.w)};
                            *(u32x4*)(Y + (size_t)row * DM + col) = __builtin_bit_cast(u32x4, pack8(v0, v1)); } } }
            }
    }
    __device__ __forceinline__ void small(f32x4 acc, int row, int col, int tc, int rt, int ct, int l16, int g, unsigned char* lds) const {
        bf16_t* Tb = (bf16_t*)T;
        const u32x2 g2 = *(const u32x2*)(gate + (size_t)row * ZLD + col);
        f32x4 v = acc * (f32x4){sigmoidf_(bflo(g2.x)), sigmoidf_(bfhi(g2.x)), sigmoidf_(bflo(g2.y)), sigmoidf_(bfhi(g2.y))};
        if (MODE == 0) *(u32x2*)(Tb + (size_t)row * DM + col) = pack4(v);
        else { const u32x2 t2 = *(const u32x2*)(Tb + (size_t)row * DM + col);
            v += (f32x4){bflo(t2.x), bfhi(t2.x), bflo(t2.y), bfhi(t2.y)};
            *(u32x2*)(Y + (size_t)row * DM + col) = pack4(v); }
    }
};
struct EpiQ {
    static constexpr bool PERM = true, AFTER_DRAIN = false;
    bf16_t* Q; const float* ss;
    __device__ __forceinline__ void operator()(const f32x4 (&acc)[2][2][4][2], const pg8::Unit& u, int wr, int wc, int fr, int fq) const {
#pragma unroll
        for (int ai = 0; ai < 2; ++ai) {
            float rsv[4];
#pragma unroll
            for (int m = 0; m < 4; ++m) rsv[m] = rs_row(ss, EPI_ROW(ai, m));
#pragma unroll
            for (int m = 0; m < 4; ++m) { const int row = EPI_ROW(ai, m); const float rs = rsv[m];
#pragma unroll
                for (int bj = 0; bj < 2; ++bj)
                    *(u32x4*)(Q + (size_t)row * DM + EPI_COL(bj)) = __builtin_bit_cast(u32x4, pack8(acc[ai][bj][m][0] * rs, acc[ai][bj][m][1] * rs)); } }
    }
    __device__ __forceinline__ void small(f32x4 acc, int row, int col, int tc, int rt, int ct, int l16, int g, unsigned char* lds) const {
        *(u32x2*)(Q + (size_t)row * DM + col) = pack4(acc * rs_row(ss, row));
    }
};
template <class Epi>
__device__ __forceinline__ void small_gemm(unsigned char* lds, const bf16_t* A, int lda, const bf16_t* Bt, int N, int K, const Epi& E) {
    const int tid = threadIdx.x, w = tid >> 6, lane = tid & 63, g = lane >> 4, l16 = lane & 15;
    const int rt = w >> 2, ct = w & 3, nct = N / 64, ntiles = 16 * nct;
    for (int t = blockIdx.x; t < ntiles; t += gridDim.x) {
        const int tr = t / nct, tc = t - tr * nct;
        const int row = MP + tr * 32 + rt * 16 + l16, colb = tc * 64 + ct * 16;
        const bf16_t* ap = A + (size_t)row * lda + 8 * g;
        const bf16_t* bp = Bt + (size_t)(colb + l16) * K + 8 * g;
        f32x4 acc0 = (f32x4){0.f, 0.f, 0.f, 0.f}, acc1 = acc0;
#pragma unroll 4
        for (int k = 0; k < K; k += 64) {
            acc0 = mfma16(*(const bf16x8*)(bp + k), *(const bf16x8*)(ap + k), acc0);
            acc1 = mfma16(*(const bf16x8*)(bp + k + 32), *(const bf16x8*)(ap + k + 32), acc1);
        }
        E.small(acc0 + acc1, row, colb + 4 * g, tc, rt, ct, l16, g, lds);
    }
}
template <class Epi>
__device__ __forceinline__ void run_gemm(unsigned char* lds, const bf16_t* A, int lda, const bf16_t* Bt, int M, int N, int K, const Epi& E, int rot) {
    pg8::Gemm g; g.A = A; g.Bt = Bt; g.M = M; g.N = N; g.K = K; g.lda = lda; g.ldb = K;
    pg8::StaticOrder S; S.init(M, N, (int)gridDim.x, (int)((blockIdx.x + rot) % gridDim.x));
    pg8::gemm_phase<Epi, pg8::StaticOrder>((PG8_LAS unsigned char*)lds, g, S, E);
    __syncthreads();
}
constexpr int T_STRIDE = 272, V_STRIDE = 528;
constexpr int VQN = 2, VW = 256 / VQN, NVT = VW / 16, NOT = NVT / 2, V2_STRIDE = VW * 2 + 16;
constexpr int M_T0 = 0, M_T1 = 17408, M_TV = 34816, M_TC = M_TV + 64 * V2_STRIDE, M_SM = M_TC + VW * T_STRIDE;
template <int BR>
__device__ __forceinline__ void mixer_prompt(const Params& p, unsigned char* lds, int b, int h, int vq) {
    const int tid = threadIdx.x, w = tid >> 6, lane = tid & 63, g = lane >> 4, l16 = lane & 15, q4 = l16 >> 2, p4 = lane & 3;
    const int tt = w & 3, vh = w >> 2;
    bf16_t* Z = (bf16_t*)(p.ws + WS_Z);
    const float* ZS = (const float*)(p.ws + WS_ZS);
    float* SSQ = (float*)(p.ws + WS_SSQ);
    const float* BEND = (const float*)(p.ws + WS_BEND);
    const int qcol = (BR == 0 ? 0 : 3072) + h * 128, kcol = (BR == 0 ? 512 : 3584) + h * 128;
    const int vcol = (BR == 0 ? 1024 : 4096) + h * 256 + vq * VW, ocol = (BR == 0 ? 2048 : 5120) + h * 256 + vq * VW;
    unsigned char* T0 = lds + M_T0; unsigned char* T1 = lds + M_T1; unsigned char* TV = lds + M_TV; unsigned char* TC = lds + M_TC;
    float* sm = (float*)(lds + M_SM);
    float* gS = sm; float* Mt = sm + 64; float* at = sm + 128; float* emt = sm + 192; float* wsv = sm + 256; float* nvec = sm + 320; float* bend = sm + 448;
    float* misc = sm + 576; float* ssq = sm + 592; float* gaL = sm + 720; float* segtot = sm + 1744; float* waL = sm + 2256;
    const unsigned aT0_ = (unsigned)(size_t)T0, aT1_ = (unsigned)(size_t)T1, aTV_ = (unsigned)(size_t)TV;
    const float* gain = (BR == 0 ? p.in[18] : p.in[19]) + h * 256 + vq * VW;
    const int tloc = 16 * tt + l16;
    f32x4 gn[NOT];
#pragma unroll
    for (int vi = 0; vi < NOT; ++vi) gn[vi] = *(const f32x4*)(gain + (VW / 2) * vh + 16 * vi + 4 * g);
    f32x4 st[NVT];
#pragma unroll
    for (int c = 0; c < NVT; ++c) st[c] = (f32x4){0.f, 0.f, 0.f, 0.f};
    float m0 = 0.f;
    const float bi = (BR == 0) ? p.in[15][h] : 0.f, bfb = (BR == 0) ? p.in[15][4 + h] : 0.f;
    if (tid < 128) nvec[tid] = 0.f;
    u32x4 kreg[2], qreg[2], vreg[2]; bf16x8 qn[4]; float igr = 0.f, lfr = 0.f, gar[2] = {0.f, 0.f};
    const int ks_s0 = tid >> 4, ks_ch = tid & 15;
#define MIX_LOAD_CHUNK(R0) do { const size_t r_ = (size_t)(R0); \
        kreg[0] = *(const u32x4*)(Z + (r_ + ks_s0) * ZLD + kcol + ks_ch * 8); kreg[1] = *(const u32x4*)(Z + (r_ + ks_s0 + 32) * ZLD + kcol + ks_ch * 8); \
        vreg[0] = *(const u32x4*)(Z + (r_ + ks_s0) * ZLD + vcol + ks_ch * 8); vreg[1] = *(const u32x4*)(Z + (r_ + ks_s0 + 32) * ZLD + vcol + ks_ch * 8); \
        if (BR == 0) { _Pragma("unroll") for (int ks = 0; ks < 4; ++ks) qn[ks] = *(const bf16x8*)(Z + (r_ + tloc) * ZLD + qcol + 32 * ks + 8 * g); \
            if (w == 0) { igr = ZS[(r_ + lane) * ZSLD + h]; lfr = ZS[(r_ + lane) * ZSLD + 4 + h]; } } \
        else { qreg[0] = *(const u32x4*)(Z + (r_ + ks_s0) * ZLD + qcol + ks_ch * 8); qreg[1] = *(const u32x4*)(Z + (r_ + ks_s0 + 32) * ZLD + qcol + ks_ch * 8); \
            if (tid < 128) gar[0] = BEND[(r_ >> 6) * 512 + h * 128 + tid]; } } while (0)
    MIX_LOAD_CHUNK(b * 2048);
    __syncthreads();
    for (int c = 0; c < 32; ++c) {
        const int r0 = b * 2048 + c * 64;
        if (c > 0 && tid < 64) { float* sp_ = SSQ + ((size_t)(r0 - 64 + tid) * 8 + BR * 4 + h) * 4 + vq * 2; sp_[0] = ssq[tid] + ssq[64 + tid]; sp_[1] = 0.f; }
        unsigned aT0 = aT0_, aT1 = aT1_, aTV = aTV_;
        asm volatile("" : "+v"(aT0), "+v"(aT1), "+v"(aTV));
        if (BR == 0) {
            if (w == 0) {
                const float ig = igr + bi, lf = logsigf_(lfr + bfb);
                float F = lf;
#pragma unroll
                for (int o = 1; o < 64; o <<= 1) { const float y = __shfl_up(F, o); if (lane >= o) F += y; }
                const float gg = ig - F; float cm = gg;
#pragma unroll
                for (int o = 1; o < 64; o <<= 1) { const float y = __shfl_up(cm, o); if (lane >= o) cm = fmaxf(cm, y); }
                const float M = fmaxf(m0, cm), a = __expf(m0 - M);
                const float ML = __shfl(M, 63), aend = __shfl(a, 63), FL = __shfl(F, 63);
                gS[lane] = gg; Mt[lane] = M; at[lane] = a; emt[lane] = __expf(-(F + M)); wsv[lane] = __expf(gg - ML);
                if (lane == 0) misc[1] = aend;
                m0 = FL + ML;
            }
            __syncthreads();
#pragma unroll
            for (int i = 0; i < 2; ++i) { const int s = ks_s0 + 32 * i; const u32x4 kw = kreg[i];
                *(u32x4*)(T0 + s * T_STRIDE + ks_ch * 16) = kw;
                const float ww = wsv[s]; u32x4 o;
                o.x = cvt_pk(bflo(kw.x) * ww, bfhi(kw.x) * ww); o.y = cvt_pk(bflo(kw.y) * ww, bfhi(kw.y) * ww);
                o.z = cvt_pk(bflo(kw.z) * ww, bfhi(kw.z) * ww); o.w = cvt_pk(bflo(kw.w) * ww, bfhi(kw.w) * ww);
                *(u32x4*)(T1 + s * T_STRIDE + ks_ch * 16) = o; }
        } else {
            if (tid < 128) bend[tid] = gar[0];
#pragma unroll
            for (int i = 0; i < 2; ++i) { const int s = ks_s0 + 32 * i;
                *(u32x4*)(T0 + s * T_STRIDE + ks_ch * 16) = kreg[i]; *(u32x4*)(T1 + s * T_STRIDE + ks_ch * 16) = qreg[i]; }
        }
#pragma unroll
        for (int i = 0; i < 2; ++i) *(u32x4*)(TV + (ks_s0 + 32 * i) * V2_STRIDE + ks_ch * 16) = vreg[i];
#pragma unroll
        for (int c16 = 0; c16 < NVT; ++c16) *(u32x2*)(TC + (16 * c16 + l16) * T_STRIDE + (16 * w + 4 * g) * 2) = pack4(st[c16]);
        __syncthreads();
        bf16x8 qf[4];
#pragma unroll
        for (int ks = 0; ks < 4; ++ks) {
            if (BR == 0) qf[ks] = qn[ks];
            else qf[ks] = *(const bf16x8*)(T1 + tloc * T_STRIDE + (32 * ks + 8 * g) * 2);
        }
        bf16_t* op = Z + (size_t)(r0 + tloc) * ZLD + ocol + (VW / 2) * vh + 4 * g;
        u32x2 gwv[NOT];
#pragma unroll
        for (int vi = 0; vi < NOT; ++vi) gwv[vi] = *(const u32x2*)(op + 16 * vi);
        if (c < 31) MIX_LOAD_CHUNK(r0 + 64);
        f32x4 sacc[4];
#pragma unroll
        for (int si = 0; si < 4; ++si) { sacc[si] = (f32x4){0.f, 0.f, 0.f, 0.f};
#pragma unroll
            for (int ks = 0; ks < 4; ++ks) sacc[si] = mfma16(*(const bf16x8*)(T0 + (16 * si + l16) * T_STRIDE + (32 * ks + 8 * g) * 2), qf[ks], sacc[si]); }
        float den = 0.f;
        {
            const float Mtt = (BR == 0) ? Mt[tloc] : 0.f;
            f32x4 gS4[4];
#pragma unroll
            for (int si = 0; si < 4; ++si) gS4[si] = (BR == 0) ? *(const f32x4*)(gS + 16 * si + 4 * g) : (f32x4){0.f, 0.f, 0.f, 0.f};
#pragma unroll
            for (int si = 0; si < 4; ++si)
#pragma unroll
                for (int r = 0; r < 4; ++r) { const int s = 16 * si + 4 * g + r;
                    float wgt;
                    if (BR == 0) { const float e = __expf(fminf(gS4[si][r] - Mtt, 0.f)); wgt = (s <= tloc) ? e : 0.f; } else wgt = (s <= tloc) ? 1.f : 0.f;
                    sacc[si][r] *= wgt; den += sacc[si][r]; }
        }
        f32x4 oacc[NOT];
#pragma unroll
        for (int vi = 0; vi < NOT; ++vi) { oacc[vi] = (f32x4){0.f, 0.f, 0.f, 0.f};
#pragma unroll
            for (int ks = 0; ks < 4; ++ks) oacc[vi] = mfma16(*(const bf16x8*)(TC + ((VW / 2) * vh + 16 * vi + l16) * T_STRIDE + (32 * ks + 8 * g) * 2), qf[ks], oacc[vi]); }
        if (BR == 0) {
            den = xsum16_32(den);
            const float a_t = at[tloc];
            float nq = 0.f;
#pragma unroll
            for (int ks = 0; ks < 4; ++ks)
#pragma unroll
                for (int j = 0; j < 8; ++j) nq += nvec[32 * ks + 8 * g + j] * bf2f((bf16_t)qf[ks][j]);
            nq = xsum16_32(nq);
            den += a_t * nq;
#pragma unroll
            for (int vi = 0; vi < NOT; ++vi) oacc[vi] *= a_t;
        }
#pragma unroll
        for (int ks = 0; ks < 2; ++ks) {
            const bf16x8 pb = pack8(sacc[2 * ks], sacc[2 * ks + 1]);
#pragma unroll
            for (int vi = 0; vi < NOT; vi += 4) {
                const unsigned a0 = aTV + (32 * ks + 4 * g + q4) * V2_STRIDE + ((VW / 2) * vh + 16 * vi) * 2 + 8 * p4, a1 = a0 + 16 * V2_STRIDE;
                bf16x8 fa, fb, fc, fd; tr_frag4(a0, a1, a0 + 32, a1 + 32, a0 + 64, a1 + 64, a0 + 96, a1 + 96, fa, fb, fc, fd);
                oacc[vi] = mfma16(fa, pb, oacc[vi]); oacc[vi + 1] = mfma16(fb, pb, oacc[vi + 1]); oacc[vi + 2] = mfma16(fc, pb, oacc[vi + 2]); oacc[vi + 3] = mfma16(fd, pb, oacc[vi + 3]); }
        }
        if (BR == 0) { const float inv = 1.f / fmaxf(fabsf(den), emt[tloc]);
#pragma unroll
            for (int vi = 0; vi < NOT; ++vi) oacc[vi] *= inv; }
        float sq = 0.f;
#pragma unroll
        for (int vi = 0; vi < NOT; ++vi)
#pragma unroll
            for (int r = 0; r < 4; ++r) sq += oacc[vi][r] * oacc[vi][r];
        sq = xsum16_32(sq);
        if (g == 0) ssq[vh * 64 + tloc] = sq;
#pragma unroll
        for (int vi = 0; vi < NOT; ++vi) {
            const float gt[4] = {bflo(gwv[vi].x), bfhi(gwv[vi].x), bflo(gwv[vi].y), bfhi(gwv[vi].y)}; f32x4 o;
#pragma unroll
            for (int r = 0; r < 4; ++r) { const float sg = sigmoidf_(gt[r]); o[r] = oacc[vi][r] * gn[vi][r] * (BR == 0 ? sg : gt[r] * sg); }
            *(u32x2*)(op + 16 * vi) = pack4(o); }
        if (BR == 0) { const float aend = misc[1];
#pragma unroll
            for (int c16 = 0; c16 < NVT; ++c16) st[c16] *= aend; }
#pragma unroll
        for (int ks = 0; ks < 2; ++ks) {
            const unsigned ka0 = (BR == 0 ? aT1 : aT0) + (32 * ks + 8 * g + q4) * T_STRIDE + (16 * w) * 2 + 8 * p4;
            const bf16x8 kf = tr_frag(ka0, ka0 + 4 * T_STRIDE);
#pragma unroll
            for (int c16 = 0; c16 < NVT; c16 += 4) {
                const unsigned v0 = aTV + (32 * ks + 8 * g + q4) * V2_STRIDE + (16 * c16) * 2 + 8 * p4, v1 = v0 + 4 * V2_STRIDE;
                bf16x8 fa, fb, fc, fd; tr_frag4(v0, v1, v0 + 32, v1 + 32, v0 + 64, v1 + 64, v0 + 96, v1 + 96, fa, fb, fc, fd);
                st[c16] = mfma16(kf, fa, st[c16]); st[c16 + 1] = mfma16(kf, fb, st[c16 + 1]); st[c16 + 2] = mfma16(kf, fc, st[c16 + 2]); st[c16 + 3] = mfma16(kf, fd, st[c16 + 3]);
            }
        }
        if (BR == 1) {
            float eb[4];
#pragma unroll
            for (int r = 0; r < 4; ++r) eb[r] = __expf(bend[16 * w + 4 * g + r]);
#pragma unroll
            for (int c16 = 0; c16 < NVT; ++c16)
#pragma unroll
                for (int r = 0; r < 4; ++r) st[c16][r] *= eb[r];
        } else {
            const int d = tid & 127, seg = tid >> 7; float a2 = 0.f;
#pragma unroll
            for (int s = 0; s < 16; ++s) a2 += bf2f(*(const bf16_t*)(T1 + (seg * 16 + s) * T_STRIDE + d * 2));
            segtot[seg * 128 + d] = a2;
        }
        __syncthreads();
        if (BR == 0 && tid < 128) nvec[tid] = misc[1] * nvec[tid] + ((segtot[tid] + segtot[128 + tid]) + (segtot[256 + tid] + segtot[384 + tid]));
    }
#undef MIX_LOAD_CHUNK
    if (tid < 64) { float* sp_ = SSQ + ((size_t)(b * 2048 + 31 * 64 + tid) * 8 + BR * 4 + h) * 4 + vq * 2; sp_[0] = ssq[tid] + ssq[64 + tid]; sp_[1] = 0.f; }
    const int bh = b * 4 + h;
    if (BR == 0) {
        float* Co = p.out + O_CP + (size_t)bh * 32768;
#pragma unroll
        for (int c16 = 0; c16 < NVT; ++c16) __builtin_nontemporal_store(st[c16], (f32x4*)(Co + (size_t)(VW * vq + 16 * c16 + l16) * 128 + 16 * w + 4 * g));
        if (vq == 0) { if (tid < 128) p.out[O_NP + bh * 128 + tid] = nvec[tid];
            if (tid == 0) p.out[O_MPP + bh] = m0; }
    } else {
        float* So = p.out + O_SP + (size_t)bh * 32768;
#pragma unroll
        for (int c16 = 0; c16 < NVT; ++c16)
#pragma unroll
            for (int r = 0; r < 4; ++r) So[(size_t)(16 * w + 4 * g + r) * 256 + VW * vq + 16 * c16 + l16] = st[c16][r];
    }
    __syncthreads();
}

__device__ __forceinline__ void gla_prep(const Params& p, unsigned char* lds, int item) {
    const int tid = threadIdx.x, d = tid & 127, seg = tid >> 7;
    const int h = item & 3, c = (item >> 2) & 31, b = item >> 7;
    bf16_t* Z = (bf16_t*)(p.ws + WS_Z);
    const float* ZS = (const float*)(p.ws + WS_ZS);
    float* BEND = (float*)(p.ws + WS_BEND);
    float* gaL = (float*)lds; float* waL = gaL + 1024; float* segtot = waL + 2048;
    const int r0 = b * 2048 + c * 64, qcol = 3072 + h * 128, kcol = 3584 + h * 128;
    gaL[tid] = ZS[(size_t)(r0 + (tid >> 4)) * ZSLD + 8 + (tid & 15)]; gaL[tid + 512] = ZS[(size_t)(r0 + 32 + (tid >> 4)) * ZSLD + 8 + (tid & 15)];
#pragma unroll
    for (int j = 0; j < 4; ++j) { const int id = tid + 512 * j; waL[id] = p.in[16][(id >> 7) * 512 + h * 128 + (id & 127)]; }
    const float ba = p.in[17][h * 128 + d];
    __syncthreads();
    float wa[16];
#pragma unroll
    for (int j = 0; j < 16; ++j) wa[j] = waL[j * 128 + d];
    float la[16]; float run = 0.f;
#pragma unroll
    for (int i = 0; i < 16; ++i) { const int t = seg * 16 + i; float x = ba;
#pragma unroll
        for (int j = 0; j < 16; ++j) x += gaL[t * 16 + j] * wa[j];
        run += logsigf_(x) * 0.0625f; la[i] = run; }
    segtot[seg * 128 + d] = run;
    __syncthreads();
    float pre = 0.f, tot = 0.f;
#pragma unroll
    for (int s2 = 0; s2 < 4; ++s2) { const float v = segtot[s2 * 128 + d]; tot += v; if (s2 < seg) pre += v; }
    if (seg == 0) BEND[(size_t)(b * 32 + c) * 512 + h * 128 + d] = tot;
    bf16_t qv[16], kv[16];
#pragma unroll
    for (int i = 0; i < 16; ++i) { const int t = seg * 16 + i; qv[i] = Z[(size_t)(r0 + t) * ZLD + qcol + d]; kv[i] = Z[(size_t)(r0 + t) * ZLD + kcol + d]; }
#pragma unroll
    for (int i = 0; i < 16; ++i) { const int t = seg * 16 + i; const float bb = la[i] + pre;
        Z[(size_t)(r0 + t) * ZLD + qcol + d] = f2bf(bf2f(qv[i]) * __expf(bb)); Z[(size_t)(r0 + t) * ZLD + kcol + d] = f2bf(bf2f(kv[i]) * __expf(-bb)); }
    __syncthreads();
}

template <int BR>
__device__ __forceinline__ void mixer_sample(const Params& p, unsigned char* lds, int b, int h) {
    const int tid = threadIdx.x, w = tid >> 6, lane = tid & 63;
    bf16_t* Z = (bf16_t*)(p.ws + WS_Z);
    const float* ZS = (const float*)(p.ws + WS_ZS);
    const int qcol = (BR == 0 ? 0 : 3072) + h * 128, kcol = (BR == 0 ? 512 : 3584) + h * 128, vcol = (BR == 0 ? 1024 : 4096) + h * 256, ocol = (BR == 0 ? 2048 : 5120) + h * 256;
    float* sm = (float*)lds;
    float* qa = sm; float* ka = sm + 512; float* kd = sm + 1024; float* dec = sm + 1536; float* vv = sm + 1664; float* qk = sm + 2688; float* sc = sm + 2704;
    float* part = sm + 2752; float* red = sm + 4800;
    const int r0 = MP + 4 * b, bh = b * 4 + h;
    const float* gain = (BR == 0 ? p.in[18] : p.in[19]) + h * 256;
    float a_t[4] = {1.f, 1.f, 1.f, 1.f}, mt[4] = {0.f, 0.f, 0.f, 0.f}, aend = 1.f;
    {
        const int t = tid >> 7, d = tid & 127;
        const float qraw = bf2f(Z[(size_t)(r0 + t) * ZLD + qcol + d]), kraw = bf2f(Z[(size_t)(r0 + t) * ZLD + kcol + d]);
#pragma unroll
        for (int i = 0; i < 2; ++i) { const int id = tid + 512 * i; vv[id] = bf2f(Z[(size_t)(r0 + (id >> 8)) * ZLD + vcol + (id & 255)]); }
        if (BR == 0) {
            const float m0 = p.in[5][bh], bi = p.in[15][h], bfb = p.in[15][4 + h];
            float F = 0.f, cm = -3.0e38f, gg[4], Mv[4];
#pragma unroll
            for (int s = 0; s < 4; ++s) { const float ig = ZS[(size_t)(r0 + s) * ZSLD + h] + bi, lf = logsigf_(ZS[(size_t)(r0 + s) * ZSLD + 4 + h] + bfb);
                F += lf; gg[s] = ig - F; cm = fmaxf(cm, gg[s]); Mv[s] = fmaxf(m0, cm); a_t[s] = __expf(m0 - Mv[s]); mt[s] = F + Mv[s]; }
            aend = a_t[3];
            float wsel = 0.f;
#pragma unroll
            for (int s = 0; s < 4; ++s) { const float ws_ = __expf(gg[s] - Mv[3]); if (s == t) wsel = ws_; }
            qa[tid] = qraw; ka[tid] = kraw; kd[tid] = wsel * kraw;
            if (tid < 128) dec[tid] = aend;
            if (tid == 0) {
#pragma unroll
                for (int s = 0; s < 4; ++s) { sc[16 + s] = gg[s]; sc[20 + s] = Mv[s]; } }
        } else {
            float la[4];
#pragma unroll
            for (int s = 0; s < 4; ++s) { float x = p.in[17][h * 128 + d];
#pragma unroll
                for (int j = 0; j < 16; ++j) x += ZS[(size_t)(r0 + s) * ZSLD + 8 + j] * p.in[16][j * 512 + h * 128 + d];
                la[s] = logsigf_(x) * 0.0625f; }
            float bt = 0.f, bendv = 0.f;
#pragma unroll
            for (int s = 0; s < 4; ++s) { bendv += la[s]; if (s <= t) bt += la[s]; }
            qa[tid] = qraw * __expf(bt); ka[tid] = kraw * __expf(-bt); kd[tid] = kraw * __expf(bendv - bt);
            if (t == 0) dec[d] = __expf(bendv);
        }
    }
    __syncthreads();
    {
        const int pr = tid >> 5, l = tid & 31, t = pr >> 2, s = pr & 3;
        const f32x4 a = *(const f32x4*)(qa + t * 128 + l * 4), k4 = *(const f32x4*)(ka + s * 128 + l * 4);
        float v = a[0] * k4[0] + a[1] * k4[1] + a[2] * k4[2] + a[3] * k4[3];
#pragma unroll
        for (int o = 16; o > 0; o >>= 1) v += __shfl_xor(v, o);
        if (l == 0) { float wgt; if (BR == 0) wgt = (s <= t) ? __expf(sc[16 + s] - sc[20 + t]) : 0.f; else wgt = (s <= t) ? 1.f : 0.f; qk[pr] = v * wgt; }
        if (BR == 0 && tid < 128) {
            const int t2 = tid >> 5;
            const f32x4 n4 = *(const f32x4*)(p.in[4] + (size_t)bh * 128 + l * 4), q4v = *(const f32x4*)(qa + t2 * 128 + l * 4);
            float v2 = n4[0] * q4v[0] + n4[1] * q4v[1] + n4[2] * q4v[2] + n4[3] * q4v[3];
#pragma unroll
            for (int o = 16; o > 0; o >>= 1) v2 += __shfl_xor(v2, o);
            if (l == 0) sc[12 + t2] = v2;
        }
    }
    __syncthreads();
    float hv[4]; int vown; bool owner;
    if (BR == 0) {
        const int l32 = lane & 31, half = lane >> 5;
        const float* C0 = p.in[3] + (size_t)bh * 32768 + 4 * l32;
        float* C1 = p.out + O_CS + (size_t)bh * 32768 + 4 * l32;
        f32x4 qa4[4], kd4[4]; const f32x4 dec4 = *(const f32x4*)(dec + 4 * l32);
#pragma unroll
        for (int t = 0; t < 4; ++t) { qa4[t] = *(const f32x4*)(qa + t * 128 + 4 * l32); kd4[t] = *(const f32x4*)(kd + t * 128 + 4 * l32); }
#pragma unroll
        for (int ib = 0; ib < 16; ib += 8) {
            f32x4 cv[8];
#pragma unroll
            for (int e = 0; e < 8; ++e) cv[e] = __builtin_nontemporal_load((const f32x4*)(C0 + (size_t)(w * 32 + 2 * (ib + e) + half) * 128));
#pragma unroll
            for (int e = 0; e < 8; ++e) { const int v = w * 32 + 2 * (ib + e) + half; const f32x4 c = cv[e];
                float wv[4], pt[4];
#pragma unroll
                for (int s = 0; s < 4; ++s) wv[s] = vv[s * 256 + v];
                f32x4 o = dec4 * c;
#pragma unroll
                for (int s = 0; s < 4; ++s) o += kd4[s] * wv[s];
                __builtin_nontemporal_store(o, (f32x4*)(C1 + (size_t)v * 128));
#pragma unroll
                for (int t = 0; t < 4; ++t) { float x = c[0] * qa4[t][0] + c[1] * qa4[t][1] + c[2] * qa4[t][2] + c[3] * qa4[t][3];
#pragma unroll
                    for (int of = 16; of > 0; of >>= 1) x += __shfl_xor(x, of);
                    pt[t] = x; }
                if (l32 == 0) {
#pragma unroll
                    for (int t = 0; t < 4; ++t) part[t * 256 + v] = pt[t]; }
            }
        }
        if (tid < 128) { float acc = aend * p.in[4][(size_t)bh * 128 + tid];
#pragma unroll
            for (int s = 0; s < 4; ++s) acc += kd[s * 128 + tid];
            p.out[O_NS + (size_t)bh * 128 + tid] = acc; }
        if (tid == 0) p.out[O_MSS + bh] = mt[3];
        __syncthreads();
        vown = tid & 255; owner = (tid < 256);
        {
            float wv2[4];
#pragma unroll
            for (int s = 0; s < 4; ++s) wv2[s] = vv[s * 256 + vown];
#pragma unroll
            for (int t = 0; t < 4; ++t) { float num = a_t[t] * part[t * 256 + vown], den = a_t[t] * sc[12 + t];
#pragma unroll
                for (int s = 0; s < 4; ++s) { num += qk[t * 4 + s] * wv2[s]; den += qk[t * 4 + s]; }
                hv[t] = num / fmaxf(fabsf(den), __expf(-mt[t])); }
        }
    } else {
        const int v4 = lane * 4;
        const float* S0 = p.in[6] + ((size_t)bh * 128 + 16 * w) * 256 + v4;
        float* S1 = p.out + O_SS + ((size_t)bh * 128 + 16 * w) * 256 + v4;
        float* part8 = sm + 4864;
        f32x4 wv4[4], pt4[4];
#pragma unroll
        for (int s = 0; s < 4; ++s) { wv4[s] = *(const f32x4*)(vv + s * 256 + v4); pt4[s] = (f32x4){0.f, 0.f, 0.f, 0.f}; }
#pragma unroll
        for (int jb = 0; jb < 16; jb += 8) {
            f32x4 s0v[8];
#pragma unroll
            for (int e = 0; e < 8; ++e) s0v[e] = __builtin_nontemporal_load((const f32x4*)(S0 + (size_t)(jb + e) * 256));
#pragma unroll
            for (int e = 0; e < 8; ++e) { const int j = jb + e, d = 16 * w + j; const f32x4 s0 = s0v[e];
                f32x4 acc = s0 * dec[d];
#pragma unroll
                for (int t = 0; t < 4; ++t) pt4[t] += s0 * qa[t * 128 + d];
#pragma unroll
                for (int s2 = 0; s2 < 4; ++s2) acc += wv4[s2] * kd[s2 * 128 + d];
                __builtin_nontemporal_store(acc, (f32x4*)(S1 + (size_t)j * 256)); } }
#pragma unroll
        for (int t = 0; t < 4; ++t) *(f32x4*)(part8 + (w * 4 + t) * 256 + v4) = pt4[t];
        __syncthreads();
        vown = tid & 255; owner = (tid < 256);
#pragma unroll
        for (int t = 0; t < 4; ++t) { float num = 0.f;
#pragma unroll
            for (int w2 = 0; w2 < 8; ++w2) num += part8[(w2 * 4 + t) * 256 + vown];
#pragma unroll
            for (int s2 = 0; s2 < 4; ++s2) num += qk[t * 4 + s2] * vv[s2 * 256 + vown];
            hv[t] = num; }
    }
#pragma unroll
    for (int t = 0; t < 4; ++t) { float q2 = owner ? hv[t] * hv[t] : 0.f; q2 = wave_sum(q2); if (lane == 0) red[w * 4 + t] = q2; }
    __syncthreads();
    if (owner) {
#pragma unroll
        for (int t = 0; t < 4; ++t) { float tot = 0.f;
#pragma unroll
            for (int w2 = 0; w2 < 8; ++w2) tot += red[w2 * 4 + t];
            const float rs = rsqrtf(tot * (1.f / 256.f) + EPSV);
            bf16_t* op = Z + (size_t)(r0 + t) * ZLD + ocol + vown;
            const float gt = bf2f(*op), sg = sigmoidf_(gt);
            *op = f2bf(hv[t] * rs * gain[vown] * (BR == 0 ? sg : gt * sg)); }
    }
    __syncthreads();
}

__device__ __forceinline__ void attn_prompt(const Params& p, unsigned char* lds, int item) {
    const int tid = threadIdx.x, w = tid >> 6, lane = tid & 63, g = lane >> 4, l16 = lane & 15, q4 = l16 >> 2, p4 = lane & 3;
    const int qt = item & 15, h = (item >> 4) & 3, b = item >> 6;
    const bf16_t* KV = (const bf16_t*)(p.ws + WS_MEMKV) + (size_t)b * 256 * 2048 + h * 256;
    const bf16_t* Q = (const bf16_t*)(p.ws + WS_QBUF);
    bf16_t* O = (bf16_t*)(p.ws + WS_OBUF);
    const size_t rq = (size_t)b * 2048 + qt * 128 + 16 * w + l16;
    const unsigned aL = (unsigned)(size_t)lds;
#pragma unroll 8
    for (int i = 0; i < 16; ++i) { const int id = tid + 512 * i, key = id >> 5, ch = id & 31;
        *(u32x4*)(lds + key * V_STRIDE + ch * 16) = *(const u32x4*)(KV + (size_t)key * 2048 + ch * 8); }
    __syncthreads();
    f32x4 s[16];
#pragma unroll
    for (int ki = 0; ki < 16; ++ki) s[ki] = (f32x4){0.f, 0.f, 0.f, 0.f};
#pragma unroll
    for (int ks = 0; ks < 8; ++ks) { const bf16x8 qfk = *(const bf16x8*)(Q + rq * DM + h * 256 + 32 * ks + 8 * g);
#pragma unroll
        for (int ki = 0; ki < 16; ++ki) s[ki] = mfma16(*(const bf16x8*)(lds + (16 * ki + l16) * V_STRIDE + (32 * ks + 8 * g) * 2), qfk, s[ki]); }
    float mx = -3.0e38f;
#pragma unroll
    for (int ki = 0; ki < 16; ++ki)
#pragma unroll
        for (int r = 0; r < 4; ++r) mx = fmaxf(mx, s[ki][r]);
    mx = xmax16_32(mx);
    float sum = 0.f;
#pragma unroll
    for (int ki = 0; ki < 16; ++ki)
#pragma unroll
        for (int r = 0; r < 4; ++r) { const float e = __expf(s[ki][r] - mx); s[ki][r] = e; sum += e; }
    sum = xsum16_32(sum);
    bf16x8 pf[8];
#pragma unroll
    for (int ks = 0; ks < 8; ++ks) pf[ks] = pack8(s[2 * ks], s[2 * ks + 1]);
    __syncthreads();
#pragma unroll 8
    for (int i = 0; i < 16; ++i) { const int id = tid + 512 * i, key = id >> 5, ch = id & 31;
        *(u32x4*)(lds + key * V_STRIDE + ch * 16) = *(const u32x4*)(KV + (size_t)key * 2048 + 1024 + ch * 8); }
    __syncthreads();
    const float inv = 1.f / sum;
#pragma unroll
    for (int hh = 0; hh < 2; ++hh) {
        f32x4 o[8];
#pragma unroll
        for (int hi = 0; hi < 8; ++hi) o[hi] = (f32x4){0.f, 0.f, 0.f, 0.f};
#pragma unroll
        for (int ks = 0; ks < 8; ++ks) {
            unsigned aLk = aL + (32 * ks + 4 * g + q4) * V_STRIDE + 8 * p4 + hh * 256;
            asm volatile("" : "+v"(aLk));
#pragma unroll
            for (int hi = 0; hi < 8; hi += 4) {
                const unsigned a0 = aLk + (16 * hi) * 2, a1 = a0 + 16 * V_STRIDE;
                bf16x8 fa, fb, fc, fd; tr_frag4(a0, a1, a0 + 32, a1 + 32, a0 + 64, a1 + 64, a0 + 96, a1 + 96, fa, fb, fc, fd);
                o[hi] = mfma16(fa, pf[ks], o[hi]); o[hi + 1] = mfma16(fb, pf[ks], o[hi + 1]); o[hi + 2] = mfma16(fc, pf[ks], o[hi + 2]); o[hi + 3] = mfma16(fd, pf[ks], o[hi + 3]);
            }
        }
#pragma unroll
        for (int hi = 0; hi < 8; ++hi) *(u32x2*)(O + rq * DM + h * 256 + hh * 128 + 16 * hi + 4 * g) = pack4(o[hi] * inv);
    }
    __syncthreads();
}
__device__ __forceinline__ void attn_sample(const Params& p, unsigned char* lds, int item) {
    const int tid = threadIdx.x, w = tid >> 6, lane = tid & 63;
    const int h = item & 3, b = item >> 2;
    const float* Kc = p.in[7] + ((size_t)b * 1024 + h) * 256;
    const float* Vc = p.in[8] + ((size_t)b * 1024 + h) * 256;
    const bf16_t* Q = (const bf16_t*)(p.ws + WS_QBUF);
    bf16_t* O = (bf16_t*)(p.ws + WS_OBUF);
    float* sc = (float*)lds; float* po = sc + 1024;
    const size_t r0 = MP + 4 * b;
    f32x4 q[4];
#pragma unroll
    for (int t = 0; t < 4; ++t) { const u32x2 qw = *(const u32x2*)(Q + (r0 + t) * DM + h * 256 + lane * 4); q[t] = (f32x4){bflo(qw.x), bfhi(qw.x), bflo(qw.y), bfhi(qw.y)}; }
    {
        const bool b5 = (lane & 32) != 0, b4 = (lane & 16) != 0, b3 = (lane & 8) != 0, b2 = (lane & 4) != 0;
#pragma unroll 2
        for (int kg = 0; kg < 8; ++kg) { const int key0 = w * 32 + kg * 4;
            f32x4 kv[4];
#pragma unroll
            for (int k = 0; k < 4; ++k) kv[k] = __builtin_nontemporal_load((const f32x4*)(Kc + (size_t)(key0 + k) * 1024 + lane * 4));
            float v[16];
#pragma unroll
            for (int k = 0; k < 4; ++k)
#pragma unroll
                for (int t = 0; t < 4; ++t) v[k * 4 + t] = kv[k][0] * q[t][0] + kv[k][1] * q[t][1] + kv[k][2] * q[t][2] + kv[k][3] * q[t][3];
            float a8[8], a4[4], a2[2];
#pragma unroll
            for (int i = 0; i < 8; ++i) { const float keep = b5 ? v[i + 8] : v[i], send = b5 ? v[i] : v[i + 8]; a8[i] = keep + __shfl_xor(send, 32); }
#pragma unroll
            for (int i = 0; i < 4; ++i) { const float keep = b4 ? a8[i + 4] : a8[i], send = b4 ? a8[i] : a8[i + 4]; a4[i] = keep + __shfl_xor(send, 16); }
#pragma unroll
            for (int i = 0; i < 2; ++i) { const float keep = b3 ? a4[i + 2] : a4[i], send = b3 ? a4[i] : a4[i + 2]; a2[i] = keep + __shfl_xor(send, 8); }
            float d = (b2 ? a2[1] : a2[0]) + __shfl_xor(b2 ? a2[0] : a2[1], 4);
            d += __shfl_xor(d, 2); d += __shfl_xor(d, 1);
            if ((lane & 3) == 0) { const int j = (lane >> 2) & 15; sc[(j & 3) * 256 + key0 + (j >> 2)] = d; }
        }
    }
    __syncthreads();
    if (w < 4) { float v[4], mx = -3.0e38f;
#pragma unroll
        for (int i = 0; i < 4; ++i) { v[i] = sc[w * 256 + lane + 64 * i]; mx = fmaxf(mx, v[i]); }
        mx = wave_max(mx); float sum = 0.f;
#pragma unroll
        for (int i = 0; i < 4; ++i) { v[i] = __expf(v[i] - mx); sum += v[i]; }
        sum = wave_sum(sum); const float inv = 1.f / sum;
#pragma unroll
        for (int i = 0; i < 4; ++i) sc[w * 256 + lane + 64 * i] = v[i] * inv; }
    __syncthreads();
    {
        const int hd4 = lane * 4; float* po8 = sc + 1024;
        f32x4 acc4[4];
#pragma unroll
        for (int t = 0; t < 4; ++t) acc4[t] = (f32x4){0.f, 0.f, 0.f, 0.f};
#pragma unroll 2
        for (int kg = 0; kg < 8; ++kg) { const int key0 = w * 32 + kg * 4;
            f32x4 v4[4], p4[4];
#pragma unroll
            for (int k = 0; k < 4; ++k) v4[k] = __builtin_nontemporal_load((const f32x4*)(Vc + (size_t)(key0 + k) * 1024 + hd4));
#pragma unroll
            for (int t = 0; t < 4; ++t) p4[t] = *(const f32x4*)(sc + t * 256 + key0);
#pragma unroll
            for (int k = 0; k < 4; ++k)
#pragma unroll
                for (int t = 0; t < 4; ++t) acc4[t] += v4[k] * p4[t][k]; }
#pragma unroll
        for (int t = 0; t < 4; ++t) *(f32x4*)(po8 + (w * 4 + t) * 256 + hd4) = acc4[t];
        __syncthreads();
        if (tid < 256) {
#pragma unroll
            for (int t = 0; t < 4; ++t) { float o = 0.f;
#pragma unroll
                for (int w2 = 0; w2 < 8; ++w2) o += po8[(w2 * 4 + t) * 256 + tid];
                O[(r0 + t) * DM + h * 256 + tid] = f2bf(o); } }
    }
    __syncthreads();
}

#ifndef ONLY_PH
#define ONLY_PH -1
#endif
#ifndef MIXEN
#define MIXEN 15
#endif
#ifndef PH_MASK
#define PH_MASK 0xffff
#endif
#define PH_ENABLED(x) ((ONLY_PH < 0 || ONLY_PH == (x)) && ((PH_MASK >> (x)) & 1) && ((KMASK >> (x)) & 1))
__device__ __forceinline__ void grid_barrier(unsigned char* wsb, unsigned char* lds) {
    XcdBarrier b; b.bar = (unsigned*)(wsb + WS_BAR); b.x = xb_xcc_id(); b.st = (volatile LAS unsigned*)(lds + LDS_BYTES - 16);
    xcd_barrier(b);
}
template <int KMASK> __global__ void __launch_bounds__(512, 2) fwd_kernel(Params p) {
    extern __shared__ __attribute__((aligned(16))) unsigned char lds[];
    cg::grid_group grid = cg::this_grid();
    volatile LAS unsigned* xb_st = (volatile LAS unsigned*)(lds + LDS_BYTES - 16);
    if (threadIdx.x == 0) { xb_st[0] = 0u; xb_st[1] = 0u; }
    __syncthreads();
    (void)xcd_barrier_post((unsigned*)(p.ws + WS_BAR), xb_st);
#ifndef DUP_MASK
#define DUP_MASK 0
#endif
#define PH_BEGIN(k) if (PH_ENABLED(k) && p.ph_lo <= (k) && (k) < p.ph_hi) for (int rep_ = 0; rep_ < (((DUP_MASK >> (k)) & 1) ? 2 : 1); ++rep_) { if ((k) > p.ph_lo || rep_) { if (p.ph_hi > 1000) grid.sync(); else grid_barrier(p.ws, lds); } \
        unsigned char* ws; float* outp; { unsigned long long w_ = (unsigned long long)p.ws, o_ = (unsigned long long)p.out; \
        unsigned a0_ = __builtin_amdgcn_readfirstlane((unsigned)w_), a1_ = __builtin_amdgcn_readfirstlane((unsigned)(w_ >> 32)), a2_ = __builtin_amdgcn_readfirstlane((unsigned)o_), a3_ = __builtin_amdgcn_readfirstlane((unsigned)(o_ >> 32)); \
        asm volatile("" : "+s"(a0_), "+s"(a1_), "+s"(a2_), "+s"(a3_)); ws = (unsigned char*)(((unsigned long long)a1_ << 32) | a0_); outp = (float*)(((unsigned long long)a3_ << 32) | a2_); } \
        bf16_t* ABUF = (bf16_t*)(ws + WS_ABUF); bf16_t* Z = (bf16_t*)(ws + WS_Z); float* XRES = (float*)(ws + WS_XRES); float* SS = (float*)(ws + WS_SS); float* TMP = outp + O_YP; \
        (void)ABUF; (void)Z; (void)XRES; (void)SS; (void)TMP;
#define PH_END }
    PH_BEGIN(0) prep_phase(p, lds); PH_END
    PH_BEGIN(1)
        EpiGateUp e1; e1.H = Z; e1.ss = nullptr;
        run_gemm(lds, ABUF, DM, (const bf16_t*)(ws + WS_WGU1), MT, 5632, 1024, e1, 0);
        EpiMemKV e2; e2.ok = outp + O_MKP; e2.ov = outp + O_MVP; e2.kv = (bf16_t*)(ws + WS_MEMKV);
        run_gemm(lds, (const bf16_t*)(ws + WS_MEMA), DM, (const bf16_t*)(ws + WS_WKV), 2048, 2048, 1024, e2, 64);
    PH_END
    PH_BEGIN(2) EpiResid e; e.res0 = p.in[0]; e.res1 = p.in[1]; e.xout = XRES; e.aout = ABUF; e.gain = p.in[13]; e.ss = SS; e.scale = 0.5f;
        run_gemm(lds, Z, DFF, (const bf16_t*)(ws + WS_WD1), MP, 1024, DFF, e, 0); small_gemm(lds, Z, DFF, (const bf16_t*)(ws + WS_WD1), 1024, DFF, e); PH_END
    PH_BEGIN(3) EpiZ e; e.Z = Z; e.ZS = (float*)(ws + WS_ZS); e.ss = SS;
        run_gemm(lds, ABUF, DM, (const bf16_t*)(ws + WS_WIN), MT, 8448, 1024, e, 0); PH_END
    PH_BEGIN(4)
        for (int it = blockIdx.x; it < 1024; it += gridDim.x) gla_prep(p, lds, it);
    PH_END
    PH_BEGIN(5)
        const int bx = (int)blockIdx.x, G = (int)gridDim.x;
        const int NCH = (G >= 256) ? 128 : 0;
        if (bx < NCH || NCH == 0) {
            for (int it0 = bx; it0 < 128; it0 += (NCH ? NCH : G)) { const int it = NCH ? ((((it0 & 7) * 8 + (it0 >> 4)) << 1) | ((it0 >> 3) & 1)) : it0;
                if (it < 64) { if (MIXEN & 1) mixer_prompt<0>(p, lds, it >> 3, (it >> 1) & 3, it & 1); } }
            for (int it0 = bx; it0 < 128; it0 += (NCH ? NCH : G)) { const int it = NCH ? ((((it0 & 7) * 8 + (it0 >> 4)) << 1) | ((it0 >> 3) & 1)) : it0;
                if (it >= 64) { if (MIXEN & 2) mixer_prompt<1>(p, lds, (it - 64) >> 3, (it >> 1) & 3, it & 1); } }
        }
        if (bx >= NCH) {
            for (int it = bx - NCH; it < 512; it += G - NCH) { if (MIXEN & 4) mixer_sample<0>(p, lds, it >> 2, it & 3); }
            for (int it = bx - NCH; it < 512; it += G - NCH) { if (MIXEN & 8) mixer_sample<1>(p, lds, it >> 2, it & 3); }
            prep_transposes(p, lds, PREP_LATE_MASK, bx - NCH, G - NCH);
        }
    PH_END
    PH_BEGIN(6)
        const float* SSQ = (const float*)(ws + WS_SSQ);
        const int lane = threadIdx.x & 63, gw = blockIdx.x * 8 + (threadIdx.x >> 6), nw = gridDim.x * 8;
        for (int i0 = gw; i0 < MP * 8; i0 += 4 * nw) {
            f32x4 sp[4]; u32x2 wv[4];
#pragma unroll
            for (int e = 0; e < 4; ++e) { const int i = i0 + e * nw; if (i < MP * 8) { sp[e] = *(const f32x4*)(SSQ + (size_t)i * 4);
                    wv[e] = *(const u32x2*)(Z + (size_t)(i >> 3) * ZLD + (((i & 7) >> 2) ? 5120 : 2048) + (i & 3) * 256 + lane * 4); } }
#pragma unroll
            for (int e = 0; e < 4; ++e) { const int i = i0 + e * nw; if (i < MP * 8) {
                    const float rs = rsqrtf(((sp[e][0] + sp[e][1]) + (sp[e][2] + sp[e][3])) * (1.f / 256.f) + EPSV);
                    f32x4 o = {bflo(wv[e].x) * rs, bfhi(wv[e].x) * rs, bflo(wv[e].y) * rs, bfhi(wv[e].y) * rs};
                    *(u32x2*)(Z + (size_t)(i >> 3) * ZLD + (((i & 7) >> 2) ? 5120 : 2048) + (i & 3) * 256 + lane * 4) = pack4(o); } }
        }
    PH_END
    PH_BEGIN(7)
        { EpiMerge<0> e; e.gate = Z + 6144; e.T = TMP; e.Y = nullptr;
          run_gemm(lds, Z + 2048, ZLD, (const bf16_t*)(ws + WS_WBRM), MP, 1024, 1024, e, 0); small_gemm(lds, Z + 2048, ZLD, (const bf16_t*)(ws + WS_WBRM), 1024, 1024, e); }
        { EpiMerge<1> e; e.gate = Z + 7168; e.T = TMP; e.Y = ABUF;
          run_gemm(lds, Z + 5120, ZLD, (const bf16_t*)(ws + WS_WBRG), MP, 1024, 1024, e, 0); small_gemm(lds, Z + 5120, ZLD, (const bf16_t*)(ws + WS_WBRG), 1024, 1024, e); }
    PH_END
    PH_BEGIN(9) EpiResid e; e.res0 = XRES; e.res1 = XRES + (size_t)MP * DM; e.xout = XRES; e.aout = (bf16_t*)(ws + WS_ABUF2); e.gain = p.in[23]; e.ss = SS + (size_t)MT * 16; e.scale = 1.f;
        run_gemm(lds, ABUF, DM, (const bf16_t*)(ws + WS_WOUT), MP, 1024, 1024, e, 0); small_gemm(lds, ABUF, DM, (const bf16_t*)(ws + WS_WOUT), 1024, 1024, e); PH_END
    PH_BEGIN(10) EpiQ e; e.Q = (bf16_t*)(ws + WS_QBUF); e.ss = SS + (size_t)MT * 16;
        run_gemm(lds, (const bf16_t*)(ws + WS_ABUF2), DM, (const bf16_t*)(ws + WS_WQ), MP, 1024, 1024, e, 0); small_gemm(lds, (const bf16_t*)(ws + WS_ABUF2), DM, (const bf16_t*)(ws + WS_WQ), 1024, 1024, e); PH_END
    PH_BEGIN(11)
#pragma unroll 1
        for (int pass = 0; pass < 2; ++pass) {
            if (((blockIdx.x & 1) != 0) == (pass == 0)) { for (int it = blockIdx.x; it < 512; it += gridDim.x) attn_sample(p, lds, it); }
            else { for (int it = blockIdx.x; it < 512; it += gridDim.x) attn_prompt(p, lds, it); }
        }
    PH_END
    PH_BEGIN(12) EpiResid e; e.res0 = XRES; e.res1 = XRES + (size_t)MP * DM; e.xout = XRES; e.aout = ABUF; e.gain = p.in[29]; e.ss = SS + (size_t)MT * 32; e.scale = 1.f;
        run_gemm(lds, (const bf16_t*)(ws + WS_OBUF), DM, (const bf16_t*)(ws + WS_WO), MP, 1024, 1024, e, 0); small_gemm(lds, (const bf16_t*)(ws + WS_OBUF), DM, (const bf16_t*)(ws + WS_WO), 1024, 1024, e); PH_END
    PH_BEGIN(13) EpiGateUp e; e.H = Z; e.ss = SS + (size_t)MT * 32;
        run_gemm(lds, ABUF, DM, (const bf16_t*)(ws + WS_WGU2), MT, 5632, 1024, e, 0); PH_END
    PH_BEGIN(14) EpiResid e; e.res0 = XRES; e.res1 = XRES + (size_t)MP * DM; e.xout = TMP; e.aout = nullptr; e.gain = nullptr; e.ss = SS + (size_t)MT * 48; e.scale = 0.5f;
        run_gemm(lds, Z, DFF, (const bf16_t*)(ws + WS_WD2), MP, 1024, DFF, e, 0); small_gemm(lds, Z, DFF, (const bf16_t*)(ws + WS_WD2), 1024, DFF, e); PH_END
    PH_BEGIN(15)
        const int lane = threadIdx.x & 63, gw = blockIdx.x * 8 + (threadIdx.x >> 6), nw = gridDim.x * 8;
        for (int r = gw; r < MT; r += nw) { const float rs = rs_row(SS + (size_t)MT * 48, r); float* y = TMP + (size_t)r * DM;
#pragma unroll
            for (int i = 0; i < 4; ++i) { f32x4 v = *(const f32x4*)(y + i * 256 + lane * 4); const f32x4 gg = *(const f32x4*)(p.in[33] + i * 256 + lane * 4);
                __builtin_nontemporal_store(v * rs * gg, (f32x4*)(y + i * 256 + lane * 4)); } }
    PH_END
}

template <int KMASK> static bool setup_kernel() {
    if (hipFuncSetAttribute((const void*)fwd_kernel<KMASK>, hipFuncAttributeMaxDynamicSharedMemorySize, LDS_BYTES) != hipSuccess) { fprintf(stderr, "kernel_launch: hipFuncSetAttribute failed\n"); return false; }
    int per_cu = 0;
    if (hipOccupancyMaxActiveBlocksPerMultiprocessor(&per_cu, (const void*)fwd_kernel<KMASK>, NTHREADS, LDS_BYTES) != hipSuccess || per_cu < 1) fprintf(stderr, "kernel_launch: occupancy query says %d\n", per_cu);
    (void)hipGetLastError();
    return true;
}
template <int KMASK> static void launch_range(Params p, int lo, int hi, int grid, hipStream_t stream) {
    p.ph_lo = lo; p.ph_hi = hi;
    if (hipMemsetAsync((char*)p.ws + WS_BAR, 0, XCD_BAR_WORDS * 4, stream) != hipSuccess) { fprintf(stderr, "kernel_launch: memset of the barrier words failed\n"); return; }
    void* args[] = {&p};
    hipError_t e = hipLaunchCooperativeKernel((const void*)fwd_kernel<KMASK>, dim3(grid), dim3(NTHREADS), args, LDS_BYTES, stream);
    if (e != hipSuccess) fprintf(stderr, "kernel_launch: cooperative launch [%d,%d) failed: %s (grid %d)\n", lo, hi, hipGetErrorString(e), grid);
}
#ifndef N_LAUNCH
#define N_LAUNCH 1
#endif
extern "C" void kernel_launch(void* const* d_in, const int* in_sizes, int n_in, void* d_out, int out_size, void* d_ws, size_t ws_size, hipStream_t stream) {
    static int grid = 0;
    if (grid == 0) {
        if (n_in != 34 || (size_t)out_size != O_END || ws_size < WS_END) { fprintf(stderr, "kernel_launch: unexpected sizes n_in %d out %d ws %zu (need %zu)\n", n_in, out_size, ws_size, (size_t)WS_END); grid = -1; return; }
        int dev = 0, cus = 0;
        (void)hipGetDevice(&dev); (void)hipDeviceGetAttribute(&cus, hipDeviceAttributeMultiprocessorCount, dev);
        bool ok = true;
#if N_LAUNCH == 1
        ok = setup_kernel<0xffff>();
#else
        ok = setup_kernel<0x3fef>() && setup_kernel<0x0010>();
#endif
        if (!ok) { grid = -1; return; }
        grid = cus;
        if (grid < 64) { fprintf(stderr, "kernel_launch: needs >= 64 CUs\n"); grid = -1; return; }
    }
    if (grid < 0) return;
    Params p{};
    for (int i = 0; i < 34; ++i) p.in[i] = (const float*)d_in[i];
    p.out = (float*)d_out; p.ws = (unsigned char*)d_ws;
#if N_LAUNCH == 1
#ifndef PROBE_K
#define PROBE_K -1
#endif
#ifndef PROBE_BACK
#define PROBE_BACK 0
#endif
    if (PROBE_K >= 0) { launch_range<0xffff>(p, 0, PROBE_K + 1, grid, stream); launch_range<0xffff>(p, PROBE_K - PROBE_BACK, 16, grid, stream); }
    else launch_range<0xffff>(p, 0, 16, grid, stream);
#else
#ifndef DBG_HI
#define DBG_HI 14
#endif
    launch_range<0x3fef>(p, 0, DBG_HI < 4 ? DBG_HI : 4, grid, stream);
    if (DBG_HI > 4) launch_range<0x0010>(p, 4, 5, grid, stream);
    if (DBG_HI > 5) launch_range<0x3fef>(p, 5, DBG_HI, grid, stream);
#endif
}
```

```cpp
#include <hip/hip_runtime.h>
#include <hip/hip_cooperative_groups.h>
#include <cstdio>
namespace cg = cooperative_groups;
namespace pg8 {
#define PG8_LAS __attribute__((address_space(3)))
typedef unsigned short bf16_t;
typedef short bf16x8 __attribute__((ext_vector_type(8)));
typedef float f32x4 __attribute__((ext_vector_type(4)));
typedef unsigned u32x4 __attribute__((ext_vector_type(4)));
constexpr int BM = 256, BK = 64, HALF = 128, HTB = HALF * BK * 2  , STAGE_BYTES = 8 * HTB, NXCD = 8, WGM = 8;

__host__ __device__ __forceinline__ int lds_byte(int r, int c) { const int st = (r >> 4) * 2 + (c >> 5), rr = r & 15, cc = c & 31, ob = rr * 64 + cc * 2; return st * 1024 + (ob ^ (((ob >> 9) & 1) << 5)); }
__host__ __device__ __forceinline__ void stage_rc(int b, int& R, int& C) { const int st = b / 1024, sb = b % 1024, swz = sb ^ (((sb >> 9) & 1) << 5); R = (st >> 1) * 16 + swz / 64; C = (st & 1) * 32 + (swz % 64) / 2; }
__host__ __device__ __forceinline__ int perm32(int rho) { const int n = rho >> 4, i = rho & 15; return 8 * (i >> 2) + 4 * n + (i & 3); }

struct Unit { int pm, pn; };
struct Gemm { const bf16_t* A; const bf16_t* Bt; int M, N, K, lda, ldb; };
struct StaticOrder {
    int nM, nN, nwg, G, c;
    __host__ __device__ void init(int M, int N, int G_, int c_) { nM = M / BM; nN = N / BM; nwg = nM * nN; G = G_; c = c_; }
    __host__ __device__ bool next(int i, Unit& u) const {
        const long L = (long)i * G + c; if (L >= nwg) return false;
        int wgid = (int)L; { const int q = nwg / NXCD, r = nwg % NXCD, xcd = wgid % NXCD, off = wgid / NXCD; wgid = (xcd < r ? xcd * (q + 1) : r * (q + 1) + (xcd - r) * q) + off; }
        const int nig = WGM * nN, gid = wgid / nig, fm = gid * WGM, gsz = (nM - fm) < WGM ? (nM - fm) : WGM;
        u.pm = fm + ((wgid % nig) % gsz); u.pn = (wgid % nig) / gsz; return true;
    }
    __device__ __forceinline__ void a_ready(const Unit&) const {}
    __device__ __forceinline__ void done(const Unit&) const {}
};
__device__ __forceinline__ unsigned cvt_pk_bf16(float lo, float hi) { unsigned r; asm volatile("v_cvt_pk_bf16_f32 %0, %1, %2" : "=v"(r) : "v"(lo), "v"(hi)); return r; }
template <class Epi, class Sched>
__device__ __forceinline__ void gemm_phase(PG8_LAS unsigned char* lds, const Gemm g, const Sched& S, const Epi& E) {
    const int tid = threadIdx.x, wid = __builtin_amdgcn_readfirstlane(tid >> 6), lane = tid & 63, wr = wid >> 2, wc = wid & 3, fr = lane & 15, fq = lane >> 4;
    const int K = g.K, nt = K / BK;
    unsigned voffA[2], voffB[2];
#pragma unroll
    for (int i = 0; i < 2; ++i) { int R, C; stage_rc(tid * 16 + i * 8192, R, C); const int Rb = Epi::PERM ? ((R & ~31) + perm32(R & 31)) : R;
        voffA[i] = (unsigned)(R * g.lda + C) * 2u; voffB[i] = (unsigned)(Rb * g.ldb + C) * 2u; }
    const size_t kstep = (size_t)(BK * 2);
    const size_t hstepA = (size_t)HALF * g.lda * 2, hstepB = (size_t)HALF * g.ldb * 2;
    const size_t tstepA = 2 * hstepA, tstepB = 2 * hstepB;
    const unsigned ldsw = (unsigned)wid * 1024u;
    const int aoff = lds_byte(wr * 64 + fr, fq * 8), boff = lds_byte(wc * 32 + fr, fq * 8);
#define PG8_SA(b, h) (((b) * 2 + (h)) * HTB)
#define PG8_SB(b, h) ((4 + (b) * 2 + (h)) * HTB)
#define PG8_STAGE(bufoff, gbase, voff) do { _Pragma("unroll") for (int _i = 0; _i < 2; ++_i) \
        __builtin_amdgcn_global_load_lds((const unsigned*)((const char*)(gbase) + (voff)[_i]), (PG8_LAS unsigned*)(lds + (bufoff) + ldsw + _i * 8192), 16, 0, 0); } while (0)
#define PG8_LDA(dst, b, h) do { _Pragma("unroll") for (int m = 0; m < 4; ++m) _Pragma("unroll") for (int k = 0; k < 2; ++k) dst[m][k] = *(const PG8_LAS bf16x8*)(lds + PG8_SA(b, h) + aoff + m * 2048 + k * 1024); } while (0)
#define PG8_LDB(dst, b, h) do { _Pragma("unroll") for (int n = 0; n < 2; ++n) _Pragma("unroll") for (int k = 0; k < 2; ++k) dst[n][k] = *(const PG8_LAS bf16x8*)(lds + PG8_SB(b, h) + boff + n * 2048 + k * 1024); } while (0)
#define PG8_MMA(ai, bj, At, Bt) do { __builtin_amdgcn_s_setprio(1); _Pragma("unroll") for (int m = 0; m < 4; ++m) _Pragma("unroll") for (int n = 0; n < 2; ++n) _Pragma("unroll") for (int k = 0; k < 2; ++k) \
        acc[ai][bj][m][n] = __builtin_amdgcn_mfma_f32_16x16x32_bf16(Bt[n][k], At[m][k], acc[ai][bj][m][n], 0, 0, 0); __builtin_amdgcn_s_setprio(0); } while (0)
#define PG8_WAIT_V(n) asm volatile("s_waitcnt vmcnt(" #n ")" ::: "memory")
#define PG8_WAIT_L(n) asm volatile("s_waitcnt lgkmcnt(" #n ")" ::: "memory")
#define PG8_BAR __builtin_amdgcn_s_barrier()
#define PG8_SCHED __builtin_amdgcn_sched_barrier(0)
    Unit cur, nxt; int ui = 0;
    if (!S.next(0, cur)) return;
    f32x4 acc[2][2][4][2];
#pragma unroll
    for (int a = 0; a < 2; ++a)
#pragma unroll
        for (int b = 0; b < 2; ++b)
#pragma unroll
            for (int m = 0; m < 4; ++m)
#pragma unroll
                for (int n = 0; n < 2; ++n) acc[a][b][m][n] = (f32x4){0.f, 0.f, 0.f, 0.f};
    bf16x8 At[4][2], B0[2][2], B1[2][2];
    const char* cA = (const char*)g.A + (size_t)cur.pm * tstepA; const char* cB = (const char*)g.Bt + (size_t)cur.pn * tstepB;
    S.a_ready(cur);
    PG8_STAGE(PG8_SB(0, 0), cB, voffB); PG8_STAGE(PG8_SA(0, 0), cA, voffA); PG8_STAGE(PG8_SB(0, 1), cB + hstepB, voffB); PG8_STAGE(PG8_SA(0, 1), cA + hstepA, voffA);
    if (wr == 1) PG8_BAR;
    PG8_WAIT_V(4); PG8_BAR;
    PG8_STAGE(PG8_SB(1, 0), cB + kstep, voffB); PG8_STAGE(PG8_SA(1, 0), cA + kstep, voffA); PG8_STAGE(PG8_SB(1, 1), cB + hstepB + kstep, voffB);
    PG8_WAIT_V(6); PG8_BAR;
    for (;;) {
        const bool has_next = S.next(ui + 1, nxt);
        const char* nA = has_next ? (const char*)g.A + (size_t)nxt.pm * tstepA : cA; const char* nB = has_next ? (const char*)g.Bt + (size_t)nxt.pn * tstepB : cB;
        for (int t = 0; t < nt; t += 2) {
            const bool last = (t == nt - 2);
            const char* a1 = cA + (size_t)(t + 1) * kstep;
            const char* a2 = last ? nA : cA + (size_t)(t + 2) * kstep; const char* b2 = last ? nB : cB + (size_t)(t + 2) * kstep;
            const char* a3 = a2 + kstep; const char* b3 = b2 + kstep;
            if (last && has_next) S.a_ready(nxt);
            PG8_LDB(B0, 0, 0); PG8_SCHED; PG8_LDA(At, 0, 0); PG8_STAGE(PG8_SA(1, 1), a1 + hstepA, voffA);
            PG8_WAIT_L(8); PG8_BAR; PG8_WAIT_L(0); PG8_MMA(0, 0, At, B0); PG8_BAR; PG8_SCHED;
            PG8_LDB(B1, 0, 1); PG8_STAGE(PG8_SB(0, 0), b2, voffB);
            PG8_BAR; PG8_WAIT_L(0); PG8_MMA(0, 1, At, B1); PG8_BAR;
            PG8_LDA(At, 0, 1); PG8_STAGE(PG8_SA(0, 0), a2, voffA);
            PG8_BAR; PG8_WAIT_L(0); PG8_MMA(1, 0, At, B0); PG8_BAR; PG8_SCHED;
            PG8_STAGE(PG8_SB(0, 1), b2 + hstepB, voffB);
            PG8_WAIT_V(6); PG8_BAR; PG8_MMA(1, 1, At, B1); PG8_BAR;
            PG8_LDB(B0, 1, 0); PG8_SCHED; PG8_LDA(At, 1, 0); PG8_STAGE(PG8_SA(0, 1), a2 + hstepA, voffA);
            PG8_WAIT_L(8); PG8_BAR; PG8_WAIT_L(0); PG8_MMA(0, 0, At, B0); PG8_BAR; PG8_SCHED;
            PG8_LDB(B1, 1, 1); PG8_STAGE(PG8_SB(1, 0), b3, voffB);
            PG8_BAR; PG8_WAIT_L(0); PG8_MMA(0, 1, At, B1); PG8_BAR;
            PG8_LDA(At, 1, 1); PG8_STAGE(PG8_SA(1, 0), a3, voffA);
            PG8_BAR; PG8_WAIT_L(0); PG8_MMA(1, 0, At, B0); PG8_BAR; PG8_SCHED;
            PG8_STAGE(PG8_SB(1, 1), b3 + hstepB, voffB);
            PG8_WAIT_V(6); PG8_BAR; PG8_MMA(1, 1, At, B1); PG8_BAR;
        }
        if constexpr (!Epi::AFTER_DRAIN) { E(acc, cur, wr, wc, fr, fq); S.done(cur); }
        if (!has_next) break;
#pragma unroll
        for (int a = 0; a < 2; ++a)
#pragma unroll
            for (int b = 0; b < 2; ++b)
#pragma unroll
                for (int m = 0; m < 4; ++m)
#pragma unroll
                    for (int n = 0; n < 2; ++n) acc[a][b][m][n] = (f32x4){0.f, 0.f, 0.f, 0.f};
        cur = nxt; cA = nA; cB = nB; ++ui;
    }
    PG8_WAIT_V(0);
    if (wr == 0) PG8_BAR;
    PG8_BAR;
    if constexpr (Epi::AFTER_DRAIN) { E.fused(acc, cur, wr, wc, fr, fq, lds, wid, lane); S.done(cur); }
#undef PG8_SA
#undef PG8_SB
#undef PG8_STAGE
#undef PG8_LDA
#undef PG8_LDB
#undef PG8_MMA
#undef PG8_WAIT_V
#undef PG8_WAIT_L
#undef PG8_BAR
#undef PG8_SCHED
}
}
using pg8::bf16_t; using pg8::bf16x8; using pg8::f32x4; using pg8::u32x4;
typedef short s16x4 __attribute__((ext_vector_type(4)));
typedef unsigned u32x2 __attribute__((ext_vector_type(2)));
#define LAS __attribute__((address_space(3)))

constexpr int MP = 16384, MS = 512, MT = MP + MS, DM = 1024, DFF = 2816, ZLD = 8192, ZSLD = 32;
constexpr int NTHREADS = 512;
constexpr float EPSV = 1e-6f;
constexpr size_t SZ_WGU = 5632ull * 1024 * 2, SZ_WD = 1024ull * 2816 * 2, SZ_WIN = 8448ull * 1024 * 2, SZ_W1K = 1024ull * 1024 * 2;
constexpr size_t WS_WGU1 = 0;
constexpr size_t WS_WD1 = WS_WGU1 + SZ_WGU;
constexpr size_t WS_WIN = WS_WD1 + SZ_WD;
constexpr size_t WS_WBRM = WS_WIN + SZ_WIN;
constexpr size_t WS_WBRG = WS_WBRM + SZ_W1K;
constexpr size_t WS_WOUT = WS_WBRG + SZ_W1K;
constexpr size_t WS_WQ = WS_WOUT + SZ_W1K;
constexpr size_t WS_WO = WS_WQ + SZ_W1K;
constexpr size_t WS_WKV = WS_WO + SZ_W1K;
constexpr size_t WS_WGU2 = WS_WKV + 2 * SZ_W1K;
constexpr size_t WS_WD2 = WS_WGU2 + SZ_WGU;
constexpr size_t WS_ABUF = WS_WD2 + SZ_WD;
constexpr size_t WS_MEMA = WS_ABUF + (size_t)MT * DM * 2;
constexpr size_t WS_MEMKV = WS_MEMA + 2048ull * 1024 * 2;
constexpr size_t WS_XRES = WS_MEMKV + 2048ull * 2048 * 2;
constexpr size_t WS_ZS = WS_XRES + (size_t)MT * DM * 4;
constexpr size_t WS_SS = WS_ZS + (size_t)MT * ZSLD * 4;
constexpr size_t WS_SSQ = WS_SS + 4ull * MT * 16 * 4;
constexpr size_t WS_BEND = WS_SSQ + (size_t)MP * 32 * 4;
constexpr size_t WS_Z = WS_BEND + 1024ull * 128 * 4;
constexpr size_t WS_ABUF2 = WS_Z + (64ull << 20);
constexpr size_t WS_QBUF = WS_Z + (128ull << 20);
constexpr size_t WS_OBUF = WS_Z + (192ull << 20);
constexpr size_t WS_BAR = WS_Z + (size_t)MT * ZLD * 2;
constexpr size_t WS_END = WS_BAR + 16384;
constexpr size_t O_YP = 0, O_YS = 16777216, O_CP = 17301504, O_NP = 18350080, O_MPP = 18354176, O_SP = 18354208, O_MKP = 19402784, O_MVP = 21499936,
                 O_CS = 23597088, O_NS = 40374304, O_MSS = 40439840, O_SS = 40440352, O_END = 57217568;
constexpr int LDS_BYTES = 156 * 1024;

struct Params { const float* in[34]; float* out; unsigned char* ws; int ph_lo, ph_hi; };

typedef float f32x2_t __attribute__((ext_vector_type(2)));
typedef __bf16 bf16x2_t __attribute__((ext_vector_type(2)));
__device__ __forceinline__ unsigned cvt_pk(float lo, float hi) { f32x2_t v = {lo, hi}; bf16x2_t b = __builtin_convertvector(v, bf16x2_t); return __builtin_bit_cast(unsigned, b); }
__device__ __forceinline__ bf16_t f2bf(float x) { return (bf16_t)(cvt_pk(x, 0.f) & 0xffffu); }
__device__ __forceinline__ float bf2f(bf16_t x) { return __uint_as_float(((unsigned)x) << 16); }
__device__ __forceinline__ float bflo(unsigned w) { return __uint_as_float(w << 16); }
__device__ __forceinline__ float bfhi(unsigned w) { return __uint_as_float(w & 0xffff0000u); }
__device__ __forceinline__ float sigmoidf_(float x) { return __builtin_amdgcn_rcpf(1.f + __expf(-x)); }
__device__ __forceinline__ float logsigf_(float x) { return fminf(x, 0.f) - __logf(1.f + __expf(-fabsf(x))); }
__device__ __forceinline__ float rs_of(float ss) { return rsqrtf(ss * (1.f / 1024.f) + EPSV); }
__device__ __forceinline__ float rs_row(const float* ssp, int row) {
    const f32x4* q = (const f32x4*)(ssp + (size_t)row * 16); const f32x4 a = q[0], b = q[1], c = q[2], d = q[3];
    const f32x4 s = (a + b) + (c + d); return rs_of((s[0] + s[1]) + (s[2] + s[3])); }
__device__ __forceinline__ f32x4 mfma16(bf16x8 a, bf16x8 b, f32x4 c) { return __builtin_amdgcn_mfma_f32_16x16x32_bf16(a, b, c, 0, 0, 0); }
__device__ __forceinline__ bf16x8 pack8(f32x4 a, f32x4 b) {
    u32x4 w; w.x = cvt_pk(a[0], a[1]); w.y = cvt_pk(a[2], a[3]); w.z = cvt_pk(b[0], b[1]); w.w = cvt_pk(b[2], b[3]);
    return __builtin_bit_cast(bf16x8, w);
}
__device__ __forceinline__ u32x2 pack4(f32x4 a) { u32x2 w; w.x = cvt_pk(a[0], a[1]); w.y = cvt_pk(a[2], a[3]); return w; }
__device__ __forceinline__ bf16x8 tr_frag(unsigned a0, unsigned a1) {
    s16x4 r0, r1;
    asm volatile("ds_read_b64_tr_b16 %0, %2\n\tds_read_b64_tr_b16 %1, %3\n\ts_waitcnt lgkmcnt(0)" : "=&v"(r0), "=&v"(r1) : "v"(a0), "v"(a1) : "memory");
    return __builtin_shufflevector(r0, r1, 0, 1, 2, 3, 4, 5, 6, 7);
}
__device__ __forceinline__ void tr_frag2(unsigned a0, unsigned a1, unsigned b0, unsigned b1, bf16x8& fa, bf16x8& fb) {
    s16x4 r0, r1, r2, r3;
    asm volatile("ds_read_b64_tr_b16 %0, %4\n\tds_read_b64_tr_b16 %1, %5\n\tds_read_b64_tr_b16 %2, %6\n\tds_read_b64_tr_b16 %3, %7\n\ts_waitcnt lgkmcnt(0)"
                 : "=&v"(r0), "=&v"(r1), "=&v"(r2), "=&v"(r3) : "v"(a0), "v"(a1), "v"(b0), "v"(b1) : "memory");
    fa = __builtin_shufflevector(r0, r1, 0, 1, 2, 3, 4, 5, 6, 7); fb = __builtin_shufflevector(r2, r3, 0, 1, 2, 3, 4, 5, 6, 7);
}
__device__ __forceinline__ void tr_frag4(unsigned a0, unsigned a1, unsigned b0, unsigned b1, unsigned c0, unsigned c1, unsigned d0, unsigned d1, bf16x8& fa, bf16x8& fb, bf16x8& fc, bf16x8& fd) {
    s16x4 r0, r1, r2, r3, r4, r5, r6, r7;
    asm volatile("ds_read_b64_tr_b16 %0, %8\n\tds_read_b64_tr_b16 %1, %9\n\tds_read_b64_tr_b16 %2, %10\n\tds_read_b64_tr_b16 %3, %11\n\t"
                 "ds_read_b64_tr_b16 %4, %12\n\tds_read_b64_tr_b16 %5, %13\n\tds_read_b64_tr_b16 %6, %14\n\tds_read_b64_tr_b16 %7, %15\n\ts_waitcnt lgkmcnt(0)"
                 : "=&v"(r0), "=&v"(r1), "=&v"(r2), "=&v"(r3), "=&v"(r4), "=&v"(r5), "=&v"(r6), "=&v"(r7)
                 : "v"(a0), "v"(a1), "v"(b0), "v"(b1), "v"(c0), "v"(c1), "v"(d0), "v"(d1) : "memory");
    fa = __builtin_shufflevector(r0, r1, 0, 1, 2, 3, 4, 5, 6, 7); fb = __builtin_shufflevector(r2, r3, 0, 1, 2, 3, 4, 5, 6, 7);
    fc = __builtin_shufflevector(r4, r5, 0, 1, 2, 3, 4, 5, 6, 7); fd = __builtin_shufflevector(r6, r7, 0, 1, 2, 3, 4, 5, 6, 7);
}
__device__ __forceinline__ float xsum16_32(float v) { v += __shfl_xor(v, 16); v += __shfl_xor(v, 32); return v; }
__device__ __forceinline__ float xmax16_32(float v) { v = fmaxf(v, __shfl_xor(v, 16)); v = fmaxf(v, __shfl_xor(v, 32)); return v; }
__device__ __forceinline__ float wave_sum(float v) { for (int o = 32; o > 0; o >>= 1) v += __shfl_xor(v, o); return v; }
__device__ __forceinline__ float wave_max(float v) { for (int o = 32; o > 0; o >>= 1) v = fmaxf(v, __shfl_xor(v, o)); return v; }

#define XB_TMO      128
#define XB_XCNT(j)  (256  + 64 * (j))
#define XB_XSUB(j)  (1280 + 64 * (j))
#define XB_XGEN(j)  (2304 + 64 * (j))
#define XB_TOP      3328
#define XB_TOPGEN   3392
#define XCD_BAR_WORDS 3456
#define XB_SPIN_CAP (1u << 18)

__device__ __forceinline__ unsigned xb_ld(unsigned* p)              { return __hip_atomic_load(p, __ATOMIC_RELAXED, __HIP_MEMORY_SCOPE_AGENT); }
__device__ __forceinline__ unsigned xb_add(unsigned* p, unsigned v) { return __hip_atomic_fetch_add(p, v, __ATOMIC_RELAXED, __HIP_MEMORY_SCOPE_AGENT); }
__device__ __forceinline__ unsigned xb_xcc_id() { return (unsigned)__builtin_amdgcn_s_getreg((3 << 11) | 20) & 0xFu; }
#define XB_SPIN(cond, bar) do { unsigned _sp = 0; while (cond) { __builtin_amdgcn_s_sleep(1); \
    if ((++_sp & 255u) == 0u) { if (xb_ld(&(bar)[XB_TMO])) break; if (_sp > XB_SPIN_CAP) { atomicAdd(&(bar)[XB_TMO], 1u); break; } } } } while (0)

struct XcdBarrier {
    unsigned* bar; unsigned x;
    volatile LAS unsigned* st;
};

__device__ __forceinline__ XcdBarrier xcd_barrier_post(unsigned* bar, volatile LAS unsigned* st) {
    XcdBarrier b; b.bar = bar; b.x = xb_xcc_id(); b.st = st;
    if (threadIdx.x == 0) (void)xb_add(&bar[XB_XCNT(b.x)], 1u);
    return b;
}
__device__ __forceinline__ void xcd_barrier_complete(unsigned* bar, unsigned x, unsigned& nloc, unsigned& nx) {
    const unsigned G = gridDim.x * gridDim.y * gridDim.z;
    unsigned sum, cnt, mine, sp = 0u;
    for (;;) {
        sum = 0u; cnt = 0u; mine = 0u;
#pragma unroll
        for (unsigned j = 0; j < 16; ++j) { const unsigned c = xb_ld(&bar[XB_XCNT(j)]); sum += c; cnt += (c > 0u) ? 1u : 0u; mine = (j == x) ? c : mine; }
        if (sum == G) break;
        __builtin_amdgcn_s_sleep(1);
        if ((++sp & 255u) == 0u) { if (xb_ld(&bar[XB_TMO])) break; if (sp > XB_SPIN_CAP) { atomicAdd(&bar[XB_TMO], 1u); break; } }
    }
    nloc = mine > 0u ? mine : 1u; nx = cnt > 0u ? cnt : 1u;
}

__device__ __forceinline__ void xcd_barrier(const XcdBarrier& b) {
    asm volatile("s_waitcnt vmcnt(0)" ::: "memory");
    __syncthreads();
    if (threadIdx.x == 0) {
        unsigned* bar = b.bar;
        __builtin_amdgcn_s_waitcnt(0);
        unsigned nloc = b.st[0], nx = b.st[1];
        if (nloc == 0u) { xcd_barrier_complete(bar, b.x, nloc, nx); b.st[0] = nloc; b.st[1] = nx; }
        const unsigned old = xb_add(&bar[XB_XSUB(b.x)], 1u);
        const unsigned gen = old / nloc;
        if (old + 1u == (gen + 1u) * nloc) {
            __builtin_amdgcn_fence(__ATOMIC_RELEASE, "agent");
            asm volatile("s_waitcnt vmcnt(0)" ::: "memory");
            const unsigned og = xb_add(&bar[XB_TOP], 1u);
            const unsigned tg = og / nx;
            if (og + 1u == (tg + 1u) * nx) xb_add(&bar[XB_TOPGEN], 1u);
            else XB_SPIN(xb_ld(&bar[XB_TOPGEN]) == tg, bar);
            __builtin_amdgcn_fence(__ATOMIC_ACQUIRE, "agent");
            xb_add(&bar[XB_XGEN(b.x)], 1u);
            asm volatile("s_waitcnt vmcnt(0)" ::: "memory");
        } else {
            XB_SPIN(xb_ld(&bar[XB_XGEN(b.x)]) == gen, bar);
            __builtin_amdgcn_fence(__ATOMIC_ACQUIRE, "agent");
            asm volatile("s_waitcnt vmcnt(0)" ::: "memory");
        }
    }
    __syncthreads();
}


constexpr int PREP_EARLY_MASK = 0x060f, PREP_LATE_MASK = 0x39f0;
__device__ __forceinline__ int win_src_col(int r) {
    if (r < 3072) return r; if (r < 6144) return r + 8; if (r < 8192) return r + 24;
    if (r < 8200) return 3072 + (r - 8192); if (r < 8216) return 6152 + (r - 8200); return -1;
}
__device__ __forceinline__ void prep_transposes(const Params& p, unsigned char* lds, int dmask, int vb, int nvb) {
    float* tile = (float*)lds;
    const int tid = threadIdx.x;
    unsigned char* ws = p.ws;
    for (int d = 0; d < 14; ++d) {
        if (!((dmask >> d) & 1)) continue;
        const float* src; bf16_t* dst; int K, ldsrc, ntn, mode = 0, rowoff = 0; float scale = 1.f;
        switch (d) {
            case 0: src = p.in[10]; dst = (bf16_t*)(ws + WS_WGU1); K = 1024; ldsrc = 2816; ntn = 44; mode = 2; rowoff = 0; break;
            case 1: src = p.in[11]; dst = (bf16_t*)(ws + WS_WGU1); K = 1024; ldsrc = 2816; ntn = 44; mode = 2; rowoff = 128; break;
            case 2: src = p.in[12]; dst = (bf16_t*)(ws + WS_WD1); K = 2816; ldsrc = 1024; ntn = 16; break;
            case 3: src = p.in[14]; dst = (bf16_t*)(ws + WS_WIN); K = 1024; ldsrc = 8216; ntn = 132; mode = 1; break;
            case 4: src = p.in[20]; dst = (bf16_t*)(ws + WS_WBRM); K = 1024; ldsrc = 1024; ntn = 16; break;
            case 5: src = p.in[21]; dst = (bf16_t*)(ws + WS_WBRG); K = 1024; ldsrc = 1024; ntn = 16; break;
            case 6: src = p.in[22]; dst = (bf16_t*)(ws + WS_WOUT); K = 1024; ldsrc = 1024; ntn = 16; break;
            case 7: src = p.in[25]; dst = (bf16_t*)(ws + WS_WQ); K = 1024; ldsrc = 1024; ntn = 16; scale = 0.0625f; break;
            case 8: src = p.in[28]; dst = (bf16_t*)(ws + WS_WO); K = 1024; ldsrc = 1024; ntn = 16; break;
            case 9: src = p.in[26]; dst = (bf16_t*)(ws + WS_WKV); K = 1024; ldsrc = 1024; ntn = 16; break;
            case 10: src = p.in[27]; dst = (bf16_t*)(ws + WS_WKV); K = 1024; ldsrc = 1024; ntn = 16; rowoff = 1024; break;
            case 11: src = p.in[30]; dst = (bf16_t*)(ws + WS_WGU2); K = 1024; ldsrc = 2816; ntn = 44; mode = 2; rowoff = 0; break;
            case 12: src = p.in[31]; dst = (bf16_t*)(ws + WS_WGU2); K = 1024; ldsrc = 2816; ntn = 44; mode = 2; rowoff = 128; break;
            default: src = p.in[32]; dst = (bf16_t*)(ws + WS_WD2); K = 2816; ldsrc = 1024; ntn = 16; break;
        }
        const int nkt = K / 64, ntiles = nkt * ntn;
        for (int t = vb; t < ntiles; t += nvb) {
            const int kt = t % nkt, nt = t / nkt, k0 = kt * 64;
            {
                const int j = tid & 63;
                int srccol; float sc = scale;
                if (mode == 1) { srccol = win_src_col(nt * 64 + j); if ((srccol >= 512 && srccol < 1024) || (srccol >= 3080 && srccol < 3592)) sc = 0.08838834764831845f; }
                else srccol = nt * 64 + j;
#pragma unroll
                for (int ps = 0; ps < 8; ++ps) { const int i = (tid >> 6) + 8 * ps;
                    float v = 0.f; if (srccol >= 0) v = __builtin_nontemporal_load(src + (size_t)(k0 + i) * ldsrc + srccol) * sc;
                    tile[i * 65 + j] = v; }
            }
            __syncthreads();
            {
                const int j = tid >> 3, kc = tid & 7;
                int dstrow;
                if (mode == 1) dstrow = nt * 64 + j;
                else { const int sc_ = nt * 64 + j; dstrow = (mode == 2) ? ((sc_ >> 7) * 256 + (sc_ & 127) + rowoff) : (sc_ + rowoff); }
                float v[8];
#pragma unroll
                for (int e = 0; e < 8; ++e) v[e] = tile[(kc * 8 + e) * 65 + j];
                u32x4 w; w.x = cvt_pk(v[0], v[1]); w.y = cvt_pk(v[2], v[3]); w.z = cvt_pk(v[4], v[5]); w.w = cvt_pk(v[6], v[7]);
                *(u32x4*)(dst + (size_t)dstrow * K + k0 + kc * 8) = w;
            }
            __syncthreads();
        }
    }
}
__device__ __forceinline__ void prep_phase(const Params& p, unsigned char* lds) {
    const int tid = threadIdx.x;
    unsigned char* ws = p.ws;
    prep_transposes(p, lds, PREP_EARLY_MASK, (int)blockIdx.x, (int)gridDim.x);
    const int lane = tid & 63, gw = blockIdx.x * 8 + (tid >> 6), nw = gridDim.x * 8;
    for (int r = gw; r < MT + 2048; r += nw) {
        const float* x; const float* g; bf16_t* o;
        if (r < MP) { x = p.in[0] + (size_t)r * DM; g = p.in[9]; o = (bf16_t*)(ws + WS_ABUF) + (size_t)r * DM; }
        else if (r < MT) { x = p.in[1] + (size_t)(r - MP) * DM; g = p.in[9]; o = (bf16_t*)(ws + WS_ABUF) + (size_t)r * DM; }
        else { x = p.in[2] + (size_t)(r - MT) * DM; g = p.in[24]; o = (bf16_t*)(ws + WS_MEMA) + (size_t)(r - MT) * DM; }
        f32x4 v[4]; float ss = 0.f;
#pragma unroll
        for (int i = 0; i < 4; ++i) { v[i] = *(const f32x4*)(x + i * 256 + lane * 4); ss += v[i][0] * v[i][0] + v[i][1] * v[i][1] + v[i][2] * v[i][2] + v[i][3] * v[i][3]; }
        ss = wave_sum(ss); const float rs = rs_of(ss);
#pragma unroll
        for (int i = 0; i < 4; ++i) { const f32x4 gg = *(const f32x4*)(g + i * 256 + lane * 4);
            u32x2 w; w.x = cvt_pk(v[i][0] * rs * gg[0], v[i][1] * rs * gg[1]); w.y = cvt_pk(v[i][2] * rs * gg[2], v[i][3] * rs * gg[3]);
            *(u32x2*)(o + i * 256 + lane * 4) = w; }
    }
}

#define EPI_ROW(ai, m) (u.pm * 256 + (ai) * 128 + wr * 64 + (m) * 16 + fr)
#define EPI_COL(bj) (u.pn * 256 + (bj) * 128 + wc * 32 + fq * 8)
struct EpiGateUp {
    static constexpr bool PERM = true, AFTER_DRAIN = false;
    bf16_t* H; const float* ss;
    __device__ __forceinline__ void operator()(const f32x4 (&acc)[2][2][4][2], const pg8::Unit& u, int wr, int wc, int fr, int fq) const {
        float rsv[2][4];
#pragma unroll
        for (int ai = 0; ai < 2; ++ai)
#pragma unroll
            for (int m = 0; m < 4; ++m) rsv[ai][m] = ss ? rs_row(ss, EPI_ROW(ai, m)) : 1.f;
#pragma unroll
        for (int ai = 0; ai < 2; ++ai)
#pragma unroll
            for (int m = 0; m < 4; ++m) { const int row = EPI_ROW(ai, m); const float rs = rsv[ai][m];
                f32x4 hv[2];
#pragma unroll
                for (int n = 0; n < 2; ++n)
#pragma unroll
                    for (int j = 0; j < 4; ++j) { const float gt = acc[ai][0][m][n][j] * rs, up = acc[ai][1][m][n][j] * rs; hv[n][j] = gt * sigmoidf_(gt) * up; }
                *(u32x4*)(H + (size_t)row * DFF + u.pn * 128 + wc * 32 + fq * 8) = __builtin_bit_cast(u32x4, pack8(hv[0], hv[1])); }
    }
};
struct EpiMemKV {
    static constexpr bool PERM = true, AFTER_DRAIN = false;
    float* ok; float* ov; bf16_t* kv;
    __device__ __forceinline__ void operator()(const f32x4 (&acc)[2][2][4][2], const pg8::Unit& u, int wr, int wc, int fr, int fq) const {
#pragma unroll
        for (int ai = 0; ai < 2; ++ai)
#pragma unroll
            for (int m = 0; m < 4; ++m) { const int row = EPI_ROW(ai, m);
#pragma unroll
                for (int bj = 0; bj < 2; ++bj) { const int col = EPI_COL(bj);
                    float* o = (col < 1024) ? (ok + (size_t)row * 1024 + col) : (ov + (size_t)row * 1024 + (col - 1024));
                    __builtin_nontemporal_store(acc[ai][bj][m][0], (f32x4*)o); __builtin_nontemporal_store(acc[ai][bj][m][1], (f32x4*)(o + 4));
                    *(u32x4*)(kv + (size_t)row * 2048 + col) = __builtin_bit_cast(u32x4, pack8(acc[ai][bj][m][0], acc[ai][bj][m][1])); } }
    }
};
struct EpiResid {
    static constexpr bool PERM = true, AFTER_DRAIN = false;
    const float* res0; const float* res1; float* xout; bf16_t* aout; const float* gain; float* ss; float scale;
    __device__ __forceinline__ void operator()(const f32x4 (&acc)[2][2][4][2], const pg8::Unit& u, int wr, int wc, int fr, int fq) const {
        f32x4 gv[2][2];
        if (aout) {
#pragma unroll
            for (int bj = 0; bj < 2; ++bj) { gv[bj][0] = *(const f32x4*)(gain + EPI_COL(bj)); gv[bj][1] = *(const f32x4*)(gain + EPI_COL(bj) + 4); } }
#pragma unroll
        for (int ai = 0; ai < 2; ++ai) {
            f32x4 rv[4][2][2];
#pragma unroll
            for (int m = 0; m < 4; ++m) { const int row = EPI_ROW(ai, m);
                const float* rp = (row < MP) ? (res0 + (size_t)row * DM) : (res1 + (size_t)(row - MP) * DM);
#pragma unroll
                for (int bj = 0; bj < 2; ++bj) { rv[m][bj][0] = *(const f32x4*)(rp + EPI_COL(bj)); rv[m][bj][1] = *(const f32x4*)(rp + EPI_COL(bj) + 4); } }
#pragma unroll
            for (int m = 0; m < 4; ++m) { const int row = EPI_ROW(ai, m);
                float sq = 0.f;
#pragma unroll
                for (int bj = 0; bj < 2; ++bj) { const int col = EPI_COL(bj);
                    const f32x4 x0 = rv[m][bj][0] + acc[ai][bj][m][0] * scale, x1 = rv[m][bj][1] + acc[ai][bj][m][1] * scale;
                    *(f32x4*)(xout + (size_t)row * DM + col) = x0; *(f32x4*)(xout + (size_t)row * DM + col + 4) = x1;
#pragma unroll
                    for (int j = 0; j < 4; ++j) sq += x0[j] * x0[j] + x1[j] * x1[j];
                    if (aout) *(u32x4*)(aout + (size_t)row * DM + col) = __builtin_bit_cast(u32x4, pack8(x0 * gv[bj][0], x1 * gv[bj][1])); }
                sq = xsum16_32(sq);
                if (fq == 0) ss[(size_t)row * 16 + u.pn * 4 + wc] = sq; }
        }
    }
    __device__ __forceinline__ void small(f32x4 acc, int row, int col, int tc, int rt, int ct, int l16, int g, unsigned char* lds) const {
        const f32x4 x = *(const f32x4*)(res1 + (size_t)(row - MP) * DM + col) + acc * scale;
        *(f32x4*)(xout + (size_t)row * DM + col) = x;
        if (aout) { const f32x4 gv4 = *(const f32x4*)(gain + col); *(u32x2*)(aout + (size_t)row * DM + col) = pack4(x * gv4); }
        float sq = x[0] * x[0] + x[1] * x[1] + x[2] * x[2] + x[3] * x[3];
        sq = xsum16_32(sq);
        float* red = (float*)lds;
        if (g == 0) red[(rt * 4 + ct) * 16 + l16] = sq;
        __syncthreads();
        if (ct == 0 && g == 0) ss[(size_t)row * 16 + tc] = (red[(rt * 4) * 16 + l16] + red[(rt * 4 + 1) * 16 + l16]) + (red[(rt * 4 + 2) * 16 + l16] + red[(rt * 4 + 3) * 16 + l16]);
        __syncthreads();
    }
};
struct EpiZ {
    static constexpr bool PERM = true, AFTER_DRAIN = false;
    bf16_t* Z; float* ZS; const float* ss;
    __device__ __forceinline__ void operator()(const f32x4 (&acc)[2][2][4][2], const pg8::Unit& u, int wr, int wc, int fr, int fq) const {
#pragma unroll
        for (int ai = 0; ai < 2; ++ai) {
            float rsv[4];
#pragma unroll
            for (int m = 0; m < 4; ++m) rsv[m] = rs_row(ss, EPI_ROW(ai, m));
#pragma unroll
            for (int m = 0; m < 4; ++m) { const int row = EPI_ROW(ai, m); const float rs = rsv[m];
                if (u.pn < 32) {
#pragma unroll
                    for (int bj = 0; bj < 2; ++bj)
                        *(u32x4*)(Z + (size_t)row * ZLD + EPI_COL(bj)) = __builtin_bit_cast(u32x4, pack8(acc[ai][bj][m][0] * rs, acc[ai][bj][m][1] * rs));
                } else if (wc == 0) {
                    *(f32x4*)(ZS + (size_t)row * ZSLD + fq * 8) = acc[ai][0][m][0] * rs; *(f32x4*)(ZS + (size_t)row * ZSLD + fq * 8 + 4) = acc[ai][0][m][1] * rs;
                } } }
    }
};
template <int MODE> struct EpiMerge {
    static constexpr bool PERM = true, AFTER_DRAIN = false;
    const bf16_t* gate; float* T; bf16_t* Y;
    __device__ __forceinline__ void operator()(const f32x4 (&acc)[2][2][4][2], const pg8::Unit& u, int wr, int wc, int fr, int fq) const {
#pragma unroll
        for (int ai = 0; ai < 2; ++ai)
#pragma unroll
            for (int mh = 0; mh < 2; ++mh) {
                u32x4 gw[2][2]; u32x4 tvb[2][2]; bf16_t* Tb = (bf16_t*)T;
#pragma unroll
                for (int mm = 0; mm < 2; ++mm) { const int row = EPI_ROW(ai, mh * 2 + mm);
#pragma unroll
                    for (int bj = 0; bj < 2; ++bj) { gw[mm][bj] = *(const u32x4*)(gate + (size_t)row * ZLD + EPI_COL(bj));
                        if (MODE == 1) tvb[mm][bj] = *(const u32x4*)(Tb + (size_t)row * DM + EPI_COL(bj)); } }
#pragma unroll
                for (int mm = 0; mm < 2; ++mm) { const int m = mh * 2 + mm, row = EPI_ROW(ai, m);
#pragma unroll
                    for (int bj = 0; bj < 2; ++bj) { const int col = EPI_COL(bj); const u32x4 g4 = gw[mm][bj];
                        f32x4 s0, s1;
                        s0[0] = sigmoidf_(bflo(g4.x)); s0[1] = sigmoidf_(bfhi(g4.x)); s0[2] = sigmoidf_(bflo(g4.y)); s0[3] = sigmoidf_(bfhi(g4.y));
                        s1[0] = sigmoidf_(bflo(g4.z)); s1[1] = sigmoidf_(bfhi(g4.z)); s1[2] = sigmoidf_(bflo(g4.w)); s1[3] = sigmoidf_(bfhi(g4.w));
                        f32x4 v0 = acc[ai][bj][m][0] * s0, v1 = acc[ai][bj][m][1] * s1;
                        if (MODE == 0) *(u32x4*)(Tb + (size_t)row * DM + col) = __builtin_bit_cast(u32x4, pack8(v0, v1));
                        else { const u32x4 t4 = tvb[mm][bj];
                            v0 += (f32x4){bflo(t4.x), bfhi(t4.x), bflo(t4.y), bfhi(t4.y)}; v1 += (f32x4){bflo(t4.z), bfhi(t4.z), bflo(t4.w), bfhi(t4.w)};
                            *(u32x4*)(Y + (size_t)row * DM + col) = __builtin_bit_cast(u32x4, pack8(v0, v1)); } } }
            }
    }
    __device__ __forceinline__ void small(f32x4 acc, int row, int col, int tc, int rt, int ct, int l16, int g, unsigned char* lds) const {
        bf16_t* Tb = (bf16_t*)T;
        const u32x2 g2 = *(const u32x2*)(gate + (size_t)row * ZLD + col);
        f32x4 v = acc * (f32x4){sigmoidf_(bflo(g2.x)), sigmoidf_(bfhi(g2.x)), sigmoidf_(bflo(g2.y)), sigmoidf_(bfhi(g2.y))};
        if (MODE == 0) *(u32x2*)(Tb + (size_t)row * DM + col) = pack4(v);
        else { const u32x2 t2 = *(const u32x2*)(Tb + (size_t)row * DM + col);
            v += (f32x4){bflo(t2.x), bfhi(t2.x), bflo(t2.y), bfhi(t2.y)};
            *(u32x2*)(Y + (size_t)row * DM + col) = pack4(v); }
    }
};
struct EpiQ {
    static constexpr bool PERM = true, AFTER_DRAIN = false;
    bf16_t* Q; const float* ss;
    __device__ __forceinline__ void operator()(const f32x4 (&acc)[2][2][4][2], const pg8::Unit& u, int wr, int wc, int fr, int fq) const {
#pragma unroll
        for (int ai = 0; ai < 2; ++ai) {
            float rsv[4];
#pragma unroll
            for (int m = 0; m < 4; ++m) rsv[m] = rs_row(ss, EPI_ROW(ai, m));
#pragma unroll
            for (int m = 0; m < 4; ++m) { const int row = EPI_ROW(ai, m); const float rs = rsv[m];
#pragma unroll
                for (int bj = 0; bj < 2; ++bj)
                    *(u32x4*)(Q + (size_t)row * DM + EPI_COL(bj)) = __builtin_bit_cast(u32x4, pack8(acc[ai][bj][m][0] * rs, acc[ai][bj][m][1] * rs)); } }
    }
    __device__ __forceinline__ void small(f32x4 acc, int row, int col, int tc, int rt, int ct, int l16, int g, unsigned char* lds) const {
        *(u32x2*)(Q + (size_t)row * DM + col) = pack4(acc * rs_row(ss, row));
    }
};
template <class Epi>
__device__ __forceinline__ void small_gemm(unsigned char* lds, const bf16_t* A, int lda, const bf16_t* Bt, int N, int K, const Epi& E) {
    const int tid = threadIdx.x, w = tid >> 6, lane = tid & 63, g = lane >> 4, l16 = lane & 15;
    const int rt = w >> 2, ct = w & 3, nct = N / 64, ntiles = 16 * nct;
    for (int t = blockIdx.x; t < ntiles; t += gridDim.x) {
        const int tr = t / nct, tc = t - tr * nct;
        const int row = MP + tr * 32 + rt * 16 + l16, colb = tc * 64 + ct * 16;
        const bf16_t* ap = A + (size_t)row * lda + 8 * g;
        const bf16_t* bp = Bt + (size_t)(colb + l16) * K + 8 * g;
        f32x4 acc0 = (f32x4){0.f, 0.f, 0.f, 0.f}, acc1 = acc0;
#pragma unroll 4
        for (int k = 0; k < K; k += 64) {
            acc0 = mfma16(*(const bf16x8*)(bp + k), *(const bf16x8*)(ap + k), acc0);
            acc1 = mfma16(*(const bf16x8*)(bp + k + 32), *(const bf16x8*)(ap + k + 32), acc1);
        }
        E.small(acc0 + acc1, row, colb + 4 * g, tc, rt, ct, l16, g, lds);
    }
}
template <class Epi>
__device__ __forceinline__ void run_gemm(unsigned char* lds, const bf16_t* A, int lda, const bf16_t* Bt, int M, int N, int K, const Epi& E, int rot) {
    pg8::Gemm g; g.A = A; g.Bt = Bt; g.M = M; g.N = N; g.K = K; g.lda = lda; g.ldb = K;
    pg8::StaticOrder S; S.init(M, N, (int)gridDim.x, (int)((blockIdx.x + rot) % gridDim.x));
    pg8::gemm_phase<Epi, pg8::StaticOrder>((PG8_LAS unsigned char*)lds, g, S, E);
    __syncthreads();
}
constexpr int T_STRIDE = 272, V_STRIDE = 528;
constexpr int VQN = 2, VW = 256 / VQN, NVT = VW / 16, NOT = NVT / 2, V2_STRIDE = VW * 2 + 16;
constexpr int M_T0 = 0, M_T1 = 17408, M_TV = 34816, M_TC = M_TV + 64 * V2_STRIDE, M_SM = M_TC + VW * T_STRIDE;
template <int BR>
__device__ __forceinline__ void mixer_prompt(const Params& p, unsigned char* lds, int b, int h, int vq) {
    const int tid = threadIdx.x, w = tid >> 6, lane = tid & 63, g = lane >> 4, l16 = lane & 15, q4 = l16 >> 2, p4 = lane & 3;
    const int tt = w & 3, vh = w >> 2;
    bf16_t* Z = (bf16_t*)(p.ws + WS_Z);
    const float* ZS = (const float*)(p.ws + WS_ZS);
    float* SSQ = (float*)(p.ws + WS_SSQ);
    const float* BEND = (const float*)(p.ws + WS_BEND);
    const int qcol = (BR == 0 ? 0 : 3072) + h * 128, kcol = (BR == 0 ? 512 : 3584) + h * 128;
    const int vcol = (BR == 0 ? 1024 : 4096) + h * 256 + vq * VW, ocol = (BR == 0 ? 2048 : 5120) + h * 256 + vq * VW;
    unsigned char* T0 = lds + M_T0; unsigned char* T1 = lds + M_T1; unsigned char* TV = lds + M_TV; unsigned char* TC = lds + M_TC;
    float* sm = (float*)(lds + M_SM);
    float* gS = sm; float* Mt = sm + 64; float* at = sm + 128; float* emt = sm + 192; float* wsv = sm + 256; float* nvec = sm + 320; float* bend = sm + 448;
    float* misc = sm + 576; float* ssq = sm + 592; float* gaL = sm + 720; float* segtot = sm + 1744; float* waL = sm + 2256;
    const unsigned aT0_ = (unsigned)(size_t)T0, aT1_ = (unsigned)(size_t)T1, aTV_ = (unsigned)(size_t)TV;
    const float* gain = (BR == 0 ? p.in[18] : p.in[19]) + h * 256 + vq * VW;
    const int tloc = 16 * tt + l16;
    f32x4 gn[NOT];
#pragma unroll
    for (int vi = 0; vi < NOT; ++vi) gn[vi] = *(const f32x4*)(gain + (VW / 2) * vh + 16 * vi + 4 * g);
    f32x4 st[NVT];
#pragma unroll
    for (int c = 0; c < NVT; ++c) st[c] = (f32x4){0.f, 0.f, 0.f, 0.f};
    float m0 = 0.f;
    const float bi = (BR == 0) ? p.in[15][h] : 0.f, bfb = (BR == 0) ? p.in[15][4 + h] : 0.f;
    if (tid < 128) nvec[tid] = 0.f;
    u32x4 kreg[2], qreg[2], vreg[2]; bf16x8 qn[4]; float igr = 0.f, lfr = 0.f, gar[2] = {0.f, 0.f};
    const int ks_s0 = tid >> 4, ks_ch = tid & 15;
#define MIX_LOAD_CHUNK(R0) do { const size_t r_ = (size_t)(R0); \
        kreg[0] = *(const u32x4*)(Z + (r_ + ks_s0) * ZLD + kcol + ks_ch * 8); kreg[1] = *(const u32x4*)(Z + (r_ + ks_s0 + 32) * ZLD + kcol + ks_ch * 8); \
        vreg[0] = *(const u32x4*)(Z + (r_ + ks_s0) * ZLD + vcol + ks_ch * 8); vreg[1] = *(const u32x4*)(Z + (r_ + ks_s0 + 32) * ZLD + vcol + ks_ch * 8); \
        if (BR == 0) { _Pragma("unroll") for (int ks = 0; ks < 4; ++ks) qn[ks] = *(const bf16x8*)(Z + (r_ + tloc) * ZLD + qcol + 32 * ks + 8 * g); \
            if (w == 0) { igr = ZS[(r_ + lane) * ZSLD + h]; lfr = ZS[(r_ + lane) * ZSLD + 4 + h]; } } \
        else { qreg[0] = *(const u32x4*)(Z + (r_ + ks_s0) * ZLD + qcol + ks_ch * 8); qreg[1] = *(const u32x4*)(Z + (r_ + ks_s0 + 32) * ZLD + qcol + ks_ch * 8); \
            if (tid < 128) gar[0] = BEND[(r_ >> 6) * 512 + h * 128 + tid]; } } while (0)
    MIX_LOAD_CHUNK(b * 2048);
    __syncthreads();
    for (int c = 0; c < 32; ++c) {
        const int r0 = b * 2048 + c * 64;
        if (c > 0 && tid < 64) { float* sp_ = SSQ + ((size_t)(r0 - 64 + tid) * 8 + BR * 4 + h) * 4 + vq * 2; sp_[0] = ssq[tid] + ssq[64 + tid]; sp_[1] = 0.f; }
        unsigned aT0 = aT0_, aT1 = aT1_, aTV = aTV_;
        asm volatile("" : "+v"(aT0), "+v"(aT1), "+v"(aTV));
        if (BR == 0) {
            if (w == 0) {
                const float ig = igr + bi, lf = logsigf_(lfr + bfb);
                float F = lf;
#pragma unroll
                for (int o = 1; o < 64; o <<= 1) { const float y = __shfl_up(F, o); if (lane >= o) F += y; }
                const float gg = ig - F; float cm = gg;
#pragma unroll
                for (int o = 1; o < 64; o <<= 1) { const float y = __shfl_up(cm, o); if (lane >= o) cm = fmaxf(cm, y); }
                const float M = fmaxf(m0, cm), a = __expf(m0 - M);
                const float ML = __shfl(M, 63), aend = __shfl(a, 63), FL = __shfl(F, 63);
                gS[lane] = gg; Mt[lane] = M; at[lane] = a; emt[lane] = __expf(-(F + M)); wsv[lane] = __expf(gg - ML);
                if (lane == 0) misc[1] = aend;
                m0 = FL + ML;
            }
            __syncthreads();
#pragma unroll
            for (int i = 0; i < 2; ++i) { const int s = ks_s0 + 32 * i; const u32x4 kw = kreg[i];
                *(u32x4*)(T0 + s * T_STRIDE + ks_ch * 16) = kw;
                const float ww = wsv[s]; u32x4 o;
                o.x = cvt_pk(bflo(kw.x) * ww, bfhi(kw.x) * ww); o.y = cvt_pk(bflo(kw.y) * ww, bfhi(kw.y) * ww);
                o.z = cvt_pk(bflo(kw.z) * ww, bfhi(kw.z) * ww); o.w = cvt_pk(bflo(kw.w) * ww, bfhi(kw.w) * ww);
                *(u32x4*)(T1 + s * T_STRIDE + ks_ch * 16) = o; }
        } else {
            if (tid < 128) bend[tid] = gar[0];
#pragma unroll
            for (int i = 0; i < 2; ++i) { const int s = ks_s0 + 32 * i;
                *(u32x4*)(T0 + s * T_STRIDE + ks_ch * 16) = kreg[i]; *(u32x4*)(T1 + s * T_STRIDE + ks_ch * 16) = qreg[i]; }
        }
#pragma unroll
        for (int i = 0; i < 2; ++i) *(u32x4*)(TV + (ks_s0 + 32 * i) * V2_STRIDE + ks_ch * 16) = vreg[i];
#pragma unroll
        for (int c16 = 0; c16 < NVT; ++c16) *(u32x2*)(TC + (16 * c16 + l16) * T_STRIDE + (16 * w + 4 * g) * 2) = pack4(st[c16]);
        __syncthreads();
        bf16x8 qf[4];
#pragma unroll
        for (int ks = 0; ks < 4; ++ks) {
            if (BR == 0) qf[ks] = qn[ks];
            else qf[ks] = *(const bf16x8*)(T1 + tloc * T_STRIDE + (32 * ks + 8 * g) * 2);
        }
        bf16_t* op = Z + (size_t)(r0 + tloc) * ZLD + ocol + (VW / 2) * vh + 4 * g;
        u32x2 gwv[NOT];
#pragma unroll
        for (int vi = 0; vi < NOT; ++vi) gwv[vi] = *(const u32x2*)(op + 16 * vi);
        if (c < 31) MIX_LOAD_CHUNK(r0 + 64);
        f32x4 sacc[4];
#pragma unroll
        for (int si = 0; si < 4; ++si) { sacc[si] = (f32x4){0.f, 0.f, 0.f, 0.f};
#pragma unroll
            for (int ks = 0; ks < 4; ++ks) sacc[si] = mfma16(*(const bf16x8*)(T0 + (16 * si + l16) * T_STRIDE + (32 * ks + 8 * g) * 2), qf[ks], sacc[si]); }
        float den = 0.f;
        {
            const float Mtt = (BR == 0) ? Mt[tloc] : 0.f;
            f32x4 gS4[4];
#pragma unroll
            for (int si = 0; si < 4; ++si) gS4[si] = (BR == 0) ? *(const f32x4*)(gS + 16 * si + 4 * g) : (f32x4){0.f, 0.f, 0.f, 0.f};
#pragma unroll
            for (int si = 0; si < 4; ++si)
#pragma unroll
                for (int r = 0; r < 4; ++r) { const int s = 16 * si + 4 * g + r;
                    float wgt;
                    if (BR == 0) { const float e = __expf(fminf(gS4[si][r] - Mtt, 0.f)); wgt = (s <= tloc) ? e : 0.f; } else wgt = (s <= tloc) ? 1.f : 0.f;
                    sacc[si][r] *= wgt; den += sacc[si][r]; }
        }
        f32x4 oacc[NOT];
#pragma unroll
        for (int vi = 0; vi < NOT; ++vi) { oacc[vi] = (f32x4){0.f, 0.f, 0.f, 0.f};
#pragma unroll
            for (int ks = 0; ks < 4; ++ks) oacc[vi] = mfma16(*(const bf16x8*)(TC + ((VW / 2) * vh + 16 * vi + l16) * T_STRIDE + (32 * ks + 8 * g) * 2), qf[ks], oacc[vi]); }
        if (BR == 0) {
            den = xsum16_32(den);
            const float a_t = at[tloc];
            float nq = 0.f;
#pragma unroll
            for (int ks = 0; ks < 4; ++ks)
#pragma unroll
                for (int j = 0; j < 8; ++j) nq += nvec[32 * ks + 8 * g + j] * bf2f((bf16_t)qf[ks][j]);
            nq = xsum16_32(nq);
            den += a_t * nq;
#pragma unroll
            for (int vi = 0; vi < NOT; ++vi) oacc[vi] *= a_t;
        }
#pragma unroll
        for (int ks = 0; ks < 2; ++ks) {
            const bf16x8 pb = pack8(sacc[2 * ks], sacc[2 * ks + 1]);
#pragma unroll
            for (int vi = 0; vi < NOT; vi += 4) {
                const unsigned a0 = aTV + (32 * ks + 4 * g + q4) * V2_STRIDE + ((VW / 2) * vh + 16 * vi) * 2 + 8 * p4, a1 = a0 + 16 * V2_STRIDE;
                bf16x8 fa, fb, fc, fd; tr_frag4(a0, a1, a0 + 32, a1 + 32, a0 + 64, a1 + 64, a0 + 96, a1 + 96, fa, fb, fc, fd);
                oacc[vi] = mfma16(fa, pb, oacc[vi]); oacc[vi + 1] = mfma16(fb, pb, oacc[vi + 1]); oacc[vi + 2] = mfma16(fc, pb, oacc[vi + 2]); oacc[vi + 3] = mfma16(fd, pb, oacc[vi + 3]); }
        }
        if (BR == 0) { const float inv = 1.f / fmaxf(fabsf(den), emt[tloc]);
#pragma unroll
            for (int vi = 0; vi < NOT; ++vi) oacc[vi] *= inv; }
        float sq = 0.f;
#pragma unroll
        for (int vi = 0; vi < NOT; ++vi)
#pragma unroll
            for (int r = 0; r < 4; ++r) sq += oacc[vi][r] * oacc[vi][r];
        sq = xsum16_32(sq);
        if (g == 0) ssq[vh * 64 + tloc] = sq;
#pragma unroll
        for (int vi = 0; vi < NOT; ++vi) {
            const float gt[4] = {bflo(gwv[vi].x), bfhi(gwv[vi].x), bflo(gwv[vi].y), bfhi(gwv[vi].y)}; f32x4 o;
#pragma unroll
            for (int r = 0; r < 4; ++r) { const float sg = sigmoidf_(gt[r]); o[r] = oacc[vi][r] * gn[vi][r] * (BR == 0 ? sg : gt[r] * sg); }
            *(u32x2*)(op + 16 * vi) = pack4(o); }
        if (BR == 0) { const float aend = misc[1];
#pragma unroll
            for (int c16 = 0; c16 < NVT; ++c16) st[c16] *= aend; }
#pragma unroll
        for (int ks = 0; ks < 2; ++ks) {
            const unsigned ka0 = (BR == 0 ? aT1 : aT0) + (32 * ks + 8 * g + q4) * T_STRIDE + (16 * w) * 2 + 8 * p4;
            const bf16x8 kf = tr_frag(ka0, ka0 + 4 * T_STRIDE);
#pragma unroll
            for (int c16 = 0; c16 < NVT; c16 += 4) {
                const unsigned v0 = aTV + (32 * ks + 8 * g + q4) * V2_STRIDE + (16 * c16) * 2 + 8 * p4, v1 = v0 + 4 * V2_STRIDE;
                bf16x8 fa, fb, fc, fd; tr_frag4(v0, v1, v0 + 32, v1 + 32, v0 + 64, v1 + 64, v0 + 96, v1 + 96, fa, fb, fc, fd);
                st[c16] = mfma16(kf, fa, st[c16]); st[c16 + 1] = mfma16(kf, fb, st[c16 + 1]); st[c16 + 2] = mfma16(kf, fc, st[c16 + 2]); st[c16 + 3] = mfma16(kf, fd, st[c16 + 3]);
            }
        }
        if (BR == 1) {
            float eb[4];
#pragma unroll
            for (int r = 0; r < 4; ++r) eb[r] = __expf(bend[16 * w + 4 * g + r]);
#pragma unroll
            for (int c16 = 0; c16 < NVT; ++c16)
#pragma unroll
                for (int r = 0; r < 4; ++r) st[c16][r] *= eb[r];
        } else {
            const int d = tid & 127, seg = tid >> 7; float a2 = 0.f;
#pragma unroll
            for (int s = 0; s < 16; ++s) a2 += bf2f(*(const bf16_t*)(T1 + (seg * 16 + s) * T_STRIDE + d * 2));
            segtot[seg * 128 + d] = a2;
        }
        __syncthreads();
        if (BR == 0 && tid < 128) nvec[tid] = misc[1] * nvec[tid] + ((segtot[tid] + segtot[128 + tid]) + (segtot[256 + tid] + segtot[384 + tid]));
    }
#undef MIX_LOAD_CHUNK
    if (tid < 64) { float* sp_ = SSQ + ((size_t)(b * 2048 + 31 * 64 + tid) * 8 + BR * 4 + h) * 4 + vq * 2; sp_[0] = ssq[tid] + ssq[64 + tid]; sp_[1] = 0.f; }
    const int bh = b * 4 + h;
    if (BR == 0) {
        float* Co = p.out + O_CP + (size_t)bh * 32768;
#pragma unroll
        for (int c16 = 0; c16 < NVT; ++c16) __builtin_nontemporal_store(st[c16], (f32x4*)(Co + (size_t)(VW * vq + 16 * c16 + l16) * 128 + 16 * w + 4 * g));
        if (vq == 0) { if (tid < 128) p.out[O_NP + bh * 128 + tid] = nvec[tid];
            if (tid == 0) p.out[O_MPP + bh] = m0; }
    } else {
        float* So = p.out + O_SP + (size_t)bh * 32768;
#pragma unroll
        for (int c16 = 0; c16 < NVT; ++c16)
#pragma unroll
            for (int r = 0; r < 4; ++r) So[(size_t)(16 * w + 4 * g + r) * 256 + VW * vq + 16 * c16 + l16] = st[c16][r];
    }
    __syncthreads();
}

__device__ __forceinline__ void gla_prep(const Params& p, unsigned char* lds, int item) {
    const int tid = threadIdx.x, d = tid & 127, seg = tid >> 7;
    const int h = item & 3, c = (item >> 2) & 31, b = item >> 7;
    bf16_t* Z = (bf16_t*)(p.ws + WS_Z);
    const float* ZS = (const float*)(p.ws + WS_ZS);
    float* BEND = (float*)(p.ws + WS_BEND);
    float* gaL = (float*)lds; float* waL = gaL + 1024; float* segtot = waL + 2048;
    const int r0 = b * 2048 + c * 64, qcol = 3072 + h * 128, kcol = 3584 + h * 128;
    gaL[tid] = ZS[(size_t)(r0 + (tid >> 4)) * ZSLD + 8 + (tid & 15)]; gaL[tid + 512] = ZS[(size_t)(r0 + 32 + (tid >> 4)) * ZSLD + 8 + (tid & 15)];
#pragma unroll
    for (int j = 0; j < 4; ++j) { const int id = tid + 512 * j; waL[id] = p.in[16][(id >> 7) * 512 + h * 128 + (id & 127)]; }
    const float ba = p.in[17][h * 128 + d];
    __syncthreads();
    float wa[16];
#pragma unroll
    for (int j = 0; j < 16; ++j) wa[j] = waL[j * 128 + d];
    float la[16]; float run = 0.f;
#pragma unroll
    for (int i = 0; i < 16; ++i) { const int t = seg * 16 + i; float x = ba;
#pragma unroll
        for (int j = 0; j < 16; ++j) x += gaL[t * 16 + j] * wa[j];
        run += logsigf_(x) * 0.0625f; la[i] = run; }
    segtot[seg * 128 + d] = run;
    __syncthreads();
    float pre = 0.f, tot = 0.f;
#pragma unroll
    for (int s2 = 0; s2 < 4; ++s2) { const float v = segtot[s2 * 128 + d]; tot += v; if (s2 < seg) pre += v; }
    if (seg == 0) BEND[(size_t)(b * 32 + c) * 512 + h * 128 + d] = tot;
    bf16_t qv[16], kv[16];
#pragma unroll
    for (int i = 0; i < 16; ++i) { const int t = seg * 16 + i; qv[i] = Z[(size_t)(r0 + t) * ZLD + qcol + d]; kv[i] = Z[(size_t)(r0 + t) * ZLD + kcol + d]; }
#pragma unroll
    for (int i = 0; i < 16; ++i) { const int t = seg * 16 + i; const float bb = la[i] + pre;
        Z[(size_t)(r0 + t) * ZLD + qcol + d] = f2bf(bf2f(qv[i]) * __expf(bb)); Z[(size_t)(r0 + t) * ZLD + kcol + d] = f2bf(bf2f(kv[i]) * __expf(-bb)); }
    __syncthreads();
}

template <int BR>
__device__ __forceinline__ void mixer_sample(const Params& p, unsigned char* lds, int b, int h) {
    const int tid = threadIdx.x, w = tid >> 6, lane = tid & 63;
    bf16_t* Z = (bf16_t*)(p.ws + WS_Z);
    const float* ZS = (const float*)(p.ws + WS_ZS);
    const int qcol = (BR == 0 ? 0 : 3072) + h * 128, kcol = (BR == 0 ? 512 : 3584) + h * 128, vcol = (BR == 0 ? 1024 : 4096) + h * 256, ocol = (BR == 0 ? 2048 : 5120) + h * 256;
    float* sm = (float*)lds;
    float* qa = sm; float* ka = sm + 512; float* kd = sm + 1024; float* dec = sm + 1536; float* vv = sm + 1664; float* qk = sm + 2688; float* sc = sm + 2704;
    float* part = sm + 2752; float* red = sm + 4800;
    const int r0 = MP + 4 * b, bh = b * 4 + h;
    const float* gain = (BR == 0 ? p.in[18] : p.in[19]) + h * 256;
    float a_t[4] = {1.f, 1.f, 1.f, 1.f}, mt[4] = {0.f, 0.f, 0.f, 0.f}, aend = 1.f;
    {
        const int t = tid >> 7, d = tid & 127;
        const float qraw = bf2f(Z[(size_t)(r0 + t) * ZLD + qcol + d]), kraw = bf2f(Z[(size_t)(r0 + t) * ZLD + kcol + d]);
#pragma unroll
        for (int i = 0; i < 2; ++i) { const int id = tid + 512 * i; vv[id] = bf2f(Z[(size_t)(r0 + (id >> 8)) * ZLD + vcol + (id & 255)]); }
        if (BR == 0) {
            const float m0 = p.in[5][bh], bi = p.in[15][h], bfb = p.in[15][4 + h];
            float F = 0.f, cm = -3.0e38f, gg[4], Mv[4];
#pragma unroll
            for (int s = 0; s < 4; ++s) { const float ig = ZS[(size_t)(r0 + s) * ZSLD + h] + bi, lf = logsigf_(ZS[(size_t)(r0 + s) * ZSLD + 4 + h] + bfb);
                F += lf; gg[s] = ig - F; cm = fmaxf(cm, gg[s]); Mv[s] = fmaxf(m0, cm); a_t[s] = __expf(m0 - Mv[s]); mt[s] = F + Mv[s]; }
            aend = a_t[3];
            float wsel = 0.f;
#pragma unroll
            for (int s = 0; s < 4; ++s) { const float ws_ = __expf(gg[s] - Mv[3]); if (s == t) wsel = ws_; }
            qa[tid] = qraw; ka[tid] = kraw; kd[tid] = wsel * kraw;
            if (tid < 128) dec[tid] = aend;
            if (tid == 0) {
#pragma unroll
                for (int s = 0; s < 4; ++s) { sc[16 + s] = gg[s]; sc[20 + s] = Mv[s]; } }
        } else {
            float la[4];
#pragma unroll
            for (int s = 0; s < 4; ++s) { float x = p.in[17][h * 128 + d];
#pragma unroll
                for (int j = 0; j < 16; ++j) x += ZS[(size_t)(r0 + s) * ZSLD + 8 + j] * p.in[16][j * 512 + h * 128 + d];
                la[s] = logsigf_(x) * 0.0625f; }
            float bt = 0.f, bendv = 0.f;
#pragma unroll
            for (int s = 0; s < 4; ++s) { bendv += la[s]; if (s <= t) bt += la[s]; }
            qa[tid] = qraw * __expf(bt); ka[tid] = kraw * __expf(-bt); kd[tid] = kraw * __expf(bendv - bt);
            if (t == 0) dec[d] = __expf(bendv);
        }
    }
    __syncthreads();
    {
        const int pr = tid >> 5, l = tid & 31, t = pr >> 2, s = pr & 3;
        const f32x4 a = *(const f32x4*)(qa + t * 128 + l * 4), k4 = *(const f32x4*)(ka + s * 128 + l * 4);
        float v = a[0] * k4[0] + a[1] * k4[1] + a[2] * k4[2] + a[3] * k4[3];
#pragma unroll
        for (int o = 16; o > 0; o >>= 1) v += __shfl_xor(v, o);
        if (l == 0) { float wgt; if (BR == 0) wgt = (s <= t) ? __expf(sc[16 + s] - sc[20 + t]) : 0.f; else wgt = (s <= t) ? 1.f : 0.f; qk[pr] = v * wgt; }
        if (BR == 0 && tid < 128) {
            const int t2 = tid >> 5;
            const f32x4 n4 = *(const f32x4*)(p.in[4] + (size_t)bh * 128 + l * 4), q4v = *(const f32x4*)(qa + t2 * 128 + l * 4);
            float v2 = n4[0] * q4v[0] + n4[1] * q4v[1] + n4[2] * q4v[2] + n4[3] * q4v[3];
#pragma unroll
            for (int o = 16; o > 0; o >>= 1) v2 += __shfl_xor(v2, o);
            if (l == 0) sc[12 + t2] = v2;
        }
    }
    __syncthreads();
    float hv[4]; int vown; bool owner;
    if (BR == 0) {
        const int l32 = lane & 31, half = lane >> 5;
        const float* C0 = p.in[3] + (size_t)bh * 32768 + 4 * l32;
        float* C1 = p.out + O_CS + (size_t)bh * 32768 + 4 * l32;
        f32x4 qa4[4], kd4[4]; const f32x4 dec4 = *(const f32x4*)(dec + 4 * l32);
#pragma unroll
        for (int t = 0; t < 4; ++t) { qa4[t] = *(const f32x4*)(qa + t * 128 + 4 * l32); kd4[t] = *(const f32x4*)(kd + t * 128 + 4 * l32); }
#pragma unroll
        for (int ib = 0; ib < 16; ib += 8) {
            f32x4 cv[8];
#pragma unroll
            for (int e = 0; e < 8; ++e) cv[e] = __builtin_nontemporal_load((const f32x4*)(C0 + (size_t)(w * 32 + 2 * (ib + e) + half) * 128));
#pragma unroll
            for (int e = 0; e < 8; ++e) { const int v = w * 32 + 2 * (ib + e) + half; const f32x4 c = cv[e];
                float wv[4], pt[4];
#pragma unroll
                for (int s = 0; s < 4; ++s) wv[s] = vv[s * 256 + v];
                f32x4 o = dec4 * c;
#pragma unroll
                for (int s = 0; s < 4; ++s) o += kd4[s] * wv[s];
                __builtin_nontemporal_store(o, (f32x4*)(C1 + (size_t)v * 128));
#pragma unroll
                for (int t = 0; t < 4; ++t) { float x = c[0] * qa4[t][0] + c[1] * qa4[t][1] + c[2] * qa4[t][2] + c[3] * qa4[t][3];
#pragma unroll
                    for (int of = 16; of > 0; of >>= 1) x += __shfl_xor(x, of);
                    pt[t] = x; }
                if (l32 == 0) {
#pragma unroll
                    for (int t = 0; t < 4; ++t) part[t * 256 + v] = pt[t]; }
            }
        }
        if (tid < 128) { float acc = aend * p.in[4][(size_t)bh * 128 + tid];
#pragma unroll
            for (int s = 0; s < 4; ++s) acc += kd[s * 128 + tid];
            p.out[O_NS + (size_t)bh * 128 + tid] = acc; }
        if (tid == 0) p.out[O_MSS + bh] = mt[3];
        __syncthreads();
        vown = tid & 255; owner = (tid < 256);
        {
            float wv2[4];
#pragma unroll
            for (int s = 0; s < 4; ++s) wv2[s] = vv[s * 256 + vown];
#pragma unroll
            for (int t = 0; t < 4; ++t) { float num = a_t[t] * part[t * 256 + vown], den = a_t[t] * sc[12 + t];
#pragma unroll
                for (int s = 0; s < 4; ++s) { num += qk[t * 4 + s] * wv2[s]; den += qk[t * 4 + s]; }
                hv[t] = num / fmaxf(fabsf(den), __expf(-mt[t])); }
        }
    } else {
        const int v4 = lane * 4;
        const float* S0 = p.in[6] + ((size_t)bh * 128 + 16 * w) * 256 + v4;
        float* S1 = p.out + O_SS + ((size_t)bh * 128 + 16 * w) * 256 + v4;
        float* part8 = sm + 4864;
        f32x4 wv4[4], pt4[4];
#pragma unroll
        for (int s = 0; s < 4; ++s) { wv4[s] = *(const f32x4*)(vv + s * 256 + v4); pt4[s] = (f32x4){0.f, 0.f, 0.f, 0.f}; }
#pragma unroll
        for (int jb = 0; jb < 16; jb += 8) {
            f32x4 s0v[8];
#pragma unroll
            for (int e = 0; e < 8; ++e) s0v[e] = __builtin_nontemporal_load((const f32x4*)(S0 + (size_t)(jb + e) * 256));
#pragma unroll
            for (int e = 0; e < 8; ++e) { const int j = jb + e, d = 16 * w + j; const f32x4 s0 = s0v[e];
                f32x4 acc = s0 * dec[d];
#pragma unroll
                for (int t = 0; t < 4; ++t) pt4[t] += s0 * qa[t * 128 + d];
#pragma unroll
                for (int s2 = 0; s2 < 4; ++s2) acc += wv4[s2] * kd[s2 * 128 + d];
                __builtin_nontemporal_store(acc, (f32x4*)(S1 + (size_t)j * 256)); } }
#pragma unroll
        for (int t = 0; t < 4; ++t) *(f32x4*)(part8 + (w * 4 + t) * 256 + v4) = pt4[t];
        __syncthreads();
        vown = tid & 255; owner = (tid < 256);
#pragma unroll
        for (int t = 0; t < 4; ++t) { float num = 0.f;
#pragma unroll
            for (int w2 = 0; w2 < 8; ++w2) num += part8[(w2 * 4 + t) * 256 + vown];
#pragma unroll
            for (int s2 = 0; s2 < 4; ++s2) num += qk[t * 4 + s2] * vv[s2 * 256 + vown];
            hv[t] = num; }
    }
#pragma unroll
    for (int t = 0; t < 4; ++t) { float q2 = owner ? hv[t] * hv[t] : 0.f; q2 = wave_sum(q2); if (lane == 0) red[w * 4 + t] = q2; }
    __syncthreads();
    if (owner) {
#pragma unroll
        for (int t = 0; t < 4; ++t) { float tot = 0.f;
#pragma unroll
            for (int w2 = 0; w2 < 8; ++w2) tot += red[w2 * 4 + t];
            const float rs = rsqrtf(tot * (1.f / 256.f) + EPSV);
            bf16_t* op = Z + (size_t)(r0 + t) * ZLD + ocol + vown;
            const float gt = bf2f(*op), sg = sigmoidf_(gt);
            *op = f2bf(hv[t] * rs * gain[vown] * (BR == 0 ? sg : gt * sg)); }
    }
    __syncthreads();
}

__device__ __forceinline__ void attn_prompt(const Params& p, unsigned char* lds, int item) {
    const int tid = threadIdx.x, w = tid >> 6, lane = tid & 63, g = lane >> 4, l16 = lane & 15, q4 = l16 >> 2, p4 = lane & 3;
    const int qt = item & 7, h = (item >> 3) & 3, b = item >> 5;
    const bf16_t* KV = (const bf16_t*)(p.ws + WS_MEMKV) + (size_t)b * 256 * 2048 + h * 256;
    const bf16_t* Q = (const bf16_t*)(p.ws + WS_QBUF);
    bf16_t* O = (bf16_t*)(p.ws + WS_OBUF);
    const size_t rq0 = (size_t)b * 2048 + qt * 256 + 16 * w + l16;
    const unsigned aL = (unsigned)(size_t)lds;
#pragma unroll 8
    for (int i = 0; i < 16; ++i) { const int id = tid + 512 * i, key = id >> 5, ch = id & 31;
        *(u32x4*)(lds + key * V_STRIDE + ch * 16) = *(const u32x4*)(KV + (size_t)key * 2048 + ch * 8); }
    __syncthreads();
    bf16x8 pf[2][8]; float inv[2];
#pragma unroll
    for (int u = 0; u < 2; ++u) {
        const size_t rq = rq0 + 128 * u;
        f32x4 s[16];
#pragma unroll
        for (int ki = 0; ki < 16; ++ki) s[ki] = (f32x4){0.f, 0.f, 0.f, 0.f};
#pragma unroll
        for (int ks = 0; ks < 8; ++ks) { const bf16x8 qfk = *(const bf16x8*)(Q + rq * DM + h * 256 + 32 * ks + 8 * g);
#pragma unroll
            for (int ki = 0; ki < 16; ++ki) s[ki] = mfma16(*(const bf16x8*)(lds + (16 * ki + l16) * V_STRIDE + (32 * ks + 8 * g) * 2), qfk, s[ki]); }
        float mx = -3.0e38f;
#pragma unroll
        for (int ki = 0; ki < 16; ++ki)
#pragma unroll
            for (int r = 0; r < 4; ++r) mx = fmaxf(mx, s[ki][r]);
        mx = xmax16_32(mx);
        float sum = 0.f;
#pragma unroll
        for (int ki = 0; ki < 16; ++ki)
#pragma unroll
            for (int r = 0; r < 4; ++r) { const float e = __expf(s[ki][r] - mx); s[ki][r] = e; sum += e; }
        sum = xsum16_32(sum); inv[u] = 1.f / sum;
#pragma unroll
        for (int ks = 0; ks < 8; ++ks) pf[u][ks] = pack8(s[2 * ks], s[2 * ks + 1]);
        __builtin_amdgcn_sched_barrier(0);
    }
    __syncthreads();
#pragma unroll 8
    for (int i = 0; i < 16; ++i) { const int id = tid + 512 * i, key = id >> 5, ch = id & 31;
        *(u32x4*)(lds + key * V_STRIDE + ch * 16) = *(const u32x4*)(KV + (size_t)key * 2048 + 1024 + ch * 8); }
    __syncthreads();
#pragma unroll
    for (int hh = 0; hh < 2; ++hh) {
        f32x4 o0[8], o1[8];
#pragma unroll
        for (int hi = 0; hi < 8; ++hi) { o0[hi] = (f32x4){0.f, 0.f, 0.f, 0.f}; o1[hi] = o0[hi]; }
#pragma unroll
        for (int ks = 0; ks < 8; ++ks) {
            unsigned aLk = aL + (32 * ks + 4 * g + q4) * V_STRIDE + 8 * p4 + hh * 256;
            asm volatile("" : "+v"(aLk));
#pragma unroll
            for (int hi = 0; hi < 8; hi += 4) {
                const unsigned a0 = aLk + (16 * hi) * 2, a1 = a0 + 16 * V_STRIDE;
                bf16x8 fa, fb, fc, fd; tr_frag4(a0, a1, a0 + 32, a1 + 32, a0 + 64, a1 + 64, a0 + 96, a1 + 96, fa, fb, fc, fd);
                o0[hi] = mfma16(fa, pf[0][ks], o0[hi]); o0[hi + 1] = mfma16(fb, pf[0][ks], o0[hi + 1]); o0[hi + 2] = mfma16(fc, pf[0][ks], o0[hi + 2]); o0[hi + 3] = mfma16(fd, pf[0][ks], o0[hi + 3]);
                o1[hi] = mfma16(fa, pf[1][ks], o1[hi]); o1[hi + 1] = mfma16(fb, pf[1][ks], o1[hi + 1]); o1[hi + 2] = mfma16(fc, pf[1][ks], o1[hi + 2]); o1[hi + 3] = mfma16(fd, pf[1][ks], o1[hi + 3]);
            }
        }
#pragma unroll
        for (int hi = 0; hi < 8; ++hi) { *(u32x2*)(O + rq0 * DM + h * 256 + hh * 128 + 16 * hi + 4 * g) = pack4(o0[hi] * inv[0]);
            *(u32x2*)(O + (rq0 + 128) * DM + h * 256 + hh * 128 + 16 * hi + 4 * g) = pack4(o1[hi] * inv[1]); }
    }
    __syncthreads();
}
__device__ __forceinline__ void attn_sample(const Params& p, unsigned char* lds, int item) {
    const int tid = threadIdx.x, w = tid >> 6, lane = tid & 63;
    const int h = item & 3, b = item >> 2;
    const float* Kc = p.in[7] + ((size_t)b * 1024 + h) * 256;
    const float* Vc = p.in[8] + ((size_t)b * 1024 + h) * 256;
    const bf16_t* Q = (const bf16_t*)(p.ws + WS_QBUF);
    bf16_t* O = (bf16_t*)(p.ws + WS_OBUF);
    float* sc = (float*)lds; float* po = sc + 1024;
    const size_t r0 = MP + 4 * b;
    f32x4 q[4];
#pragma unroll
    for (int t = 0; t < 4; ++t) { const u32x2 qw = *(const u32x2*)(Q + (r0 + t) * DM + h * 256 + lane * 4); q[t] = (f32x4){bflo(qw.x), bfhi(qw.x), bflo(qw.y), bfhi(qw.y)}; }
    {
        const bool b5 = (lane & 32) != 0, b4 = (lane & 16) != 0, b3 = (lane & 8) != 0, b2 = (lane & 4) != 0;
#pragma unroll 2
        for (int kg = 0; kg < 8; ++kg) { const int key0 = w * 32 + kg * 4;
            f32x4 kv[4];
#pragma unroll
            for (int k = 0; k < 4; ++k) kv[k] = __builtin_nontemporal_load((const f32x4*)(Kc + (size_t)(key0 + k) * 1024 + lane * 4));
            float v[16];
#pragma unroll
            for (int k = 0; k < 4; ++k)
#pragma unroll
                for (int t = 0; t < 4; ++t) v[k * 4 + t] = kv[k][0] * q[t][0] + kv[k][1] * q[t][1] + kv[k][2] * q[t][2] + kv[k][3] * q[t][3];
            float a8[8], a4[4], a2[2];
#pragma unroll
            for (int i = 0; i < 8; ++i) { const float keep = b5 ? v[i + 8] : v[i], send = b5 ? v[i] : v[i + 8]; a8[i] = keep + __shfl_xor(send, 32); }
#pragma unroll
            for (int i = 0; i < 4; ++i) { const float keep = b4 ? a8[i + 4] : a8[i], send = b4 ? a8[i] : a8[i + 4]; a4[i] = keep + __shfl_xor(send, 16); }
#pragma unroll
            for (int i = 0; i < 2; ++i) { const float keep = b3 ? a4[i + 2] : a4[i], send = b3 ? a4[i] : a4[i + 2]; a2[i] = keep + __shfl_xor(send, 8); }
            float d = (b2 ? a2[1] : a2[0]) + __shfl_xor(b2 ? a2[0] : a2[1], 4);
            d += __shfl_xor(d, 2); d += __shfl_xor(d, 1);
            if ((lane & 3) == 0) { const int j = (lane >> 2) & 15; sc[(j & 3) * 256 + key0 + (j >> 2)] = d; }
        }
    }
    __syncthreads();
    if (w < 4) { float v[4], mx = -3.0e38f;
#pragma unroll
        for (int i = 0; i < 4; ++i) { v[i] = sc[w * 256 + lane + 64 * i]; mx = fmaxf(mx, v[i]); }
        mx = wave_max(mx); float sum = 0.f;
#pragma unroll
        for (int i = 0; i < 4; ++i) { v[i] = __expf(v[i] - mx); sum += v[i]; }
        sum = wave_sum(sum); const float inv = 1.f / sum;
#pragma unroll
        for (int i = 0; i < 4; ++i) sc[w * 256 + lane + 64 * i] = v[i] * inv; }
    __syncthreads();
    {
        const int hd4 = lane * 4; float* po8 = sc + 1024;
        f32x4 acc4[4];
#pragma unroll
        for (int t = 0; t < 4; ++t) acc4[t] = (f32x4){0.f, 0.f, 0.f, 0.f};
#pragma unroll 2
        for (int kg = 0; kg < 8; ++kg) { const int key0 = w * 32 + kg * 4;
            f32x4 v4[4], p4[4];
#pragma unroll
            for (int k = 0; k < 4; ++k) v4[k] = __builtin_nontemporal_load((const f32x4*)(Vc + (size_t)(key0 + k) * 1024 + hd4));
#pragma unroll
            for (int t = 0; t < 4; ++t) p4[t] = *(const f32x4*)(sc + t * 256 + key0);
#pragma unroll
            for (int k = 0; k < 4; ++k)
#pragma unroll
                for (int t = 0; t < 4; ++t) acc4[t] += v4[k] * p4[t][k]; }
#pragma unroll
        for (int t = 0; t < 4; ++t) *(f32x4*)(po8 + (w * 4 + t) * 256 + hd4) = acc4[t];
        __syncthreads();
        if (tid < 256) {
#pragma unroll
            for (int t = 0; t < 4; ++t) { float o = 0.f;
#pragma unroll
                for (int w2 = 0; w2 < 8; ++w2) o += po8[(w2 * 4 + t) * 256 + tid];
                O[(r0 + t) * DM + h * 256 + tid] = f2bf(o); } }
    }
    __syncthreads();
}

#ifndef ONLY_PH
#define ONLY_PH -1
#endif
#ifndef MIXEN
#define MIXEN 15
#endif
#ifndef PH_MASK
#define PH_MASK 0xffff
#endif
#define PH_ENABLED(x) ((ONLY_PH < 0 || ONLY_PH == (x)) && ((PH_MASK >> (x)) & 1) && ((KMASK >> (x)) & 1))
__device__ __forceinline__ void grid_barrier(unsigned char* wsb, unsigned char* lds) {
    XcdBarrier b; b.bar = (unsigned*)(wsb + WS_BAR); b.x = xb_xcc_id(); b.st = (volatile LAS unsigned*)(lds + LDS_BYTES - 16);
    xcd_barrier(b);
}
template <int KMASK> __global__ void __launch_bounds__(512, 2) fwd_kernel(Params p) {
    extern __shared__ __attribute__((aligned(16))) unsigned char lds[];
    cg::grid_group grid = cg::this_grid();
    volatile LAS unsigned* xb_st = (volatile LAS unsigned*)(lds + LDS_BYTES - 16);
    if (threadIdx.x == 0) { xb_st[0] = 0u; xb_st[1] = 0u; }
    __syncthreads();
    (void)xcd_barrier_post((unsigned*)(p.ws + WS_BAR), xb_st);
#ifndef DUP_MASK
#define DUP_MASK 0
#endif
#define PH_BEGIN(k) if (PH_ENABLED(k) && p.ph_lo <= (k) && (k) < p.ph_hi) for (int rep_ = 0; rep_ < (((DUP_MASK >> (k)) & 1) ? 2 : 1); ++rep_) { if ((k) > p.ph_lo || rep_) { if (p.ph_hi > 1000) grid.sync(); else grid_barrier(p.ws, lds); } \
        unsigned char* ws; float* outp; { unsigned long long w_ = (unsigned long long)p.ws, o_ = (unsigned long long)p.out; \
        unsigned a0_ = __builtin_amdgcn_readfirstlane((unsigned)w_), a1_ = __builtin_amdgcn_readfirstlane((unsigned)(w_ >> 32)), a2_ = __builtin_amdgcn_readfirstlane((unsigned)o_), a3_ = __builtin_amdgcn_readfirstlane((unsigned)(o_ >> 32)); \
        asm volatile("" : "+s"(a0_), "+s"(a1_), "+s"(a2_), "+s"(a3_)); ws = (unsigned char*)(((unsigned long long)a1_ << 32) | a0_); outp = (float*)(((unsigned long long)a3_ << 32) | a2_); } \
        bf16_t* ABUF = (bf16_t*)(ws + WS_ABUF); bf16_t* Z = (bf16_t*)(ws + WS_Z); float* XRES = (float*)(ws + WS_XRES); float* SS = (float*)(ws + WS_SS); float* TMP = outp + O_YP; \
        (void)ABUF; (void)Z; (void)XRES; (void)SS; (void)TMP;
#define PH_END }
    PH_BEGIN(0) prep_phase(p, lds); PH_END
    PH_BEGIN(1)
        EpiGateUp e1; e1.H = Z; e1.ss = nullptr;
        run_gemm(lds, ABUF, DM, (const bf16_t*)(ws + WS_WGU1), MT, 5632, 1024, e1, 0);
        EpiMemKV e2; e2.ok = outp + O_MKP; e2.ov = outp + O_MVP; e2.kv = (bf16_t*)(ws + WS_MEMKV);
        run_gemm(lds, (const bf16_t*)(ws + WS_MEMA), DM, (const bf16_t*)(ws + WS_WKV), 2048, 2048, 1024, e2, 64);
    PH_END
    PH_BEGIN(2) EpiResid e; e.res0 = p.in[0]; e.res1 = p.in[1]; e.xout = XRES; e.aout = ABUF; e.gain = p.in[13]; e.ss = SS; e.scale = 0.5f;
        run_gemm(lds, Z, DFF, (const bf16_t*)(ws + WS_WD1), MP, 1024, DFF, e, 0); small_gemm(lds, Z, DFF, (const bf16_t*)(ws + WS_WD1), 1024, DFF, e); PH_END
    PH_BEGIN(3) EpiZ e; e.Z = Z; e.ZS = (float*)(ws + WS_ZS); e.ss = SS;
        run_gemm(lds, ABUF, DM, (const bf16_t*)(ws + WS_WIN), MT, 8448, 1024, e, 0); PH_END
    PH_BEGIN(4)
        for (int it = blockIdx.x; it < 1024; it += gridDim.x) gla_prep(p, lds, it);
    PH_END
    PH_BEGIN(5)
        const int bx = (int)blockIdx.x, G = (int)gridDim.x;
        const int NCH = (G >= 256) ? 128 : 0;
        if (bx < NCH || NCH == 0) {
            for (int it0 = bx; it0 < 128; it0 += (NCH ? NCH : G)) { const int it = NCH ? ((((it0 & 7) * 8 + (it0 >> 4)) << 1) | ((it0 >> 3) & 1)) : it0;
                if (it < 64) { if (MIXEN & 1) mixer_prompt<0>(p, lds, it >> 3, (it >> 1) & 3, it & 1); } }
            for (int it0 = bx; it0 < 128; it0 += (NCH ? NCH : G)) { const int it = NCH ? ((((it0 & 7) * 8 + (it0 >> 4)) << 1) | ((it0 >> 3) & 1)) : it0;
                if (it >= 64) { if (MIXEN & 2) mixer_prompt<1>(p, lds, (it - 64) >> 3, (it >> 1) & 3, it & 1); } }
        }
        if (bx >= NCH) {
            for (int it = bx - NCH; it < 512; it += G - NCH) { if (MIXEN & 4) mixer_sample<0>(p, lds, it >> 2, it & 3); }
            for (int it = bx - NCH; it < 512; it += G - NCH) { if (MIXEN & 8) mixer_sample<1>(p, lds, it >> 2, it & 3); }
            prep_transposes(p, lds, PREP_LATE_MASK, bx - NCH, G - NCH);
        }
    PH_END
    PH_BEGIN(6)
        const float* SSQ = (const float*)(ws + WS_SSQ);
        const int lane = threadIdx.x & 63, gw = blockIdx.x * 8 + (threadIdx.x >> 6), nw = gridDim.x * 8;
        for (int i0 = gw; i0 < MP * 8; i0 += 4 * nw) {
            f32x4 sp[4]; u32x2 wv[4];
#pragma unroll
            for (int e = 0; e < 4; ++e) { const int i = i0 + e * nw; if (i < MP * 8) { sp[e] = *(const f32x4*)(SSQ + (size_t)i * 4);
                    wv[e] = *(const u32x2*)(Z + (size_t)(i >> 3) * ZLD + (((i & 7) >> 2) ? 5120 : 2048) + (i & 3) * 256 + lane * 4); } }
#pragma unroll
            for (int e = 0; e < 4; ++e) { const int i = i0 + e * nw; if (i < MP * 8) {
                    const float rs = rsqrtf(((sp[e][0] + sp[e][1]) + (sp[e][2] + sp[e][3])) * (1.f / 256.f) + EPSV);
                    f32x4 o = {bflo(wv[e].x) * rs, bfhi(wv[e].x) * rs, bflo(wv[e].y) * rs, bfhi(wv[e].y) * rs};
                    *(u32x2*)(Z + (size_t)(i >> 3) * ZLD + (((i & 7) >> 2) ? 5120 : 2048) + (i & 3) * 256 + lane * 4) = pack4(o); } }
        }
    PH_END
    PH_BEGIN(7)
        { EpiMerge<0> e; e.gate = Z + 6144; e.T = TMP; e.Y = nullptr;
          run_gemm(lds, Z + 2048, ZLD, (const bf16_t*)(ws + WS_WBRM), MP, 1024, 1024, e, 0); small_gemm(lds, Z + 2048, ZLD, (const bf16_t*)(ws + WS_WBRM), 1024, 1024, e); }
        { EpiMerge<1> e; e.gate = Z + 7168; e.T = TMP; e.Y = ABUF;
          run_gemm(lds, Z + 5120, ZLD, (const bf16_t*)(ws + WS_WBRG), MP, 1024, 1024, e, 0); small_gemm(lds, Z + 5120, ZLD, (const bf16_t*)(ws + WS_WBRG), 1024, 1024, e); }
    PH_END
    PH_BEGIN(9) EpiResid e; e.res0 = XRES; e.res1 = XRES + (size_t)MP * DM; e.xout = XRES; e.aout = (bf16_t*)(ws + WS_ABUF2); e.gain = p.in[23]; e.ss = SS + (size_t)MT * 16; e.scale = 1.f;
        run_gemm(lds, ABUF, DM, (const bf16_t*)(ws + WS_WOUT), MP, 1024, 1024, e, 0); small_gemm(lds, ABUF, DM, (const bf16_t*)(ws + WS_WOUT), 1024, 1024, e); PH_END
    PH_BEGIN(10) EpiQ e; e.Q = (bf16_t*)(ws + WS_QBUF); e.ss = SS + (size_t)MT * 16;
        run_gemm(lds, (const bf16_t*)(ws + WS_ABUF2), DM, (const bf16_t*)(ws + WS_WQ), MP, 1024, 1024, e, 0); small_gemm(lds, (const bf16_t*)(ws + WS_ABUF2), DM, (const bf16_t*)(ws + WS_WQ), 1024, 1024, e); PH_END
    PH_BEGIN(11)
#pragma unroll 1
        for (int pass = 0; pass < 2; ++pass) {
            if (((blockIdx.x & 1) != 0) == (pass == 0)) { for (int it = blockIdx.x; it < 512; it += gridDim.x) attn_sample(p, lds, it); }
            else { for (int it = blockIdx.x; it < 256; it += gridDim.x) attn_prompt(p, lds, it); }
        }
    PH_END
    PH_BEGIN(12) EpiResid e; e.res0 = XRES; e.res1 = XRES + (size_t)MP * DM; e.xout = XRES; e.aout = ABUF; e.gain = p.in[29]; e.ss = SS + (size_t)MT * 32; e.scale = 1.f;
        run_gemm(lds, (const bf16_t*)(ws + WS_OBUF), DM, (const bf16_t*)(ws + WS_WO), MP, 1024, 1024, e, 0); small_gemm(lds, (const bf16_t*)(ws + WS_OBUF), DM, (const bf16_t*)(ws + WS_WO), 1024, 1024, e); PH_END
    PH_BEGIN(13) EpiGateUp e; e.H = Z; e.ss = SS + (size_t)MT * 32;
        run_gemm(lds, ABUF, DM, (const bf16_t*)(ws + WS_WGU2), MT, 5632, 1024, e, 0); PH_END
    PH_BEGIN(14) EpiResid e; e.res0 = XRES; e.res1 = XRES + (size_t)MP * DM; e.xout = TMP; e.aout = nullptr; e.gain = nullptr; e.ss = SS + (size_t)MT * 48; e.scale = 0.5f;
        run_gemm(lds, Z, DFF, (const bf16_t*)(ws + WS_WD2), MP, 1024, DFF, e, 0); small_gemm(lds, Z, DFF, (const bf16_t*)(ws + WS_WD2), 1024, DFF, e); PH_END
    PH_BEGIN(15)
        const int lane = threadIdx.x & 63, gw = blockIdx.x * 8 + (threadIdx.x >> 6), nw = gridDim.x * 8;
        for (int r = gw; r < MT; r += nw) { const float rs = rs_row(SS + (size_t)MT * 48, r); float* y = TMP + (size_t)r * DM;
#pragma unroll
            for (int i = 0; i < 4; ++i) { f32x4 v = *(const f32x4*)(y + i * 256 + lane * 4); const f32x4 gg = *(const f32x4*)(p.in[33] + i * 256 + lane * 4);
                __builtin_nontemporal_store(v * rs * gg, (f32x4*)(y + i * 256 + lane * 4)); } }
    PH_END
}

template <int KMASK> static bool setup_kernel() {
    if (hipFuncSetAttribute((const void*)fwd_kernel<KMASK>, hipFuncAttributeMaxDynamicSharedMemorySize, LDS_BYTES) != hipSuccess) { fprintf(stderr, "kernel_launch: hipFuncSetAttribute failed\n"); return false; }
    int per_cu = 0;
    if (hipOccupancyMaxActiveBlocksPerMultiprocessor(&per_cu, (const void*)fwd_kernel<KMASK>, NTHREADS, LDS_BYTES) != hipSuccess || per_cu < 1) fprintf(stderr, "kernel_launch: occupancy query says %d\n", per_cu);
    (void)hipGetLastError();
    return true;
}
template <int KMASK> static void launch_range(Params p, int lo, int hi, int grid, hipStream_t stream) {
    p.ph_lo = lo; p.ph_hi = hi;
    if (hipMemsetAsync((char*)p.ws + WS_BAR, 0, XCD_BAR_WORDS * 4, stream) != hipSuccess) { fprintf(stderr, "kernel_launch: memset of the barrier words failed\n"); return; }
    void* args[] = {&p};
    hipError_t e = hipLaunchCooperativeKernel((const void*)fwd_kernel<KMASK>, dim3(grid), dim3(NTHREADS), args, LDS_BYTES, stream);
    if (e != hipSuccess) fprintf(stderr, "kernel_launch: cooperative launch [%d,%d) failed: %s (grid %d)\n", lo, hi, hipGetErrorString(e), grid);
}
#ifndef N_LAUNCH
#define N_LAUNCH 1
#endif
extern "C" void kernel_launch(void* const* d_in, const int* in_sizes, int n_in, void* d_out, int out_size, void* d_ws, size_t ws_size, hipStream_t stream) {
    static int grid = 0;
    if (grid == 0) {
        if (n_in != 34 || (size_t)out_size != O_END || ws_size < WS_END) { fprintf(stderr, "kernel_launch: unexpected sizes n_in %d out %d ws %zu (need %zu)\n", n_in, out_size, ws_size, (size_t)WS_END); grid = -1; return; }
        int dev = 0, cus = 0;
        (void)hipGetDevice(&dev); (void)hipDeviceGetAttribute(&cus, hipDeviceAttributeMultiprocessorCount, dev);
        bool ok = true;
#if N_LAUNCH == 1
        ok = setup_kernel<0xffff>();
#else
        ok = setup_kernel<0x3fef>() && setup_kernel<0x0010>();
#endif
        if (!ok) { grid = -1; return; }
        grid = cus;
        if (grid < 64) { fprintf(stderr, "kernel_launch: needs >= 64 CUs\n"); grid = -1; return; }
    }
    if (grid < 0) return;
    Params p{};
    for (int i = 0; i < 34; ++i) p.in[i] = (const float*)d_in[i];
    p.out = (float*)d_out; p.ws = (unsigned char*)d_ws;
#if N_LAUNCH == 1
#ifndef PROBE_K
#define PROBE_K -1
#endif
#ifndef PROBE_BACK
#define PROBE_BACK 0
#endif
    if (PROBE_K >= 0) { launch_range<0xffff>(p, 0, PROBE_K + 1, grid, stream); launch_range<0xffff>(p, PROBE_K - PROBE_BACK, 16, grid, stream); }
    else launch_range<0xffff>(p, 0, 16, grid, stream);
#else
#ifndef DBG_HI
#define DBG_HI 14
#endif
    launch_range<0x3fef>(p, 0, DBG_HI < 4 ? DBG_HI : 4, grid, stream);
    if (DBG_HI > 4) launch_range<0x0010>(p, 4, 5, grid, stream);
    if (DBG_HI > 5) launch_range<0x3fef>(p, 5, DBG_HI, grid, stream);
#endif
}
```

```cpp
#include <hip/hip_runtime.h>
#include <hip/hip_cooperative_groups.h>
#include <cstdio>
namespace cg = cooperative_groups;
namespace pg8 {
#define PG8_LAS __attribute__((address_space(3)))
typedef unsigned short bf16_t;
typedef short bf16x8 __attribute__((ext_vector_type(8)));
typedef float f32x4 __attribute__((ext_vector_type(4)));
typedef unsigned u32x4 __attribute__((ext_vector_type(4)));
constexpr int BM = 256, BK = 64, HALF = 128, HTB = HALF * BK * 2  , STAGE_BYTES = 8 * HTB, NXCD = 8, WGM = 8;

__host__ __device__ __forceinline__ int lds_byte(int r, int c) { const int st = (r >> 4) * 2 + (c >> 5), rr = r & 15, cc = c & 31, ob = rr * 64 + cc * 2; return st * 1024 + (ob ^ (((ob >> 9) & 1) << 5)); }
__host__ __device__ __forceinline__ void stage_rc(int b, int& R, int& C) { const int st = b / 1024, sb = b % 1024, swz = sb ^ (((sb >> 9) & 1) << 5); R = (st >> 1) * 16 + swz / 64; C = (st & 1) * 32 + (swz % 64) / 2; }
__host__ __device__ __forceinline__ int perm32(int rho) { const int n = rho >> 4, i = rho & 15; return 8 * (i >> 2) + 4 * n + (i & 3); }

struct Unit { int pm, pn; };
struct Gemm { const bf16_t* A; const bf16_t* Bt; int M, N, K, lda, ldb; };
struct StaticOrder {
    int nM, nN, nwg, G, c;
    __host__ __device__ void init(int M, int N, int G_, int c_) { nM = M / BM; nN = N / BM; nwg = nM * nN; G = G_; c = c_; }
    __host__ __device__ bool next(int i, Unit& u) const {
        const long L = (long)i * G + c; if (L >= nwg) return false;
        int wgid = (int)L; { const int q = nwg / NXCD, r = nwg % NXCD, xcd = wgid % NXCD, off = wgid / NXCD; wgid = (xcd < r ? xcd * (q + 1) : r * (q + 1) + (xcd - r) * q) + off; }
        const int nig = WGM * nN, gid = wgid / nig, fm = gid * WGM, gsz = (nM - fm) < WGM ? (nM - fm) : WGM;
        u.pm = fm + ((wgid % nig) % gsz); u.pn = (wgid % nig) / gsz; return true;
    }
    __device__ __forceinline__ void a_ready(const Unit&) const {}
    __device__ __forceinline__ void done(const Unit&) const {}
};
__device__ __forceinline__ unsigned cvt_pk_bf16(float lo, float hi) { unsigned r; asm volatile("v_cvt_pk_bf16_f32 %0, %1, %2" : "=v"(r) : "v"(lo), "v"(hi)); return r; }
template <class Epi, class Sched>
__device__ __forceinline__ void gemm_phase(PG8_LAS unsigned char* lds, const Gemm g, const Sched& S, const Epi& E) {
    const int tid = threadIdx.x, wid = __builtin_amdgcn_readfirstlane(tid >> 6), lane = tid & 63, wr = wid >> 2, wc = wid & 3, fr = lane & 15, fq = lane >> 4;
    const int K = g.K, nt = K / BK;
    unsigned voffA[2], voffB[2];
#pragma unroll
    for (int i = 0; i < 2; ++i) { int R, C; stage_rc(tid * 16 + i * 8192, R, C); const int Rb = Epi::PERM ? ((R & ~31) + perm32(R & 31)) : R;
        voffA[i] = (unsigned)(R * g.lda + C) * 2u; voffB[i] = (unsigned)(Rb * g.ldb + C) * 2u; }
    const size_t kstep = (size_t)(BK * 2);
    const size_t hstepA = (size_t)HALF * g.lda * 2, hstepB = (size_t)HALF * g.ldb * 2;
    const size_t tstepA = 2 * hstepA, tstepB = 2 * hstepB;
    const unsigned ldsw = (unsigned)wid * 1024u;
    const int aoff = lds_byte(wr * 64 + fr, fq * 8), boff = lds_byte(wc * 32 + fr, fq * 8);
#define PG8_SA(b, h) (((b) * 2 + (h)) * HTB)
#define PG8_SB(b, h) ((4 + (b) * 2 + (h)) * HTB)
#define PG8_STAGE(bufoff, gbase, voff) do { _Pragma("unroll") for (int _i = 0; _i < 2; ++_i) \
        __builtin_amdgcn_global_load_lds((const unsigned*)((const char*)(gbase) + (voff)[_i]), (PG8_LAS unsigned*)(lds + (bufoff) + ldsw + _i * 8192), 16, 0, 0); } while (0)
#define PG8_LDA(dst, b, h) do { _Pragma("unroll") for (int m = 0; m < 4; ++m) _Pragma("unroll") for (int k = 0; k < 2; ++k) dst[m][k] = *(const PG8_LAS bf16x8*)(lds + PG8_SA(b, h) + aoff + m * 2048 + k * 1024); } while (0)
#define PG8_LDB(dst, b, h) do { _Pragma("unroll") for (int n = 0; n < 2; ++n) _Pragma("unroll") for (int k = 0; k < 2; ++k) dst[n][k] = *(const PG8_LAS bf16x8*)(lds + PG8_SB(b, h) + boff + n * 2048 + k * 1024); } while (0)
#define PG8_MMA(ai, bj, At, Bt) do { __builtin_amdgcn_s_setprio(1); _Pragma("unroll") for (int m = 0; m < 4; ++m) _Pragma("unroll") for (int n = 0; n < 2; ++n) _Pragma("unroll") for (int k = 0; k < 2; ++k) \
        acc[ai][bj][m][n] = __builtin_amdgcn_mfma_f32_16x16x32_bf16(Bt[n][k], At[m][k], acc[ai][bj][m][n], 0, 0, 0); __builtin_amdgcn_s_setprio(0); } while (0)
#define PG8_WAIT_V(n) asm volatile("s_waitcnt vmcnt(" #n ")" ::: "memory")
#define PG8_WAIT_L(n) asm volatile("s_waitcnt lgkmcnt(" #n ")" ::: "memory")
#define PG8_BAR __builtin_amdgcn_s_barrier()
#define PG8_SCHED __builtin_amdgcn_sched_barrier(0)
    Unit cur, nxt; int ui = 0;
    if (!S.next(0, cur)) return;
    f32x4 acc[2][2][4][2];
#pragma unroll
    for (int a = 0; a < 2; ++a)
#pragma unroll
        for (int b = 0; b < 2; ++b)
#pragma unroll
            for (int m = 0; m < 4; ++m)
#pragma unroll
                for (int n = 0; n < 2; ++n) acc[a][b][m][n] = (f32x4){0.f, 0.f, 0.f, 0.f};
    bf16x8 At[4][2], B0[2][2], B1[2][2];
    const char* cA = (const char*)g.A + (size_t)cur.pm * tstepA; const char* cB = (const char*)g.Bt + (size_t)cur.pn * tstepB;
    S.a_ready(cur);
    PG8_STAGE(PG8_SB(0, 0), cB, voffB); PG8_STAGE(PG8_SA(0, 0), cA, voffA); PG8_STAGE(PG8_SB(0, 1), cB + hstepB, voffB); PG8_STAGE(PG8_SA(0, 1), cA + hstepA, voffA);
    if (wr == 1) PG8_BAR;
    PG8_WAIT_V(4); PG8_BAR;
    PG8_STAGE(PG8_SB(1, 0), cB + kstep, voffB); PG8_STAGE(PG8_SA(1, 0), cA + kstep, voffA); PG8_STAGE(PG8_SB(1, 1), cB + hstepB + kstep, voffB);
    PG8_WAIT_V(6); PG8_BAR;
    for (;;) {
        const bool has_next = S.next(ui + 1, nxt);
        const char* nA = has_next ? (const char*)g.A + (size_t)nxt.pm * tstepA : cA; const char* nB = has_next ? (const char*)g.Bt + (size_t)nxt.pn * tstepB : cB;
        for (int t = 0; t < nt; t += 2) {
            const bool last = (t == nt - 2);
            const char* a1 = cA + (size_t)(t + 1) * kstep;
            const char* a2 = last ? nA : cA + (size_t)(t + 2) * kstep; const char* b2 = last ? nB : cB + (size_t)(t + 2) * kstep;
            const char* a3 = a2 + kstep; const char* b3 = b2 + kstep;
            if (last && has_next) S.a_ready(nxt);
            PG8_LDB(B0, 0, 0); PG8_SCHED; PG8_LDA(At, 0, 0); PG8_STAGE(PG8_SA(1, 1), a1 + hstepA, voffA);
            PG8_WAIT_L(8); PG8_BAR; PG8_WAIT_L(0); PG8_MMA(0, 0, At, B0); PG8_BAR; PG8_SCHED;
            PG8_LDB(B1, 0, 1); PG8_STAGE(PG8_SB(0, 0), b2, voffB);
            PG8_BAR; PG8_WAIT_L(0); PG8_MMA(0, 1, At, B1); PG8_BAR;
            PG8_LDA(At, 0, 1); PG8_STAGE(PG8_SA(0, 0), a2, voffA);
            PG8_BAR; PG8_WAIT_L(0); PG8_MMA(1, 0, At, B0); PG8_BAR; PG8_SCHED;
            PG8_STAGE(PG8_SB(0, 1), b2 + hstepB, voffB);
            PG8_WAIT_V(6); PG8_BAR; PG8_MMA(1, 1, At, B1); PG8_BAR;
            PG8_LDB(B0, 1, 0); PG8_SCHED; PG8_LDA(At, 1, 0); PG8_STAGE(PG8_SA(0, 1), a2 + hstepA, voffA);
            PG8_WAIT_L(8); PG8_BAR; PG8_WAIT_L(0); PG8_MMA(0, 0, At, B0); PG8_BAR; PG8_SCHED;
            PG8_LDB(B1, 1, 1); PG8_STAGE(PG8_SB(1, 0), b3, voffB);
            PG8_BAR; PG8_WAIT_L(0); PG8_MMA(0, 1, At, B1); PG8_BAR;
            PG8_LDA(At, 1, 1); PG8_STAGE(PG8_SA(1, 0), a3, voffA);
            PG8_BAR; PG8_WAIT_L(0); PG8_MMA(1, 0, At, B0); PG8_BAR; PG8_SCHED;
            PG8_STAGE(PG8_SB(1, 1), b3 + hstepB, voffB);
            PG8_WAIT_V(6); PG8_BAR; PG8_MMA(1, 1, At, B1); PG8_BAR;
        }
        if constexpr (!Epi::AFTER_DRAIN) { E(acc, cur, wr, wc, fr, fq); S.done(cur); }
        if (!has_next) break;
#pragma unroll
        for (int a = 0; a < 2; ++a)
#pragma unroll
            for (int b = 0; b < 2; ++b)
#pragma unroll
                for (int m = 0; m < 4; ++m)
#pragma unroll
                    for (int n = 0; n < 2; ++n) acc[a][b][m][n] = (f32x4){0.f, 0.f, 0.f, 0.f};
        cur = nxt; cA = nA; cB = nB; ++ui;
    }
    PG8_WAIT_V(0);
    if (wr == 0) PG8_BAR;
    PG8_BAR;
    if constexpr (Epi::AFTER_DRAIN) { E.fused(acc, cur, wr, wc, fr, fq, lds, wid, lane); S.done(cur); }
#undef PG8_SA
#undef PG8_SB
#undef PG8_STAGE
#undef PG8_LDA
#undef PG8_LDB
#undef PG8_MMA
#undef PG8_WAIT_V
#undef PG8_WAIT_L
#undef PG8_BAR
#undef PG8_SCHED
}
}
using pg8::bf16_t; using pg8::bf16x8; using pg8::f32x4; using pg8::u32x4;
typedef short s16x4 __attribute__((ext_vector_type(4)));
typedef unsigned u32x2 __attribute__((ext_vector_type(2)));
#define LAS __attribute__((address_space(3)))

constexpr int MP = 16384, MS = 512, MT = MP + MS, DM = 1024, DFF = 2816, ZLD = 8192, ZSLD = 32;
constexpr int NTHREADS = 512;
constexpr float EPSV = 1e-6f;
constexpr size_t SZ_WGU = 5632ull * 1024 * 2, SZ_WD = 1024ull * 2816 * 2, SZ_WIN = 8448ull * 1024 * 2, SZ_W1K = 1024ull * 1024 * 2;
constexpr size_t WS_WGU1 = 0;
constexpr size_t WS_WD1 = WS_WGU1 + SZ_WGU;
constexpr size_t WS_WIN = WS_WD1 + SZ_WD;
constexpr size_t WS_WBRM = WS_WIN + SZ_WIN;
constexpr size_t WS_WBRG = WS_WBRM + SZ_W1K;
constexpr size_t WS_WOUT = WS_WBRG + SZ_W1K;
constexpr size_t WS_WQ = WS_WOUT + SZ_W1K;
constexpr size_t WS_WO = WS_WQ + SZ_W1K;
constexpr size_t WS_WKV = WS_WO + SZ_W1K;
constexpr size_t WS_WGU2 = WS_WKV + 2 * SZ_W1K;
constexpr size_t WS_WD2 = WS_WGU2 + SZ_WGU;
constexpr size_t WS_ABUF = WS_WD2 + SZ_WD;
constexpr size_t WS_MEMA = WS_ABUF + (size_t)MT * DM * 2;
constexpr size_t WS_MEMKV = WS_MEMA + 2048ull * 1024 * 2;
constexpr size_t WS_XRES = WS_MEMKV + 2048ull * 2048 * 2;
constexpr size_t WS_ZS = WS_XRES + (size_t)MT * DM * 4;
constexpr size_t WS_SS = WS_ZS + (size_t)MT * ZSLD * 4;
constexpr size_t WS_SSQ = WS_SS + 4ull * MT * 16 * 4;
constexpr size_t WS_BEND = WS_SSQ + (size_t)MP * 32 * 4;
constexpr size_t WS_Z = WS_BEND + 1024ull * 128 * 4;
constexpr size_t WS_ABUF2 = WS_Z + (64ull << 20);
constexpr size_t WS_QBUF = WS_Z + (128ull << 20);
constexpr size_t WS_OBUF = WS_Z + (192ull << 20);
constexpr size_t WS_BAR = WS_Z + (size_t)MT * ZLD * 2;
constexpr size_t WS_END = WS_BAR + 16384;
constexpr size_t O_YP = 0, O_YS = 16777216, O_CP = 17301504, O_NP = 18350080, O_MPP = 18354176, O_SP = 18354208, O_MKP = 19402784, O_MVP = 21499936,
                 O_CS = 23597088, O_NS = 40374304, O_MSS = 40439840, O_SS = 40440352, O_END = 57217568;
constexpr int LDS_BYTES = 156 * 1024;

struct Params { const float* in[34]; float* out; unsigned char* ws; int ph_lo, ph_hi; };

typedef float f32x2_t __attribute__((ext_vector_type(2)));
typedef __bf16 bf16x2_t __attribute__((ext_vector_type(2)));
__device__ __forceinline__ unsigned cvt_pk(float lo, float hi) { f32x2_t v = {lo, hi}; bf16x2_t b = __builtin_convertvector(v, bf16x2_t); return __builtin_bit_cast(unsigned, b); }
__device__ __forceinline__ bf16_t f2bf(float x) { return (bf16_t)(cvt_pk(x, 0.f) & 0xffffu); }
__device__ __forceinline__ float bf2f(bf16_t x) { return __uint_as_float(((unsigned)x) << 16); }
__device__ __forceinline__ float bflo(unsigned w) { return __uint_as_float(w << 16); }
__device__ __forceinline__ float bfhi(unsigned w) { return __uint_as_float(w & 0xffff0000u); }
__device__ __forceinline__ float sigmoidf_(float x) { return __builtin_amdgcn_rcpf(1.f + __expf(-x)); }
__device__ __forceinline__ float logsigf_(float x) { return fminf(x, 0.f) - __logf(1.f + __expf(-fabsf(x))); }
__device__ __forceinline__ float rs_of(float ss) { return rsqrtf(ss * (1.f / 1024.f) + EPSV); }
__device__ __forceinline__ float rs_row(const float* ssp, int row) {
    const f32x4* q = (const f32x4*)(ssp + (size_t)row * 16); const f32x4 a = q[0], b = q[1], c = q[2], d = q[3];
    const f32x4 s = (a + b) + (c + d); return rs_of((s[0] + s[1]) + (s[2] + s[3])); }
__device__ __forceinline__ float rs_row_q(const float* ssp, int row, int fq) {
    const f32x4 a = *(const f32x4*)(ssp + (size_t)row * 16 + fq * 4);
    float s_ = (a[0] + a[1]) + (a[2] + a[3]); s_ += __shfl_xor(s_, 16); s_ += __shfl_xor(s_, 32); return rs_of(s_); }
__device__ __forceinline__ f32x4 mfma16(bf16x8 a, bf16x8 b, f32x4 c) { return __builtin_amdgcn_mfma_f32_16x16x32_bf16(a, b, c, 0, 0, 0); }
__device__ __forceinline__ bf16x8 pack8(f32x4 a, f32x4 b) {
    u32x4 w; w.x = cvt_pk(a[0], a[1]); w.y = cvt_pk(a[2], a[3]); w.z = cvt_pk(b[0], b[1]); w.w = cvt_pk(b[2], b[3]);
    return __builtin_bit_cast(bf16x8, w);
}
__device__ __forceinline__ u32x2 pack4(f32x4 a) { u32x2 w; w.x = cvt_pk(a[0], a[1]); w.y = cvt_pk(a[2], a[3]); return w; }
__device__ __forceinline__ bf16x8 tr_frag(unsigned a0, unsigned a1) {
    s16x4 r0, r1;
    asm volatile("ds_read_b64_tr_b16 %0, %2\n\tds_read_b64_tr_b16 %1, %3\n\ts_waitcnt lgkmcnt(0)" : "=&v"(r0), "=&v"(r1) : "v"(a0), "v"(a1) : "memory");
    return __builtin_shufflevector(r0, r1, 0, 1, 2, 3, 4, 5, 6, 7);
}
__device__ __forceinline__ void tr_frag2(unsigned a0, unsigned a1, unsigned b0, unsigned b1, bf16x8& fa, bf16x8& fb) {
    s16x4 r0, r1, r2, r3;
    asm volatile("ds_read_b64_tr_b16 %0, %4\n\tds_read_b64_tr_b16 %1, %5\n\tds_read_b64_tr_b16 %2, %6\n\tds_read_b64_tr_b16 %3, %7\n\ts_waitcnt lgkmcnt(0)"
                 : "=&v"(r0), "=&v"(r1), "=&v"(r2), "=&v"(r3) : "v"(a0), "v"(a1), "v"(b0), "v"(b1) : "memory");
    fa = __builtin_shufflevector(r0, r1, 0, 1, 2, 3, 4, 5, 6, 7); fb = __builtin_shufflevector(r2, r3, 0, 1, 2, 3, 4, 5, 6, 7);
}
__device__ __forceinline__ void tr_frag4(unsigned a0, unsigned a1, unsigned b0, unsigned b1, unsigned c0, unsigned c1, unsigned d0, unsigned d1, bf16x8& fa, bf16x8& fb, bf16x8& fc, bf16x8& fd) {
    s16x4 r0, r1, r2, r3, r4, r5, r6, r7;
    asm volatile("ds_read_b64_tr_b16 %0, %8\n\tds_read_b64_tr_b16 %1, %9\n\tds_read_b64_tr_b16 %2, %10\n\tds_read_b64_tr_b16 %3, %11\n\t"
                 "ds_read_b64_tr_b16 %4, %12\n\tds_read_b64_tr_b16 %5, %13\n\tds_read_b64_tr_b16 %6, %14\n\tds_read_b64_tr_b16 %7, %15\n\ts_waitcnt lgkmcnt(0)"
                 : "=&v"(r0), "=&v"(r1), "=&v"(r2), "=&v"(r3), "=&v"(r4), "=&v"(r5), "=&v"(r6), "=&v"(r7)
                 : "v"(a0), "v"(a1), "v"(b0), "v"(b1), "v"(c0), "v"(c1), "v"(d0), "v"(d1) : "memory");
    fa = __builtin_shufflevector(r0, r1, 0, 1, 2, 3, 4, 5, 6, 7); fb = __builtin_shufflevector(r2, r3, 0, 1, 2, 3, 4, 5, 6, 7);
    fc = __builtin_shufflevector(r4, r5, 0, 1, 2, 3, 4, 5, 6, 7); fd = __builtin_shufflevector(r6, r7, 0, 1, 2, 3, 4, 5, 6, 7);
}
__device__ __forceinline__ float xsum16_32(float v) { v += __shfl_xor(v, 16); v += __shfl_xor(v, 32); return v; }
__device__ __forceinline__ float xmax16_32(float v) { v = fmaxf(v, __shfl_xor(v, 16)); v = fmaxf(v, __shfl_xor(v, 32)); return v; }
__device__ __forceinline__ float wave_sum(float v) { for (int o = 32; o > 0; o >>= 1) v += __shfl_xor(v, o); return v; }
__device__ __forceinline__ float wave_max(float v) { for (int o = 32; o > 0; o >>= 1) v = fmaxf(v, __shfl_xor(v, o)); return v; }

#define XB_TMO      128
#define XB_XCNT(j)  (256  + 64 * (j))
#define XB_XSUB(j)  (1280 + 64 * (j))
#define XB_XGEN(j)  (2304 + 64 * (j))
#define XB_TOP      3328
#define XB_TOPGEN   3392
#define XCD_BAR_WORDS 3456
#define XB_SPIN_CAP (1u << 18)

__device__ __forceinline__ unsigned xb_ld(unsigned* p)              { return __hip_atomic_load(p, __ATOMIC_RELAXED, __HIP_MEMORY_SCOPE_AGENT); }
__device__ __forceinline__ unsigned xb_add(unsigned* p, unsigned v) { return __hip_atomic_fetch_add(p, v, __ATOMIC_RELAXED, __HIP_MEMORY_SCOPE_AGENT); }
__device__ __forceinline__ unsigned xb_xcc_id() { return (unsigned)__builtin_amdgcn_s_getreg((3 << 11) | 20) & 0xFu; }
#define XB_SPIN(cond, bar) do { unsigned _sp = 0; while (cond) { __builtin_amdgcn_s_sleep(1); \
    if ((++_sp & 255u) == 0u) { if (xb_ld(&(bar)[XB_TMO])) break; if (_sp > XB_SPIN_CAP) { atomicAdd(&(bar)[XB_TMO], 1u); break; } } } } while (0)

struct XcdBarrier {
    unsigned* bar; unsigned x;
    volatile LAS unsigned* st;
};

__device__ __forceinline__ XcdBarrier xcd_barrier_post(unsigned* bar, volatile LAS unsigned* st) {
    XcdBarrier b; b.bar = bar; b.x = xb_xcc_id(); b.st = st;
    if (threadIdx.x == 0) (void)xb_add(&bar[XB_XCNT(b.x)], 1u);
    return b;
}
__device__ __forceinline__ void xcd_barrier_complete(unsigned* bar, unsigned x, unsigned& nloc, unsigned& nx) {
    const unsigned G = gridDim.x * gridDim.y * gridDim.z;
    unsigned sum, cnt, mine, sp = 0u;
    for (;;) {
        sum = 0u; cnt = 0u; mine = 0u;
#pragma unroll
        for (unsigned j = 0; j < 16; ++j) { const unsigned c = xb_ld(&bar[XB_XCNT(j)]); sum += c; cnt += (c > 0u) ? 1u : 0u; mine = (j == x) ? c : mine; }
        if (sum == G) break;
        __builtin_amdgcn_s_sleep(1);
        if ((++sp & 255u) == 0u) { if (xb_ld(&bar[XB_TMO])) break; if (sp > XB_SPIN_CAP) { atomicAdd(&bar[XB_TMO], 1u); break; } }
    }
    nloc = mine > 0u ? mine : 1u; nx = cnt > 0u ? cnt : 1u;
}

__device__ __forceinline__ void xcd_barrier(const XcdBarrier& b) {
    asm volatile("s_waitcnt vmcnt(0)" ::: "memory");
    __syncthreads();
    if (threadIdx.x == 0) {
        unsigned* bar = b.bar;
        __builtin_amdgcn_s_waitcnt(0);
        unsigned nloc = b.st[0], nx = b.st[1];
        if (nloc == 0u) { xcd_barrier_complete(bar, b.x, nloc, nx); b.st[0] = nloc; b.st[1] = nx; }
        const unsigned old = xb_add(&bar[XB_XSUB(b.x)], 1u);
        const unsigned gen = old / nloc;
        if (old + 1u == (gen + 1u) * nloc) {
            __builtin_amdgcn_fence(__ATOMIC_RELEASE, "agent");
            asm volatile("s_waitcnt vmcnt(0)" ::: "memory");
            const unsigned og = xb_add(&bar[XB_TOP], 1u);
            const unsigned tg = og / nx;
            if (og + 1u == (tg + 1u) * nx) xb_add(&bar[XB_TOPGEN], 1u);
            else XB_SPIN(xb_ld(&bar[XB_TOPGEN]) == tg, bar);
            __builtin_amdgcn_fence(__ATOMIC_ACQUIRE, "agent");
            xb_add(&bar[XB_XGEN(b.x)], 1u);
            asm volatile("s_waitcnt vmcnt(0)" ::: "memory");
        } else {
            XB_SPIN(xb_ld(&bar[XB_XGEN(b.x)]) == gen, bar);
            __builtin_amdgcn_fence(__ATOMIC_ACQUIRE, "agent");
            asm volatile("s_waitcnt vmcnt(0)" ::: "memory");
        }
    }
    __syncthreads();
}


constexpr int PREP_EARLY_MASK = 0x060f, PREP_LATE_MASK = 0x39f0;
__device__ __forceinline__ int win_src_col(int r) {
    if (r < 3072) return r; if (r < 6144) return r + 8; if (r < 8192) return r + 24;
    if (r < 8200) return 3072 + (r - 8192); if (r < 8216) return 6152 + (r - 8200); return -1;
}
__device__ __forceinline__ void prep_transposes(const Params& p, unsigned char* lds, int dmask, int vb, int nvb) {
    float* tile = (float*)lds;
    const int tid = threadIdx.x;
    unsigned char* ws = p.ws;
    for (int d = 0; d < 14; ++d) {
        if (!((dmask >> d) & 1)) continue;
        const float* src; bf16_t* dst; int K, ldsrc, ntn, mode = 0, rowoff = 0; float scale = 1.f;
        switch (d) {
            case 0: src = p.in[10]; dst = (bf16_t*)(ws + WS_WGU1); K = 1024; ldsrc = 2816; ntn = 44; mode = 2; rowoff = 0; break;
            case 1: src = p.in[11]; dst = (bf16_t*)(ws + WS_WGU1); K = 1024; ldsrc = 2816; ntn = 44; mode = 2; rowoff = 128; break;
            case 2: src = p.in[12]; dst = (bf16_t*)(ws + WS_WD1); K = 2816; ldsrc = 1024; ntn = 16; break;
            case 3: src = p.in[14]; dst = (bf16_t*)(ws + WS_WIN); K = 1024; ldsrc = 8216; ntn = 132; mode = 1; break;
            case 4: src = p.in[20]; dst = (bf16_t*)(ws + WS_WBRM); K = 1024; ldsrc = 1024; ntn = 16; break;
            case 5: src = p.in[21]; dst = (bf16_t*)(ws + WS_WBRG); K = 1024; ldsrc = 1024; ntn = 16; break;
            case 6: src = p.in[22]; dst = (bf16_t*)(ws + WS_WOUT); K = 1024; ldsrc = 1024; ntn = 16; break;
            case 7: src = p.in[25]; dst = (bf16_t*)(ws + WS_WQ); K = 1024; ldsrc = 1024; ntn = 16; scale = 0.0625f; break;
            case 8: src = p.in[28]; dst = (bf16_t*)(ws + WS_WO); K = 1024; ldsrc = 1024; ntn = 16; break;
            case 9: src = p.in[26]; dst = (bf16_t*)(ws + WS_WKV); K = 1024; ldsrc = 1024; ntn = 16; break;
            case 10: src = p.in[27]; dst = (bf16_t*)(ws + WS_WKV); K = 1024; ldsrc = 1024; ntn = 16; rowoff = 1024; break;
            case 11: src = p.in[30]; dst = (bf16_t*)(ws + WS_WGU2); K = 1024; ldsrc = 2816; ntn = 44; mode = 2; rowoff = 0; break;
            case 12: src = p.in[31]; dst = (bf16_t*)(ws + WS_WGU2); K = 1024; ldsrc = 2816; ntn = 44; mode = 2; rowoff = 128; break;
            default: src = p.in[32]; dst = (bf16_t*)(ws + WS_WD2); K = 2816; ldsrc = 1024; ntn = 16; break;
        }
        const int nkt = K / 64, ntiles = nkt * ntn;
        for (int t = vb; t < ntiles; t += nvb) {
            const int kt = t % nkt, nt = t / nkt, k0 = kt * 64;
            {
                const int j = tid & 63;
                int srccol; float sc = scale;
                if (mode == 1) { srccol = win_src_col(nt * 64 + j); if ((srccol >= 512 && srccol < 1024) || (srccol >= 3080 && srccol < 3592)) sc = 0.08838834764831845f; }
                else srccol = nt * 64 + j;
#pragma unroll
                for (int ps = 0; ps < 8; ++ps) { const int i = (tid >> 6) + 8 * ps;
                    float v = 0.f; if (srccol >= 0) v = __builtin_nontemporal_load(src + (size_t)(k0 + i) * ldsrc + srccol) * sc;
                    tile[i * 65 + j] = v; }
            }
            __syncthreads();
            {
                const int j = tid >> 3, kc = tid & 7;
                int dstrow;
                if (mode == 1) dstrow = nt * 64 + j;
                else { const int sc_ = nt * 64 + j; dstrow = (mode == 2) ? ((sc_ >> 7) * 256 + (sc_ & 127) + rowoff) : (sc_ + rowoff); }
                float v[8];
#pragma unroll
                for (int e = 0; e < 8; ++e) v[e] = tile[(kc * 8 + e) * 65 + j];
                u32x4 w; w.x = cvt_pk(v[0], v[1]); w.y = cvt_pk(v[2], v[3]); w.z = cvt_pk(v[4], v[5]); w.w = cvt_pk(v[6], v[7]);
                *(u32x4*)(dst + (size_t)dstrow * K + k0 + kc * 8) = w;
            }
            __syncthreads();
        }
    }
}
__device__ __forceinline__ void prep_phase(const Params& p, unsigned char* lds) {
    const int tid = threadIdx.x;
    unsigned char* ws = p.ws;
    prep_transposes(p, lds, PREP_EARLY_MASK, (int)blockIdx.x, (int)gridDim.x);
    const int lane = tid & 63, gw = blockIdx.x * 8 + (tid >> 6), nw = gridDim.x * 8;
    for (int r = gw; r < MT + 2048; r += nw) {
        const float* x; const float* g; bf16_t* o;
        if (r < MP) { x = p.in[0] + (size_t)r * DM; g = p.in[9]; o = (bf16_t*)(ws + WS_ABUF) + (size_t)r * DM; }
        else if (r < MT) { x = p.in[1] + (size_t)(r - MP) * DM; g = p.in[9]; o = (bf16_t*)(ws + WS_ABUF) + (size_t)r * DM; }
        else { x = p.in[2] + (size_t)(r - MT) * DM; g = p.in[24]; o = (bf16_t*)(ws + WS_MEMA) + (size_t)(r - MT) * DM; }
        f32x4 v[4]; float ss = 0.f;
#pragma unroll
        for (int i = 0; i < 4; ++i) { v[i] = *(const f32x4*)(x + i * 256 + lane * 4); ss += v[i][0] * v[i][0] + v[i][1] * v[i][1] + v[i][2] * v[i][2] + v[i][3] * v[i][3]; }
        ss = wave_sum(ss); const float rs = rs_of(ss);
#pragma unroll
        for (int i = 0; i < 4; ++i) { const f32x4 gg = *(const f32x4*)(g + i * 256 + lane * 4);
            u32x2 w; w.x = cvt_pk(v[i][0] * rs * gg[0], v[i][1] * rs * gg[1]); w.y = cvt_pk(v[i][2] * rs * gg[2], v[i][3] * rs * gg[3]);
            *(u32x2*)(o + i * 256 + lane * 4) = w; }
    }
}

#define EPI_ROW(ai, m) (u.pm * 256 + (ai) * 128 + wr * 64 + (m) * 16 + fr)
#define EPI_COL(bj) (u.pn * 256 + (bj) * 128 + wc * 32 + fq * 8)
struct EpiGateUp {
    static constexpr bool PERM = true, AFTER_DRAIN = false;
    bf16_t* H; const float* ss;
    __device__ __forceinline__ void operator()(const f32x4 (&acc)[2][2][4][2], const pg8::Unit& u, int wr, int wc, int fr, int fq) const {
        float rsv[2][4];
#pragma unroll
        for (int ai = 0; ai < 2; ++ai)
#pragma unroll
            for (int m = 0; m < 4; ++m) rsv[ai][m] = ss ? rs_row_q(ss, EPI_ROW(ai, m), fq) : 1.f;
#pragma unroll
        for (int ai = 0; ai < 2; ++ai)
#pragma unroll
            for (int m = 0; m < 4; ++m) { const int row = EPI_ROW(ai, m); const float rs = rsv[ai][m];
                f32x4 hv[2];
#pragma unroll
                for (int n = 0; n < 2; ++n)
#pragma unroll
                    for (int j = 0; j < 4; ++j) { const float gt = acc[ai][0][m][n][j] * rs, up = acc[ai][1][m][n][j] * rs; hv[n][j] = gt * sigmoidf_(gt) * up; }
                *(u32x4*)(H + (size_t)row * DFF + u.pn * 128 + wc * 32 + fq * 8) = __builtin_bit_cast(u32x4, pack8(hv[0], hv[1])); }
    }
};
struct EpiMemKV {
    static constexpr bool PERM = true, AFTER_DRAIN = false;
    float* ok; float* ov; bf16_t* kv;
    __device__ __forceinline__ void operator()(const f32x4 (&acc)[2][2][4][2], const pg8::Unit& u, int wr, int wc, int fr, int fq) const {
#pragma unroll
        for (int ai = 0; ai < 2; ++ai)
#pragma unroll
            for (int m = 0; m < 4; ++m) { const int row = EPI_ROW(ai, m);
#pragma unroll
                for (int bj = 0; bj < 2; ++bj) { const int col = EPI_COL(bj);
                    float* o = (col < 1024) ? (ok + (size_t)row * 1024 + col) : (ov + (size_t)row * 1024 + (col - 1024));
                    __builtin_nontemporal_store(acc[ai][bj][m][0], (f32x4*)o); __builtin_nontemporal_store(acc[ai][bj][m][1], (f32x4*)(o + 4));
                    *(u32x4*)(kv + (size_t)row * 2048 + col) = __builtin_bit_cast(u32x4, pack8(acc[ai][bj][m][0], acc[ai][bj][m][1])); } }
    }
};
struct EpiResid {
    static constexpr bool PERM = true, AFTER_DRAIN = false;
    const float* res0; const float* res1; float* xout; bf16_t* aout; const float* gain; float* ss; float scale;
    __device__ __forceinline__ void operator()(const f32x4 (&acc)[2][2][4][2], const pg8::Unit& u, int wr, int wc, int fr, int fq) const {
        f32x4 gv[2][2];
        if (aout) {
#pragma unroll
            for (int bj = 0; bj < 2; ++bj) { gv[bj][0] = *(const f32x4*)(gain + EPI_COL(bj)); gv[bj][1] = *(const f32x4*)(gain + EPI_COL(bj) + 4); } }
#pragma unroll
        for (int ai = 0; ai < 2; ++ai) {
            f32x4 rv[4][2][2];
#pragma unroll
            for (int m = 0; m < 4; ++m) { const int row = EPI_ROW(ai, m);
                const float* rp = (row < MP) ? (res0 + (size_t)row * DM) : (res1 + (size_t)(row - MP) * DM);
#pragma unroll
                for (int bj = 0; bj < 2; ++bj) { rv[m][bj][0] = *(const f32x4*)(rp + EPI_COL(bj)); rv[m][bj][1] = *(const f32x4*)(rp + EPI_COL(bj) + 4); } }
#pragma unroll
            for (int m = 0; m < 4; ++m) { const int row = EPI_ROW(ai, m);
                float sq = 0.f;
#pragma unroll
                for (int bj = 0; bj < 2; ++bj) { const int col = EPI_COL(bj);
                    const f32x4 x0 = rv[m][bj][0] + acc[ai][bj][m][0] * scale, x1 = rv[m][bj][1] + acc[ai][bj][m][1] * scale;
                    *(f32x4*)(xout + (size_t)row * DM + col) = x0; *(f32x4*)(xout + (size_t)row * DM + col + 4) = x1;
#pragma unroll
                    for (int j = 0; j < 4; ++j) sq += x0[j] * x0[j] + x1[j] * x1[j];
                    if (aout) *(u32x4*)(aout + (size_t)row * DM + col) = __builtin_bit_cast(u32x4, pack8(x0 * gv[bj][0], x1 * gv[bj][1])); }
                sq = xsum16_32(sq);
                if (fq == 0) ss[(size_t)row * 16 + u.pn * 4 + wc] = sq; }
        }
    }
    __device__ __forceinline__ void small(f32x4 acc, int row, int col, int tc, int rt, int ct, int l16, int g, unsigned char* lds) const {
        const f32x4 x = *(const f32x4*)(res1 + (size_t)(row - MP) * DM + col) + acc * scale;
        *(f32x4*)(xout + (size_t)row * DM + col) = x;
        if (aout) { const f32x4 gv4 = *(const f32x4*)(gain + col); *(u32x2*)(aout + (size_t)row * DM + col) = pack4(x * gv4); }
        float sq = x[0] * x[0] + x[1] * x[1] + x[2] * x[2] + x[3] * x[3];
        sq = xsum16_32(sq);
        float* red = (float*)lds;
        if (g == 0) red[(rt * 4 + ct) * 16 + l16] = sq;
        __syncthreads();
        if (ct == 0 && g == 0) ss[(size_t)row * 16 + tc] = (red[(rt * 4) * 16 + l16] + red[(rt * 4 + 1) * 16 + l16]) + (red[(rt * 4 + 2) * 16 + l16] + red[(rt * 4 + 3) * 16 + l16]);
        __syncthreads();
    }
};
struct EpiZ {
    static constexpr bool PERM = true, AFTER_DRAIN = false;
    bf16_t* Z; float* ZS; const float* ss;
    __device__ __forceinline__ void operator()(const f32x4 (&acc)[2][2][4][2], const pg8::Unit& u, int wr, int wc, int fr, int fq) const {
#pragma unroll
        for (int ai = 0; ai < 2; ++ai) {
            float rsv[4];
#pragma unroll
            for (int m = 0; m < 4; ++m) rsv[m] = rs_row_q(ss, EPI_ROW(ai, m), fq);
#pragma unroll
            for (int m = 0; m < 4; ++m) { const int row = EPI_ROW(ai, m); const float rs = rsv[m];
                if (u.pn < 32) {
#pragma unroll
                    for (int bj = 0; bj < 2; ++bj)
                        *(u32x4*)(Z + (size_t)row * ZLD + EPI_COL(bj)) = __builtin_bit_cast(u32x4, pack8(acc[ai][bj][m][0] * rs, acc[ai][bj][m][1] * rs));
                } else if (wc == 0) {
                    *(f32x4*)(ZS + (size_t)row * ZSLD + fq * 8) = acc[ai][0][m][0] * rs; *(f32x4*)(ZS + (size_t)row * ZSLD + fq * 8 + 4) = acc[ai][0][m][1] * rs;
                } } }
    }
};
template <int MODE> struct EpiMerge {
    static constexpr bool PERM = true, AFTER_DRAIN = false;
    const bf16_t* gate; float* T; bf16_t* Y;
    __device__ __forceinline__ void operator()(const f32x4 (&acc)[2][2][4][2], const pg8::Unit& u, int wr, int wc, int fr, int fq) const {
#pragma unroll
        for (int ai = 0; ai < 2; ++ai)
#pragma unroll
            for (int mh = 0; mh < 2; ++mh) {
                u32x4 gw[2][2]; u32x4 tvb[2][2]; bf16_t* Tb = (bf16_t*)T;
#pragma unroll
                for (int mm = 0; mm < 2; ++mm) { const int row = EPI_ROW(ai, mh * 2 + mm);
#pragma unroll
                    for (int bj = 0; bj < 2; ++bj) { gw[mm][bj] = *(const u32x4*)(gate + (size_t)row * ZLD + EPI_COL(bj));
                        if (MODE == 1) tvb[mm][bj] = *(const u32x4*)(Tb + (size_t)row * DM + EPI_COL(bj)); } }
#pragma unroll
                for (int mm = 0; mm < 2; ++mm) { const int m = mh * 2 + mm, row = EPI_ROW(ai, m);
#pragma unroll
                    for (int bj = 0; bj < 2; ++bj) { const int col = EPI_COL(bj); const u32x4 g4 = gw[mm][bj];
                        f32x4 s0, s1;
                        s0[0] = sigmoidf_(bflo(g4.x)); s0[1] = sigmoidf_(bfhi(g4.x)); s0[2] = sigmoidf_(bflo(g4.y)); s0[3] = sigmoidf_(bfhi(g4.y));
                        s1[0] = sigmoidf_(bflo(g4.z)); s1[1] = sigmoidf_(bfhi(g4.z)); s1[2] = sigmoidf_(bflo(g4.w)); s1[3] = sigmoidf_(bfhi(g4.w));
                        f32x4 v0 = acc[ai][bj][m][0] * s0, v1 = acc[ai][bj][m][1] * s1;
                        if (MODE == 0) *(u32x4*)(Tb + (size_t)row * DM + col) = __builtin_bit_cast(u32x4, pack8(v0, v1));
                        else { const u32x4 t4 = tvb[mm][bj];
                            v0 += (f32x4){bflo(t4.x), bfhi(t4.x), bflo(t4.y), bfhi(t4.y)}; v1 += (f32x4){bflo(t4.z), bfhi(t4.z), bflo(t4.w), bfhi(t4.w)};
                            *(u32x4*)(Y + (size_t)row * DM + col) = __builtin_bit_cast(u32x4, pack8(v0, v1)); } } }
            }
    }
    __device__ __forceinline__ void small(f32x4 acc, int row, int col, int tc, int rt, int ct, int l16, int g, unsigned char* lds) const {
        bf16_t* Tb = (bf16_t*)T;
        const u32x2 g2 = *(const u32x2*)(gate + (size_t)row * ZLD + col);
        f32x4 v = acc * (f32x4){sigmoidf_(bflo(g2.x)), sigmoidf_(bfhi(g2.x)), sigmoidf_(bflo(g2.y)), sigmoidf_(bfhi(g2.y))};
        if (MODE == 0) *(u32x2*)(Tb + (size_t)row * DM + col) = pack4(v);
        else { const u32x2 t2 = *(const u32x2*)(Tb + (size_t)row * DM + col);
            v += (f32x4){bflo(t2.x), bfhi(t2.x), bflo(t2.y), bfhi(t2.y)};
            *(u32x2*)(Y + (size_t)row * DM + col) = pack4(v); }
    }
};
struct EpiQ {
    static constexpr bool PERM = true, AFTER_DRAIN = false;
    bf16_t* Q; const float* ss;
    __device__ __forceinline__ void operator()(const f32x4 (&acc)[2][2][4][2], const pg8::Unit& u, int wr, int wc, int fr, int fq) const {
#pragma unroll
        for (int ai = 0; ai < 2; ++ai) {
            float rsv[4];
#pragma unroll
            for (int m = 0; m < 4; ++m) rsv[m] = rs_row_q(ss, EPI_ROW(ai, m), fq);
#pragma unroll
            for (int m = 0; m < 4; ++m) { const int row = EPI_ROW(ai, m); const float rs = rsv[m];
#pragma unroll
                for (int bj = 0; bj < 2; ++bj)
                    *(u32x4*)(Q + (size_t)row * DM + EPI_COL(bj)) = __builtin_bit_cast(u32x4, pack8(acc[ai][bj][m][0] * rs, acc[ai][bj][m][1] * rs)); } }
    }
    __device__ __forceinline__ void small(f32x4 acc, int row, int col, int tc, int rt, int ct, int l16, int g, unsigned char* lds) const {
        *(u32x2*)(Q + (size_t)row * DM + col) = pack4(acc * rs_row(ss, row));
    }
};
template <class Epi>
__device__ __forceinline__ void small_gemm(unsigned char* lds, const bf16_t* A, int lda, const bf16_t* Bt, int N, int K, const Epi& E) {
    const int tid = threadIdx.x, w = tid >> 6, lane = tid & 63, g = lane >> 4, l16 = lane & 15;
    const int rt = w >> 2, ct = w & 3, nct = N / 64, ntiles = 16 * nct;
    for (int t = blockIdx.x; t < ntiles; t += gridDim.x) {
        const int tr = t / nct, tc = t - tr * nct;
        const int row = MP + tr * 32 + rt * 16 + l16, colb = tc * 64 + ct * 16;
        const bf16_t* ap = A + (size_t)row * lda + 8 * g;
        const bf16_t* bp = Bt + (size_t)(colb + l16) * K + 8 * g;
        f32x4 acc0 = (f32x4){0.f, 0.f, 0.f, 0.f}, acc1 = acc0;
#pragma unroll 4
        for (int k = 0; k < K; k += 64) {
            acc0 = mfma16(*(const bf16x8*)(bp + k), *(const bf16x8*)(ap + k), acc0);
            acc1 = mfma16(*(const bf16x8*)(bp + k + 32), *(const bf16x8*)(ap + k + 32), acc1);
        }
        E.small(acc0 + acc1, row, colb + 4 * g, tc, rt, ct, l16, g, lds);
    }
}
template <class Epi>
__device__ __forceinline__ void run_gemm(unsigned char* lds, const bf16_t* A, int lda, const bf16_t* Bt, int M, int N, int K, const Epi& E, int rot) {
    pg8::Gemm g; g.A = A; g.Bt = Bt; g.M = M; g.N = N; g.K = K; g.lda = lda; g.ldb = K;
    pg8::StaticOrder S; S.init(M, N, (int)gridDim.x, (int)((blockIdx.x + rot) % gridDim.x));
    pg8::gemm_phase<Epi, pg8::StaticOrder>((PG8_LAS unsigned char*)lds, g, S, E);
    __syncthreads();
}
constexpr int T_STRIDE = 272, V_STRIDE = 528;
constexpr int VQN = 2, VW = 256 / VQN, NVT = VW / 16, NOT = NVT / 2, V2_STRIDE = VW * 2 + 16;
constexpr int M_T0 = 0, M_T1 = 17408, M_TV = 34816, M_TC = M_TV + 64 * V2_STRIDE, M_SM = M_TC + VW * T_STRIDE;
template <int BR>
__device__ __forceinline__ void mixer_prompt(const Params& p, unsigned char* lds, int b, int h, int vq) {
    const int tid = threadIdx.x, w = tid >> 6, lane = tid & 63, g = lane >> 4, l16 = lane & 15, q4 = l16 >> 2, p4 = lane & 3;
    const int tt = w & 3, vh = w >> 2;
    bf16_t* Z = (bf16_t*)(p.ws + WS_Z);
    const float* ZS = (const float*)(p.ws + WS_ZS);
    float* SSQ = (float*)(p.ws + WS_SSQ);
    const float* BEND = (const float*)(p.ws + WS_BEND);
    const int qcol = (BR == 0 ? 0 : 3072) + h * 128, kcol = (BR == 0 ? 512 : 3584) + h * 128;
    const int vcol = (BR == 0 ? 1024 : 4096) + h * 256 + vq * VW, ocol = (BR == 0 ? 2048 : 5120) + h * 256 + vq * VW;
    unsigned char* T0 = lds + M_T0; unsigned char* T1 = lds + M_T1; unsigned char* TV = lds + M_TV; unsigned char* TC = lds + M_TC;
    float* sm = (float*)(lds + M_SM);
    float* gS = sm; float* Mt = sm + 64; float* at = sm + 128; float* emt = sm + 192; float* wsv = sm + 256; float* nvec = sm + 320; float* bend = sm + 448;
    float* misc = sm + 576; float* ssq = sm + 592; float* gaL = sm + 720; float* segtot = sm + 1744; float* waL = sm + 2256;
    const unsigned aT0_ = (unsigned)(size_t)T0, aT1_ = (unsigned)(size_t)T1, aTV_ = (unsigned)(size_t)TV;
    const float* gain = (BR == 0 ? p.in[18] : p.in[19]) + h * 256 + vq * VW;
    const int tloc = 16 * tt + l16;
    f32x4 gn[NOT];
#pragma unroll
    for (int vi = 0; vi < NOT; ++vi) gn[vi] = *(const f32x4*)(gain + (VW / 2) * vh + 16 * vi + 4 * g);
    f32x4 st[NVT];
#pragma unroll
    for (int c = 0; c < NVT; ++c) st[c] = (f32x4){0.f, 0.f, 0.f, 0.f};
    float m0 = 0.f;
    const float bi = (BR == 0) ? p.in[15][h] : 0.f, bfb = (BR == 0) ? p.in[15][4 + h] : 0.f;
    if (tid < 128) nvec[tid] = 0.f;
    u32x4 kreg[2], qreg[2], vreg[2]; bf16x8 qn[4]; float igr = 0.f, lfr = 0.f, gar[2] = {0.f, 0.f};
    const int ks_s0 = tid >> 4, ks_ch = tid & 15;
#define MIX_LOAD_CHUNK(R0) do { const size_t r_ = (size_t)(R0); \
        kreg[0] = *(const u32x4*)(Z + (r_ + ks_s0) * ZLD + kcol + ks_ch * 8); kreg[1] = *(const u32x4*)(Z + (r_ + ks_s0 + 32) * ZLD + kcol + ks_ch * 8); \
        vreg[0] = *(const u32x4*)(Z + (r_ + ks_s0) * ZLD + vcol + ks_ch * 8); vreg[1] = *(const u32x4*)(Z + (r_ + ks_s0 + 32) * ZLD + vcol + ks_ch * 8); \
        if (BR == 0) { _Pragma("unroll") for (int ks = 0; ks < 4; ++ks) qn[ks] = *(const bf16x8*)(Z + (r_ + tloc) * ZLD + qcol + 32 * ks + 8 * g); \
            if (w == 0) { igr = ZS[(r_ + lane) * ZSLD + h]; lfr = ZS[(r_ + lane) * ZSLD + 4 + h]; } } \
        else { qreg[0] = *(const u32x4*)(Z + (r_ + ks_s0) * ZLD + qcol + ks_ch * 8); qreg[1] = *(const u32x4*)(Z + (r_ + ks_s0 + 32) * ZLD + qcol + ks_ch * 8); \
            if (tid < 128) gar[0] = BEND[(r_ >> 6) * 512 + h * 128 + tid]; } } while (0)
    MIX_LOAD_CHUNK(b * 2048);
    __syncthreads();
    for (int c = 0; c < 32; ++c) {
        const int r0 = b * 2048 + c * 64;
        if (c > 0 && tid < 64) { float* sp_ = SSQ + ((size_t)(r0 - 64 + tid) * 8 + BR * 4 + h) * 4 + vq * 2; sp_[0] = ssq[tid] + ssq[64 + tid]; sp_[1] = 0.f; }
        unsigned aT0 = aT0_, aT1 = aT1_, aTV = aTV_;
        asm volatile("" : "+v"(aT0), "+v"(aT1), "+v"(aTV));
        if (BR == 0) {
            if (w == 0) {
                const float ig = igr + bi, lf = logsigf_(lfr + bfb);
                float F = lf;
#pragma unroll
                for (int o = 1; o < 64; o <<= 1) { const float y = __shfl_up(F, o); if (lane >= o) F += y; }
                const float gg = ig - F; float cm = gg;
#pragma unroll
                for (int o = 1; o < 64; o <<= 1) { const float y = __shfl_up(cm, o); if (lane >= o) cm = fmaxf(cm, y); }
                const float M = fmaxf(m0, cm), a = __expf(m0 - M);
                const float ML = __shfl(M, 63), aend = __shfl(a, 63), FL = __shfl(F, 63);
                gS[lane] = gg; Mt[lane] = M; at[lane] = a; emt[lane] = __expf(-(F + M)); wsv[lane] = __expf(gg - ML);
                if (lane == 0) misc[1] = aend;
                m0 = FL + ML;
            }
            __syncthreads();
#pragma unroll
            for (int i = 0; i < 2; ++i) { const int s = ks_s0 + 32 * i; const u32x4 kw = kreg[i];
                *(u32x4*)(T0 + s * T_STRIDE + ks_ch * 16) = kw;
                const float ww = wsv[s]; u32x4 o;
                o.x = cvt_pk(bflo(kw.x) * ww, bfhi(kw.x) * ww); o.y = cvt_pk(bflo(kw.y) * ww, bfhi(kw.y) * ww);
                o.z = cvt_pk(bflo(kw.z) * ww, bfhi(kw.z) * ww); o.w = cvt_pk(bflo(kw.w) * ww, bfhi(kw.w) * ww);
                *(u32x4*)(T1 + s * T_STRIDE + ks_ch * 16) = o; }
        } else {
            if (tid < 128) bend[tid] = gar[0];
#pragma unroll
            for (int i = 0; i < 2; ++i) { const int s = ks_s0 + 32 * i;
                *(u32x4*)(T0 + s * T_STRIDE + ks_ch * 16) = kreg[i]; *(u32x4*)(T1 + s * T_STRIDE + ks_ch * 16) = qreg[i]; }
        }
#pragma unroll
        for (int i = 0; i < 2; ++i) *(u32x4*)(TV + (ks_s0 + 32 * i) * V2_STRIDE + ks_ch * 16) = vreg[i];
#pragma unroll
        for (int c16 = 0; c16 < NVT; ++c16) *(u32x2*)(TC + (16 * c16 + l16) * T_STRIDE + (16 * w + 4 * g) * 2) = pack4(st[c16]);
        __syncthreads();
        bf16x8 qf[4];
#pragma unroll
        for (int ks = 0; ks < 4; ++ks) {
            if (BR == 0) qf[ks] = qn[ks];
            else qf[ks] = *(const bf16x8*)(T1 + tloc * T_STRIDE + (32 * ks + 8 * g) * 2);
        }
        bf16_t* op = Z + (size_t)(r0 + tloc) * ZLD + ocol + (VW / 2) * vh + 4 * g;
        u32x2 gwv[NOT];
#pragma unroll
        for (int vi = 0; vi < NOT; ++vi) gwv[vi] = *(const u32x2*)(op + 16 * vi);
        if (c < 31) MIX_LOAD_CHUNK(r0 + 64);
        f32x4 sacc[4];
#pragma unroll
        for (int si = 0; si < 4; ++si) { sacc[si] = (f32x4){0.f, 0.f, 0.f, 0.f};
#pragma unroll
            for (int ks = 0; ks < 4; ++ks) sacc[si] = mfma16(*(const bf16x8*)(T0 + (16 * si + l16) * T_STRIDE + (32 * ks + 8 * g) * 2), qf[ks], sacc[si]); }
        float den = 0.f;
        {
            const float Mtt = (BR == 0) ? Mt[tloc] : 0.f;
            f32x4 gS4[4];
#pragma unroll
            for (int si = 0; si < 4; ++si) gS4[si] = (BR == 0) ? *(const f32x4*)(gS + 16 * si + 4 * g) : (f32x4){0.f, 0.f, 0.f, 0.f};
#pragma unroll
            for (int si = 0; si < 4; ++si)
#pragma unroll
                for (int r = 0; r < 4; ++r) { const int s = 16 * si + 4 * g + r;
                    float wgt;
                    if (BR == 0) { const float e = __expf(fminf(gS4[si][r] - Mtt, 0.f)); wgt = (s <= tloc) ? e : 0.f; } else wgt = (s <= tloc) ? 1.f : 0.f;
                    sacc[si][r] *= wgt; den += sacc[si][r]; }
        }
        f32x4 oacc[NOT];
#pragma unroll
        for (int vi = 0; vi < NOT; ++vi) { oacc[vi] = (f32x4){0.f, 0.f, 0.f, 0.f};
#pragma unroll
            for (int ks = 0; ks < 4; ++ks) oacc[vi] = mfma16(*(const bf16x8*)(TC + ((VW / 2) * vh + 16 * vi + l16) * T_STRIDE + (32 * ks + 8 * g) * 2), qf[ks], oacc[vi]); }
        if (BR == 0) {
            den = xsum16_32(den);
            const float a_t = at[tloc];
            float nq = 0.f;
#pragma unroll
            for (int ks = 0; ks < 4; ++ks)
#pragma unroll
                for (int j = 0; j < 8; ++j) nq += nvec[32 * ks + 8 * g + j] * bf2f((bf16_t)qf[ks][j]);
            nq = xsum16_32(nq);
            den += a_t * nq;
#pragma unroll
            for (int vi = 0; vi < NOT; ++vi) oacc[vi] *= a_t;
        }
#pragma unroll
        for (int ks = 0; ks < 2; ++ks) {
            const bf16x8 pb = pack8(sacc[2 * ks], sacc[2 * ks + 1]);
#pragma unroll
            for (int vi = 0; vi < NOT; vi += 4) {
                const unsigned a0 = aTV + (32 * ks + 4 * g + q4) * V2_STRIDE + ((VW / 2) * vh + 16 * vi) * 2 + 8 * p4, a1 = a0 + 16 * V2_STRIDE;
                bf16x8 fa, fb, fc, fd; tr_frag4(a0, a1, a0 + 32, a1 + 32, a0 + 64, a1 + 64, a0 + 96, a1 + 96, fa, fb, fc, fd);
                oacc[vi] = mfma16(fa, pb, oacc[vi]); oacc[vi + 1] = mfma16(fb, pb, oacc[vi + 1]); oacc[vi + 2] = mfma16(fc, pb, oacc[vi + 2]); oacc[vi + 3] = mfma16(fd, pb, oacc[vi + 3]); }
        }
        if (BR == 0) { const float inv = 1.f / fmaxf(fabsf(den), emt[tloc]);
#pragma unroll
            for (int vi = 0; vi < NOT; ++vi) oacc[vi] *= inv; }
        float sq = 0.f;
#pragma unroll
        for (int vi = 0; vi < NOT; ++vi)
#pragma unroll
            for (int r = 0; r < 4; ++r) sq += oacc[vi][r] * oacc[vi][r];
        sq = xsum16_32(sq);
        if (g == 0) ssq[vh * 64 + tloc] = sq;
#pragma unroll
        for (int vi = 0; vi < NOT; ++vi) {
            const float gt[4] = {bflo(gwv[vi].x), bfhi(gwv[vi].x), bflo(gwv[vi].y), bfhi(gwv[vi].y)}; f32x4 o;
#pragma unroll
            for (int r = 0; r < 4; ++r) { const float sg = sigmoidf_(gt[r]); o[r] = oacc[vi][r] * gn[vi][r] * (BR == 0 ? sg : gt[r] * sg); }
            *(u32x2*)(op + 16 * vi) = pack4(o); }
        if (BR == 0) { const float aend = misc[1];
#pragma unroll
            for (int c16 = 0; c16 < NVT; ++c16) st[c16] *= aend; }
#pragma unroll
        for (int ks = 0; ks < 2; ++ks) {
            const unsigned ka0 = (BR == 0 ? aT1 : aT0) + (32 * ks + 8 * g + q4) * T_STRIDE + (16 * w) * 2 + 8 * p4;
            const bf16x8 kf = tr_frag(ka0, ka0 + 4 * T_STRIDE);
#pragma unroll
            for (int c16 = 0; c16 < NVT; c16 += 4) {
                const unsigned v0 = aTV + (32 * ks + 8 * g + q4) * V2_STRIDE + (16 * c16) * 2 + 8 * p4, v1 = v0 + 4 * V2_STRIDE;
                bf16x8 fa, fb, fc, fd; tr_frag4(v0, v1, v0 + 32, v1 + 32, v0 + 64, v1 + 64, v0 + 96, v1 + 96, fa, fb, fc, fd);
                st[c16] = mfma16(kf, fa, st[c16]); st[c16 + 1] = mfma16(kf, fb, st[c16 + 1]); st[c16 + 2] = mfma16(kf, fc, st[c16 + 2]); st[c16 + 3] = mfma16(kf, fd, st[c16 + 3]);
            }
        }
        if (BR == 1) {
            float eb[4];
#pragma unroll
            for (int r = 0; r < 4; ++r) eb[r] = __expf(bend[16 * w + 4 * g + r]);
#pragma unroll
            for (int c16 = 0; c16 < NVT; ++c16)
#pragma unroll
                for (int r = 0; r < 4; ++r) st[c16][r] *= eb[r];
        } else {
            const int d = tid & 127, seg = tid >> 7; float a2 = 0.f;
#pragma unroll
            for (int s = 0; s < 16; ++s) a2 += bf2f(*(const bf16_t*)(T1 + (seg * 16 + s) * T_STRIDE + d * 2));
            segtot[seg * 128 + d] = a2;
        }
        __syncthreads();
        if (BR == 0 && tid < 128) nvec[tid] = misc[1] * nvec[tid] + ((segtot[tid] + segtot[128 + tid]) + (segtot[256 + tid] + segtot[384 + tid]));
    }
#undef MIX_LOAD_CHUNK
    if (tid < 64) { float* sp_ = SSQ + ((size_t)(b * 2048 + 31 * 64 + tid) * 8 + BR * 4 + h) * 4 + vq * 2; sp_[0] = ssq[tid] + ssq[64 + tid]; sp_[1] = 0.f; }
    const int bh = b * 4 + h;
    if (BR == 0) {
        float* Co = p.out + O_CP + (size_t)bh * 32768;
#pragma unroll
        for (int c16 = 0; c16 < NVT; ++c16) __builtin_nontemporal_store(st[c16], (f32x4*)(Co + (size_t)(VW * vq + 16 * c16 + l16) * 128 + 16 * w + 4 * g));
        if (vq == 0) { if (tid < 128) p.out[O_NP + bh * 128 + tid] = nvec[tid];
            if (tid == 0) p.out[O_MPP + bh] = m0; }
    } else {
        float* So = p.out + O_SP + (size_t)bh * 32768;
#pragma unroll
        for (int c16 = 0; c16 < NVT; ++c16)
#pragma unroll
            for (int r = 0; r < 4; ++r) So[(size_t)(16 * w + 4 * g + r) * 256 + VW * vq + 16 * c16 + l16] = st[c16][r];
    }
    __syncthreads();
}

__device__ __forceinline__ void gla_prep(const Params& p, unsigned char* lds, int item) {
    const int tid = threadIdx.x, d = tid & 127, seg = tid >> 7;
    const int h = item & 3, c = (item >> 2) & 31, b = item >> 7;
    bf16_t* Z = (bf16_t*)(p.ws + WS_Z);
    const float* ZS = (const float*)(p.ws + WS_ZS);
    float* BEND = (float*)(p.ws + WS_BEND);
    float* gaL = (float*)lds; float* waL = gaL + 1024; float* segtot = waL + 2048;
    const int r0 = b * 2048 + c * 64, qcol = 3072 + h * 128, kcol = 3584 + h * 128;
    gaL[tid] = ZS[(size_t)(r0 + (tid >> 4)) * ZSLD + 8 + (tid & 15)]; gaL[tid + 512] = ZS[(size_t)(r0 + 32 + (tid >> 4)) * ZSLD + 8 + (tid & 15)];
#pragma unroll
    for (int j = 0; j < 4; ++j) { const int id = tid + 512 * j; waL[id] = p.in[16][(id >> 7) * 512 + h * 128 + (id & 127)]; }
    const float ba = p.in[17][h * 128 + d];
    __syncthreads();
    float wa[16];
#pragma unroll
    for (int j = 0; j < 16; ++j) wa[j] = waL[j * 128 + d];
    float la[16]; float run = 0.f;
#pragma unroll
    for (int i = 0; i < 16; ++i) { const int t = seg * 16 + i; float x = ba;
#pragma unroll
        for (int j = 0; j < 16; ++j) x += gaL[t * 16 + j] * wa[j];
        run += logsigf_(x) * 0.0625f; la[i] = run; }
    segtot[seg * 128 + d] = run;
    __syncthreads();
    float pre = 0.f, tot = 0.f;
#pragma unroll
    for (int s2 = 0; s2 < 4; ++s2) { const float v = segtot[s2 * 128 + d]; tot += v; if (s2 < seg) pre += v; }
    if (seg == 0) BEND[(size_t)(b * 32 + c) * 512 + h * 128 + d] = tot;
    bf16_t qv[16], kv[16];
#pragma unroll
    for (int i = 0; i < 16; ++i) { const int t = seg * 16 + i; qv[i] = Z[(size_t)(r0 + t) * ZLD + qcol + d]; kv[i] = Z[(size_t)(r0 + t) * ZLD + kcol + d]; }
#pragma unroll
    for (int i = 0; i < 16; ++i) { const int t = seg * 16 + i; const float bb = la[i] + pre;
        Z[(size_t)(r0 + t) * ZLD + qcol + d] = f2bf(bf2f(qv[i]) * __expf(bb)); Z[(size_t)(r0 + t) * ZLD + kcol + d] = f2bf(bf2f(kv[i]) * __expf(-bb)); }
    __syncthreads();
}

template <int BR>
__device__ __forceinline__ void mixer_sample(const Params& p, unsigned char* lds, int b, int h) {
    const int tid = threadIdx.x, w = tid >> 6, lane = tid & 63;
    bf16_t* Z = (bf16_t*)(p.ws + WS_Z);
    const float* ZS = (const float*)(p.ws + WS_ZS);
    const int qcol = (BR == 0 ? 0 : 3072) + h * 128, kcol = (BR == 0 ? 512 : 3584) + h * 128, vcol = (BR == 0 ? 1024 : 4096) + h * 256, ocol = (BR == 0 ? 2048 : 5120) + h * 256;
    float* sm = (float*)lds;
    float* qa = sm; float* ka = sm + 512; float* kd = sm + 1024; float* dec = sm + 1536; float* vv = sm + 1664; float* qk = sm + 2688; float* sc = sm + 2704;
    float* part = sm + 2752; float* red = sm + 4800;
    const int r0 = MP + 4 * b, bh = b * 4 + h;
    const float* gain = (BR == 0 ? p.in[18] : p.in[19]) + h * 256;
    float a_t[4] = {1.f, 1.f, 1.f, 1.f}, mt[4] = {0.f, 0.f, 0.f, 0.f}, aend = 1.f;
    {
        const int t = tid >> 7, d = tid & 127;
        const float qraw = bf2f(Z[(size_t)(r0 + t) * ZLD + qcol + d]), kraw = bf2f(Z[(size_t)(r0 + t) * ZLD + kcol + d]);
#pragma unroll
        for (int i = 0; i < 2; ++i) { const int id = tid + 512 * i; vv[id] = bf2f(Z[(size_t)(r0 + (id >> 8)) * ZLD + vcol + (id & 255)]); }
        if (BR == 0) {
            const float m0 = p.in[5][bh], bi = p.in[15][h], bfb = p.in[15][4 + h];
            float F = 0.f, cm = -3.0e38f, gg[4], Mv[4];
#pragma unroll
            for (int s = 0; s < 4; ++s) { const float ig = ZS[(size_t)(r0 + s) * ZSLD + h] + bi, lf = logsigf_(ZS[(size_t)(r0 + s) * ZSLD + 4 + h] + bfb);
                F += lf; gg[s] = ig - F; cm = fmaxf(cm, gg[s]); Mv[s] = fmaxf(m0, cm); a_t[s] = __expf(m0 - Mv[s]); mt[s] = F + Mv[s]; }
            aend = a_t[3];
            float wsel = 0.f;
#pragma unroll
            for (int s = 0; s < 4; ++s) { const float ws_ = __expf(gg[s] - Mv[3]); if (s == t) wsel = ws_; }
            qa[tid] = qraw; ka[tid] = kraw; kd[tid] = wsel * kraw;
            if (tid < 128) dec[tid] = aend;
            if (tid == 0) {
#pragma unroll
                for (int s = 0; s < 4; ++s) { sc[16 + s] = gg[s]; sc[20 + s] = Mv[s]; } }
        } else {
            float la[4];
#pragma unroll
            for (int s = 0; s < 4; ++s) { float x = p.in[17][h * 128 + d];
#pragma unroll
                for (int j = 0; j < 16; ++j) x += ZS[(size_t)(r0 + s) * ZSLD + 8 + j] * p.in[16][j * 512 + h * 128 + d];
                la[s] = logsigf_(x) * 0.0625f; }
            float bt = 0.f, bendv = 0.f;
#pragma unroll
            for (int s = 0; s < 4; ++s) { bendv += la[s]; if (s <= t) bt += la[s]; }
            qa[tid] = qraw * __expf(bt); ka[tid] = kraw * __expf(-bt); kd[tid] = kraw * __expf(bendv - bt);
            if (t == 0) dec[d] = __expf(bendv);
        }
    }
    __syncthreads();
    {
        const int pr = tid >> 5, l = tid & 31, t = pr >> 2, s = pr & 3;
        const f32x4 a = *(const f32x4*)(qa + t * 128 + l * 4), k4 = *(const f32x4*)(ka + s * 128 + l * 4);
        float v = a[0] * k4[0] + a[1] * k4[1] + a[2] * k4[2] + a[3] * k4[3];
#pragma unroll
        for (int o = 16; o > 0; o >>= 1) v += __shfl_xor(v, o);
        if (l == 0) { float wgt; if (BR == 0) wgt = (s <= t) ? __expf(sc[16 + s] - sc[20 + t]) : 0.f; else wgt = (s <= t) ? 1.f : 0.f; qk[pr] = v * wgt; }
        if (BR == 0 && tid < 128) {
            const int t2 = tid >> 5;
            const f32x4 n4 = *(const f32x4*)(p.in[4] + (size_t)bh * 128 + l * 4), q4v = *(const f32x4*)(qa + t2 * 128 + l * 4);
            float v2 = n4[0] * q4v[0] + n4[1] * q4v[1] + n4[2] * q4v[2] + n4[3] * q4v[3];
#pragma unroll
            for (int o = 16; o > 0; o >>= 1) v2 += __shfl_xor(v2, o);
            if (l == 0) sc[12 + t2] = v2;
        }
    }
    __syncthreads();
    float hv[4]; int vown; bool owner;
    if (BR == 0) {
        const int l32 = lane & 31, half = lane >> 5;
        const float* C0 = p.in[3] + (size_t)bh * 32768 + 4 * l32;
        float* C1 = p.out + O_CS + (size_t)bh * 32768 + 4 * l32;
        f32x4 qa4[4], kd4[4]; const f32x4 dec4 = *(const f32x4*)(dec + 4 * l32);
#pragma unroll
        for (int t = 0; t < 4; ++t) { qa4[t] = *(const f32x4*)(qa + t * 128 + 4 * l32); kd4[t] = *(const f32x4*)(kd + t * 128 + 4 * l32); }
#pragma unroll
        for (int ib = 0; ib < 16; ib += 8) {
            f32x4 cv[8];
#pragma unroll
            for (int e = 0; e < 8; ++e) cv[e] = __builtin_nontemporal_load((const f32x4*)(C0 + (size_t)(w * 32 + 2 * (ib + e) + half) * 128));
#pragma unroll
            for (int e = 0; e < 8; ++e) { const int v = w * 32 + 2 * (ib + e) + half; const f32x4 c = cv[e];
                float wv[4], pt[4];
#pragma unroll
                for (int s = 0; s < 4; ++s) wv[s] = vv[s * 256 + v];
                f32x4 o = dec4 * c;
#pragma unroll
                for (int s = 0; s < 4; ++s) o += kd4[s] * wv[s];
                __builtin_nontemporal_store(o, (f32x4*)(C1 + (size_t)v * 128));
#pragma unroll
                for (int t = 0; t < 4; ++t) { float x = c[0] * qa4[t][0] + c[1] * qa4[t][1] + c[2] * qa4[t][2] + c[3] * qa4[t][3];
#pragma unroll
                    for (int of = 16; of > 0; of >>= 1) x += __shfl_xor(x, of);
                    pt[t] = x; }
                if (l32 == 0) {
#pragma unroll
                    for (int t = 0; t < 4; ++t) part[t * 256 + v] = pt[t]; }
            }
        }
        if (tid < 128) { float acc = aend * p.in[4][(size_t)bh * 128 + tid];
#pragma unroll
            for (int s = 0; s < 4; ++s) acc += kd[s * 128 + tid];
            p.out[O_NS + (size_t)bh * 128 + tid] = acc; }
        if (tid == 0) p.out[O_MSS + bh] = mt[3];
        __syncthreads();
        vown = tid & 255; owner = (tid < 256);
        {
            float wv2[4];
#pragma unroll
            for (int s = 0; s < 4; ++s) wv2[s] = vv[s * 256 + vown];
#pragma unroll
            for (int t = 0; t < 4; ++t) { float num = a_t[t] * part[t * 256 + vown], den = a_t[t] * sc[12 + t];
#pragma unroll
                for (int s = 0; s < 4; ++s) { num += qk[t * 4 + s] * wv2[s]; den += qk[t * 4 + s]; }
                hv[t] = num / fmaxf(fabsf(den), __expf(-mt[t])); }
        }
    } else {
        const int v4 = lane * 4;
        const float* S0 = p.in[6] + ((size_t)bh * 128 + 16 * w) * 256 + v4;
        float* S1 = p.out + O_SS + ((size_t)bh * 128 + 16 * w) * 256 + v4;
        float* part8 = sm + 4864;
        f32x4 wv4[4], pt4[4];
#pragma unroll
        for (int s = 0; s < 4; ++s) { wv4[s] = *(const f32x4*)(vv + s * 256 + v4); pt4[s] = (f32x4){0.f, 0.f, 0.f, 0.f}; }
#pragma unroll
        for (int jb = 0; jb < 16; jb += 8) {
            f32x4 s0v[8];
#pragma unroll
            for (int e = 0; e < 8; ++e) s0v[e] = __builtin_nontemporal_load((const f32x4*)(S0 + (size_t)(jb + e) * 256));
#pragma unroll
            for (int e = 0; e < 8; ++e) { const int j = jb + e, d = 16 * w + j; const f32x4 s0 = s0v[e];
                f32x4 acc = s0 * dec[d];
#pragma unroll
                for (int t = 0; t < 4; ++t) pt4[t] += s0 * qa[t * 128 + d];
#pragma unroll
                for (int s2 = 0; s2 < 4; ++s2) acc += wv4[s2] * kd[s2 * 128 + d];
                __builtin_nontemporal_store(acc, (f32x4*)(S1 + (size_t)j * 256)); } }
#pragma unroll
        for (int t = 0; t < 4; ++t) *(f32x4*)(part8 + (w * 4 + t) * 256 + v4) = pt4[t];
        __syncthreads();
        vown = tid & 255; owner = (tid < 256);
#pragma unroll
        for (int t = 0; t < 4; ++t) { float num = 0.f;
#pragma unroll
            for (int w2 = 0; w2 < 8; ++w2) num += part8[(w2 * 4 + t) * 256 + vown];
#pragma unroll
            for (int s2 = 0; s2 < 4; ++s2) num += qk[t * 4 + s2] * vv[s2 * 256 + vown];
            hv[t] = num; }
    }
#pragma unroll
    for (int t = 0; t < 4; ++t) { float q2 = owner ? hv[t] * hv[t] : 0.f; q2 = wave_sum(q2); if (lane == 0) red[w * 4 + t] = q2; }
    __syncthreads();
    if (owner) {
#pragma unroll
        for (int t = 0; t < 4; ++t) { float tot = 0.f;
#pragma unroll
            for (int w2 = 0; w2 < 8; ++w2) tot += red[w2 * 4 + t];
            const float rs = rsqrtf(tot * (1.f / 256.f) + EPSV);
            bf16_t* op = Z + (size_t)(r0 + t) * ZLD + ocol + vown;
            const float gt = bf2f(*op), sg = sigmoidf_(gt);
            *op = f2bf(hv[t] * rs * gain[vown] * (BR == 0 ? sg : gt * sg)); }
    }
    __syncthreads();
}

__device__ __forceinline__ void attn_prompt(const Params& p, unsigned char* lds, int item) {
    const int tid = threadIdx.x, w = tid >> 6, lane = tid & 63, g = lane >> 4, l16 = lane & 15, q4 = l16 >> 2, p4 = lane & 3;
    const int qt = item & 7, h = (item >> 3) & 3, b = item >> 5;
    const bf16_t* KV = (const bf16_t*)(p.ws + WS_MEMKV) + (size_t)b * 256 * 2048 + h * 256;
    const bf16_t* Q = (const bf16_t*)(p.ws + WS_QBUF);
    bf16_t* O = (bf16_t*)(p.ws + WS_OBUF);
    const size_t rq0 = (size_t)b * 2048 + qt * 256 + 16 * w + l16;
    const unsigned aL = (unsigned)(size_t)lds;
#pragma unroll 8
    for (int i = 0; i < 16; ++i) { const int id = tid + 512 * i, key = id >> 5, ch = id & 31;
        *(u32x4*)(lds + key * V_STRIDE + ch * 16) = *(const u32x4*)(KV + (size_t)key * 2048 + ch * 8); }
    __syncthreads();
    bf16x8 pf[2][8]; float inv[2];
#pragma unroll
    for (int u = 0; u < 2; ++u) {
        const size_t rq = rq0 + 128 * u;
        f32x4 s[16];
#pragma unroll
        for (int ki = 0; ki < 16; ++ki) s[ki] = (f32x4){0.f, 0.f, 0.f, 0.f};
#pragma unroll
        for (int ks = 0; ks < 8; ++ks) { const bf16x8 qfk = *(const bf16x8*)(Q + rq * DM + h * 256 + 32 * ks + 8 * g);
#pragma unroll
            for (int ki = 0; ki < 16; ++ki) s[ki] = mfma16(*(const bf16x8*)(lds + (16 * ki + l16) * V_STRIDE + (32 * ks + 8 * g) * 2), qfk, s[ki]); }
        float mx = -3.0e38f;
#pragma unroll
        for (int ki = 0; ki < 16; ++ki)
#pragma unroll
            for (int r = 0; r < 4; ++r) mx = fmaxf(mx, s[ki][r]);
        mx = xmax16_32(mx);
        float sum = 0.f;
#pragma unroll
        for (int ki = 0; ki < 16; ++ki)
#pragma unroll
            for (int r = 0; r < 4; ++r) { const float e = __expf(s[ki][r] - mx); s[ki][r] = e; sum += e; }
        sum = xsum16_32(sum); inv[u] = 1.f / sum;
#pragma unroll
        for (int ks = 0; ks < 8; ++ks) pf[u][ks] = pack8(s[2 * ks], s[2 * ks + 1]);
        __builtin_amdgcn_sched_barrier(0);
    }
    __syncthreads();
#pragma unroll 8
    for (int i = 0; i < 16; ++i) { const int id = tid + 512 * i, key = id >> 5, ch = id & 31;
        *(u32x4*)(lds + key * V_STRIDE + ch * 16) = *(const u32x4*)(KV + (size_t)key * 2048 + 1024 + ch * 8); }
    __syncthreads();
#pragma unroll
    for (int hh = 0; hh < 2; ++hh) {
        f32x4 o0[8], o1[8];
#pragma unroll
        for (int hi = 0; hi < 8; ++hi) { o0[hi] = (f32x4){0.f, 0.f, 0.f, 0.f}; o1[hi] = o0[hi]; }
#pragma unroll
        for (int ks = 0; ks < 8; ++ks) {
            unsigned aLk = aL + (32 * ks + 4 * g + q4) * V_STRIDE + 8 * p4 + hh * 256;
            asm volatile("" : "+v"(aLk));
#pragma unroll
            for (int hi = 0; hi < 8; hi += 4) {
                const unsigned a0 = aLk + (16 * hi) * 2, a1 = a0 + 16 * V_STRIDE;
                bf16x8 fa, fb, fc, fd; tr_frag4(a0, a1, a0 + 32, a1 + 32, a0 + 64, a1 + 64, a0 + 96, a1 + 96, fa, fb, fc, fd);
                o0[hi] = mfma16(fa, pf[0][ks], o0[hi]); o0[hi + 1] = mfma16(fb, pf[0][ks], o0[hi + 1]); o0[hi + 2] = mfma16(fc, pf[0][ks], o0[hi + 2]); o0[hi + 3] = mfma16(fd, pf[0][ks], o0[hi + 3]);
                o1[hi] = mfma16(fa, pf[1][ks], o1[hi]); o1[hi + 1] = mfma16(fb, pf[1][ks], o1[hi + 1]); o1[hi + 2] = mfma16(fc, pf[1][ks], o1[hi + 2]); o1[hi + 3] = mfma16(fd, pf[1][ks], o1[hi + 3]);
            }
        }
#pragma unroll
        for (int hi = 0; hi < 8; ++hi) { *(u32x2*)(O + rq0 * DM + h * 256 + hh * 128 + 16 * hi + 4 * g) = pack4(o0[hi] * inv[0]);
            *(u32x2*)(O + (rq0 + 128) * DM + h * 256 + hh * 128 + 16 * hi + 4 * g) = pack4(o1[hi] * inv[1]); }
    }
    __syncthreads();
}
__device__ __forceinline__ void attn_sample(const Params& p, unsigned char* lds, int item) {
    const int tid = threadIdx.x, w = tid >> 6, lane = tid & 63;
    const int h = item & 3, b = item >> 2;
    const float* Kc = p.in[7] + ((size_t)b * 1024 + h) * 256;
    const float* Vc = p.in[8] + ((size_t)b * 1024 + h) * 256;
    const bf16_t* Q = (const bf16_t*)(p.ws + WS_QBUF);
    bf16_t* O = (bf16_t*)(p.ws + WS_OBUF);
    float* sc = (float*)lds; float* po = sc + 1024;
    const size_t r0 = MP + 4 * b;
    f32x4 q[4];
#pragma unroll
    for (int t = 0; t < 4; ++t) { const u32x2 qw = *(const u32x2*)(Q + (r0 + t) * DM + h * 256 + lane * 4); q[t] = (f32x4){bflo(qw.x), bfhi(qw.x), bflo(qw.y), bfhi(qw.y)}; }
    {
        const bool b5 = (lane & 32) != 0, b4 = (lane & 16) != 0, b3 = (lane & 8) != 0, b2 = (lane & 4) != 0;
#pragma unroll 2
        for (int kg = 0; kg < 8; ++kg) { const int key0 = w * 32 + kg * 4;
            f32x4 kv[4];
#pragma unroll
            for (int k = 0; k < 4; ++k) kv[k] = __builtin_nontemporal_load((const f32x4*)(Kc + (size_t)(key0 + k) * 1024 + lane * 4));
            float v[16];
#pragma unroll
            for (int k = 0; k < 4; ++k)
#pragma unroll
                for (int t = 0; t < 4; ++t) v[k * 4 + t] = kv[k][0] * q[t][0] + kv[k][1] * q[t][1] + kv[k][2] * q[t][2] + kv[k][3] * q[t][3];
            float a8[8], a4[4], a2[2];
#pragma unroll
            for (int i = 0; i < 8; ++i) { const float keep = b5 ? v[i + 8] : v[i], send = b5 ? v[i] : v[i + 8]; a8[i] = keep + __shfl_xor(send, 32); }
#pragma unroll
            for (int i = 0; i < 4; ++i) { const float keep = b4 ? a8[i + 4] : a8[i], send = b4 ? a8[i] : a8[i + 4]; a4[i] = keep + __shfl_xor(send, 16); }
#pragma unroll
            for (int i = 0; i < 2; ++i) { const float keep = b3 ? a4[i + 2] : a4[i], send = b3 ? a4[i] : a4[i + 2]; a2[i] = keep + __shfl_xor(send, 8); }
            float d = (b2 ? a2[1] : a2[0]) + __shfl_xor(b2 ? a2[0] : a2[1], 4);
            d += __shfl_xor(d, 2); d += __shfl_xor(d, 1);
            if ((lane & 3) == 0) { const int j = (lane >> 2) & 15; sc[(j & 3) * 256 + key0 + (j >> 2)] = d; }
        }
    }
    __syncthreads();
    if (w < 4) { float v[4], mx = -3.0e38f;
#pragma unroll
        for (int i = 0; i < 4; ++i) { v[i] = sc[w * 256 + lane + 64 * i]; mx = fmaxf(mx, v[i]); }
        mx = wave_max(mx); float sum = 0.f;
#pragma unroll
        for (int i = 0; i < 4; ++i) { v[i] = __expf(v[i] - mx); sum += v[i]; }
        sum = wave_sum(sum); const float inv = 1.f / sum;
#pragma unroll
        for (int i = 0; i < 4; ++i) sc[w * 256 + lane + 64 * i] = v[i] * inv; }
    __syncthreads();
    {
        const int hd4 = lane * 4; float* po8 = sc + 1024;
        f32x4 acc4[4];
#pragma unroll
        for (int t = 0; t < 4; ++t) acc4[t] = (f32x4){0.f, 0.f, 0.f, 0.f};
#pragma unroll 2
        for (int kg = 0; kg < 8; ++kg) { const int key0 = w * 32 + kg * 4;
            f32x4 v4[4], p4[4];
#pragma unroll
            for (int k = 0; k < 4; ++k) v4[k] = __builtin_nontemporal_load((const f32x4*)(Vc + (size_t)(key0 + k) * 1024 + hd4));
#pragma unroll
            for (int t = 0; t < 4; ++t) p4[t] = *(const f32x4*)(sc + t * 256 + key0);
#pragma unroll
            for (int k = 0; k < 4; ++k)
#pragma unroll
                for (int t = 0; t < 4; ++t) acc4[t] += v4[k] * p4[t][k]; }
#pragma unroll
        for (int t = 0; t < 4; ++t) *(f32x4*)(po8 + (w * 4 + t) * 256 + hd4) = acc4[t];
        __syncthreads();
        if (tid < 256) {
#pragma unroll
            for (int t = 0; t < 4; ++t) { float o = 0.f;
#pragma unroll
                for (int w2 = 0; w2 < 8; ++w2) o += po8[(w2 * 4 + t) * 256 + tid];
                O[(r0 + t) * DM + h * 256 + tid] = f2bf(o); } }
    }
    __syncthreads();
}

#ifndef ONLY_PH
#define ONLY_PH -1
#endif
#ifndef MIXEN
#define MIXEN 15
#endif
#ifndef PH_MASK
#define PH_MASK 0xffff
#endif
#define PH_ENABLED(x) ((ONLY_PH < 0 || ONLY_PH == (x)) && ((PH_MASK >> (x)) & 1) && ((KMASK >> (x)) & 1))
__device__ __forceinline__ void grid_barrier(unsigned char* wsb, unsigned char* lds) {
    XcdBarrier b; b.bar = (unsigned*)(wsb + WS_BAR); b.x = xb_xcc_id(); b.st = (volatile LAS unsigned*)(lds + LDS_BYTES - 16);
    xcd_barrier(b);
}
template <int KMASK> __global__ void __launch_bounds__(512, 2) fwd_kernel(Params p) {
    extern __shared__ __attribute__((aligned(16))) unsigned char lds[];
    cg::grid_group grid = cg::this_grid();
    volatile LAS unsigned* xb_st = (volatile LAS unsigned*)(lds + LDS_BYTES - 16);
    if (threadIdx.x == 0) { xb_st[0] = 0u; xb_st[1] = 0u; }
    __syncthreads();
    (void)xcd_barrier_post((unsigned*)(p.ws + WS_BAR), xb_st);
#ifndef DUP_MASK
#define DUP_MASK 0
#endif
#define PH_BEGIN(k) if (PH_ENABLED(k) && p.ph_lo <= (k) && (k) < p.ph_hi) for (int rep_ = 0; rep_ < (((DUP_MASK >> (k)) & 1) ? 2 : 1); ++rep_) { if ((k) > p.ph_lo || rep_) { if (p.ph_hi > 1000) grid.sync(); else grid_barrier(p.ws, lds); } \
        unsigned char* ws; float* outp; { unsigned long long w_ = (unsigned long long)p.ws, o_ = (unsigned long long)p.out; \
        unsigned a0_ = __builtin_amdgcn_readfirstlane((unsigned)w_), a1_ = __builtin_amdgcn_readfirstlane((unsigned)(w_ >> 32)), a2_ = __builtin_amdgcn_readfirstlane((unsigned)o_), a3_ = __builtin_amdgcn_readfirstlane((unsigned)(o_ >> 32)); \
        asm volatile("" : "+s"(a0_), "+s"(a1_), "+s"(a2_), "+s"(a3_)); ws = (unsigned char*)(((unsigned long long)a1_ << 32) | a0_); outp = (float*)(((unsigned long long)a3_ << 32) | a2_); } \
        bf16_t* ABUF = (bf16_t*)(ws + WS_ABUF); bf16_t* Z = (bf16_t*)(ws + WS_Z); float* XRES = (float*)(ws + WS_XRES); float* SS = (float*)(ws + WS_SS); float* TMP = outp + O_YP; \
        (void)ABUF; (void)Z; (void)XRES; (void)SS; (void)TMP;
#define PH_END }
    PH_BEGIN(0) prep_phase(p, lds); PH_END
    PH_BEGIN(1)
        EpiGateUp e1; e1.H = Z; e1.ss = nullptr;
        run_gemm(lds, ABUF, DM, (const bf16_t*)(ws + WS_WGU1), MT, 5632, 1024, e1, 0);
        EpiMemKV e2; e2.ok = outp + O_MKP; e2.ov = outp + O_MVP; e2.kv = (bf16_t*)(ws + WS_MEMKV);
        run_gemm(lds, (const bf16_t*)(ws + WS_MEMA), DM, (const bf16_t*)(ws + WS_WKV), 2048, 2048, 1024, e2, 64);
    PH_END
    PH_BEGIN(2) EpiResid e; e.res0 = p.in[0]; e.res1 = p.in[1]; e.xout = XRES; e.aout = ABUF; e.gain = p.in[13]; e.ss = SS; e.scale = 0.5f;
        run_gemm(lds, Z, DFF, (const bf16_t*)(ws + WS_WD1), MP, 1024, DFF, e, 0); small_gemm(lds, Z, DFF, (const bf16_t*)(ws + WS_WD1), 1024, DFF, e); PH_END
    PH_BEGIN(3) EpiZ e; e.Z = Z; e.ZS = (float*)(ws + WS_ZS); e.ss = SS;
        run_gemm(lds, ABUF, DM, (const bf16_t*)(ws + WS_WIN), MT, 8448, 1024, e, 0); PH_END
    PH_BEGIN(4)
        for (int it = blockIdx.x; it < 1024; it += gridDim.x) gla_prep(p, lds, it);
    PH_END
    PH_BEGIN(5)
        const int bx = (int)blockIdx.x, G = (int)gridDim.x;
        const int NCH = (G >= 256) ? 128 : 0;
        if (bx < NCH || NCH == 0) {
            for (int it0 = bx; it0 < 128; it0 += (NCH ? NCH : G)) { const int it = NCH ? ((((it0 & 7) * 8 + (it0 >> 4)) << 1) | ((it0 >> 3) & 1)) : it0;
                if (it < 64) { if (MIXEN & 1) mixer_prompt<0>(p, lds, it >> 3, (it >> 1) & 3, it & 1); } }
            for (int it0 = bx; it0 < 128; it0 += (NCH ? NCH : G)) { const int it = NCH ? ((((it0 & 7) * 8 + (it0 >> 4)) << 1) | ((it0 >> 3) & 1)) : it0;
                if (it >= 64) { if (MIXEN & 2) mixer_prompt<1>(p, lds, (it - 64) >> 3, (it >> 1) & 3, it & 1); } }
        }
        if (bx >= NCH) {
            for (int it = bx - NCH; it < 512; it += G - NCH) { if (MIXEN & 4) mixer_sample<0>(p, lds, it >> 2, it & 3); }
            for (int it = bx - NCH; it < 512; it += G - NCH) { if (MIXEN & 8) mixer_sample<1>(p, lds, it >> 2, it & 3); }
            prep_transposes(p, lds, PREP_LATE_MASK, bx - NCH, G - NCH);
        }
    PH_END
    PH_BEGIN(6)
        const float* SSQ = (const float*)(ws + WS_SSQ);
        const int lane = threadIdx.x & 63, gw = blockIdx.x * 8 + (threadIdx.x >> 6), nw = gridDim.x * 8;
        for (int i0 = gw; i0 < MP * 8; i0 += 4 * nw) {
            f32x4 sp[4]; u32x2 wv[4];
#pragma unroll
            for (int e = 0; e < 4; ++e) { const int i = i0 + e * nw; if (i < MP * 8) { sp[e] = *(const f32x4*)(SSQ + (size_t)i * 4);
                    wv[e] = *(const u32x2*)(Z + (size_t)(i >> 3) * ZLD + (((i & 7) >> 2) ? 5120 : 2048) + (i & 3) * 256 + lane * 4); } }
#pragma unroll
            for (int e = 0; e < 4; ++e) { const int i = i0 + e * nw; if (i < MP * 8) {
                    const float rs = rsqrtf(((sp[e][0] + sp[e][1]) + (sp[e][2] + sp[e][3])) * (1.f / 256.f) + EPSV);
                    f32x4 o = {bflo(wv[e].x) * rs, bfhi(wv[e].x) * rs, bflo(wv[e].y) * rs, bfhi(wv[e].y) * rs};
                    *(u32x2*)(Z + (size_t)(i >> 3) * ZLD + (((i & 7) >> 2) ? 5120 : 2048) + (i & 3) * 256 + lane * 4) = pack4(o); } }
        }
    PH_END
    PH_BEGIN(7)
        { EpiMerge<0> e; e.gate = Z + 6144; e.T = TMP; e.Y = nullptr;
          run_gemm(lds, Z + 2048, ZLD, (const bf16_t*)(ws + WS_WBRM), MP, 1024, 1024, e, 0); small_gemm(lds, Z + 2048, ZLD, (const bf16_t*)(ws + WS_WBRM), 1024, 1024, e); }
        { EpiMerge<1> e; e.gate = Z + 7168; e.T = TMP; e.Y = ABUF;
          run_gemm(lds, Z + 5120, ZLD, (const bf16_t*)(ws + WS_WBRG), MP, 1024, 1024, e, 0); small_gemm(lds, Z + 5120, ZLD, (const bf16_t*)(ws + WS_WBRG), 1024, 1024, e); }
    PH_END
    PH_BEGIN(9) EpiResid e; e.res0 = XRES; e.res1 = XRES + (size_t)MP * DM; e.xout = XRES; e.aout = (bf16_t*)(ws + WS_ABUF2); e.gain = p.in[23]; e.ss = SS + (size_t)MT * 16; e.scale = 1.f;
        run_gemm(lds, ABUF, DM, (const bf16_t*)(ws + WS_WOUT), MP, 1024, 1024, e, 0); small_gemm(lds, ABUF, DM, (const bf16_t*)(ws + WS_WOUT), 1024, 1024, e); PH_END
    PH_BEGIN(10) EpiQ e; e.Q = (bf16_t*)(ws + WS_QBUF); e.ss = SS + (size_t)MT * 16;
        run_gemm(lds, (const bf16_t*)(ws + WS_ABUF2), DM, (const bf16_t*)(ws + WS_WQ), MP, 1024, 1024, e, 0); small_gemm(lds, (const bf16_t*)(ws + WS_ABUF2), DM, (const bf16_t*)(ws + WS_WQ), 1024, 1024, e); PH_END
    PH_BEGIN(11)
#pragma unroll 1
        for (int pass = 0; pass < 2; ++pass) {
            if (((blockIdx.x & 1) != 0) == (pass == 0)) { for (int it = blockIdx.x; it < 512; it += gridDim.x) attn_sample(p, lds, it); }
            else { for (int it = blockIdx.x; it < 256; it += gridDim.x) attn_prompt(p, lds, it); }
        }
    PH_END
    PH_BEGIN(12) EpiResid e; e.res0 = XRES; e.res1 = XRES + (size_t)MP * DM; e.xout = XRES; e.aout = ABUF; e.gain = p.in[29]; e.ss = SS + (size_t)MT * 32; e.scale = 1.f;
        run_gemm(lds, (const bf16_t*)(ws + WS_OBUF), DM, (const bf16_t*)(ws + WS_WO), MP, 1024, 1024, e, 0); small_gemm(lds, (const bf16_t*)(ws + WS_OBUF), DM, (const bf16_t*)(ws + WS_WO), 1024, 1024, e); PH_END
    PH_BEGIN(13) EpiGateUp e; e.H = Z; e.ss = SS + (size_t)MT * 32;
        run_gemm(lds, ABUF, DM, (const bf16_t*)(ws + WS_WGU2), MT, 5632, 1024, e, 0); PH_END
    PH_BEGIN(14) EpiResid e; e.res0 = XRES; e.res1 = XRES + (size_t)MP * DM; e.xout = TMP; e.aout = nullptr; e.gain = nullptr; e.ss = SS + (size_t)MT * 48; e.scale = 0.5f;
        run_gemm(lds, Z, DFF, (const bf16_t*)(ws + WS_WD2), MP, 1024, DFF, e, 0); small_gemm(lds, Z, DFF, (const bf16_t*)(ws + WS_WD2), 1024, DFF, e); PH_END
    PH_BEGIN(15)
        const int lane = threadIdx.x & 63, gw = blockIdx.x * 8 + (threadIdx.x >> 6), nw = gridDim.x * 8;
        for (int r = gw; r < MT; r += nw) { const float rs = rs_row(SS + (size_t)MT * 48, r); float* y = TMP + (size_t)r * DM;
#pragma unroll
            for (int i = 0; i < 4; ++i) { f32x4 v = *(const f32x4*)(y + i * 256 + lane * 4); const f32x4 gg = *(const f32x4*)(p.in[33] + i * 256 + lane * 4);
                __builtin_nontemporal_store(v * rs * gg, (f32x4*)(y + i * 256 + lane * 4)); } }
    PH_END
}

template <int KMASK> static bool setup_kernel() {
    if (hipFuncSetAttribute((const void*)fwd_kernel<KMASK>, hipFuncAttributeMaxDynamicSharedMemorySize, LDS_BYTES) != hipSuccess) { fprintf(stderr, "kernel_launch: hipFuncSetAttribute failed\n"); return false; }
    int per_cu = 0;
    if (hipOccupancyMaxActiveBlocksPerMultiprocessor(&per_cu, (const void*)fwd_kernel<KMASK>, NTHREADS, LDS_BYTES) != hipSuccess || per_cu < 1) fprintf(stderr, "kernel_launch: occupancy query says %d\n", per_cu);
    (void)hipGetLastError();
    return true;
}
template <int KMASK> static void launch_range(Params p, int lo, int hi, int grid, hipStream_t stream) {
    p.ph_lo = lo; p.ph_hi = hi;
    if (hipMemsetAsync((char*)p.ws + WS_BAR, 0, XCD_BAR_WORDS * 4, stream) != hipSuccess) { fprintf(stderr, "kernel_launch: memset of the barrier words failed\n"); return; }
    void* args[] = {&p};
    hipError_t e = hipLaunchCooperativeKernel((const void*)fwd_kernel<KMASK>, dim3(grid), dim3(NTHREADS), args, LDS_BYTES, stream);
    if (e != hipSuccess) fprintf(stderr, "kernel_launch: cooperative launch [%d,%d) failed: %s (grid %d)\n", lo, hi, hipGetErrorString(e), grid);
}
#ifndef N_LAUNCH
#define N_LAUNCH 1
#endif
extern "C" void kernel_launch(void* const* d_in, const int* in_sizes, int n_in, void* d_out, int out_size, void* d_ws, size_t ws_size, hipStream_t stream) {
    static int grid = 0;
    if (grid == 0) {
        if (n_in != 34 || (size_t)out_size != O_END || ws_size < WS_END) { fprintf(stderr, "kernel_launch: unexpected sizes n_in %d out %d ws %zu (need %zu)\n", n_in, out_size, ws_size, (size_t)WS_END); grid = -1; return; }
        int dev = 0, cus = 0;
        (void)hipGetDevice(&dev); (void)hipDeviceGetAttribute(&cus, hipDeviceAttributeMultiprocessorCount, dev);
        bool ok = true;
#if N_LAUNCH == 1
        ok = setup_kernel<0xffff>();
#else
        ok = setup_kernel<0x3fef>() && setup_kernel<0x0010>();
#endif
        if (!ok) { grid = -1; return; }
        grid = cus;
        if (grid < 64) { fprintf(stderr, "kernel_launch: needs >= 64 CUs\n"); grid = -1; return; }
    }
    if (grid < 0) return;
    Params p{};
    for (int i = 0; i < 34; ++i) p.in[i] = (const float*)d_in[i];
    p.out = (float*)d_out; p.ws = (unsigned char*)d_ws;
#if N_LAUNCH == 1
#ifndef PROBE_K
#define PROBE_K -1
#endif
#ifndef PROBE_BACK
#define PROBE_BACK 0
#endif
    if (PROBE_K >= 0) { launch_range<0xffff>(p, 0, PROBE_K + 1, grid, stream); launch_range<0xffff>(p, PROBE_K - PROBE_BACK, 16, grid, stream); }
    else launch_range<0xffff>(p, 0, 16, grid, stream);
#else
#ifndef DBG_HI
#define DBG_HI 14
#endif
    launch_range<0x3fef>(p, 0, DBG_HI < 4 ? DBG_HI : 4, grid, stream);
    if (DBG_HI > 4) launch_range<0x0010>(p, 4, 5, grid, stream);
    if (DBG_HI > 5) launch_range<0x3fef>(p, 5, DBG_HI, grid, stream);
#endif
}
```

```cpp
#include <hip/hip_runtime.h>
#include <hip/hip_cooperative_groups.h>
#include <cstdio>
namespace cg = cooperative_groups;
namespace pg8 {
#define PG8_LAS __attribute__((address_space(3)))
typedef unsigned short bf16_t;
typedef short bf16x8 __attribute__((ext_vector_type(8)));
typedef float f32x4 __attribute__((ext_vector_type(4)));
typedef unsigned u32x4 __attribute__((ext_vector_type(4)));
constexpr int BM = 256, BK = 64, HALF = 128, HTB = HALF * BK * 2  , STAGE_BYTES = 8 * HTB, NXCD = 8, WGM = 8;

__host__ __device__ __forceinline__ int lds_byte(int r, int c) { const int st = (r >> 4) * 2 + (c >> 5), rr = r & 15, cc = c & 31, ob = rr * 64 + cc * 2; return st * 1024 + (ob ^ (((ob >> 9) & 1) << 5)); }
__host__ __device__ __forceinline__ void stage_rc(int b, int& R, int& C) { const int st = b / 1024, sb = b % 1024, swz = sb ^ (((sb >> 9) & 1) << 5); R = (st >> 1) * 16 + swz / 64; C = (st & 1) * 32 + (swz % 64) / 2; }
__host__ __device__ __forceinline__ int perm32(int rho) { const int n = rho >> 4, i = rho & 15; return 8 * (i >> 2) + 4 * n + (i & 3); }

struct Unit { int pm, pn; };
struct Gemm { const bf16_t* A; const bf16_t* Bt; int M, N, K, lda, ldb; };
struct StaticOrder {
    int nM, nN, nwg, G, c;
    __host__ __device__ void init(int M, int N, int G_, int c_) { nM = M / BM; nN = N / BM; nwg = nM * nN; G = G_; c = c_; }
    __host__ __device__ bool next(int i, Unit& u) const {
        const long L = (long)i * G + c; if (L >= nwg) return false;
        int wgid = (int)L; { const int q = nwg / NXCD, r = nwg % NXCD, xcd = wgid % NXCD, off = wgid / NXCD; wgid = (xcd < r ? xcd * (q + 1) : r * (q + 1) + (xcd - r) * q) + off; }
        const int nig = WGM * nN, gid = wgid / nig, fm = gid * WGM, gsz = (nM - fm) < WGM ? (nM - fm) : WGM;
        u.pm = fm + ((wgid % nig) % gsz); u.pn = (wgid % nig) / gsz; return true;
    }
    __device__ __forceinline__ void a_ready(const Unit&) const {}
    __device__ __forceinline__ void done(const Unit&) const {}
};
__device__ __forceinline__ unsigned cvt_pk_bf16(float lo, float hi) { unsigned r; asm volatile("v_cvt_pk_bf16_f32 %0, %1, %2" : "=v"(r) : "v"(lo), "v"(hi)); return r; }
template <class Epi, class Sched>
__device__ __forceinline__ void gemm_phase(PG8_LAS unsigned char* lds, const Gemm g, const Sched& S, const Epi& E) {
    const int tid = threadIdx.x, wid = __builtin_amdgcn_readfirstlane(tid >> 6), lane = tid & 63, wr = wid >> 2, wc = wid & 3, fr = lane & 15, fq = lane >> 4;
    const int K = g.K, nt = K / BK;
    unsigned voffA[2], voffB[2];
#pragma unroll
    for (int i = 0; i < 2; ++i) { int R, C; stage_rc(tid * 16 + i * 8192, R, C); const int Rb = Epi::PERM ? ((R & ~31) + perm32(R & 31)) : R;
        voffA[i] = (unsigned)(R * g.lda + C) * 2u; voffB[i] = (unsigned)(Rb * g.ldb + C) * 2u; }
    const size_t kstep = (size_t)(BK * 2);
    const size_t hstepA = (size_t)HALF * g.lda * 2, hstepB = (size_t)HALF * g.ldb * 2;
    const size_t tstepA = 2 * hstepA, tstepB = 2 * hstepB;
    const unsigned ldsw = (unsigned)wid * 1024u;
    const int aoff = lds_byte(wr * 64 + fr, fq * 8), boff = lds_byte(wc * 32 + fr, fq * 8);
#define PG8_SA(b, h) (((b) * 2 + (h)) * HTB)
#define PG8_SB(b, h) ((4 + (b) * 2 + (h)) * HTB)
#define PG8_STAGE(bufoff, gbase, voff) do { _Pragma("unroll") for (int _i = 0; _i < 2; ++_i) \
        __builtin_amdgcn_global_load_lds((const unsigned*)((const char*)(gbase) + (voff)[_i]), (PG8_LAS unsigned*)(lds + (bufoff) + ldsw + _i * 8192), 16, 0, 0); } while (0)
#define PG8_LDA(dst, b, h) do { _Pragma("unroll") for (int m = 0; m < 4; ++m) _Pragma("unroll") for (int k = 0; k < 2; ++k) dst[m][k] = *(const PG8_LAS bf16x8*)(lds + PG8_SA(b, h) + aoff + m * 2048 + k * 1024); } while (0)
#define PG8_LDB(dst, b, h) do { _Pragma("unroll") for (int n = 0; n < 2; ++n) _Pragma("unroll") for (int k = 0; k < 2; ++k) dst[n][k] = *(const PG8_LAS bf16x8*)(lds + PG8_SB(b, h) + boff + n * 2048 + k * 1024); } while (0)
#define PG8_MMA(ai, bj, At, Bt) do { __builtin_amdgcn_s_setprio(1); _Pragma("unroll") for (int m = 0; m < 4; ++m) _Pragma("unroll") for (int n = 0; n < 2; ++n) _Pragma("unroll") for (int k = 0; k < 2; ++k) \
        acc[ai][bj][m][n] = __builtin_amdgcn_mfma_f32_16x16x32_bf16(Bt[n][k], At[m][k], acc[ai][bj][m][n], 0, 0, 0); __builtin_amdgcn_s_setprio(0); } while (0)
#define PG8_WAIT_V(n) asm volatile("s_waitcnt vmcnt(" #n ")" ::: "memory")
#define PG8_WAIT_L(n) asm volatile("s_waitcnt lgkmcnt(" #n ")" ::: "memory")
#define PG8_BAR __builtin_amdgcn_s_barrier()
#define PG8_SCHED __builtin_amdgcn_sched_barrier(0)
    Unit cur, nxt; int ui = 0;
    if (!S.next(0, cur)) return;
    f32x4 acc[2][2][4][2];
#pragma unroll
    for (int a = 0; a < 2; ++a)
#pragma unroll
        for (int b = 0; b < 2; ++b)
#pragma unroll
            for (int m = 0; m < 4; ++m)
#pragma unroll
                for (int n = 0; n < 2; ++n) acc[a][b][m][n] = (f32x4){0.f, 0.f, 0.f, 0.f};
    bf16x8 At[4][2], B0[2][2], B1[2][2];
    const char* cA = (const char*)g.A + (size_t)cur.pm * tstepA; const char* cB = (const char*)g.Bt + (size_t)cur.pn * tstepB;
    S.a_ready(cur);
    PG8_STAGE(PG8_SB(0, 0), cB, voffB); PG8_STAGE(PG8_SA(0, 0), cA, voffA); PG8_STAGE(PG8_SB(0, 1), cB + hstepB, voffB); PG8_STAGE(PG8_SA(0, 1), cA + hstepA, voffA);
    if (wr == 1) PG8_BAR;
    PG8_WAIT_V(4); PG8_BAR;
    PG8_STAGE(PG8_SB(1, 0), cB + kstep, voffB); PG8_STAGE(PG8_SA(1, 0), cA + kstep, voffA); PG8_STAGE(PG8_SB(1, 1), cB + hstepB + kstep, voffB);
    PG8_WAIT_V(6); PG8_BAR;
    for (;;) {
        const bool has_next = S.next(ui + 1, nxt);
        const char* nA = has_next ? (const char*)g.A + (size_t)nxt.pm * tstepA : cA; const char* nB = has_next ? (const char*)g.Bt + (size_t)nxt.pn * tstepB : cB;
        for (int t = 0; t < nt; t += 2) {
            const bool last = (t == nt - 2);
            const char* a1 = cA + (size_t)(t + 1) * kstep;
            const char* a2 = last ? nA : cA + (size_t)(t + 2) * kstep; const char* b2 = last ? nB : cB + (size_t)(t + 2) * kstep;
            const char* a3 = a2 + kstep; const char* b3 = b2 + kstep;
            if (last && has_next) S.a_ready(nxt);
            PG8_LDB(B0, 0, 0); PG8_SCHED; PG8_LDA(At, 0, 0); PG8_STAGE(PG8_SA(1, 1), a1 + hstepA, voffA);
            PG8_WAIT_L(8); PG8_BAR; PG8_WAIT_L(0); PG8_MMA(0, 0, At, B0); PG8_BAR; PG8_SCHED;
            PG8_LDB(B1, 0, 1); PG8_STAGE(PG8_SB(0, 0), b2, voffB);
            PG8_BAR; PG8_WAIT_L(0); PG8_MMA(0, 1, At, B1); PG8_BAR;
            PG8_LDA(At, 0, 1); PG8_STAGE(PG8_SA(0, 0), a2, voffA);
            PG8_BAR; PG8_WAIT_L(0); PG8_MMA(1, 0, At, B0); PG8_BAR; PG8_SCHED;
            PG8_STAGE(PG8_SB(0, 1), b2 + hstepB, voffB);
            PG8_WAIT_V(6); PG8_BAR; PG8_MMA(1, 1, At, B1); PG8_BAR;
            PG8_LDB(B0, 1, 0); PG8_SCHED; PG8_LDA(At, 1, 0); PG8_STAGE(PG8_SA(0, 1), a2 + hstepA, voffA);
            PG8_WAIT_L(8); PG8_BAR; PG8_WAIT_L(0); PG8_MMA(0, 0, At, B0); PG8_BAR; PG8_SCHED;
            PG8_LDB(B1, 1, 1); PG8_STAGE(PG8_SB(1, 0), b3, voffB);
            PG8_BAR; PG8_WAIT_L(0); PG8_MMA(0, 1, At, B1); PG8_BAR;
            PG8_LDA(At, 1, 1); PG8_STAGE(PG8_SA(1, 0), a3, voffA);
            PG8_BAR; PG8_WAIT_L(0); PG8_MMA(1, 0, At, B0); PG8_BAR; PG8_SCHED;
            PG8_STAGE(PG8_SB(1, 1), b3 + hstepB, voffB);
            PG8_WAIT_V(6); PG8_BAR; PG8_MMA(1, 1, At, B1); PG8_BAR;
        }
        if constexpr (!Epi::AFTER_DRAIN) { E(acc, cur, wr, wc, fr, fq); S.done(cur); }
        if (!has_next) break;
#pragma unroll
        for (int a = 0; a < 2; ++a)
#pragma unroll
            for (int b = 0; b < 2; ++b)
#pragma unroll
                for (int m = 0; m < 4; ++m)
#pragma unroll
                    for (int n = 0; n < 2; ++n) acc[a][b][m][n] = (f32x4){0.f, 0.f, 0.f, 0.f};
        cur = nxt; cA = nA; cB = nB; ++ui;
    }
    PG8_WAIT_V(0);
    if (wr == 0) PG8_BAR;
    PG8_BAR;
    if constexpr (Epi::AFTER_DRAIN) { E.fused(acc, cur, wr, wc, fr, fq, lds, wid, lane); S.done(cur); }
#undef PG8_SA
#undef PG8_SB
#undef PG8_STAGE
#undef PG8_LDA
#undef PG8_LDB
#undef PG8_MMA
#undef PG8_WAIT_V
#undef PG8_WAIT_L
#undef PG8_BAR
#undef PG8_SCHED
}
}
using pg8::bf16_t; using pg8::bf16x8; using pg8::f32x4; using pg8::u32x4;
typedef short s16x4 __attribute__((ext_vector_type(4)));
typedef unsigned u32x2 __attribute__((ext_vector_type(2)));
#define LAS __attribute__((address_space(3)))

constexpr int MP = 16384, MS = 512, MT = MP + MS, DM = 1024, DFF = 2816, ZLD = 8192, ZSLD = 32;
constexpr int NTHREADS = 512;
constexpr float EPSV = 1e-6f;
constexpr size_t SZ_WGU = 5632ull * 1024 * 2, SZ_WD = 1024ull * 2816 * 2, SZ_WIN = 8448ull * 1024 * 2, SZ_W1K = 1024ull * 1024 * 2;
constexpr size_t WS_WGU1 = 0;
constexpr size_t WS_WD1 = WS_WGU1 + SZ_WGU;
constexpr size_t WS_WIN = WS_WD1 + SZ_WD;
constexpr size_t WS_WBRM = WS_WIN + SZ_WIN;
constexpr size_t WS_WBRG = WS_WBRM + SZ_W1K;
constexpr size_t WS_WOUT = WS_WBRG + SZ_W1K;
constexpr size_t WS_WQ = WS_WOUT + SZ_W1K;
constexpr size_t WS_WO = WS_WQ + SZ_W1K;
constexpr size_t WS_WKV = WS_WO + SZ_W1K;
constexpr size_t WS_WGU2 = WS_WKV + 2 * SZ_W1K;
constexpr size_t WS_WD2 = WS_WGU2 + SZ_WGU;
constexpr size_t WS_ABUF = WS_WD2 + SZ_WD;
constexpr size_t WS_MEMA = WS_ABUF + (size_t)MT * DM * 2;
constexpr size_t WS_MEMKV = WS_MEMA + 2048ull * 1024 * 2;
constexpr size_t WS_XRES = WS_MEMKV + 2048ull * 2048 * 2;
constexpr size_t WS_ZS = WS_XRES + (size_t)MT * DM * 4;
constexpr size_t WS_SS = WS_ZS + (size_t)MT * ZSLD * 4;
constexpr size_t WS_SSQ = WS_SS + 4ull * MT * 16 * 4;
constexpr size_t WS_BEND = WS_SSQ + (size_t)MP * 32 * 4;
constexpr size_t WS_Z = WS_BEND + 1024ull * 128 * 4;
constexpr size_t WS_ABUF2 = WS_Z + (64ull << 20);
constexpr size_t WS_QBUF = WS_Z + (128ull << 20);
constexpr size_t WS_OBUF = WS_Z + (192ull << 20);
constexpr size_t WS_BAR = WS_Z + (size_t)MT * ZLD * 2;
constexpr size_t WS_END = WS_BAR + 16384;
constexpr size_t O_YP = 0, O_YS = 16777216, O_CP = 17301504, O_NP = 18350080, O_MPP = 18354176, O_SP = 18354208, O_MKP = 19402784, O_MVP = 21499936,
                 O_CS = 23597088, O_NS = 40374304, O_MSS = 40439840, O_SS = 40440352, O_END = 57217568;
constexpr int LDS_BYTES = 156 * 1024;

struct Params { const float* in[34]; float* out; unsigned char* ws; int ph_lo, ph_hi; };

typedef float f32x2_t __attribute__((ext_vector_type(2)));
typedef __bf16 bf16x2_t __attribute__((ext_vector_type(2)));
__device__ __forceinline__ unsigned cvt_pk(float lo, float hi) { f32x2_t v = {lo, hi}; bf16x2_t b = __builtin_convertvector(v, bf16x2_t); return __builtin_bit_cast(unsigned, b); }
__device__ __forceinline__ bf16_t f2bf(float x) { return (bf16_t)(cvt_pk(x, 0.f) & 0xffffu); }
__device__ __forceinline__ float bf2f(bf16_t x) { return __uint_as_float(((unsigned)x) << 16); }
__device__ __forceinline__ float bflo(unsigned w) { return __uint_as_float(w << 16); }
__device__ __forceinline__ float bfhi(unsigned w) { return __uint_as_float(w & 0xffff0000u); }
__device__ __forceinline__ float sigmoidf_(float x) { return __builtin_amdgcn_rcpf(1.f + __expf(-x)); }
__device__ __forceinline__ float logsigf_(float x) { return fminf(x, 0.f) - __logf(1.f + __expf(-fabsf(x))); }
__device__ __forceinline__ float rs_of(float ss) { return rsqrtf(ss * (1.f / 1024.f) + EPSV); }
__device__ __forceinline__ float rs_row(const float* ssp, int row) {
    const f32x4* q = (const f32x4*)(ssp + (size_t)row * 16); const f32x4 a = q[0], b = q[1], c = q[2], d = q[3];
    const f32x4 s = (a + b) + (c + d); return rs_of((s[0] + s[1]) + (s[2] + s[3])); }
__device__ __forceinline__ float rs_row_q(const float* ssp, int row, int fq) {
    const f32x4 a = *(const f32x4*)(ssp + (size_t)row * 16 + fq * 4);
    float s_ = (a[0] + a[1]) + (a[2] + a[3]); s_ += __shfl_xor(s_, 16); s_ += __shfl_xor(s_, 32); return rs_of(s_); }
__device__ __forceinline__ f32x4 mfma16(bf16x8 a, bf16x8 b, f32x4 c) { return __builtin_amdgcn_mfma_f32_16x16x32_bf16(a, b, c, 0, 0, 0); }
__device__ __forceinline__ bf16x8 pack8(f32x4 a, f32x4 b) {
    u32x4 w; w.x = cvt_pk(a[0], a[1]); w.y = cvt_pk(a[2], a[3]); w.z = cvt_pk(b[0], b[1]); w.w = cvt_pk(b[2], b[3]);
    return __builtin_bit_cast(bf16x8, w);
}
__device__ __forceinline__ u32x2 pack4(f32x4 a) { u32x2 w; w.x = cvt_pk(a[0], a[1]); w.y = cvt_pk(a[2], a[3]); return w; }
__device__ __forceinline__ bf16x8 tr_frag(unsigned a0, unsigned a1) {
    s16x4 r0, r1;
    asm volatile("ds_read_b64_tr_b16 %0, %2\n\tds_read_b64_tr_b16 %1, %3\n\ts_waitcnt lgkmcnt(0)" : "=&v"(r0), "=&v"(r1) : "v"(a0), "v"(a1) : "memory");
    return __builtin_shufflevector(r0, r1, 0, 1, 2, 3, 4, 5, 6, 7);
}
__device__ __forceinline__ void tr_frag2(unsigned a0, unsigned a1, unsigned b0, unsigned b1, bf16x8& fa, bf16x8& fb) {
    s16x4 r0, r1, r2, r3;
    asm volatile("ds_read_b64_tr_b16 %0, %4\n\tds_read_b64_tr_b16 %1, %5\n\tds_read_b64_tr_b16 %2, %6\n\tds_read_b64_tr_b16 %3, %7\n\ts_waitcnt lgkmcnt(0)"
                 : "=&v"(r0), "=&v"(r1), "=&v"(r2), "=&v"(r3) : "v"(a0), "v"(a1), "v"(b0), "v"(b1) : "memory");
    fa = __builtin_shufflevector(r0, r1, 0, 1, 2, 3, 4, 5, 6, 7); fb = __builtin_shufflevector(r2, r3, 0, 1, 2, 3, 4, 5, 6, 7);
}
__device__ __forceinline__ void tr_frag4(unsigned a0, unsigned a1, unsigned b0, unsigned b1, unsigned c0, unsigned c1, unsigned d0, unsigned d1, bf16x8& fa, bf16x8& fb, bf16x8& fc, bf16x8& fd) {
    s16x4 r0, r1, r2, r3, r4, r5, r6, r7;
    asm volatile("ds_read_b64_tr_b16 %0, %8\n\tds_read_b64_tr_b16 %1, %9\n\tds_read_b64_tr_b16 %2, %10\n\tds_read_b64_tr_b16 %3, %11\n\t"
                 "ds_read_b64_tr_b16 %4, %12\n\tds_read_b64_tr_b16 %5, %13\n\tds_read_b64_tr_b16 %6, %14\n\tds_read_b64_tr_b16 %7, %15\n\ts_waitcnt lgkmcnt(0)"
                 : "=&v"(r0), "=&v"(r1), "=&v"(r2), "=&v"(r3), "=&v"(r4), "=&v"(r5), "=&v"(r6), "=&v"(r7)
                 : "v"(a0), "v"(a1), "v"(b0), "v"(b1), "v"(c0), "v"(c1), "v"(d0), "v"(d1) : "memory");
    fa = __builtin_shufflevector(r0, r1, 0, 1, 2, 3, 4, 5, 6, 7); fb = __builtin_shufflevector(r2, r3, 0, 1, 2, 3, 4, 5, 6, 7);
    fc = __builtin_shufflevector(r4, r5, 0, 1, 2, 3, 4, 5, 6, 7); fd = __builtin_shufflevector(r6, r7, 0, 1, 2, 3, 4, 5, 6, 7);
}
__device__ __forceinline__ float xsum16_32(float v) { v += __shfl_xor(v, 16); v += __shfl_xor(v, 32); return v; }
__device__ __forceinline__ float xmax16_32(float v) { v = fmaxf(v, __shfl_xor(v, 16)); v = fmaxf(v, __shfl_xor(v, 32)); return v; }
__device__ __forceinline__ float wave_sum(float v) { for (int o = 32; o > 0; o >>= 1) v += __shfl_xor(v, o); return v; }
__device__ __forceinline__ float wave_max(float v) { for (int o = 32; o > 0; o >>= 1) v = fmaxf(v, __shfl_xor(v, o)); return v; }

#define XB_TMO      128
#define XB_XCNT(j)  (256  + 64 * (j))
#define XB_XSUB(j)  (1280 + 64 * (j))
#define XB_XGEN(j)  (2304 + 64 * (j))
#define XB_TOP      3328
#define XB_TOPGEN   3392
#define XCD_BAR_WORDS 3456
#define XB_SPIN_CAP (1u << 18)

__device__ __forceinline__ unsigned xb_ld(unsigned* p)              { return __hip_atomic_load(p, __ATOMIC_RELAXED, __HIP_MEMORY_SCOPE_AGENT); }
__device__ __forceinline__ unsigned xb_add(unsigned* p, unsigned v) { return __hip_atomic_fetch_add(p, v, __ATOMIC_RELAXED, __HIP_MEMORY_SCOPE_AGENT); }
__device__ __forceinline__ unsigned xb_xcc_id() { return (unsigned)__builtin_amdgcn_s_getreg((3 << 11) | 20) & 0xFu; }
#define XB_SPIN(cond, bar) do { unsigned _sp = 0; while (cond) { __builtin_amdgcn_s_sleep(1); \
    if ((++_sp & 255u) == 0u) { if (xb_ld(&(bar)[XB_TMO])) break; if (_sp > XB_SPIN_CAP) { atomicAdd(&(bar)[XB_TMO], 1u); break; } } } } while (0)

struct XcdBarrier {
    unsigned* bar; unsigned x;
    volatile LAS unsigned* st;
};

__device__ __forceinline__ XcdBarrier xcd_barrier_post(unsigned* bar, volatile LAS unsigned* st) {
    XcdBarrier b; b.bar = bar; b.x = xb_xcc_id(); b.st = st;
    if (threadIdx.x == 0) (void)xb_add(&bar[XB_XCNT(b.x)], 1u);
    return b;
}
__device__ __forceinline__ void xcd_barrier_complete(unsigned* bar, unsigned x, unsigned& nloc, unsigned& nx) {
    const unsigned G = gridDim.x * gridDim.y * gridDim.z;
    unsigned sum, cnt, mine, sp = 0u;
    for (;;) {
        sum = 0u; cnt = 0u; mine = 0u;
#pragma unroll
        for (unsigned j = 0; j < 16; ++j) { const unsigned c = xb_ld(&bar[XB_XCNT(j)]); sum += c; cnt += (c > 0u) ? 1u : 0u; mine = (j == x) ? c : mine; }
        if (sum == G) break;
        __builtin_amdgcn_s_sleep(1);
        if ((++sp & 255u) == 0u) { if (xb_ld(&bar[XB_TMO])) break; if (sp > XB_SPIN_CAP) { atomicAdd(&bar[XB_TMO], 1u); break; } }
    }
    nloc = mine > 0u ? mine : 1u; nx = cnt > 0u ? cnt : 1u;
}

__device__ __forceinline__ void xcd_barrier(const XcdBarrier& b) {
    asm volatile("s_waitcnt vmcnt(0)" ::: "memory");
    __syncthreads();
    if (threadIdx.x == 0) {
        unsigned* bar = b.bar;
        __builtin_amdgcn_s_waitcnt(0);
        unsigned nloc = b.st[0], nx = b.st[1];
        if (nloc == 0u) { xcd_barrier_complete(bar, b.x, nloc, nx); b.st[0] = nloc; b.st[1] = nx; }
        const unsigned old = xb_add(&bar[XB_XSUB(b.x)], 1u);
        const unsigned gen = old / nloc;
        if (old + 1u == (gen + 1u) * nloc) {
            __builtin_amdgcn_fence(__ATOMIC_RELEASE, "agent");
            asm volatile("s_waitcnt vmcnt(0)" ::: "memory");
            const unsigned og = xb_add(&bar[XB_TOP], 1u);
            const unsigned tg = og / nx;
            if (og + 1u == (tg + 1u) * nx) xb_add(&bar[XB_TOPGEN], 1u);
            else XB_SPIN(xb_ld(&bar[XB_TOPGEN]) == tg, bar);
            __builtin_amdgcn_fence(__ATOMIC_ACQUIRE, "agent");
            xb_add(&bar[XB_XGEN(b.x)], 1u);
            asm volatile("s_waitcnt vmcnt(0)" ::: "memory");
        } else {
            XB_SPIN(xb_ld(&bar[XB_XGEN(b.x)]) == gen, bar);
            __builtin_amdgcn_fence(__ATOMIC_ACQUIRE, "agent");
            asm volatile("s_waitcnt vmcnt(0)" ::: "memory");
        }
    }
    __syncthreads();
}


constexpr int PREP_EARLY_MASK = 0x060f, PREP_LATE_MASK = 0x39f0;
__device__ __forceinline__ int win_src_col(int r) {
    if (r < 3072) return r; if (r < 6144) return r + 8; if (r < 8192) return r + 24;
    if (r < 8200) return 3072 + (r - 8192); if (r < 8216) return 6152 + (r - 8200); return -1;
}
__device__ __forceinline__ void prep_transposes(const Params& p, unsigned char* lds, int dmask, int vb, int nvb) {
    float* tile = (float*)lds;
    const int tid = threadIdx.x;
    unsigned char* ws = p.ws;
    for (int d = 0; d < 14; ++d) {
        if (!((dmask >> d) & 1)) continue;
        const float* src; bf16_t* dst; int K, ldsrc, ntn, mode = 0, rowoff = 0; float scale = 1.f;
        switch (d) {
            case 0: src = p.in[10]; dst = (bf16_t*)(ws + WS_WGU1); K = 1024; ldsrc = 2816; ntn = 44; mode = 2; rowoff = 0; break;
            case 1: src = p.in[11]; dst = (bf16_t*)(ws + WS_WGU1); K = 1024; ldsrc = 2816; ntn = 44; mode = 2; rowoff = 128; break;
            case 2: src = p.in[12]; dst = (bf16_t*)(ws + WS_WD1); K = 2816; ldsrc = 1024; ntn = 16; break;
            case 3: src = p.in[14]; dst = (bf16_t*)(ws + WS_WIN); K = 1024; ldsrc = 8216; ntn = 132; mode = 1; break;
            case 4: src = p.in[20]; dst = (bf16_t*)(ws + WS_WBRM); K = 1024; ldsrc = 1024; ntn = 16; break;
            case 5: src = p.in[21]; dst = (bf16_t*)(ws + WS_WBRG); K = 1024; ldsrc = 1024; ntn = 16; break;
            case 6: src = p.in[22]; dst = (bf16_t*)(ws + WS_WOUT); K = 1024; ldsrc = 1024; ntn = 16; break;
            case 7: src = p.in[25]; dst = (bf16_t*)(ws + WS_WQ); K = 1024; ldsrc = 1024; ntn = 16; scale = 0.0625f; break;
            case 8: src = p.in[28]; dst = (bf16_t*)(ws + WS_WO); K = 1024; ldsrc = 1024; ntn = 16; break;
            case 9: src = p.in[26]; dst = (bf16_t*)(ws + WS_WKV); K = 1024; ldsrc = 1024; ntn = 16; break;
            case 10: src = p.in[27]; dst = (bf16_t*)(ws + WS_WKV); K = 1024; ldsrc = 1024; ntn = 16; rowoff = 1024; break;
            case 11: src = p.in[30]; dst = (bf16_t*)(ws + WS_WGU2); K = 1024; ldsrc = 2816; ntn = 44; mode = 2; rowoff = 0; break;
            case 12: src = p.in[31]; dst = (bf16_t*)(ws + WS_WGU2); K = 1024; ldsrc = 2816; ntn = 44; mode = 2; rowoff = 128; break;
            default: src = p.in[32]; dst = (bf16_t*)(ws + WS_WD2); K = 2816; ldsrc = 1024; ntn = 16; break;
        }
        const int nkt = K / 64, ntiles = nkt * ntn;
        for (int t = vb; t < ntiles; t += nvb) {
            const int kt = t % nkt, nt = t / nkt, k0 = kt * 64;
            {
                const int j = tid & 63;
                int srccol; float sc = scale;
                if (mode == 1) { srccol = win_src_col(nt * 64 + j); if ((srccol >= 512 && srccol < 1024) || (srccol >= 3080 && srccol < 3592)) sc = 0.08838834764831845f; }
                else srccol = nt * 64 + j;
#pragma unroll
                for (int ps = 0; ps < 8; ++ps) { const int i = (tid >> 6) + 8 * ps;
                    float v = 0.f; if (srccol >= 0) v = __builtin_nontemporal_load(src + (size_t)(k0 + i) * ldsrc + srccol) * sc;
                    tile[i * 65 + j] = v; }
            }
            __syncthreads();
            {
                const int j = tid >> 3, kc = tid & 7;
                int dstrow;
                if (mode == 1) dstrow = nt * 64 + j;
                else { const int sc_ = nt * 64 + j; dstrow = (mode == 2) ? ((sc_ >> 7) * 256 + (sc_ & 127) + rowoff) : (sc_ + rowoff); }
                float v[8];
#pragma unroll
                for (int e = 0; e < 8; ++e) v[e] = tile[(kc * 8 + e) * 65 + j];
                u32x4 w; w.x = cvt_pk(v[0], v[1]); w.y = cvt_pk(v[2], v[3]); w.z = cvt_pk(v[4], v[5]); w.w = cvt_pk(v[6], v[7]);
                *(u32x4*)(dst + (size_t)dstrow * K + k0 + kc * 8) = w;
            }
            __syncthreads();
        }
    }
}
__device__ __forceinline__ void prep_phase(const Params& p, unsigned char* lds) {
    const int tid = threadIdx.x;
    unsigned char* ws = p.ws;
    prep_transposes(p, lds, PREP_EARLY_MASK, (int)blockIdx.x, (int)gridDim.x);
    const int lane = tid & 63, gw = blockIdx.x * 8 + (tid >> 6), nw = gridDim.x * 8;
    for (int r = gw; r < MT + 2048; r += nw) {
        const float* x; const float* g; bf16_t* o;
        if (r < MP) { x = p.in[0] + (size_t)r * DM; g = p.in[9]; o = (bf16_t*)(ws + WS_ABUF) + (size_t)r * DM; }
        else if (r < MT) { x = p.in[1] + (size_t)(r - MP) * DM; g = p.in[9]; o = (bf16_t*)(ws + WS_ABUF) + (size_t)r * DM; }
        else { x = p.in[2] + (size_t)(r - MT) * DM; g = p.in[24]; o = (bf16_t*)(ws + WS_MEMA) + (size_t)(r - MT) * DM; }
        f32x4 v[4]; float ss = 0.f;
#pragma unroll
        for (int i = 0; i < 4; ++i) { v[i] = *(const f32x4*)(x + i * 256 + lane * 4); ss += v[i][0] * v[i][0] + v[i][1] * v[i][1] + v[i][2] * v[i][2] + v[i][3] * v[i][3]; }
        ss = wave_sum(ss); const float rs = rs_of(ss);
#pragma unroll
        for (int i = 0; i < 4; ++i) { const f32x4 gg = *(const f32x4*)(g + i * 256 + lane * 4);
            u32x2 w; w.x = cvt_pk(v[i][0] * rs * gg[0], v[i][1] * rs * gg[1]); w.y = cvt_pk(v[i][2] * rs * gg[2], v[i][3] * rs * gg[3]);
            *(u32x2*)(o + i * 256 + lane * 4) = w; }
    }
}

#define EPI_ROW(ai, m) (u.pm * 256 + (ai) * 128 + wr * 64 + (m) * 16 + fr)
#define EPI_COL(bj) (u.pn * 256 + (bj) * 128 + wc * 32 + fq * 8)
struct EpiGateUp {
    static constexpr bool PERM = true, AFTER_DRAIN = false;
    bf16_t* H; const float* ss;
    __device__ __forceinline__ void operator()(const f32x4 (&acc)[2][2][4][2], const pg8::Unit& u, int wr, int wc, int fr, int fq) const {
        float rsv[2][4];
#pragma unroll
        for (int ai = 0; ai < 2; ++ai)
#pragma unroll
            for (int m = 0; m < 4; ++m) rsv[ai][m] = ss ? rs_row_q(ss, EPI_ROW(ai, m), fq) : 1.f;
#pragma unroll
        for (int ai = 0; ai < 2; ++ai)
#pragma unroll
            for (int m = 0; m < 4; ++m) { const int row = EPI_ROW(ai, m); const float rs = rsv[ai][m];
                f32x4 hv[2];
#pragma unroll
                for (int n = 0; n < 2; ++n)
#pragma unroll
                    for (int j = 0; j < 4; ++j) { const float gt = acc[ai][0][m][n][j] * rs, up = acc[ai][1][m][n][j] * rs; hv[n][j] = gt * sigmoidf_(gt) * up; }
                *(u32x4*)(H + (size_t)row * DFF + u.pn * 128 + wc * 32 + fq * 8) = __builtin_bit_cast(u32x4, pack8(hv[0], hv[1])); }
    }
};
struct EpiMemKV {
    static constexpr bool PERM = true, AFTER_DRAIN = false;
    float* ok; float* ov; bf16_t* kv;
    __device__ __forceinline__ void operator()(const f32x4 (&acc)[2][2][4][2], const pg8::Unit& u, int wr, int wc, int fr, int fq) const {
#pragma unroll
        for (int ai = 0; ai < 2; ++ai)
#pragma unroll
            for (int m = 0; m < 4; ++m) { const int row = EPI_ROW(ai, m);
#pragma unroll
                for (int bj = 0; bj < 2; ++bj) { const int col = EPI_COL(bj);
                    float* o = (col < 1024) ? (ok + (size_t)row * 1024 + col) : (ov + (size_t)row * 1024 + (col - 1024));
                    __builtin_nontemporal_store(acc[ai][bj][m][0], (f32x4*)o); __builtin_nontemporal_store(acc[ai][bj][m][1], (f32x4*)(o + 4));
                    *(u32x4*)(kv + (size_t)row * 2048 + col) = __builtin_bit_cast(u32x4, pack8(acc[ai][bj][m][0], acc[ai][bj][m][1])); } }
    }
};
struct EpiResid {
    static constexpr bool PERM = true, AFTER_DRAIN = false;
    const float* res0; const float* res1; float* xout; bf16_t* aout; const float* gain; float* ss; float scale;
    __device__ __forceinline__ void operator()(const f32x4 (&acc)[2][2][4][2], const pg8::Unit& u, int wr, int wc, int fr, int fq) const {
        f32x4 gv[2][2];
        if (aout) {
#pragma unroll
            for (int bj = 0; bj < 2; ++bj) { gv[bj][0] = *(const f32x4*)(gain + EPI_COL(bj)); gv[bj][1] = *(const f32x4*)(gain + EPI_COL(bj) + 4); } }
#pragma unroll
        for (int ai = 0; ai < 2; ++ai) {
            f32x4 rv[4][2][2];
#pragma unroll
            for (int m = 0; m < 4; ++m) { const int row = EPI_ROW(ai, m);
                const float* rp = (row < MP) ? (res0 + (size_t)row * DM) : (res1 + (size_t)(row - MP) * DM);
#pragma unroll
                for (int bj = 0; bj < 2; ++bj) { rv[m][bj][0] = *(const f32x4*)(rp + EPI_COL(bj)); rv[m][bj][1] = *(const f32x4*)(rp + EPI_COL(bj) + 4); } }
#pragma unroll
            for (int m = 0; m < 4; ++m) { const int row = EPI_ROW(ai, m);
                float sq = 0.f;
#pragma unroll
                for (int bj = 0; bj < 2; ++bj) { const int col = EPI_COL(bj);
                    const f32x4 x0 = rv[m][bj][0] + acc[ai][bj][m][0] * scale, x1 = rv[m][bj][1] + acc[ai][bj][m][1] * scale;
                    *(f32x4*)(xout + (size_t)row * DM + col) = x0; *(f32x4*)(xout + (size_t)row * DM + col + 4) = x1;
#pragma unroll
                    for (int j = 0; j < 4; ++j) sq += x0[j] * x0[j] + x1[j] * x1[j];
                    if (aout) *(u32x4*)(aout + (size_t)row * DM + col) = __builtin_bit_cast(u32x4, pack8(x0 * gv[bj][0], x1 * gv[bj][1])); }
                sq = xsum16_32(sq);
                if (fq == 0) ss[(size_t)row * 16 + u.pn * 4 + wc] = sq; }
        }
    }
    __device__ __forceinline__ void small(f32x4 acc, int row, int col, int tc, int rt, int ct, int l16, int g, unsigned char* lds) const {
        const f32x4 x = *(const f32x4*)(res1 + (size_t)(row - MP) * DM + col) + acc * scale;
        *(f32x4*)(xout + (size_t)row * DM + col) = x;
        if (aout) { const f32x4 gv4 = *(const f32x4*)(gain + col); *(u32x2*)(aout + (size_t)row * DM + col) = pack4(x * gv4); }
        float sq = x[0] * x[0] + x[1] * x[1] + x[2] * x[2] + x[3] * x[3];
        sq = xsum16_32(sq);
        float* red = (float*)lds;
        if (g == 0) red[(rt * 4 + ct) * 16 + l16] = sq;
        __syncthreads();
        if (ct == 0 && g == 0) ss[(size_t)row * 16 + tc] = (red[(rt * 4) * 16 + l16] + red[(rt * 4 + 1) * 16 + l16]) + (red[(rt * 4 + 2) * 16 + l16] + red[(rt * 4 + 3) * 16 + l16]);
        __syncthreads();
    }
};
struct EpiZ {
    static constexpr bool PERM = true, AFTER_DRAIN = false;
    bf16_t* Z; float* ZS; const float* ss;
    __device__ __forceinline__ void operator()(const f32x4 (&acc)[2][2][4][2], const pg8::Unit& u, int wr, int wc, int fr, int fq) const {
#pragma unroll
        for (int ai = 0; ai < 2; ++ai) {
            float rsv[4];
#pragma unroll
            for (int m = 0; m < 4; ++m) rsv[m] = rs_row_q(ss, EPI_ROW(ai, m), fq);
#pragma unroll
            for (int m = 0; m < 4; ++m) { const int row = EPI_ROW(ai, m); const float rs = rsv[m];
                if (u.pn < 32) {
#pragma unroll
                    for (int bj = 0; bj < 2; ++bj)
                        *(u32x4*)(Z + (size_t)row * ZLD + EPI_COL(bj)) = __builtin_bit_cast(u32x4, pack8(acc[ai][bj][m][0] * rs, acc[ai][bj][m][1] * rs));
                } else if (wc == 0) {
                    *(f32x4*)(ZS + (size_t)row * ZSLD + fq * 8) = acc[ai][0][m][0] * rs; *(f32x4*)(ZS + (size_t)row * ZSLD + fq * 8 + 4) = acc[ai][0][m][1] * rs;
                } } }
    }
};
template <int MODE> struct EpiMerge {
    static constexpr bool PERM = true, AFTER_DRAIN = false;
    const bf16_t* gate; float* T; bf16_t* Y;
    __device__ __forceinline__ void operator()(const f32x4 (&acc)[2][2][4][2], const pg8::Unit& u, int wr, int wc, int fr, int fq) const {
#pragma unroll
        for (int ai = 0; ai < 2; ++ai)
#pragma unroll
            for (int mh = 0; mh < 2; ++mh) {
                u32x4 gw[2][2]; u32x4 tvb[2][2]; bf16_t* Tb = (bf16_t*)T;
#pragma unroll
                for (int mm = 0; mm < 2; ++mm) { const int row = EPI_ROW(ai, mh * 2 + mm);
#pragma unroll
                    for (int bj = 0; bj < 2; ++bj) { gw[mm][bj] = *(const u32x4*)(gate + (size_t)row * ZLD + EPI_COL(bj));
                        if (MODE == 1) tvb[mm][bj] = *(const u32x4*)(Tb + (size_t)row * DM + EPI_COL(bj)); } }
#pragma unroll
                for (int mm = 0; mm < 2; ++mm) { const int m = mh * 2 + mm, row = EPI_ROW(ai, m);
#pragma unroll
                    for (int bj = 0; bj < 2; ++bj) { const int col = EPI_COL(bj); const u32x4 g4 = gw[mm][bj];
                        f32x4 s0, s1;
                        s0[0] = sigmoidf_(bflo(g4.x)); s0[1] = sigmoidf_(bfhi(g4.x)); s0[2] = sigmoidf_(bflo(g4.y)); s0[3] = sigmoidf_(bfhi(g4.y));
                        s1[0] = sigmoidf_(bflo(g4.z)); s1[1] = sigmoidf_(bfhi(g4.z)); s1[2] = sigmoidf_(bflo(g4.w)); s1[3] = sigmoidf_(bfhi(g4.w));
                        f32x4 v0 = acc[ai][bj][m][0] * s0, v1 = acc[ai][bj][m][1] * s1;
                        if (MODE == 0) *(u32x4*)(Tb + (size_t)row * DM + col) = __builtin_bit_cast(u32x4, pack8(v0, v1));
                        else { const u32x4 t4 = tvb[mm][bj];
                            v0 += (f32x4){bflo(t4.x), bfhi(t4.x), bflo(t4.y), bfhi(t4.y)}; v1 += (f32x4){bflo(t4.z), bfhi(t4.z), bflo(t4.w), bfhi(t4.w)};
                            *(u32x4*)(Y + (size_t)row * DM + col) = __builtin_bit_cast(u32x4, pack8(v0, v1)); } } }
            }
    }
    __device__ __forceinline__ void small(f32x4 acc, int row, int col, int tc, int rt, int ct, int l16, int g, unsigned char* lds) const {
        bf16_t* Tb = (bf16_t*)T;
        const u32x2 g2 = *(const u32x2*)(gate + (size_t)row * ZLD + col);
        f32x4 v = acc * (f32x4){sigmoidf_(bflo(g2.x)), sigmoidf_(bfhi(g2.x)), sigmoidf_(bflo(g2.y)), sigmoidf_(bfhi(g2.y))};
        if (MODE == 0) *(u32x2*)(Tb + (size_t)row * DM + col) = pack4(v);
        else { const u32x2 t2 = *(const u32x2*)(Tb + (size_t)row * DM + col);
            v += (f32x4){bflo(t2.x), bfhi(t2.x), bflo(t2.y), bfhi(t2.y)};
            *(u32x2*)(Y + (size_t)row * DM + col) = pack4(v); }
    }
};
struct EpiQ {
    static constexpr bool PERM = true, AFTER_DRAIN = false;
    bf16_t* Q; const float* ss;
    __device__ __forceinline__ void operator()(const f32x4 (&acc)[2][2][4][2], const pg8::Unit& u, int wr, int wc, int fr, int fq) const {
#pragma unroll
        for (int ai = 0; ai < 2; ++ai) {
            float rsv[4];
#pragma unroll
            for (int m = 0; m < 4; ++m) rsv[m] = rs_row_q(ss, EPI_ROW(ai, m), fq);
#pragma unroll
            for (int m = 0; m < 4; ++m) { const int row = EPI_ROW(ai, m); const float rs = rsv[m];
#pragma unroll
                for (int bj = 0; bj < 2; ++bj)
                    *(u32x4*)(Q + (size_t)row * DM + EPI_COL(bj)) = __builtin_bit_cast(u32x4, pack8(acc[ai][bj][m][0] * rs, acc[ai][bj][m][1] * rs)); } }
    }
    __device__ __forceinline__ void small(f32x4 acc, int row, int col, int tc, int rt, int ct, int l16, int g, unsigned char* lds) const {
        *(u32x2*)(Q + (size_t)row * DM + col) = pack4(acc * rs_row_q(ss, row, g));
    }
};
template <class Epi>
__device__ __forceinline__ void small_gemm(unsigned char* lds, const bf16_t* A, int lda, const bf16_t* Bt, int N, int K, const Epi& E) {
    const int tid = threadIdx.x, w = tid >> 6, lane = tid & 63, g = lane >> 4, l16 = lane & 15;
    const int rt = w >> 2, ct = w & 3, nct = N / 64, ntiles = 16 * nct;
    for (int t = blockIdx.x; t < ntiles; t += gridDim.x) {
        const int tr = t / nct, tc = t - tr * nct;
        const int row = MP + tr * 32 + rt * 16 + l16, colb = tc * 64 + ct * 16;
        const bf16_t* ap = A + (size_t)row * lda + 8 * g;
        const bf16_t* bp = Bt + (size_t)(colb + l16) * K + 8 * g;
        f32x4 acc0 = (f32x4){0.f, 0.f, 0.f, 0.f}, acc1 = acc0;
#pragma unroll 4
        for (int k = 0; k < K; k += 64) {
            acc0 = mfma16(*(const bf16x8*)(bp + k), *(const bf16x8*)(ap + k), acc0);
            acc1 = mfma16(*(const bf16x8*)(bp + k + 32), *(const bf16x8*)(ap + k + 32), acc1);
        }
        E.small(acc0 + acc1, row, colb + 4 * g, tc, rt, ct, l16, g, lds);
    }
}
template <class Epi>
__device__ __forceinline__ void run_gemm(unsigned char* lds, const bf16_t* A, int lda, const bf16_t* Bt, int M, int N, int K, const Epi& E, int rot) {
    pg8::Gemm g; g.A = A; g.Bt = Bt; g.M = M; g.N = N; g.K = K; g.lda = lda; g.ldb = K;
    pg8::StaticOrder S; S.init(M, N, (int)gridDim.x, (int)((blockIdx.x + rot) % gridDim.x));
    pg8::gemm_phase<Epi, pg8::StaticOrder>((PG8_LAS unsigned char*)lds, g, S, E);
    __syncthreads();
}
constexpr int T_STRIDE = 272, V_STRIDE = 528;
constexpr int VQN = 2, VW = 256 / VQN, NVT = VW / 16, NOT = NVT / 2, V2_STRIDE = VW * 2 + 16;
constexpr int M_T0 = 0, M_T1 = 17408, M_TV = 34816, M_TC = M_TV + 64 * V2_STRIDE, M_SM = M_TC + VW * T_STRIDE;
template <int BR>
__device__ __forceinline__ void mixer_prompt(const Params& p, unsigned char* lds, int b, int h, int vq) {
    const int tid = threadIdx.x, w = tid >> 6, lane = tid & 63, g = lane >> 4, l16 = lane & 15, q4 = l16 >> 2, p4 = lane & 3;
    const int tt = w & 3, vh = w >> 2;
    bf16_t* Z = (bf16_t*)(p.ws + WS_Z);
    const float* ZS = (const float*)(p.ws + WS_ZS);
    float* SSQ = (float*)(p.ws + WS_SSQ);
    const float* BEND = (const float*)(p.ws + WS_BEND);
    const int qcol = (BR == 0 ? 0 : 3072) + h * 128, kcol = (BR == 0 ? 512 : 3584) + h * 128;
    const int vcol = (BR == 0 ? 1024 : 4096) + h * 256 + vq * VW, ocol = (BR == 0 ? 2048 : 5120) + h * 256 + vq * VW;
    unsigned char* T0 = lds + M_T0; unsigned char* T1 = lds + M_T1; unsigned char* TV = lds + M_TV; unsigned char* TC = lds + M_TC;
    float* sm = (float*)(lds + M_SM);
    float* gS = sm; float* Mt = sm + 64; float* at = sm + 128; float* emt = sm + 192; float* wsv = sm + 256; float* nvec = sm + 320; float* bend = sm + 448;
    float* misc = sm + 576; float* ssq = sm + 592; float* gaL = sm + 720; float* segtot = sm + 1744; float* waL = sm + 2256;
    const unsigned aT0_ = (unsigned)(size_t)T0, aT1_ = (unsigned)(size_t)T1, aTV_ = (unsigned)(size_t)TV;
    const float* gain = (BR == 0 ? p.in[18] : p.in[19]) + h * 256 + vq * VW;
    const int tloc = 16 * tt + l16;
    f32x4 gn[NOT];
#pragma unroll
    for (int vi = 0; vi < NOT; ++vi) gn[vi] = *(const f32x4*)(gain + (VW / 2) * vh + 16 * vi + 4 * g);
    f32x4 st[NVT];
#pragma unroll
    for (int c = 0; c < NVT; ++c) st[c] = (f32x4){0.f, 0.f, 0.f, 0.f};
    float m0 = 0.f;
    const float bi = (BR == 0) ? p.in[15][h] : 0.f, bfb = (BR == 0) ? p.in[15][4 + h] : 0.f;
    if (tid < 128) nvec[tid] = 0.f;
    u32x4 kreg[2], qreg[2], vreg[2]; bf16x8 qn[4]; float igr = 0.f, lfr = 0.f, gar[2] = {0.f, 0.f};
    const int ks_s0 = tid >> 4, ks_ch = tid & 15;
#define MIX_LOAD_CHUNK(R0) do { const size_t r_ = (size_t)(R0); \
        kreg[0] = *(const u32x4*)(Z + (r_ + ks_s0) * ZLD + kcol + ks_ch * 8); kreg[1] = *(const u32x4*)(Z + (r_ + ks_s0 + 32) * ZLD + kcol + ks_ch * 8); \
        vreg[0] = *(const u32x4*)(Z + (r_ + ks_s0) * ZLD + vcol + ks_ch * 8); vreg[1] = *(const u32x4*)(Z + (r_ + ks_s0 + 32) * ZLD + vcol + ks_ch * 8); \
        if (BR == 0) { _Pragma("unroll") for (int ks = 0; ks < 4; ++ks) qn[ks] = *(const bf16x8*)(Z + (r_ + tloc) * ZLD + qcol + 32 * ks + 8 * g); \
            if (w == 0) { igr = ZS[(r_ + lane) * ZSLD + h]; lfr = ZS[(r_ + lane) * ZSLD + 4 + h]; } } \
        else { qreg[0] = *(const u32x4*)(Z + (r_ + ks_s0) * ZLD + qcol + ks_ch * 8); qreg[1] = *(const u32x4*)(Z + (r_ + ks_s0 + 32) * ZLD + qcol + ks_ch * 8); \
            if (tid < 128) gar[0] = BEND[(r_ >> 6) * 512 + h * 128 + tid]; } } while (0)
    MIX_LOAD_CHUNK(b * 2048);
    __syncthreads();
    for (int c = 0; c < 32; ++c) {
        const int r0 = b * 2048 + c * 64;
        if (c > 0 && tid < 64) { float* sp_ = SSQ + ((size_t)(r0 - 64 + tid) * 8 + BR * 4 + h) * 4 + vq * 2; sp_[0] = ssq[tid] + ssq[64 + tid]; sp_[1] = 0.f; }
        unsigned aT0 = aT0_, aT1 = aT1_, aTV = aTV_;
        asm volatile("" : "+v"(aT0), "+v"(aT1), "+v"(aTV));
        if (BR == 0) {
            if (w == 0) {
                const float ig = igr + bi, lf = logsigf_(lfr + bfb);
                float F = lf;
#pragma unroll
                for (int o = 1; o < 64; o <<= 1) { const float y = __shfl_up(F, o); if (lane >= o) F += y; }
                const float gg = ig - F; float cm = gg;
#pragma unroll
                for (int o = 1; o < 64; o <<= 1) { const float y = __shfl_up(cm, o); if (lane >= o) cm = fmaxf(cm, y); }
                const float M = fmaxf(m0, cm), a = __expf(m0 - M);
                const float ML = __shfl(M, 63), aend = __shfl(a, 63), FL = __shfl(F, 63);
                gS[lane] = gg; Mt[lane] = M; at[lane] = a; emt[lane] = __expf(-(F + M)); wsv[lane] = __expf(gg - ML);
                if (lane == 0) misc[1] = aend;
                m0 = FL + ML;
            }
            __syncthreads();
#pragma unroll
            for (int i = 0; i < 2; ++i) { const int s = ks_s0 + 32 * i; const u32x4 kw = kreg[i];
                *(u32x4*)(T0 + s * T_STRIDE + ks_ch * 16) = kw;
                const float ww = wsv[s]; u32x4 o;
                o.x = cvt_pk(bflo(kw.x) * ww, bfhi(kw.x) * ww); o.y = cvt_pk(bflo(kw.y) * ww, bfhi(kw.y) * ww);
                o.z = cvt_pk(bflo(kw.z) * ww, bfhi(kw.z) * ww); o.w = cvt_pk(bflo(kw.w) * ww, bfhi(kw.w) * ww);
                *(u32x4*)(T1 + s * T_STRIDE + ks_ch * 16) = o; }
        } else {
            if (tid < 128) bend[tid] = gar[0];
#pragma unroll
            for (int i = 0; i < 2; ++i) { const int s = ks_s0 + 32 * i;
                *(u32x4*)(T0 + s * T_STRIDE + ks_ch * 16) = kreg[i]; *(u32x4*)(T1 + s * T_STRIDE + ks_ch * 16) = qreg[i]; }
        }
#pragma unroll
        for (int i = 0; i < 2; ++i) *(u32x4*)(TV + (ks_s0 + 32 * i) * V2_STRIDE + ks_ch * 16) = vreg[i];
#pragma unroll
        for (int c16 = 0; c16 < NVT; ++c16) *(u32x2*)(TC + (16 * c16 + l16) * T_STRIDE + (16 * w + 4 * g) * 2) = pack4(st[c16]);
        __syncthreads();
        bf16x8 qf[4];
#pragma unroll
        for (int ks = 0; ks < 4; ++ks) {
            if (BR == 0) qf[ks] = qn[ks];
            else qf[ks] = *(const bf16x8*)(T1 + tloc * T_STRIDE + (32 * ks + 8 * g) * 2);
        }
        bf16_t* op = Z + (size_t)(r0 + tloc) * ZLD + ocol + (VW / 2) * vh + 4 * g;
        u32x2 gwv[NOT];
#pragma unroll
        for (int vi = 0; vi < NOT; ++vi) gwv[vi] = *(const u32x2*)(op + 16 * vi);
        if (c < 31) MIX_LOAD_CHUNK(r0 + 64);
        f32x4 sacc[4];
#pragma unroll
        for (int si = 0; si < 4; ++si) { sacc[si] = (f32x4){0.f, 0.f, 0.f, 0.f};
#pragma unroll
            for (int ks = 0; ks < 4; ++ks) sacc[si] = mfma16(*(const bf16x8*)(T0 + (16 * si + l16) * T_STRIDE + (32 * ks + 8 * g) * 2), qf[ks], sacc[si]); }
        float den = 0.f;
        {
            const float Mtt = (BR == 0) ? Mt[tloc] : 0.f;
            f32x4 gS4[4];
#pragma unroll
            for (int si = 0; si < 4; ++si) gS4[si] = (BR == 0) ? *(const f32x4*)(gS + 16 * si + 4 * g) : (f32x4){0.f, 0.f, 0.f, 0.f};
#pragma unroll
            for (int si = 0; si < 4; ++si)
#pragma unroll
                for (int r = 0; r < 4; ++r) { const int s = 16 * si + 4 * g + r;
                    float wgt;
                    if (BR == 0) { const float e = __expf(fminf(gS4[si][r] - Mtt, 0.f)); wgt = (s <= tloc) ? e : 0.f; } else wgt = (s <= tloc) ? 1.f : 0.f;
                    sacc[si][r] *= wgt; den += sacc[si][r]; }
        }
        f32x4 oacc[NOT];
#pragma unroll
        for (int vi = 0; vi < NOT; ++vi) { oacc[vi] = (f32x4){0.f, 0.f, 0.f, 0.f};
#pragma unroll
            for (int ks = 0; ks < 4; ++ks) oacc[vi] = mfma16(*(const bf16x8*)(TC + ((VW / 2) * vh + 16 * vi + l16) * T_STRIDE + (32 * ks + 8 * g) * 2), qf[ks], oacc[vi]); }
        if (BR == 0) {
            den = xsum16_32(den);
            const float a_t = at[tloc];
            float nq = 0.f;
#pragma unroll
            for (int ks = 0; ks < 4; ++ks)
#pragma unroll
                for (int j = 0; j < 8; ++j) nq += nvec[32 * ks + 8 * g + j] * bf2f((bf16_t)qf[ks][j]);
            nq = xsum16_32(nq);
            den += a_t * nq;
#pragma unroll
            for (int vi = 0; vi < NOT; ++vi) oacc[vi] *= a_t;
        }
#pragma unroll
        for (int ks = 0; ks < 2; ++ks) {
            const bf16x8 pb = pack8(sacc[2 * ks], sacc[2 * ks + 1]);
#pragma unroll
            for (int vi = 0; vi < NOT; vi += 4) {
                const unsigned a0 = aTV + (32 * ks + 4 * g + q4) * V2_STRIDE + ((VW / 2) * vh + 16 * vi) * 2 + 8 * p4, a1 = a0 + 16 * V2_STRIDE;
                bf16x8 fa, fb, fc, fd; tr_frag4(a0, a1, a0 + 32, a1 + 32, a0 + 64, a1 + 64, a0 + 96, a1 + 96, fa, fb, fc, fd);
                oacc[vi] = mfma16(fa, pb, oacc[vi]); oacc[vi + 1] = mfma16(fb, pb, oacc[vi + 1]); oacc[vi + 2] = mfma16(fc, pb, oacc[vi + 2]); oacc[vi + 3] = mfma16(fd, pb, oacc[vi + 3]); }
        }
        if (BR == 0) { const float inv = 1.f / fmaxf(fabsf(den), emt[tloc]);
#pragma unroll
            for (int vi = 0; vi < NOT; ++vi) oacc[vi] *= inv; }
        float sq = 0.f;
#pragma unroll
        for (int vi = 0; vi < NOT; ++vi)
#pragma unroll
            for (int r = 0; r < 4; ++r) sq += oacc[vi][r] * oacc[vi][r];
        sq = xsum16_32(sq);
        if (g == 0) ssq[vh * 64 + tloc] = sq;
#pragma unroll
        for (int vi = 0; vi < NOT; ++vi) {
            const float gt[4] = {bflo(gwv[vi].x), bfhi(gwv[vi].x), bflo(gwv[vi].y), bfhi(gwv[vi].y)}; f32x4 o;
#pragma unroll
            for (int r = 0; r < 4; ++r) { const float sg = sigmoidf_(gt[r]); o[r] = oacc[vi][r] * gn[vi][r] * (BR == 0 ? sg : gt[r] * sg); }
            *(u32x2*)(op + 16 * vi) = pack4(o); }
        if (BR == 0) { const float aend = misc[1];
#pragma unroll
            for (int c16 = 0; c16 < NVT; ++c16) st[c16] *= aend; }
#pragma unroll
        for (int ks = 0; ks < 2; ++ks) {
            const unsigned ka0 = (BR == 0 ? aT1 : aT0) + (32 * ks + 8 * g + q4) * T_STRIDE + (16 * w) * 2 + 8 * p4;
            const bf16x8 kf = tr_frag(ka0, ka0 + 4 * T_STRIDE);
#pragma unroll
            for (int c16 = 0; c16 < NVT; c16 += 4) {
                const unsigned v0 = aTV + (32 * ks + 8 * g + q4) * V2_STRIDE + (16 * c16) * 2 + 8 * p4, v1 = v0 + 4 * V2_STRIDE;
                bf16x8 fa, fb, fc, fd; tr_frag4(v0, v1, v0 + 32, v1 + 32, v0 + 64, v1 + 64, v0 + 96, v1 + 96, fa, fb, fc, fd);
                st[c16] = mfma16(kf, fa, st[c16]); st[c16 + 1] = mfma16(kf, fb, st[c16 + 1]); st[c16 + 2] = mfma16(kf, fc, st[c16 + 2]); st[c16 + 3] = mfma16(kf, fd, st[c16 + 3]);
            }
        }
        if (BR == 1) {
            float eb[4];
#pragma unroll
            for (int r = 0; r < 4; ++r) eb[r] = __expf(bend[16 * w + 4 * g + r]);
#pragma unroll
            for (int c16 = 0; c16 < NVT; ++c16)
#pragma unroll
                for (int r = 0; r < 4; ++r) st[c16][r] *= eb[r];
        } else {
            const int d = tid & 127, seg = tid >> 7; float a2 = 0.f;
#pragma unroll
            for (int s = 0; s < 16; ++s) a2 += bf2f(*(const bf16_t*)(T1 + (seg * 16 + s) * T_STRIDE + d * 2));
            segtot[seg * 128 + d] = a2;
        }
        __syncthreads();
        if (BR == 0 && tid < 128) nvec[tid] = misc[1] * nvec[tid] + ((segtot[tid] + segtot[128 + tid]) + (segtot[256 + tid] + segtot[384 + tid]));
    }
#undef MIX_LOAD_CHUNK
    if (tid < 64) { float* sp_ = SSQ + ((size_t)(b * 2048 + 31 * 64 + tid) * 8 + BR * 4 + h) * 4 + vq * 2; sp_[0] = ssq[tid] + ssq[64 + tid]; sp_[1] = 0.f; }
    const int bh = b * 4 + h;
    if (BR == 0) {
        float* Co = p.out + O_CP + (size_t)bh * 32768;
#pragma unroll
        for (int c16 = 0; c16 < NVT; ++c16) __builtin_nontemporal_store(st[c16], (f32x4*)(Co + (size_t)(VW * vq + 16 * c16 + l16) * 128 + 16 * w + 4 * g));
        if (vq == 0) { if (tid < 128) p.out[O_NP + bh * 128 + tid] = nvec[tid];
            if (tid == 0) p.out[O_MPP + bh] = m0; }
    } else {
        float* So = p.out + O_SP + (size_t)bh * 32768;
#pragma unroll
        for (int c16 = 0; c16 < NVT; ++c16)
#pragma unroll
            for (int r = 0; r < 4; ++r) So[(size_t)(16 * w + 4 * g + r) * 256 + VW * vq + 16 * c16 + l16] = st[c16][r];
    }
    __syncthreads();
}

__device__ __forceinline__ void gla_prep(const Params& p, unsigned char* lds, int item) {
    const int tid = threadIdx.x, d = tid & 127, seg = tid >> 7;
    const int h = item & 3, c = (item >> 2) & 31, b = item >> 7;
    bf16_t* Z = (bf16_t*)(p.ws + WS_Z);
    const float* ZS = (const float*)(p.ws + WS_ZS);
    float* BEND = (float*)(p.ws + WS_BEND);
    float* gaL = (float*)lds; float* waL = gaL + 1024; float* segtot = waL + 2048;
    const int r0 = b * 2048 + c * 64, qcol = 3072 + h * 128, kcol = 3584 + h * 128;
    gaL[tid] = ZS[(size_t)(r0 + (tid >> 4)) * ZSLD + 8 + (tid & 15)]; gaL[tid + 512] = ZS[(size_t)(r0 + 32 + (tid >> 4)) * ZSLD + 8 + (tid & 15)];
#pragma unroll
    for (int j = 0; j < 4; ++j) { const int id = tid + 512 * j; waL[id] = p.in[16][(id >> 7) * 512 + h * 128 + (id & 127)]; }
    const float ba = p.in[17][h * 128 + d];
    __syncthreads();
    float wa[16];
#pragma unroll
    for (int j = 0; j < 16; ++j) wa[j] = waL[j * 128 + d];
    float la[16]; float run = 0.f;
#pragma unroll
    for (int i = 0; i < 16; ++i) { const int t = seg * 16 + i; float x = ba;
#pragma unroll
        for (int j = 0; j < 16; ++j) x += gaL[t * 16 + j] * wa[j];
        run += logsigf_(x) * 0.0625f; la[i] = run; }
    segtot[seg * 128 + d] = run;
    __syncthreads();
    float pre = 0.f, tot = 0.f;
#pragma unroll
    for (int s2 = 0; s2 < 4; ++s2) { const float v = segtot[s2 * 128 + d]; tot += v; if (s2 < seg) pre += v; }
    if (seg == 0) BEND[(size_t)(b * 32 + c) * 512 + h * 128 + d] = tot;
    bf16_t qv[16], kv[16];
#pragma unroll
    for (int i = 0; i < 16; ++i) { const int t = seg * 16 + i; qv[i] = Z[(size_t)(r0 + t) * ZLD + qcol + d]; kv[i] = Z[(size_t)(r0 + t) * ZLD + kcol + d]; }
#pragma unroll
    for (int i = 0; i < 16; ++i) { const int t = seg * 16 + i; const float bb = la[i] + pre;
        Z[(size_t)(r0 + t) * ZLD + qcol + d] = f2bf(bf2f(qv[i]) * __expf(bb)); Z[(size_t)(r0 + t) * ZLD + kcol + d] = f2bf(bf2f(kv[i]) * __expf(-bb)); }
    __syncthreads();
}

template <int BR>
__device__ __forceinline__ void mixer_sample(const Params& p, unsigned char* lds, int b, int h) {
    const int tid = threadIdx.x, w = tid >> 6, lane = tid & 63;
    bf16_t* Z = (bf16_t*)(p.ws + WS_Z);
    const float* ZS = (const float*)(p.ws + WS_ZS);
    const int qcol = (BR == 0 ? 0 : 3072) + h * 128, kcol = (BR == 0 ? 512 : 3584) + h * 128, vcol = (BR == 0 ? 1024 : 4096) + h * 256, ocol = (BR == 0 ? 2048 : 5120) + h * 256;
    float* sm = (float*)lds;
    float* qa = sm; float* ka = sm + 512; float* kd = sm + 1024; float* dec = sm + 1536; float* vv = sm + 1664; float* qk = sm + 2688; float* sc = sm + 2704;
    float* part = sm + 2752; float* red = sm + 4800;
    const int r0 = MP + 4 * b, bh = b * 4 + h;
    const float* gain = (BR == 0 ? p.in[18] : p.in[19]) + h * 256;
    float a_t[4] = {1.f, 1.f, 1.f, 1.f}, mt[4] = {0.f, 0.f, 0.f, 0.f}, aend = 1.f;
    {
        const int t = tid >> 7, d = tid & 127;
        const float qraw = bf2f(Z[(size_t)(r0 + t) * ZLD + qcol + d]), kraw = bf2f(Z[(size_t)(r0 + t) * ZLD + kcol + d]);
#pragma unroll
        for (int i = 0; i < 2; ++i) { const int id = tid + 512 * i; vv[id] = bf2f(Z[(size_t)(r0 + (id >> 8)) * ZLD + vcol + (id & 255)]); }
        if (BR == 0) {
            const float m0 = p.in[5][bh], bi = p.in[15][h], bfb = p.in[15][4 + h];
            float F = 0.f, cm = -3.0e38f, gg[4], Mv[4];
#pragma unroll
            for (int s = 0; s < 4; ++s) { const float ig = ZS[(size_t)(r0 + s) * ZSLD + h] + bi, lf = logsigf_(ZS[(size_t)(r0 + s) * ZSLD + 4 + h] + bfb);
                F += lf; gg[s] = ig - F; cm = fmaxf(cm, gg[s]); Mv[s] = fmaxf(m0, cm); a_t[s] = __expf(m0 - Mv[s]); mt[s] = F + Mv[s]; }
            aend = a_t[3];
            float wsel = 0.f;
#pragma unroll
            for (int s = 0; s < 4; ++s) { const float ws_ = __expf(gg[s] - Mv[3]); if (s == t) wsel = ws_; }
            qa[tid] = qraw; ka[tid] = kraw; kd[tid] = wsel * kraw;
            if (tid < 128) dec[tid] = aend;
            if (tid == 0) {
#pragma unroll
                for (int s = 0; s < 4; ++s) { sc[16 + s] = gg[s]; sc[20 + s] = Mv[s]; } }
        } else {
            float la[4];
#pragma unroll
            for (int s = 0; s < 4; ++s) { float x = p.in[17][h * 128 + d];
#pragma unroll
                for (int j = 0; j < 16; ++j) x += ZS[(size_t)(r0 + s) * ZSLD + 8 + j] * p.in[16][j * 512 + h * 128 + d];
                la[s] = logsigf_(x) * 0.0625f; }
            float bt = 0.f, bendv = 0.f;
#pragma unroll
            for (int s = 0; s < 4; ++s) { bendv += la[s]; if (s <= t) bt += la[s]; }
            qa[tid] = qraw * __expf(bt); ka[tid] = kraw * __expf(-bt); kd[tid] = kraw * __expf(bendv - bt);
            if (t == 0) dec[d] = __expf(bendv);
        }
    }
    __syncthreads();
    {
        const int pr = tid >> 5, l = tid & 31, t = pr >> 2, s = pr & 3;
        const f32x4 a = *(const f32x4*)(qa + t * 128 + l * 4), k4 = *(const f32x4*)(ka + s * 128 + l * 4);
        float v = a[0] * k4[0] + a[1] * k4[1] + a[2] * k4[2] + a[3] * k4[3];
#pragma unroll
        for (int o = 16; o > 0; o >>= 1) v += __shfl_xor(v, o);
        if (l == 0) { float wgt; if (BR == 0) wgt = (s <= t) ? __expf(sc[16 + s] - sc[20 + t]) : 0.f; else wgt = (s <= t) ? 1.f : 0.f; qk[pr] = v * wgt; }
        if (BR == 0 && tid < 128) {
            const int t2 = tid >> 5;
            const f32x4 n4 = *(const f32x4*)(p.in[4] + (size_t)bh * 128 + l * 4), q4v = *(const f32x4*)(qa + t2 * 128 + l * 4);
            float v2 = n4[0] * q4v[0] + n4[1] * q4v[1] + n4[2] * q4v[2] + n4[3] * q4v[3];
#pragma unroll
            for (int o = 16; o > 0; o >>= 1) v2 += __shfl_xor(v2, o);
            if (l == 0) sc[12 + t2] = v2;
        }
    }
    __syncthreads();
    float hv[4]; int vown; bool owner;
    if (BR == 0) {
        const int l32 = lane & 31, half = lane >> 5;
        const float* C0 = p.in[3] + (size_t)bh * 32768 + 4 * l32;
        float* C1 = p.out + O_CS + (size_t)bh * 32768 + 4 * l32;
        f32x4 qa4[4], kd4[4]; const f32x4 dec4 = *(const f32x4*)(dec + 4 * l32);
#pragma unroll
        for (int t = 0; t < 4; ++t) { qa4[t] = *(const f32x4*)(qa + t * 128 + 4 * l32); kd4[t] = *(const f32x4*)(kd + t * 128 + 4 * l32); }
#pragma unroll
        for (int ib = 0; ib < 16; ib += 8) {
            f32x4 cv[8];
#pragma unroll
            for (int e = 0; e < 8; ++e) cv[e] = __builtin_nontemporal_load((const f32x4*)(C0 + (size_t)(w * 32 + 2 * (ib + e) + half) * 128));
#pragma unroll
            for (int e = 0; e < 8; ++e) { const int v = w * 32 + 2 * (ib + e) + half; const f32x4 c = cv[e];
                float wv[4], pt[4];
#pragma unroll
                for (int s = 0; s < 4; ++s) wv[s] = vv[s * 256 + v];
                f32x4 o = dec4 * c;
#pragma unroll
                for (int s = 0; s < 4; ++s) o += kd4[s] * wv[s];
                __builtin_nontemporal_store(o, (f32x4*)(C1 + (size_t)v * 128));
#pragma unroll
                for (int t = 0; t < 4; ++t) { float x = c[0] * qa4[t][0] + c[1] * qa4[t][1] + c[2] * qa4[t][2] + c[3] * qa4[t][3];
#pragma unroll
                    for (int of = 16; of > 0; of >>= 1) x += __shfl_xor(x, of);
                    pt[t] = x; }
                if (l32 == 0) {
#pragma unroll
                    for (int t = 0; t < 4; ++t) part[t * 256 + v] = pt[t]; }
            }
        }
        if (tid < 128) { float acc = aend * p.in[4][(size_t)bh * 128 + tid];
#pragma unroll
            for (int s = 0; s < 4; ++s) acc += kd[s * 128 + tid];
            p.out[O_NS + (size_t)bh * 128 + tid] = acc; }
        if (tid == 0) p.out[O_MSS + bh] = mt[3];
        __syncthreads();
        vown = tid & 255; owner = (tid < 256);
        {
            float wv2[4];
#pragma unroll
            for (int s = 0; s < 4; ++s) wv2[s] = vv[s * 256 + vown];
#pragma unroll
            for (int t = 0; t < 4; ++t) { float num = a_t[t] * part[t * 256 + vown], den = a_t[t] * sc[12 + t];
#pragma unroll
                for (int s = 0; s < 4; ++s) { num += qk[t * 4 + s] * wv2[s]; den += qk[t * 4 + s]; }
                hv[t] = num / fmaxf(fabsf(den), __expf(-mt[t])); }
        }
    } else {
        const int v4 = lane * 4;
        const float* S0 = p.in[6] + ((size_t)bh * 128 + 16 * w) * 256 + v4;
        float* S1 = p.out + O_SS + ((size_t)bh * 128 + 16 * w) * 256 + v4;
        float* part8 = sm + 4864;
        f32x4 wv4[4], pt4[4];
#pragma unroll
        for (int s = 0; s < 4; ++s) { wv4[s] = *(const f32x4*)(vv + s * 256 + v4); pt4[s] = (f32x4){0.f, 0.f, 0.f, 0.f}; }
#pragma unroll
        for (int jb = 0; jb < 16; jb += 8) {
            f32x4 s0v[8];
#pragma unroll
            for (int e = 0; e < 8; ++e) s0v[e] = __builtin_nontemporal_load((const f32x4*)(S0 + (size_t)(jb + e) * 256));
#pragma unroll
            for (int e = 0; e < 8; ++e) { const int j = jb + e, d = 16 * w + j; const f32x4 s0 = s0v[e];
                f32x4 acc = s0 * dec[d];
#pragma unroll
                for (int t = 0; t < 4; ++t) pt4[t] += s0 * qa[t * 128 + d];
#pragma unroll
                for (int s2 = 0; s2 < 4; ++s2) acc += wv4[s2] * kd[s2 * 128 + d];
                __builtin_nontemporal_store(acc, (f32x4*)(S1 + (size_t)j * 256)); } }
#pragma unroll
        for (int t = 0; t < 4; ++t) *(f32x4*)(part8 + (w * 4 + t) * 256 + v4) = pt4[t];
        __syncthreads();
        vown = tid & 255; owner = (tid < 256);
#pragma unroll
        for (int t = 0; t < 4; ++t) { float num = 0.f;
#pragma unroll
            for (int w2 = 0; w2 < 8; ++w2) num += part8[(w2 * 4 + t) * 256 + vown];
#pragma unroll
            for (int s2 = 0; s2 < 4; ++s2) num += qk[t * 4 + s2] * vv[s2 * 256 + vown];
            hv[t] = num; }
    }
#pragma unroll
    for (int t = 0; t < 4; ++t) { float q2 = owner ? hv[t] * hv[t] : 0.f; q2 = wave_sum(q2); if (lane == 0) red[w * 4 + t] = q2; }
    __syncthreads();
    if (owner) {
#pragma unroll
        for (int t = 0; t < 4; ++t) { float tot = 0.f;
#pragma unroll
            for (int w2 = 0; w2 < 8; ++w2) tot += red[w2 * 4 + t];
            const float rs = rsqrtf(tot * (1.f / 256.f) + EPSV);
            bf16_t* op = Z + (size_t)(r0 + t) * ZLD + ocol + vown;
            const float gt = bf2f(*op), sg = sigmoidf_(gt);
            *op = f2bf(hv[t] * rs * gain[vown] * (BR == 0 ? sg : gt * sg)); }
    }
    __syncthreads();
}

__device__ __forceinline__ void attn_prompt(const Params& p, unsigned char* lds, int item) {
    const int tid = threadIdx.x, w = tid >> 6, lane = tid & 63, g = lane >> 4, l16 = lane & 15, q4 = l16 >> 2, p4 = lane & 3;
    const int qt = item & 7, h = (item >> 3) & 3, b = item >> 5;
    const bf16_t* KV = (const bf16_t*)(p.ws + WS_MEMKV) + (size_t)b * 256 * 2048 + h * 256;
    const bf16_t* Q = (const bf16_t*)(p.ws + WS_QBUF);
    bf16_t* O = (bf16_t*)(p.ws + WS_OBUF);
    const size_t rq0 = (size_t)b * 2048 + qt * 256 + 16 * w + l16;
    const unsigned aL = (unsigned)(size_t)lds;
#pragma unroll 8
    for (int i = 0; i < 16; ++i) { const int id = tid + 512 * i, key = id >> 5, ch = id & 31;
        *(u32x4*)(lds + key * V_STRIDE + ch * 16) = *(const u32x4*)(KV + (size_t)key * 2048 + ch * 8); }
    __syncthreads();
    bf16x8 pf[2][8]; float inv[2];
#pragma unroll
    for (int u = 0; u < 2; ++u) {
        const size_t rq = rq0 + 128 * u;
        f32x4 s[16];
#pragma unroll
        for (int ki = 0; ki < 16; ++ki) s[ki] = (f32x4){0.f, 0.f, 0.f, 0.f};
#pragma unroll
        for (int ks = 0; ks < 8; ++ks) { const bf16x8 qfk = *(const bf16x8*)(Q + rq * DM + h * 256 + 32 * ks + 8 * g);
#pragma unroll
            for (int ki = 0; ki < 16; ++ki) s[ki] = mfma16(*(const bf16x8*)(lds + (16 * ki + l16) * V_STRIDE + (32 * ks + 8 * g) * 2), qfk, s[ki]); }
        float mx = -3.0e38f;
#pragma unroll
        for (int ki = 0; ki < 16; ++ki)
#pragma unroll
            for (int r = 0; r < 4; ++r) mx = fmaxf(mx, s[ki][r]);
        mx = xmax16_32(mx);
        float sum = 0.f;
#pragma unroll
        for (int ki = 0; ki < 16; ++ki)
#pragma unroll
            for (int r = 0; r < 4; ++r) { const float e = __expf(s[ki][r] - mx); s[ki][r] = e; sum += e; }
        sum = xsum16_32(sum); inv[u] = 1.f / sum;
#pragma unroll
        for (int ks = 0; ks < 8; ++ks) pf[u][ks] = pack8(s[2 * ks], s[2 * ks + 1]);
        __builtin_amdgcn_sched_barrier(0);
    }
    __syncthreads();
#pragma unroll 8
    for (int i = 0; i < 16; ++i) { const int id = tid + 512 * i, key = id >> 5, ch = id & 31;
        *(u32x4*)(lds + key * V_STRIDE + ch * 16) = *(const u32x4*)(KV + (size_t)key * 2048 + 1024 + ch * 8); }
    __syncthreads();
#pragma unroll
    for (int hh = 0; hh < 2; ++hh) {
        f32x4 o0[8], o1[8];
#pragma unroll
        for (int hi = 0; hi < 8; ++hi) { o0[hi] = (f32x4){0.f, 0.f, 0.f, 0.f}; o1[hi] = o0[hi]; }
#pragma unroll
        for (int ks = 0; ks < 8; ++ks) {
            unsigned aLk = aL + (32 * ks + 4 * g + q4) * V_STRIDE + 8 * p4 + hh * 256;
            asm volatile("" : "+v"(aLk));
#pragma unroll
            for (int hi = 0; hi < 8; hi += 4) {
                const unsigned a0 = aLk + (16 * hi) * 2, a1 = a0 + 16 * V_STRIDE;
                bf16x8 fa, fb, fc, fd; tr_frag4(a0, a1, a0 + 32, a1 + 32, a0 + 64, a1 + 64, a0 + 96, a1 + 96, fa, fb, fc, fd);
                o0[hi] = mfma16(fa, pf[0][ks], o0[hi]); o0[hi + 1] = mfma16(fb, pf[0][ks], o0[hi + 1]); o0[hi + 2] = mfma16(fc, pf[0][ks], o0[hi + 2]); o0[hi + 3] = mfma16(fd, pf[0][ks], o0[hi + 3]);
                o1[hi] = mfma16(fa, pf[1][ks], o1[hi]); o1[hi + 1] = mfma16(fb, pf[1][ks], o1[hi + 1]); o1[hi + 2] = mfma16(fc, pf[1][ks], o1[hi + 2]); o1[hi + 3] = mfma16(fd, pf[1][ks], o1[hi + 3]);
            }
        }
#pragma unroll
        for (int hi = 0; hi < 8; ++hi) { *(u32x2*)(O + rq0 * DM + h * 256 + hh * 128 + 16 * hi + 4 * g) = pack4(o0[hi] * inv[0]);
            *(u32x2*)(O + (rq0 + 128) * DM + h * 256 + hh * 128 + 16 * hi + 4 * g) = pack4(o1[hi] * inv[1]); }
    }
    __syncthreads();
}
__device__ __forceinline__ void attn_sample(const Params& p, unsigned char* lds, int item) {
    const int tid = threadIdx.x, w = tid >> 6, lane = tid & 63;
    const int h = item & 3, b = item >> 2;
    const float* Kc = p.in[7] + ((size_t)b * 1024 + h) * 256;
    const float* Vc = p.in[8] + ((size_t)b * 1024 + h) * 256;
    const bf16_t* Q = (const bf16_t*)(p.ws + WS_QBUF);
    bf16_t* O = (bf16_t*)(p.ws + WS_OBUF);
    float* sc = (float*)lds; float* po = sc + 1024;
    const size_t r0 = MP + 4 * b;
    f32x4 q[4];
#pragma unroll
    for (int t = 0; t < 4; ++t) { const u32x2 qw = *(const u32x2*)(Q + (r0 + t) * DM + h * 256 + lane * 4); q[t] = (f32x4){bflo(qw.x), bfhi(qw.x), bflo(qw.y), bfhi(qw.y)}; }
    {
        const bool b5 = (lane & 32) != 0, b4 = (lane & 16) != 0, b3 = (lane & 8) != 0, b2 = (lane & 4) != 0;
#pragma unroll 2
        for (int kg = 0; kg < 8; ++kg) { const int key0 = w * 32 + kg * 4;
            f32x4 kv[4];
#pragma unroll
            for (int k = 0; k < 4; ++k) kv[k] = __builtin_nontemporal_load((const f32x4*)(Kc + (size_t)(key0 + k) * 1024 + lane * 4));
            float v[16];
#pragma unroll
            for (int k = 0; k < 4; ++k)
#pragma unroll
                for (int t = 0; t < 4; ++t) v[k * 4 + t] = kv[k][0] * q[t][0] + kv[k][1] * q[t][1] + kv[k][2] * q[t][2] + kv[k][3] * q[t][3];
            float a8[8], a4[4], a2[2];
#pragma unroll
            for (int i = 0; i < 8; ++i) { const float keep = b5 ? v[i + 8] : v[i], send = b5 ? v[i] : v[i + 8]; a8[i] = keep + __shfl_xor(send, 32); }
#pragma unroll
            for (int i = 0; i < 4; ++i) { const float keep = b4 ? a8[i + 4] : a8[i], send = b4 ? a8[i] : a8[i + 4]; a4[i] = keep + __shfl_xor(send, 16); }
#pragma unroll
            for (int i = 0; i < 2; ++i) { const float keep = b3 ? a4[i + 2] : a4[i], send = b3 ? a4[i] : a4[i + 2]; a2[i] = keep + __shfl_xor(send, 8); }
            float d = (b2 ? a2[1] : a2[0]) + __shfl_xor(b2 ? a2[0] : a2[1], 4);
            d += __shfl_xor(d, 2); d += __shfl_xor(d, 1);
            if ((lane & 3) == 0) { const int j = (lane >> 2) & 15; sc[(j & 3) * 256 + key0 + (j >> 2)] = d; }
        }
    }
    __syncthreads();
    if (w < 4) { float v[4], mx = -3.0e38f;
#pragma unroll
        for (int i = 0; i < 4; ++i) { v[i] = sc[w * 256 + lane + 64 * i]; mx = fmaxf(mx, v[i]); }
        mx = wave_max(mx); float sum = 0.f;
#pragma unroll
        for (int i = 0; i < 4; ++i) { v[i] = __expf(v[i] - mx); sum += v[i]; }
        sum = wave_sum(sum); const float inv = 1.f / sum;
#pragma unroll
        for (int i = 0; i < 4; ++i) sc[w * 256 + lane + 64 * i] = v[i] * inv; }
    __syncthreads();
    {
        const int hd4 = lane * 4; float* po8 = sc + 1024;
        f32x4 acc4[4];
#pragma unroll
        for (int t = 0; t < 4; ++t) acc4[t] = (f32x4){0.f, 0.f, 0.f, 0.f};
#pragma unroll 2
        for (int kg = 0; kg < 8; ++kg) { const int key0 = w * 32 + kg * 4;
            f32x4 v4[4], p4[4];
#pragma unroll
            for (int k = 0; k < 4; ++k) v4[k] = __builtin_nontemporal_load((const f32x4*)(Vc + (size_t)(key0 + k) * 1024 + hd4));
#pragma unroll
            for (int t = 0; t < 4; ++t) p4[t] = *(const f32x4*)(sc + t * 256 + key0);
#pragma unroll
            for (int k = 0; k < 4; ++k)
#pragma unroll
                for (int t = 0; t < 4; ++t) acc4[t] += v4[k] * p4[t][k]; }
#pragma unroll
        for (int t = 0; t < 4; ++t) *(f32x4*)(po8 + (w * 4 + t) * 256 + hd4) = acc4[t];
        __syncthreads();
        if (tid < 256) {
#pragma unroll
            for (int t = 0; t < 4; ++t) { float o = 0.f;
#pragma unroll
                for (int w2 = 0; w2 < 8; ++w2) o += po8[(w2 * 4 + t) * 256 + tid];
                O[(r0 + t) * DM + h * 256 + tid] = f2bf(o); } }
    }
    __syncthreads();
}

#ifndef ONLY_PH
#define ONLY_PH -1
#endif
#ifndef MIXEN
#define MIXEN 15
#endif
#ifndef PH_MASK
#define PH_MASK 0xffff
#endif
#define PH_ENABLED(x) ((ONLY_PH < 0 || ONLY_PH == (x)) && ((PH_MASK >> (x)) & 1) && ((KMASK >> (x)) & 1))
__device__ __forceinline__ void grid_barrier(unsigned char* wsb, unsigned char* lds) {
    XcdBarrier b; b.bar = (unsigned*)(wsb + WS_BAR); b.x = xb_xcc_id(); b.st = (volatile LAS unsigned*)(lds + LDS_BYTES - 16);
    xcd_barrier(b);
}
template <int KMASK> __global__ void __launch_bounds__(512, 2) fwd_kernel(Params p) {
    extern __shared__ __attribute__((aligned(16))) unsigned char lds[];
    cg::grid_group grid = cg::this_grid();
    volatile LAS unsigned* xb_st = (volatile LAS unsigned*)(lds + LDS_BYTES - 16);
    if (threadIdx.x == 0) { xb_st[0] = 0u; xb_st[1] = 0u; }
    __syncthreads();
    (void)xcd_barrier_post((unsigned*)(p.ws + WS_BAR), xb_st);
#ifndef DUP_MASK
#define DUP_MASK 0
#endif
#define PH_BEGIN(k) if (PH_ENABLED(k) && p.ph_lo <= (k) && (k) < p.ph_hi) for (int rep_ = 0; rep_ < (((DUP_MASK >> (k)) & 1) ? 2 : 1); ++rep_) { if ((k) > p.ph_lo || rep_) { if (p.ph_hi > 1000) grid.sync(); else grid_barrier(p.ws, lds); } \
        unsigned char* ws; float* outp; { unsigned long long w_ = (unsigned long long)p.ws, o_ = (unsigned long long)p.out; \
        unsigned a0_ = __builtin_amdgcn_readfirstlane((unsigned)w_), a1_ = __builtin_amdgcn_readfirstlane((unsigned)(w_ >> 32)), a2_ = __builtin_amdgcn_readfirstlane((unsigned)o_), a3_ = __builtin_amdgcn_readfirstlane((unsigned)(o_ >> 32)); \
        asm volatile("" : "+s"(a0_), "+s"(a1_), "+s"(a2_), "+s"(a3_)); ws = (unsigned char*)(((unsigned long long)a1_ << 32) | a0_); outp = (float*)(((unsigned long long)a3_ << 32) | a2_); } \
        bf16_t* ABUF = (bf16_t*)(ws + WS_ABUF); bf16_t* Z = (bf16_t*)(ws + WS_Z); float* XRES = (float*)(ws + WS_XRES); float* SS = (float*)(ws + WS_SS); float* TMP = outp + O_YP; \
        (void)ABUF; (void)Z; (void)XRES; (void)SS; (void)TMP;
#define PH_END }
    PH_BEGIN(0) prep_phase(p, lds); PH_END
    PH_BEGIN(1)
        EpiGateUp e1; e1.H = Z; e1.ss = nullptr;
        run_gemm(lds, ABUF, DM, (const bf16_t*)(ws + WS_WGU1), MT, 5632, 1024, e1, 0);
        EpiMemKV e2; e2.ok = outp + O_MKP; e2.ov = outp + O_MVP; e2.kv = (bf16_t*)(ws + WS_MEMKV);
        run_gemm(lds, (const bf16_t*)(ws + WS_MEMA), DM, (const bf16_t*)(ws + WS_WKV), 2048, 2048, 1024, e2, 64);
    PH_END
    PH_BEGIN(2) EpiResid e; e.res0 = p.in[0]; e.res1 = p.in[1]; e.xout = XRES; e.aout = ABUF; e.gain = p.in[13]; e.ss = SS; e.scale = 0.5f;
        run_gemm(lds, Z, DFF, (const bf16_t*)(ws + WS_WD1), MP, 1024, DFF, e, 0); small_gemm(lds, Z, DFF, (const bf16_t*)(ws + WS_WD1), 1024, DFF, e); PH_END
    PH_BEGIN(3) EpiZ e; e.Z = Z; e.ZS = (float*)(ws + WS_ZS); e.ss = SS;
        run_gemm(lds, ABUF, DM, (const bf16_t*)(ws + WS_WIN), MT, 8448, 1024, e, 0); PH_END
    PH_BEGIN(4)
        for (int it = blockIdx.x; it < 1024; it += gridDim.x) gla_prep(p, lds, it);
    PH_END
    PH_BEGIN(5)
        const int bx = (int)blockIdx.x, G = (int)gridDim.x;
        const int NCH = (G >= 256) ? 128 : 0;
        if (bx < NCH || NCH == 0) {
            for (int it0 = bx; it0 < 128; it0 += (NCH ? NCH : G)) { const int it = NCH ? ((((it0 & 7) * 8 + (it0 >> 4)) << 1) | ((it0 >> 3) & 1)) : it0;
                if (it < 64) { if (MIXEN & 1) mixer_prompt<0>(p, lds, it >> 3, (it >> 1) & 3, it & 1); } }
            for (int it0 = bx; it0 < 128; it0 += (NCH ? NCH : G)) { const int it = NCH ? ((((it0 & 7) * 8 + (it0 >> 4)) << 1) | ((it0 >> 3) & 1)) : it0;
                if (it >= 64) { if (MIXEN & 2) mixer_prompt<1>(p, lds, (it - 64) >> 3, (it >> 1) & 3, it & 1); } }
        }
        if (bx >= NCH) {
            for (int it = bx - NCH; it < 512; it += G - NCH) { if (MIXEN & 4) mixer_sample<0>(p, lds, it >> 2, it & 3); }
            for (int it = bx - NCH; it < 512; it += G - NCH) { if (MIXEN & 8) mixer_sample<1>(p, lds, it >> 2, it & 3); }
            prep_transposes(p, lds, PREP_LATE_MASK, bx - NCH, G - NCH);
        }
    PH_END
    PH_BEGIN(6)
        const float* SSQ = (const float*)(ws + WS_SSQ);
        const int lane = threadIdx.x & 63, gw = blockIdx.x * 8 + (threadIdx.x >> 6), nw = gridDim.x * 8;
        for (int i0 = gw; i0 < MP * 8; i0 += 4 * nw) {
            f32x4 sp[4]; u32x2 wv[4];
#pragma unroll
            for (int e = 0; e < 4; ++e) { const int i = i0 + e * nw; if (i < MP * 8) { sp[e] = *(const f32x4*)(SSQ + (size_t)i * 4);
                    wv[e] = *(const u32x2*)(Z + (size_t)(i >> 3) * ZLD + (((i & 7) >> 2) ? 5120 : 2048) + (i & 3) * 256 + lane * 4); } }
#pragma unroll
            for (int e = 0; e < 4; ++e) { const int i = i0 + e * nw; if (i < MP * 8) {
                    const float rs = rsqrtf(((sp[e][0] + sp[e][1]) + (sp[e][2] + sp[e][3])) * (1.f / 256.f) + EPSV);
                    f32x4 o = {bflo(wv[e].x) * rs, bfhi(wv[e].x) * rs, bflo(wv[e].y) * rs, bfhi(wv[e].y) * rs};
                    *(u32x2*)(Z + (size_t)(i >> 3) * ZLD + (((i & 7) >> 2) ? 5120 : 2048) + (i & 3) * 256 + lane * 4) = pack4(o); } }
        }
    PH_END
    PH_BEGIN(7)
        { EpiMerge<0> e; e.gate = Z + 6144; e.T = TMP; e.Y = nullptr;
          run_gemm(lds, Z + 2048, ZLD, (const bf16_t*)(ws + WS_WBRM), MP, 1024, 1024, e, 0); small_gemm(lds, Z + 2048, ZLD, (const bf16_t*)(ws + WS_WBRM), 1024, 1024, e); }
        { EpiMerge<1> e; e.gate = Z + 7168; e.T = TMP; e.Y = ABUF;
          run_gemm(lds, Z + 5120, ZLD, (const bf16_t*)(ws + WS_WBRG), MP, 1024, 1024, e, 0); small_gemm(lds, Z + 5120, ZLD, (const bf16_t*)(ws + WS_WBRG), 1024, 1024, e); }
    PH_END
    PH_BEGIN(9) EpiResid e; e.res0 = XRES; e.res1 = XRES + (size_t)MP * DM; e.xout = XRES; e.aout = (bf16_t*)(ws + WS_ABUF2); e.gain = p.in[23]; e.ss = SS + (size_t)MT * 16; e.scale = 1.f;
        run_gemm(lds, ABUF, DM, (const bf16_t*)(ws + WS_WOUT), MP, 1024, 1024, e, 0); small_gemm(lds, ABUF, DM, (const bf16_t*)(ws + WS_WOUT), 1024, 1024, e); PH_END
    PH_BEGIN(10) EpiQ e; e.Q = (bf16_t*)(ws + WS_QBUF); e.ss = SS + (size_t)MT * 16;
        run_gemm(lds, (const bf16_t*)(ws + WS_ABUF2), DM, (const bf16_t*)(ws + WS_WQ), MP, 1024, 1024, e, 0); small_gemm(lds, (const bf16_t*)(ws + WS_ABUF2), DM, (const bf16_t*)(ws + WS_WQ), 1024, 1024, e); PH_END
    PH_BEGIN(11)
#pragma unroll 1
        for (int pass = 0; pass < 2; ++pass) {
            if (((blockIdx.x & 1) != 0) == (pass == 0)) { for (int it = blockIdx.x; it < 512; it += gridDim.x) attn_sample(p, lds, it); }
            else { for (int it = blockIdx.x; it < 256; it += gridDim.x) attn_prompt(p, lds, it); }
        }
    PH_END
    PH_BEGIN(12) EpiResid e; e.res0 = XRES; e.res1 = XRES + (size_t)MP * DM; e.xout = XRES; e.aout = ABUF; e.gain = p.in[29]; e.ss = SS + (size_t)MT * 32; e.scale = 1.f;
        run_gemm(lds, (const bf16_t*)(ws + WS_OBUF), DM, (const bf16_t*)(ws + WS_WO), MP, 1024, 1024, e, 0); small_gemm(lds, (const bf16_t*)(ws + WS_OBUF), DM, (const bf16_t*)(ws + WS_WO), 1024, 1024, e); PH_END
    PH_BEGIN(13) EpiGateUp e; e.H = Z; e.ss = SS + (size_t)MT * 32;
        run_gemm(lds, ABUF, DM, (const bf16_t*)(ws + WS_WGU2), MT, 5632, 1024, e, 0); PH_END
    PH_BEGIN(14) EpiResid e; e.res0 = XRES; e.res1 = XRES + (size_t)MP * DM; e.xout = TMP; e.aout = nullptr; e.gain = nullptr; e.ss = SS + (size_t)MT * 48; e.scale = 0.5f;
        run_gemm(lds, Z, DFF, (const bf16_t*)(ws + WS_WD2), MP, 1024, DFF, e, 0); small_gemm(lds, Z, DFF, (const bf16_t*)(ws + WS_WD2), 1024, DFF, e); PH_END
    PH_BEGIN(15)
        const int lane = threadIdx.x & 63, gw = blockIdx.x * 8 + (threadIdx.x >> 6), nw = gridDim.x * 8;
        for (int r = gw; r < MT; r += nw) { const float rs = rs_row_q(SS + (size_t)MT * 48, r, lane >> 4); float* y = TMP + (size_t)r * DM;
#pragma unroll
            for (int i = 0; i < 4; ++i) { f32x4 v = *(const f32x4*)(y + i * 256 + lane * 4); const f32x4 gg = *(const f32x4*)(p.in[33] + i * 256 + lane * 4);
                __builtin_nontemporal_store(v * rs * gg, (f32x4*)(y + i * 256 + lane * 4)); } }
    PH_END
}

template <int KMASK> static bool setup_kernel() {
    if (hipFuncSetAttribute((const void*)fwd_kernel<KMASK>, hipFuncAttributeMaxDynamicSharedMemorySize, LDS_BYTES) != hipSuccess) { fprintf(stderr, "kernel_launch: hipFuncSetAttribute failed\n"); return false; }
    int per_cu = 0;
    if (hipOccupancyMaxActiveBlocksPerMultiprocessor(&per_cu, (const void*)fwd_kernel<KMASK>, NTHREADS, LDS_BYTES) != hipSuccess || per_cu < 1) fprintf(stderr, "kernel_launch: occupancy query says %d\n", per_cu);
    (void)hipGetLastError();
    return true;
}
template <int KMASK> static void launch_range(Params p, int lo, int hi, int grid, hipStream_t stream) {
    p.ph_lo = lo; p.ph_hi = hi;
    if (hipMemsetAsync((char*)p.ws + WS_BAR, 0, XCD_BAR_WORDS * 4, stream) != hipSuccess) { fprintf(stderr, "kernel_launch: memset of the barrier words failed\n"); return; }
    void* args[] = {&p};
    hipError_t e = hipLaunchCooperativeKernel((const void*)fwd_kernel<KMASK>, dim3(grid), dim3(NTHREADS), args, LDS_BYTES, stream);
    if (e != hipSuccess) fprintf(stderr, "kernel_launch: cooperative launch [%d,%d) failed: %s (grid %d)\n", lo, hi, hipGetErrorString(e), grid);
}
#ifndef N_LAUNCH
#define N_LAUNCH 1
#endif
extern "C" void kernel_launch(void* const* d_in, const int* in_sizes, int n_in, void* d_out, int out_size, void* d_ws, size_t ws_size, hipStream_t stream) {
    static int grid = 0;
    if (grid == 0) {
        if (n_in != 34 || (size_t)out_size != O_END || ws_size < WS_END) { fprintf(stderr, "kernel_launch: unexpected sizes n_in %d out %d ws %zu (need %zu)\n", n_in, out_size, ws_size, (size_t)WS_END); grid = -1; return; }
        int dev = 0, cus = 0;
        (void)hipGetDevice(&dev); (void)hipDeviceGetAttribute(&cus, hipDeviceAttributeMultiprocessorCount, dev);
        bool ok = true;
#if N_LAUNCH == 1
        ok = setup_kernel<0xffff>();
#else
        ok = setup_kernel<0x3fef>() && setup_kernel<0x0010>();
#endif
        if (!ok) { grid = -1; return; }
        grid = cus;
        if (grid < 64) { fprintf(stderr, "kernel_launch: needs >= 64 CUs\n"); grid = -1; return; }
    }
    if (grid < 0) return;
    Params p{};
    for (int i = 0; i < 34; ++i) p.in[i] = (const float*)d_in[i];
    p.out = (float*)d_out; p.ws = (unsigned char*)d_ws;
#if N_LAUNCH == 1
#ifndef PROBE_K
#define PROBE_K -1
#endif
#ifndef PROBE_BACK
#define PROBE_BACK 0
#endif
    if (PROBE_K >= 0) { launch_range<0xffff>(p, 0, PROBE_K + 1, grid, stream); launch_range<0xffff>(p, PROBE_K - PROBE_BACK, 16, grid, stream); }
    else launch_range<0xffff>(p, 0, 16, grid, stream);
#else
#ifndef DBG_HI
#define DBG_HI 14
#endif
    launch_range<0x3fef>(p, 0, DBG_HI < 4 ? DBG_HI : 4, grid, stream);
    if (DBG_HI > 4) launch_range<0x0010>(p, 4, 5, grid, stream);
    if (DBG_HI > 5) launch_range<0x3fef>(p, 5, DBG_HI, grid, stream);
#endif
}
```
